# Optimizing an MI355X kernel written in HIP

```python
import math
import jax, jax.numpy as jnp
from jax import lax
import numpy as np

D_MODEL = 2048
BATCH = 16
SEQ = 2048
DEPTH = 2

CHUNK = 64
Q_BLOCK = 128
NORM_EPS = 1e-6
D_FF = ((8 * D_MODEL // 3 + 127) // 128) * 128

RET_WIDTH = D_MODEL // 2
RET_HEADS = 4
RET_HEAD_DIM = RET_WIDTH // RET_HEADS
RET_THETA = 10000.0

SSM_WIDTH = D_MODEL - RET_WIDTH
SSM_GROUP = 16
SSM_GROUPS = SSM_WIDTH // SSM_GROUP
SSM_STATE = 64
DT_MIN = 1e-3
DT_MAX = 1e-1

DIFF_HEAD_DIM = 128
DIFF_HEADS = D_MODEL // (2 * DIFF_HEAD_DIM)
ROPE_THETA = 500000.0
ROPE_FRAC = 4

N_EVEN = (DEPTH + 1) // 2
N_ODD = DEPTH // 2

kernel_name = "chunk_causal_retention_s5_diffattn_macaron"


def rms_norm(x, g):
    xf = x.astype(jnp.float32)
    y = xf * lax.rsqrt(jnp.mean(xf * xf, axis=-1, keepdims=True) + NORM_EPS)
    return (y * g.astype(jnp.float32)).astype(x.dtype)


def head_rms(x):
    xf = x.astype(jnp.float32)
    return (xf * lax.rsqrt(jnp.mean(xf * xf, axis=-1, keepdims=True) + NORM_EPS)).astype(x.dtype)


def swiglu(x, w_gate, w_up, w_down):
    return (jax.nn.silu(x @ w_gate) * (x @ w_up)) @ w_down


def rope_tables(seq, rot_dim, theta):
    inv = 1.0 / (theta ** (jnp.arange(0, rot_dim, 2, dtype=jnp.float32) / rot_dim))
    ang = jnp.arange(seq, dtype=jnp.float32)[:, None] * inv[None, :]
    return jnp.cos(ang), jnp.sin(ang)


def apply_rotary(x, cos, sin):
    half = cos.shape[-1]
    c = cos[:, None, :].astype(x.dtype)
    s = sin[:, None, :].astype(x.dtype)
    x1 = x[..., :half]
    x2 = x[..., half:2 * half]
    return jnp.concatenate([x1 * c - x2 * s, x2 * c + x1 * s, x[..., 2 * half:]], axis=-1)


def retention(q, k, v):
    b, s, h, d = q.shape
    nc = s // CHUNK
    dt = q.dtype
    log_g = jnp.log(1.0 - 2.0 ** (-5.0 - jnp.arange(h, dtype=jnp.float32)))
    idx = jnp.arange(CHUNK, dtype=jnp.float32)
    intra_decay = jnp.exp(log_g[:, None, None] * jnp.abs(idx[:, None] - idx[None, :])).astype(dt)
    q_decay = jnp.exp(log_g[None, :] * (idx[:, None] + 1.0)).astype(dt)[None, :, :, None]
    k_decay = jnp.exp(log_g[None, :] * (CHUNK - 1.0 - idx[:, None])).astype(dt)[None, :, :, None]
    chunk_decay = jnp.exp(log_g * CHUNK).astype(dt)[None, :, None, None]
    k = k * (d ** -0.5)
    qc = q.reshape(b, nc, CHUNK, h, d)
    kc = k.reshape(b, nc, CHUNK, h, d)
    vc = v.reshape(b, nc, CHUNK, h, d)
    scores = jnp.einsum('bnihd,bnjhd->bnhij', qc, kc) * intra_decay
    intra = jnp.einsum('bnhij,bnjhd->bnihd', scores, vc)

    def step(state, xs):
        q_i, k_i, v_i = xs
        inter = jnp.einsum('bihd,bhde->bihe', q_i * q_decay, state)
        state = state * chunk_decay + jnp.einsum('bjhd,bjhe->bhde', k_i * k_decay, v_i)
        return state, inter

    xs = (jnp.moveaxis(qc, 1, 0), jnp.moveaxis(kc, 1, 0), jnp.moveaxis(vc, 1, 0))
    _, inter = lax.scan(step, jnp.zeros((b, h, d, d), dt), xs)
    out = intra + jnp.moveaxis(inter, 0, 1)
    return out.reshape(b, s, h, d)


def s5_block(u, lam_re, lam_im, log_step, b_re, b_im, c_re, c_im, d_skip, w_glu, b_glu):
    bsz, s, _ = u.shape
    dt = u.dtype
    ug = u.reshape(bsz, s, SSM_GROUPS, SSM_GROUP)
    f32 = jnp.float32
    step = jnp.exp(log_step.astype(f32))[:, None]
    lr = lam_re.astype(f32)
    li = lam_im.astype(f32)
    mag = jnp.exp(lr * step)
    a_re = mag * jnp.cos(li * step)
    a_im = mag * jnp.sin(li * step)
    den = lr * lr + li * li
    nr = a_re - 1.0
    f_re = (nr * lr + a_im * li) / den
    f_im = (a_im * lr - nr * li) / den
    br = b_re.astype(f32)
    bi = b_im.astype(f32)
    bb_re = (f_re[..., None] * br - f_im[..., None] * bi).astype(dt)
    bb_im = (f_re[..., None] * bi + f_im[..., None] * br).astype(dt)
    x_re = jnp.einsum('bsgp,gnp->bsgn', ug, bb_re)
    x_im = jnp.einsum('bsgp,gnp->bsgn', ug, bb_im)
    shape = (1, s, SSM_GROUPS, SSM_STATE)
    a_re_s = jnp.broadcast_to(a_re.astype(dt)[None, None], shape)
    a_im_s = jnp.broadcast_to(a_im.astype(dt)[None, None], shape)

    def combine(left, right):
        ar1, ai1, br1, bi1 = left
        ar2, ai2, br2, bi2 = right
        return (ar1 * ar2 - ai1 * ai2,
                ar1 * ai2 + ai1 * ar2,
                ar2 * br1 - ai2 * bi1 + br2,
                ar2 * bi1 + ai2 * br1 + bi2)

    _, _, h_re, h_im = lax.associative_scan(combine, (a_re_s, a_im_s, x_re, x_im), axis=1)
    y = (jnp.einsum('bsgn,gpn->bsgp', h_re, c_re) - jnp.einsum('bsgn,gpn->bsgp', h_im, c_im))
    y = y.reshape(bsz, s, SSM_WIDTH) + d_skip * u
    z = jax.nn.gelu(y)
    return z * jax.nn.sigmoid(z @ w_glu + b_glu)


def retention_s5_mixer(h, w_in, w_out, lam_re, lam_im, log_step, b_re, b_im, c_re, c_im,
                       d_skip, w_glu, b_glu, ret_cos, ret_sin):
    b, s, _ = h.shape
    proj = h @ w_in
    q, k, v, g, u = jnp.split(proj, [RET_WIDTH, 2 * RET_WIDTH, 3 * RET_WIDTH, 4 * RET_WIDTH], axis=-1)
    q = apply_rotary(q.reshape(b, s, RET_HEADS, RET_HEAD_DIM), ret_cos, ret_sin)
    k = apply_rotary(k.reshape(b, s, RET_HEADS, RET_HEAD_DIM), ret_cos, ret_sin)
    v = v.reshape(b, s, RET_HEADS, RET_HEAD_DIM)
    y_a = head_rms(retention(q, k, v)).reshape(b, s, RET_WIDTH) * jax.nn.silu(g)
    y_b = s5_block(u, lam_re, lam_im, log_step, b_re, b_im, c_re, c_im, d_skip, w_glu, b_glu)
    return jnp.concatenate([y_a, y_b], axis=-1) @ w_out


def diff_attention(h, w_qkv, w_out, lq1, lk1, lq2, lk2, subln, cos, sin, lambda_init):
    b, s, _ = h.shape
    q, k, v = jnp.split(h @ w_qkv, 3, axis=-1)
    q = apply_rotary(q.reshape(b, s, 2 * DIFF_HEADS, DIFF_HEAD_DIM), cos, sin)
    k = apply_rotary(k.reshape(b, s, 2 * DIFF_HEADS, DIFF_HEAD_DIM), cos, sin)
    q = q.reshape(b, s, DIFF_HEADS, 2, DIFF_HEAD_DIM)
    k = k.reshape(b, s, DIFF_HEADS, 2, DIFF_HEAD_DIM)
    v = v.reshape(b, s, DIFF_HEADS, 2 * DIFF_HEAD_DIM)
    f32 = jnp.float32
    lam = (jnp.exp(jnp.sum(lq1.astype(f32) * lk1.astype(f32)))
           - jnp.exp(jnp.sum(lq2.astype(f32) * lk2.astype(f32))) + lambda_init)
    scale = DIFF_HEAD_DIM ** -0.5
    neg = jnp.finfo(f32).min
    outs = []
    for blk in range(s // Q_BLOCK):
        q0 = blk * Q_BLOCK
        kv_end = q0 + Q_BLOCK
        qb = q[:, q0:kv_end]
        kb = k[:, :kv_end]
        vb = v[:, :kv_end]
        sc = jnp.einsum('bqhcd,bkhcd->bhcqk', qb, kb).astype(f32) * scale
        q_chunk = jnp.arange(q0, kv_end) // CHUNK
        k_chunk = jnp.arange(kv_end) // CHUNK
        sc = jnp.where(q_chunk[:, None] >= k_chunk[None, :], sc, neg)
        p = jax.nn.softmax(sc, axis=-1)
        attn = p[:, :, 0] - lam * p[:, :, 1]
        outs.append(jnp.einsum('bhqk,bkhe->bqhe', attn.astype(v.dtype), vb))
    o = jnp.concatenate(outs, axis=1)
    o = rms_norm(o, subln) * (1.0 - lambda_init)
    return o.reshape(b, s, D_MODEL) @ w_out


def setup_inputs(seed: int = 0) -> dict:
    key = jax.random.key(seed)
    ks = jax.random.split(key, 32)
    f32 = jnp.float32
    D = D_MODEL

    def nrm(k, shape, scale):
        return jax.random.normal(k, shape, f32) * scale

    n_idx = jnp.arange(SSM_STATE, dtype=f32)
    return {
        "x": jax.random.normal(ks[0], (BATCH, SEQ, D), f32),
        "ffn_norm": 1.0 + nrm(ks[1], (DEPTH, 2, D), 0.01),
        "ffn_w_gate": nrm(ks[2], (DEPTH, 2, D, D_FF), D ** -0.5),
        "ffn_w_up": nrm(ks[3], (DEPTH, 2, D, D_FF), D ** -0.5),
        "ffn_w_down": nrm(ks[4], (DEPTH, 2, D_FF, D), D_FF ** -0.5),
        "mix_norm": 1.0 + nrm(ks[5], (DEPTH, D), 0.01),
        "ab_w_in": nrm(ks[6], (N_EVEN, D, 4 * RET_WIDTH + SSM_WIDTH), D ** -0.5),
        "ab_w_out": nrm(ks[7], (N_EVEN, RET_WIDTH + SSM_WIDTH, D), (RET_WIDTH + SSM_WIDTH) ** -0.5),
        "ssm_lambda_re": -0.5 + nrm(ks[8], (N_EVEN, SSM_GROUPS, SSM_STATE), 0.01),
        "ssm_lambda_im": math.pi * n_idx + nrm(ks[9], (N_EVEN, SSM_GROUPS, SSM_STATE), 0.01),
        "ssm_log_step": jax.random.uniform(ks[10], (N_EVEN, SSM_GROUPS), f32,
                                           math.log(DT_MIN), math.log(DT_MAX)),
        "ssm_b_re": nrm(ks[11], (N_EVEN, SSM_GROUPS, SSM_STATE, SSM_GROUP), (2 * SSM_GROUP) ** -0.5),
        "ssm_b_im": nrm(ks[12], (N_EVEN, SSM_GROUPS, SSM_STATE, SSM_GROUP), (2 * SSM_GROUP) ** -0.5),
        "ssm_c_re": nrm(ks[13], (N_EVEN, SSM_GROUPS, SSM_GROUP, SSM_STATE), SSM_STATE ** -0.5),
        "ssm_c_im": nrm(ks[14], (N_EVEN, SSM_GROUPS, SSM_GROUP, SSM_STATE), SSM_STATE ** -0.5),
        "ssm_d": nrm(ks[15], (N_EVEN, SSM_WIDTH), 1.0),
        "ssm_w_glu": nrm(ks[16], (N_EVEN, SSM_WIDTH, SSM_WIDTH), SSM_WIDTH ** -0.5),
        "ssm_b_glu": nrm(ks[17], (N_EVEN, SSM_WIDTH), 0.01),
        "c_w_qkv": nrm(ks[18], (N_ODD, D, 3 * D), D ** -0.5),
        "c_w_out": nrm(ks[19], (N_ODD, D, D), D ** -0.5),
        "c_lambda_q1": nrm(ks[20], (N_ODD, DIFF_HEAD_DIM), 0.1),
        "c_lambda_k1": nrm(ks[21], (N_ODD, DIFF_HEAD_DIM), 0.1),
        "c_lambda_q2": nrm(ks[22], (N_ODD, DIFF_HEAD_DIM), 0.1),
        "c_lambda_k2": nrm(ks[23], (N_ODD, DIFF_HEAD_DIM), 0.1),
        "c_subln": 1.0 + nrm(ks[24], (N_ODD, 2 * DIFF_HEAD_DIM), 0.01),
        "final_norm": 1.0 + nrm(ks[25], (D,), 0.01),
    }


def reference(x, ffn_norm, ffn_w_gate, ffn_w_up, ffn_w_down, mix_norm, ab_w_in, ab_w_out,
              ssm_lambda_re, ssm_lambda_im, ssm_log_step, ssm_b_re, ssm_b_im, ssm_c_re, ssm_c_im,
              ssm_d, ssm_w_glu, ssm_b_glu, c_w_qkv, c_w_out, c_lambda_q1, c_lambda_k1,
              c_lambda_q2, c_lambda_k2, c_subln, final_norm):
    s = x.shape[1]
    ret_cos, ret_sin = rope_tables(s, RET_HEAD_DIM, RET_THETA)
    att_cos, att_sin = rope_tables(s, DIFF_HEAD_DIM // ROPE_FRAC, ROPE_THETA)
    h = x
    for layer in range(DEPTH):
        i = layer // 2
        h = h + 0.5 * swiglu(rms_norm(h, ffn_norm[layer, 0]), ffn_w_gate[layer, 0],
                             ffn_w_up[layer, 0], ffn_w_down[layer, 0])
        hn = rms_norm(h, mix_norm[layer])
        if layer % 2 == 0:
            mix = retention_s5_mixer(hn, ab_w_in[i], ab_w_out[i], ssm_lambda_re[i], ssm_lambda_im[i],
                                     ssm_log_step[i], ssm_b_re[i], ssm_b_im[i], ssm_c_re[i],
                                     ssm_c_im[i], ssm_d[i], ssm_w_glu[i], ssm_b_glu[i],
                                     ret_cos, ret_sin)
        else:
            lambda_init = 0.8 - 0.6 * math.exp(-0.3 * layer)
            mix = diff_attention(hn, c_w_qkv[i], c_w_out[i], c_lambda_q1[i], c_lambda_k1[i],
                                 c_lambda_q2[i], c_lambda_k2[i], c_subln[i], att_cos, att_sin,
                                 lambda_init)
        h = h + mix
        h = h + 0.5 * swiglu(rms_norm(h, ffn_norm[layer, 1]), ffn_w_gate[layer, 1],
                             ffn_w_up[layer, 1], ffn_w_down[layer, 1])
    return rms_norm(h, final_norm)
```

```cpp
#include <hip/hip_runtime.h>
#include <hip/hip_cooperative_groups.h>
#include <cstdio>
#include <cstdint>
namespace cg = cooperative_groups;

#define LAS __attribute__((address_space(3)))
typedef unsigned short bf16_t;
typedef short bf16x8 __attribute__((ext_vector_type(8)));
typedef short s16x4 __attribute__((ext_vector_type(4)));
typedef float f32x4 __attribute__((ext_vector_type(4)));
typedef float f32x16 __attribute__((ext_vector_type(16)));
typedef unsigned u32x4 __attribute__((ext_vector_type(4)));
typedef unsigned u32x2 __attribute__((ext_vector_type(2)));

#ifndef MK_PER_PHASE
#define MK_PER_PHASE 0
#endif

constexpr int TT = 32768, SEQ = 2048, DM = 2048, DFF = 5504, NGU = 2 * DFF;
constexpr int PW = 5120, QW = 6144;
constexpr float EPS = 1e-6f;
constexpr float LAMBDA_INIT = 0.35550906759f;
constexpr float QSCALE = 0.08838834764831845f * 1.4426950408889634f;

constexpr size_t MiB = 1u << 20;
constexpr size_t WS_CTL = 0;
constexpr size_t WS_RCOS = 1 * MiB, WS_RSIN = 2 * MiB, WS_ACOS = 3 * MiB, WS_ASIN = 3 * MiB + 128 * 1024, WS_S5A = 3 * MiB + 512 * 1024, WS_S5BB = 4 * MiB;
constexpr size_t WS_W = 8 * MiB;
constexpr size_t SZ_WGU = (size_t)NGU * DM * 2, SZ_WD = (size_t)DM * DFF * 2;
constexpr size_t WS_WGU = WS_W, WS_WD = WS_WGU + 4 * SZ_WGU, WS_WIN = WS_WD + 4 * SZ_WD, WS_WOUT = WS_WIN + (size_t)PW * DM * 2,
                 WS_WGLU = WS_WOUT + (size_t)DM * DM * 2, WS_WQKV = WS_WGLU + (size_t)1024 * 1024 * 2, WS_WCO = WS_WQKV + (size_t)QW * DM * 2,
                 WS_WEND = WS_WCO + (size_t)DM * DM * 2;
constexpr size_t WS_XN = 328 * MiB;
constexpr size_t WS_BIG = 456 * MiB;
constexpr size_t WS_Z = WS_BIG + (size_t)TT * PW * 2;
constexpr size_t WS_END = WS_BIG + (size_t)TT * QW * 2;
static_assert(WS_WEND <= WS_XN && WS_XN + (size_t)TT * DM * 2 <= WS_BIG && WS_Z + (size_t)TT * 1024 * 2 <= WS_END, "ws map");

constexpr int LDS_BYTES = 147456;

namespace pg8 {
constexpr int BM = 256, BK = 64, HALF = 128, HTB = HALF * BK * 2, STAGE_BYTES = 8 * HTB, NXCD = 8, WGM = 8;
__host__ __device__ __forceinline__ int lds_byte(int r, int c) { const int st = (r >> 4) * 2 + (c >> 5), rr = r & 15, cc = c & 31, ob = rr * 64 + cc * 2; return st * 1024 + (ob ^ (((ob >> 9) & 1) << 5)); }
__host__ __device__ __forceinline__ void stage_rc(int b, int& R, int& C) { const int st = b / 1024, sb = b % 1024, swz = sb ^ (((sb >> 9) & 1) << 5); R = (st >> 1) * 16 + swz / 64; C = (st & 1) * 32 + (swz % 64) / 2; }
__host__ __device__ __forceinline__ int perm32(int rho) { const int n = rho >> 4, i = rho & 15; return 8 * (i >> 2) + 4 * n + (i & 3); }
struct Unit { int pm, pn; };
struct Gemm { const bf16_t* A; const bf16_t* Bt; int M, N, K; };
struct StaticOrder {
    int nM, nN, nwg, G, c;
    __host__ __device__ void init(int M, int N, int G_, int c_) { nM = M / BM; nN = N / BM; nwg = nM * nN; G = G_; c = c_; }
    __host__ __device__ bool next(int i, Unit& u) const {
        const long L = (long)i * G + c; if (L >= nwg) return false;
        int wgid = (int)L; { const int q = nwg / NXCD, r = nwg % NXCD, xcd = wgid % NXCD, off = wgid / NXCD; wgid = (xcd < r ? xcd * (q + 1) : r * (q + 1) + (xcd - r) * q) + off; }
        const int nig = WGM * nN, gid = wgid / nig, fm = gid * WGM, gsz = (nM - fm) < WGM ? (nM - fm) : WGM;
        u.pm = fm + ((wgid % nig) % gsz); u.pn = (wgid % nig) / gsz; return true;
    }
    __device__ __forceinline__ void a_ready(const Unit&) const {}
    __device__ __forceinline__ void done(const Unit&) const {}
};
__device__ __forceinline__ unsigned cvt_pk_bf16(float lo, float hi) { unsigned r; asm volatile("v_cvt_pk_bf16_f32 %0, %1, %2" : "=v"(r) : "v"(lo), "v"(hi)); return r; }

template <class Epi, class Sched, bool ALIGN_EPI = false, bool SP2 = false>
__device__ __forceinline__ void gemm_phase(LAS unsigned char* lds, const Gemm g, const Sched& S, const Epi& E) {
    const int tid = threadIdx.x, wid = __builtin_amdgcn_readfirstlane(tid >> 6), lane = tid & 63, wr = wid >> 2, wc = wid & 3, fr = lane & 15, fq = lane >> 4;
    const int K = g.K, nt = K / BK;
    unsigned voffA[2], voffB[2];
#pragma unroll
    for (int i = 0; i < 2; ++i) { int R, C; stage_rc(tid * 16 + i * 8192, R, C); const int Rb = Epi::PERM ? ((R & ~31) + perm32(R & 31)) : R;
        voffA[i] = (unsigned)(R * K + C) * 2u; voffB[i] = (unsigned)(Rb * K + C) * 2u; }
    const size_t kstep = (size_t)(BK * 2);
    const size_t hstep = (size_t)HALF * K * 2;
    const size_t tstep = 2 * hstep;
    const unsigned ldsw = (unsigned)wid * 1024u;
    const int aoff = lds_byte(wr * 64 + fr, fq * 8), boff = lds_byte(wc * 32 + fr, fq * 8);
#define PG8_SA(b, h) (((b) * 2 + (h)) * HTB)
#define PG8_SB(b, h) ((4 + (b) * 2 + (h)) * HTB)
#define PG8_STAGE(bufoff, gbase, voff) do { _Pragma("unroll") for (int _i = 0; _i < 2; ++_i) \
        __builtin_amdgcn_global_load_lds((const unsigned*)((const char*)(gbase) + (voff)[_i]), (LAS unsigned*)(lds + (bufoff) + ldsw + _i * 8192), 16, 0, 0); } while (0)
#define PG8_LDA(dst, b, h) do { _Pragma("unroll") for (int m = 0; m < 4; ++m) _Pragma("unroll") for (int k = 0; k < 2; ++k) dst[m][k] = *(const LAS bf16x8*)(lds + PG8_SA(b, h) + aoff + m * 2048 + k * 1024); } while (0)
#define PG8_LDB(dst, b, h) do { _Pragma("unroll") for (int n = 0; n < 2; ++n) _Pragma("unroll") for (int k = 0; k < 2; ++k) dst[n][k] = *(const LAS bf16x8*)(lds + PG8_SB(b, h) + boff + n * 2048 + k * 1024); } while (0)
#define PG8_MMA(ai, bj, At, Bt) do { __builtin_amdgcn_s_setprio(1); _Pragma("unroll") for (int m = 0; m < 4; ++m) _Pragma("unroll") for (int n = 0; n < 2; ++n) _Pragma("unroll") for (int k = 0; k < 2; ++k) \
        acc[ai][bj][m][n] = __builtin_amdgcn_mfma_f32_16x16x32_bf16(Bt[n][k], At[m][k], acc[ai][bj][m][n], 0, 0, 0); __builtin_amdgcn_s_setprio(0); } while (0)
#define PG8_WAIT_V(n) asm volatile("s_waitcnt vmcnt(" #n ")" ::: "memory")
#define PG8_WAIT_L(n) asm volatile("s_waitcnt lgkmcnt(" #n ")" ::: "memory")
#define PG8_BAR __builtin_amdgcn_s_barrier()
#define PG8_SCHED __builtin_amdgcn_sched_barrier(0)
    Unit cur, nxt; int ui = 0;
    if (!S.next(0, cur)) return;
    f32x4 acc[2][2][4][2];
#pragma unroll
    for (int a = 0; a < 2; ++a)
#pragma unroll
        for (int b = 0; b < 2; ++b)
#pragma unroll
            for (int m = 0; m < 4; ++m)
#pragma unroll
                for (int n = 0; n < 2; ++n) acc[a][b][m][n] = (f32x4){0.f, 0.f, 0.f, 0.f};
    bf16x8 At[4][2], B0[2][2], B1[2][2];
    const char* cA = (const char*)g.A + (size_t)cur.pm * tstep; const char* cB = (const char*)g.Bt + (size_t)cur.pn * tstep;
    S.a_ready(cur);
    if constexpr (SP2) {
        PG8_STAGE(PG8_SB(0, 0), cB, voffB); PG8_STAGE(PG8_SB(0, 1), cB + hstep, voffB); PG8_STAGE(PG8_SA(0, 0), cA, voffA); PG8_STAGE(PG8_SA(0, 1), cA + hstep, voffA);
        if (wr == 1) PG8_BAR;
        PG8_WAIT_V(2); PG8_BAR;
        PG8_STAGE(PG8_SB(1, 0), cB + kstep, voffB); PG8_STAGE(PG8_SA(1, 0), cA + kstep, voffA); PG8_STAGE(PG8_SB(1, 1), cB + hstep + kstep, voffB);
        PG8_WAIT_V(6); PG8_BAR;
    } else {
        PG8_STAGE(PG8_SB(0, 0), cB, voffB); PG8_STAGE(PG8_SA(0, 0), cA, voffA); PG8_STAGE(PG8_SB(0, 1), cB + hstep, voffB); PG8_STAGE(PG8_SA(0, 1), cA + hstep, voffA);
        if (wr == 1) PG8_BAR;
        PG8_WAIT_V(4); PG8_BAR;
        PG8_STAGE(PG8_SB(1, 0), cB + kstep, voffB); PG8_STAGE(PG8_SA(1, 0), cA + kstep, voffA); PG8_STAGE(PG8_SB(1, 1), cB + hstep + kstep, voffB);
        PG8_WAIT_V(6); PG8_BAR;
    }
    for (;;) {
        const bool has_next = S.next(ui + 1, nxt);
        const char* nA = has_next ? (const char*)g.A + (size_t)nxt.pm * tstep : cA; const char* nB = has_next ? (const char*)g.Bt + (size_t)nxt.pn * tstep : cB;
        for (int t = 0; t < nt; t += 2) {
            const bool last = (t == nt - 2);
            const char* a1 = cA + (size_t)(t + 1) * kstep;
            const char* a2 = last ? nA : cA + (size_t)(t + 2) * kstep; const char* b2 = last ? nB : cB + (size_t)(t + 2) * kstep;
            const char* a3 = a2 + kstep; const char* b3 = b2 + kstep;
            if (last && has_next) S.a_ready(nxt);
            if constexpr (SP2) {
            PG8_LDB(B0, 0, 0); PG8_LDB(B1, 0, 1); PG8_SCHED; PG8_LDA(At, 0, 0); PG8_STAGE(PG8_SA(1, 1), a1 + hstep, voffA);
            PG8_WAIT_V(8); PG8_WAIT_L(0); PG8_BAR; PG8_MMA(0, 0, At, B0); PG8_MMA(0, 1, At, B1); PG8_BAR; PG8_SCHED;
            PG8_LDA(At, 0, 1); PG8_STAGE(PG8_SB(0, 0), b2, voffB); PG8_STAGE(PG8_SB(0, 1), b2 + hstep, voffB); PG8_STAGE(PG8_SA(0, 0), a2, voffA);
            PG8_WAIT_V(8); PG8_WAIT_L(0); PG8_BAR; PG8_MMA(1, 0, At, B0); PG8_MMA(1, 1, At, B1); PG8_BAR; PG8_SCHED;
            PG8_LDB(B0, 1, 0); PG8_LDB(B1, 1, 1); PG8_SCHED; PG8_LDA(At, 1, 0); PG8_STAGE(PG8_SA(0, 1), a2 + hstep, voffA);
            PG8_WAIT_V(8); PG8_WAIT_L(0); PG8_BAR; PG8_MMA(0, 0, At, B0); PG8_MMA(0, 1, At, B1); PG8_BAR; PG8_SCHED;
            PG8_LDA(At, 1, 1); PG8_STAGE(PG8_SB(1, 0), b3, voffB); PG8_STAGE(PG8_SB(1, 1), b3 + hstep, voffB); PG8_STAGE(PG8_SA(1, 0), a3, voffA);
            PG8_WAIT_V(8); PG8_WAIT_L(0); PG8_BAR; PG8_MMA(1, 0, At, B0); PG8_MMA(1, 1, At, B1); PG8_BAR; PG8_SCHED;
            } else {
            PG8_LDB(B0, 0, 0); PG8_SCHED; PG8_LDA(At, 0, 0); PG8_STAGE(PG8_SA(1, 1), a1 + hstep, voffA);
            PG8_WAIT_L(8); PG8_BAR; PG8_WAIT_L(0); PG8_MMA(0, 0, At, B0); PG8_BAR; PG8_SCHED;
            PG8_LDB(B1, 0, 1); PG8_STAGE(PG8_SB(0, 0), b2, voffB);
            PG8_BAR; PG8_WAIT_L(0); PG8_MMA(0, 1, At, B1); PG8_BAR;
            PG8_LDA(At, 0, 1); PG8_STAGE(PG8_SA(0, 0), a2, voffA);
            PG8_BAR; PG8_WAIT_L(0); PG8_MMA(1, 0, At, B0); PG8_BAR; PG8_SCHED;
            PG8_STAGE(PG8_SB(0, 1), b2 + hstep, voffB);
            PG8_WAIT_V(6); PG8_BAR; PG8_MMA(1, 1, At, B1); PG8_BAR;
            PG8_LDB(B0, 1, 0); PG8_SCHED; PG8_LDA(At, 1, 0); PG8_STAGE(PG8_SA(0, 1), a2 + hstep, voffA);
            PG8_WAIT_L(8); PG8_BAR; PG8_WAIT_L(0); PG8_MMA(0, 0, At, B0); PG8_BAR; PG8_SCHED;
            PG8_LDB(B1, 1, 1); PG8_STAGE(PG8_SB(1, 0), b3, voffB);
            PG8_BAR; PG8_WAIT_L(0); PG8_MMA(0, 1, At, B1); PG8_BAR;
            PG8_LDA(At, 1, 1); PG8_STAGE(PG8_SA(1, 0), a3, voffA);
            PG8_BAR; PG8_WAIT_L(0); PG8_MMA(1, 0, At, B0); PG8_BAR; PG8_SCHED;
            PG8_STAGE(PG8_SB(1, 1), b3 + hstep, voffB);
            PG8_WAIT_V(6); PG8_BAR; PG8_MMA(1, 1, At, B1); PG8_BAR;
            }
        }
        if constexpr (ALIGN_EPI) { if (wr == 0) PG8_BAR; }
        if constexpr (!Epi::AFTER_DRAIN) { E(acc, cur, wr, wc, fr, fq); S.done(cur); }
        if (!has_next) break;
#pragma unroll
        for (int a = 0; a < 2; ++a)
#pragma unroll
            for (int b = 0; b < 2; ++b)
#pragma unroll
                for (int m = 0; m < 4; ++m)
#pragma unroll
                    for (int n = 0; n < 2; ++n) acc[a][b][m][n] = (f32x4){0.f, 0.f, 0.f, 0.f};
        cur = nxt; cA = nA; cB = nB; ++ui;
        if constexpr (ALIGN_EPI) { if (wr == 1) PG8_BAR; }
    }
    PG8_WAIT_V(0);
    if constexpr (!ALIGN_EPI) { if (wr == 0) PG8_BAR; }
    PG8_BAR;
#undef PG8_SA
#undef PG8_SB
#undef PG8_STAGE
#undef PG8_LDA
#undef PG8_LDB
#undef PG8_MMA
#undef PG8_WAIT_V
#undef PG8_WAIT_L
#undef PG8_BAR
#undef PG8_SCHED
}
}

__device__ __forceinline__ unsigned f2bf(float f) { unsigned u = __builtin_bit_cast(unsigned, f); return (u + 0x7fffu + ((u >> 16) & 1u)) >> 16; }
__device__ __forceinline__ unsigned pk2(float lo, float hi) { return f2bf(lo) | (f2bf(hi) << 16); }
__device__ __forceinline__ float bf2f(unsigned short b) { return __builtin_bit_cast(float, (unsigned)b << 16); }
__device__ __forceinline__ float bflo(unsigned w) { return __builtin_bit_cast(float, w << 16); }
__device__ __forceinline__ float bfhi(unsigned w) { return __builtin_bit_cast(float, w & 0xffff0000u); }
__device__ __forceinline__ float fast_sigmoid(float x) { return __builtin_amdgcn_rcpf(1.0f + __builtin_amdgcn_exp2f(-1.4426950408889634f * x)); }
__device__ __forceinline__ float silu_f(float x) { return x * fast_sigmoid(x); }
__device__ __forceinline__ float gelu_tanh_f(float y) { return y * fast_sigmoid(1.5957691216057308f * (y + 0.044715f * y * y * y)); }
__device__ __forceinline__ float wave_sum(float v) {
#pragma unroll
    for (int o = 1; o < 64; o <<= 1) v += __shfl_xor(v, o);
    return v;
}
__device__ __forceinline__ void sincos_d(double a, double& s, double& c) {
    const double k = rint(a * 0.15915494309189535);
    const double r = fma(-k, 6.283185307179586, a), r2 = r * r;
    double ts = r, tc = 1.0; s = r; c = 1.0;
    for (int n = 1; n <= 13; ++n) { tc *= -r2 / (double)((2 * n - 1) * (2 * n)); c += tc; ts *= -r2 / (double)((2 * n) * (2 * n + 1)); s += ts; }
}

using pg8::Unit; using pg8::cvt_pk_bf16;
struct EpiSwiglu {
    static constexpr bool PERM = true, AFTER_DRAIN = false;
    bf16_t* O; int ldo;
    __device__ __forceinline__ void operator()(const f32x4 (&acc)[2][2][4][2], const Unit& u, int wr, int wc, int fr, int fq) const {
        const int row0 = u.pm * 256 + wr * 64 + fr, col0 = u.pn * 128 + wc * 32 + 8 * fq;
#pragma unroll
        for (int ai = 0; ai < 2; ++ai)
#pragma unroll
            for (int m = 0; m < 4; ++m) {
                bf16_t* rowp = O + (size_t)(row0 + ai * 128 + m * 16) * ldo + col0;
                const f32x4 g0 = acc[ai][0][m][0], g1 = acc[ai][0][m][1], u0 = acc[ai][1][m][0], u1 = acc[ai][1][m][1];
                u32x4 w;
                w.x = cvt_pk_bf16(silu_f(g0[0]) * u0[0], silu_f(g0[1]) * u0[1]); w.y = cvt_pk_bf16(silu_f(g0[2]) * u0[2], silu_f(g0[3]) * u0[3]);
                w.z = cvt_pk_bf16(silu_f(g1[0]) * u1[0], silu_f(g1[1]) * u1[1]); w.w = cvt_pk_bf16(silu_f(g1[2]) * u1[2], silu_f(g1[3]) * u1[3]);
                *(u32x4*)rowp = w;
            }
    }
};
struct EpiResid {
    static constexpr bool PERM = false, AFTER_DRAIN = false;
    const float* base; float* out; int ldc; float scale;
    __device__ __forceinline__ void operator()(const f32x4 (&acc)[2][2][4][2], const Unit& u, int wr, int wc, int fr, int fq) const {
        const int col0 = u.pn * 256 + wc * 32 + 4 * fq;
#pragma unroll
        for (int ai = 0; ai < 2; ++ai)
#pragma unroll
            for (int m = 0; m < 4; ++m) {
                const size_t off = (size_t)(u.pm * 256 + ai * 128 + wr * 64 + m * 16 + fr) * ldc + col0;
#pragma unroll
                for (int bj = 0; bj < 2; ++bj)
#pragma unroll
                    for (int n = 0; n < 2; ++n) { const f32x4 b = *(const f32x4*)(base + off + bj * 128 + n * 16); *(f32x4*)(out + off + bj * 128 + n * 16) = b + acc[ai][bj][m][n] * scale; }
            }
    }
};
struct EpiWin {
    static constexpr bool PERM = true, AFTER_DRAIN = false;
    bf16_t* O; const float* cs; const float* sn;
    __device__ __forceinline__ void operator()(const f32x4 (&acc)[2][2][4][2], const Unit& u, int wr, int wc, int fr, int fq) const {
        const int row0 = u.pm * 256 + wr * 64 + fr, col0 = u.pn * 256 + wc * 32 + 8 * fq;
        const bool rot = u.pn < 8;
#pragma unroll
        for (int ai = 0; ai < 2; ++ai)
#pragma unroll
            for (int m = 0; m < 4; ++m) {
                const int row = row0 + ai * 128 + m * 16;
                f32x4 a0 = acc[ai][0][m][0], a1 = acc[ai][0][m][1], b0 = acc[ai][1][m][0], b1 = acc[ai][1][m][1];
                if (rot) {
                    const int pos = row & (SEQ - 1);
                    const float* cp = cs + pos * 128 + wc * 32 + 8 * fq; const float* sp = sn + pos * 128 + wc * 32 + 8 * fq;
                    const f32x4 c0 = *(const f32x4*)cp, c1 = *(const f32x4*)(cp + 4), s0 = *(const f32x4*)sp, s1 = *(const f32x4*)(sp + 4);
                    const f32x4 na0 = a0 * c0 - b0 * s0, nb0 = b0 * c0 + a0 * s0, na1 = a1 * c1 - b1 * s1, nb1 = b1 * c1 + a1 * s1;
                    a0 = na0; b0 = nb0; a1 = na1; b1 = nb1;
                }
                bf16_t* rowp = O + (size_t)row * PW + col0;
                u32x4 w; w.x = cvt_pk_bf16(a0[0], a0[1]); w.y = cvt_pk_bf16(a0[2], a0[3]); w.z = cvt_pk_bf16(a1[0], a1[1]); w.w = cvt_pk_bf16(a1[2], a1[3]);
                *(u32x4*)rowp = w;
                u32x4 v; v.x = cvt_pk_bf16(b0[0], b0[1]); v.y = cvt_pk_bf16(b0[2], b0[3]); v.z = cvt_pk_bf16(b1[0], b1[1]); v.w = cvt_pk_bf16(b1[2], b1[3]);
                *(u32x4*)(rowp + 128) = v;
            }
    }
};
struct EpiQkv {
    static constexpr bool PERM = false, AFTER_DRAIN = false;
    bf16_t* O; const float* cs; const float* sn;
    __device__ __forceinline__ void operator()(const f32x4 (&acc)[2][2][4][2], const Unit& u, int wr, int wc, int fr, int fq) const {
        const int col0 = u.pn * 256 + wc * 32 + 4 * fq;
        const bool rot = (u.pn < 16) && (wc == 0);
        const float sc = (u.pn < 8) ? QSCALE : 1.0f;
#pragma unroll
        for (int ai = 0; ai < 2; ++ai)
#pragma unroll
            for (int m = 0; m < 4; ++m) {
                const int row = u.pm * 256 + ai * 128 + wr * 64 + m * 16 + fr;
                f32x4 c = (f32x4){1.f, 1.f, 1.f, 1.f}, s = (f32x4){0.f, 0.f, 0.f, 0.f};
                if (rot) { const int pos = row & (SEQ - 1); c = *(const f32x4*)(cs + pos * 16 + 4 * fq); s = *(const f32x4*)(sn + pos * 16 + 4 * fq); }
#pragma unroll
                for (int bj = 0; bj < 2; ++bj) {
                    const f32x4 x0 = acc[ai][bj][m][0], x1 = acc[ai][bj][m][1];
                    const f32x4 n0 = (x0 * c - x1 * s) * sc, n1 = (x1 * c + x0 * s) * sc;
                    bf16_t* p = O + (size_t)row * QW + col0 + bj * 128;
                    u32x2 w0; w0.x = cvt_pk_bf16(n0[0], n0[1]); w0.y = cvt_pk_bf16(n0[2], n0[3]); *(u32x2*)p = w0;
                    u32x2 w1; w1.x = cvt_pk_bf16(n1[0], n1[1]); w1.y = cvt_pk_bf16(n1[2], n1[3]); *(u32x2*)(p + 16) = w1;
                }
            }
    }
};
struct EpiGlu {
    static constexpr bool PERM = true, AFTER_DRAIN = false;
    const bf16_t* Z; const float* bias; bf16_t* Y;
    __device__ __forceinline__ void operator()(const f32x4 (&acc)[2][2][4][2], const Unit& u, int wr, int wc, int fr, int fq) const {
        const int row0 = u.pm * 256 + wr * 64 + fr, col0 = u.pn * 256 + wc * 32 + 8 * fq;
#pragma unroll
        for (int bj = 0; bj < 2; ++bj) {
            const f32x4 bv0 = *(const f32x4*)(bias + col0 + bj * 128), bv1 = *(const f32x4*)(bias + col0 + bj * 128 + 4);
#pragma unroll
            for (int ai = 0; ai < 2; ++ai)
#pragma unroll
                for (int m = 0; m < 4; ++m) {
                    const int row = row0 + ai * 128 + m * 16;
                    const u32x4 zz = *(const u32x4*)(Z + (size_t)row * 1024 + col0 + bj * 128);
                    const f32x4 v0 = acc[ai][bj][m][0] + bv0, v1 = acc[ai][bj][m][1] + bv1;
                    u32x4 w;
                    w.x = cvt_pk_bf16(bflo(zz.x) * fast_sigmoid(v0[0]), bfhi(zz.x) * fast_sigmoid(v0[1]));
                    w.y = cvt_pk_bf16(bflo(zz.y) * fast_sigmoid(v0[2]), bfhi(zz.y) * fast_sigmoid(v0[3]));
                    w.z = cvt_pk_bf16(bflo(zz.z) * fast_sigmoid(v1[0]), bfhi(zz.z) * fast_sigmoid(v1[1]));
                    w.w = cvt_pk_bf16(bflo(zz.w) * fast_sigmoid(v1[2]), bfhi(zz.w) * fast_sigmoid(v1[3]));
                    *(u32x4*)(Y + (size_t)row * DM + 1024 + col0 + bj * 128) = w;
                }
        }
    }
};

template <class Epi>
__device__ __forceinline__ void run_gemm(LAS unsigned char* lds, const bf16_t* A, const bf16_t* Bt, int M, int N, int K, const Epi& E) {
    pg8::Gemm g{A, Bt, M, N, K}; pg8::StaticOrder S; S.init(M, N, (int)gridDim.x, (int)blockIdx.x);
    pg8::gemm_phase<Epi, pg8::StaticOrder, true, true>(lds, g, S, E);
}

__device__ __forceinline__ void conv_matrix(const float* __restrict__ W, bf16_t* __restrict__ WT, int K, int N, int mode, LAS float* scr, int gw, int NGW, int lane) {
    const int nblk = N / 32, nitems = (K / 64) * nblk;
    for (int item = gw; item < nitems; item += NGW) {
        const int kb = item / nblk, nb = item % nblk, k0 = 64 * kb, n0 = 32 * nb;
#pragma unroll 8
        for (int i = 0; i < 32; ++i) { const int kk = 2 * i + (lane >> 5); scr[kk * 33 + (lane & 31)] = W[(size_t)(k0 + kk) * N + n0 + (lane & 31)]; }
        asm volatile("s_waitcnt lgkmcnt(0)" ::: "memory");
        const int c = lane & 7;
        const int rbase = (mode == 0) ? n0 : ((n0 >> 7) * 256 + (n0 & 127) + (mode == 2 ? 128 : 0));
#pragma unroll
        for (int j = 0; j < 4; ++j) { const int n = (lane >> 3) + 8 * j; const LAS float* s = scr + (8 * c) * 33 + n;
            u32x4 o; o.x = pk2(s[0 * 33], s[1 * 33]); o.y = pk2(s[2 * 33], s[3 * 33]); o.z = pk2(s[4 * 33], s[5 * 33]); o.w = pk2(s[6 * 33], s[7 * 33]);
            *(u32x4*)(WT + (size_t)(rbase + n) * K + k0 + 8 * c) = o; }
        asm volatile("s_waitcnt lgkmcnt(0)" ::: "memory");
    }
}

template <bool TO_BF16>
__device__ __forceinline__ void rmsnorm_phase(const float* in, const float* __restrict__ g, bf16_t* outb, float* outf, int gw, int NGW, int lane) {
    f32x4 gv[8];
#pragma unroll
    for (int j = 0; j < 8; ++j) gv[j] = ((const f32x4*)g)[lane + 64 * j];
    for (int row = gw; row < TT; row += NGW) {
        const f32x4* xr = (const f32x4*)(in + (size_t)row * DM) + lane;
        f32x4 v[8]; float ss = 0.f;
#pragma unroll
        for (int j = 0; j < 8; ++j) { v[j] = xr[64 * j]; ss += (v[j][0] * v[j][0] + v[j][1] * v[j][1]) + (v[j][2] * v[j][2] + v[j][3] * v[j][3]); }
        const float rs = 1.0f / sqrtf(wave_sum(ss) * (1.0f / DM) + EPS);
#pragma unroll
        for (int j = 0; j < 8; ++j) {
            const f32x4 y = v[j] * rs * gv[j];
            if constexpr (TO_BF16) { u32x2 w; w.x = pk2(y[0], y[1]); w.y = pk2(y[2], y[3]); *((u32x2*)(outb + (size_t)row * DM) + lane + 64 * j) = w; }
            else { *((f32x4*)(outf + (size_t)row * DM) + lane + 64 * j) = y; }
        }
    }
}

__device__ __forceinline__ void tables_phase(unsigned char* ws, const float* const* in_unused, const float* lam_re, const float* lam_im, const float* log_step, const float* b_re, const float* b_im,
                                             const float* lq1, const float* lk1, const float* lq2, const float* lk2, int gtid, int NT_) {
    float* rcos = (float*)(ws + WS_RCOS); float* rsin = (float*)(ws + WS_RSIN); float* acos_ = (float*)(ws + WS_ACOS); float* asin_ = (float*)(ws + WS_ASIN);
    float* s5a = (float*)(ws + WS_S5A); float* s5bb = (float*)(ws + WS_S5BB);
    for (int i = gtid; i < SEQ * 128; i += NT_) {
        const int pos = i >> 7, f = i & 127;
        const float inv = (float)exp2(-((double)(2 * f) / 256.0) * 13.287712379549449);
        const float ang = (float)pos * inv; double s, c; sincos_d((double)ang, s, c); rcos[i] = (float)c; rsin[i] = (float)s;
    }
    for (int i = gtid; i < SEQ * 16; i += NT_) {
        const int pos = i >> 4, f = i & 15;
        const float inv = (float)exp2(-((double)(2 * f) / 32.0) * 18.931568569324174);
        const float ang = (float)pos * inv; double s, c; sincos_d((double)ang, s, c); acos_[i] = (float)c; asin_[i] = (float)s;
    }
    for (int i = gtid; i < 64 * 64; i += NT_) {
        const int g = i >> 6;
        const double step = exp((double)log_step[g]), lr = (double)lam_re[i], li = (double)lam_im[i];
        const double mag = exp(lr * step); double s, c; sincos_d(li * step, s, c);
        const double are = mag * c, aim = mag * s, den = lr * lr + li * li, nr = are - 1.0;
        const double fre = (nr * lr + aim * li) / den, fim = (aim * lr - nr * li) / den;
        s5a[2 * i] = (float)are; s5a[2 * i + 1] = (float)aim;
        for (int p = 0; p < 16; ++p) { const double br = (double)b_re[i * 16 + p], bi = (double)b_im[i * 16 + p];
            s5bb[(size_t)i * 32 + p] = (float)(fre * br - fim * bi); s5bb[(size_t)i * 32 + 16 + p] = (float)(fre * bi + fim * br); }
    }
    if (gtid == 0) { float s1 = 0.f, s2 = 0.f; for (int i = 0; i < 128; ++i) { s1 += lq1[i] * lk1[i]; s2 += lq2[i] * lk2[i]; }
        ((float*)(ws + WS_CTL))[0] = expf(s1) - expf(s2) + LAMBDA_INIT; }
}

__device__ __forceinline__ void s5_phase(LAS unsigned char* lds, const unsigned char* ws, const bf16_t* proj, const float* c_re, const float* c_im, const float* dskip, bf16_t* z,
                                         int vcu, int G, int wave, int lane) {
    if (wave >= 4) return;
    const float* s5a = (const float*)(ws + WS_S5A); const float* s5bb = (const float*)(ws + WS_S5BB);
    LAS bf16_t* Hc = (LAS bf16_t*)(lds + wave * 8704);
    const int fr = lane & 15, fq = lane >> 4;
    for (int seq = vcu * 4 + wave; seq < 1024; seq += G * 4) {
        const int b = seq >> 6, g = seq & 63, n = lane;
        float bbre[16], bbim[16];
#pragma unroll
        for (int p = 0; p < 16; ++p) { bbre[p] = s5bb[(size_t)(g * 64 + n) * 32 + p]; bbim[p] = s5bb[(size_t)(g * 64 + n) * 32 + 16 + p]; }
        const float are = s5a[2 * (g * 64 + n)], aim = s5a[2 * (g * 64 + n) + 1];
        bf16x8 cf[4];
#pragma unroll
        for (int ks = 0; ks < 4; ++ks) { u32x4 w; unsigned* wp = (unsigned*)&w;
#pragma unroll
            for (int j2 = 0; j2 < 4; ++j2) { float v[2];
#pragma unroll
                for (int e = 0; e < 2; ++e) { const int k = 32 * ks + 8 * fq + 2 * j2 + e; v[e] = (k < 64) ? c_re[(size_t)(g * 16 + fr) * 64 + k] : -c_im[(size_t)(g * 16 + fr) * 64 + (k - 64)]; }
                wp[j2] = pk2(v[0], v[1]); }
            cf[ks] = __builtin_bit_cast(bf16x8, w); }
        const float dsk = dskip[g * 16 + fr];
        float hre = 0.f, him = 0.f;
        for (int ch = 0; ch < SEQ / 32; ++ch) {
            const size_t row0 = (size_t)b * SEQ + ch * 32;
            const bf16_t* up = proj + (row0 + (lane & 31)) * PW + 4096 + g * 16;
            const u32x4 ua = *(const u32x4*)up, ub = *(const u32x4*)(up + 8);
            float uf[16];
            uf[0] = bflo(ua.x); uf[1] = bfhi(ua.x); uf[2] = bflo(ua.y); uf[3] = bfhi(ua.y); uf[4] = bflo(ua.z); uf[5] = bfhi(ua.z); uf[6] = bflo(ua.w); uf[7] = bfhi(ua.w);
            uf[8] = bflo(ub.x); uf[9] = bfhi(ub.x); uf[10] = bflo(ub.y); uf[11] = bfhi(ub.y); uf[12] = bflo(ub.z); uf[13] = bfhi(ub.z); uf[14] = bflo(ub.w); uf[15] = bfhi(ub.w);
#pragma unroll
            for (int k = 0; k < 32; ++k) {
                float xr = 0.f, xi = 0.f;
#pragma unroll
                for (int p = 0; p < 16; ++p) { const float su = __builtin_bit_cast(float, __builtin_amdgcn_readlane(__builtin_bit_cast(int, uf[p]), k)); xr = fmaf(su, bbre[p], xr); xi = fmaf(su, bbim[p], xi); }
                const float nr = are * hre - aim * him + xr, ni = are * him + aim * hre + xi; hre = nr; him = ni;
                Hc[k * 136 + n] = (bf16_t)f2bf(hre); Hc[k * 136 + 64 + n] = (bf16_t)f2bf(him);
            }
#pragma unroll
            for (int sb = 0; sb < 2; ++sb) {
                f32x4 y = (f32x4){0.f, 0.f, 0.f, 0.f};
#pragma unroll
                for (int ks = 0; ks < 4; ++ks) { const bf16x8 hf = *(const LAS bf16x8*)(Hc + (16 * sb + fr) * 136 + 32 * ks + 8 * fq); y = __builtin_amdgcn_mfma_f32_16x16x32_bf16(hf, cf[ks], y, 0, 0, 0); }
#pragma unroll
                for (int i = 0; i < 4; ++i) { const size_t row = row0 + 16 * sb + 4 * fq + i;
                    const float uu = bf2f(proj[row * PW + 4096 + g * 16 + fr]); const float yy = y[i] + dsk * uu;
                    z[row * 1024 + g * 16 + fr] = (bf16_t)f2bf(gelu_tanh_f(yy)); }
            }
        }
    }
}

#define MF32(a, b, c) __builtin_amdgcn_mfma_f32_32x32x16_bf16((a), (b), (c), 0, 0, 0)
#define AT_WAITV(n) asm volatile("s_waitcnt vmcnt(" #n ")" ::: "memory")
#define AT_BAR() asm volatile("s_waitcnt lgkmcnt(0)\n\ts_barrier" ::: "memory")
__device__ __forceinline__ s16x4 vtr(const LAS unsigned char* p) { typedef short v4i16_t __attribute__((ext_vector_type(4))); return __builtin_bit_cast(s16x4, __builtin_amdgcn_ds_read_tr16_b64_v4i16((LAS v4i16_t*)p)); }
__device__ __forceinline__ int crow(int i, int h) { return (i & 3) + 8 * (i >> 2) + 4 * h; }

template <int MODE>
__device__ __forceinline__ void attn_unit(LAS unsigned char* lds, const bf16_t* src, const int pitch, const int kcol, const int vcol, const int b, const int h, const int ub,
                                          bf16_t* outp, const bf16_t* gsrc, const float* subln, const float lam) {
    constexpr int NKS = MODE ? 8 : 16, NDB = 4, ROWS = MODE ? 64 : 128;
    const int tid = threadIdx.x, lane = tid & 63, r = lane & 31, hh = lane >> 5;
    const int wid = __builtin_amdgcn_readfirstlane(tid >> 6);
    const int rg = MODE ? (wid & 1) : (wid & 3), vh = MODE ? ((wid >> 1) & 1) : (wid >> 2), cc = MODE ? (wid >> 2) : 0;
    const size_t rowbase = (size_t)b * SEQ; const int q0 = ub * ROWS, NT = MODE ? (ub + 1) : (2 * ub + 2);
    const int qrow = q0 + rg * 32 + r;
    AT_WAITV(0);
#define AT_ISSUE(t, buf) do { const bf16_t* gk_ = src + (rowbase + (size_t)(t) * 64) * pitch; \
        _Pragma("unroll") for (int i_ = 0; i_ < 4; ++i_) { const int c_ = wid * 4 + i_; const int row_ = c_ * 2 + hh; \
            const bf16_t* pk_ = gk_ + (size_t)row_ * pitch + kcol + ((r ^ (row_ & 15)) << 3); \
            __builtin_amdgcn_global_load_lds((const unsigned*)pk_, (LAS unsigned*)(lds + (buf) * 65536 + c_ * 1024), 16, 0, 0); \
            const bf16_t* pv_ = gk_ + (size_t)row_ * pitch + vcol + ((r ^ ((row_ & 3) << 2)) << 3); \
            __builtin_amdgcn_global_load_lds((const unsigned*)pv_, (LAS unsigned*)(lds + (buf) * 65536 + 32768 + c_ * 1024), 16, 0, 0); } } while (0)
    AT_ISSUE(0, 0);
    bf16x8 qf[NKS];
    { const bf16_t* qp = src + (rowbase + qrow) * pitch + h * 256 + cc * 128 + 8 * hh;
#pragma unroll
      for (int d0 = 0; d0 < NKS; ++d0) qf[d0] = *(const bf16x8*)(qp + 16 * d0); }
    f32x16 O[NDB];
#pragma unroll
    for (int db = 0; db < NDB; ++db)
#pragma unroll
        for (int i = 0; i < 16; ++i) O[db][i] = 0.f;
    float mrun = -1e30f, lrun = 0.f;
    const float lgam = __builtin_log2f(1.0f - __builtin_amdgcn_exp2f(-5.0f - (float)h));
    const int r15 = r & 15;
    const int kunit0 = cc * 16;
    const int q4 = (lane & 15) >> 2, p4 = lane & 3, blk16 = (lane >> 4) & 1;
    const int vlane = (4 * hh + q4) * 512 + ((2 * blk16 + (p4 >> 1)) << 4) + 8 * (p4 & 1);
    for (int t = 0; t < NT; ++t) {
        if (t + 1 < NT) { AT_ISSUE(t + 1, (t + 1) & 1); AT_WAITV(8); } else { AT_WAITV(0); }
        AT_BAR();
        const bool active = MODE ? true : !(t == NT - 1 && rg < 2);
        if (active) {
            const LAS unsigned char* Kb = lds + (t & 1) * 65536; const LAS unsigned char* Vb = Kb + 32768;
            int r15v = r15, q4v = q4 << 2; asm volatile("" : "+v"(r15v), "+v"(q4v));
            bf16x8 pf[4];
            if constexpr (MODE) {
                f32x16 p0, p1;
#pragma unroll
                for (int i = 0; i < 16; ++i) { p0[i] = 0.f; p1[i] = 0.f; }
                { const LAS unsigned char* kr0 = Kb + r * 512; const LAS unsigned char* kr1 = Kb + (32 + r) * 512;
#pragma unroll
                  for (int d0 = 0; d0 < NKS; ++d0) { const int uo = ((kunit0 + 2 * d0 + hh) ^ r15v) << 4;
                      const bf16x8 k0 = *(const LAS bf16x8*)(kr0 + uo); const bf16x8 k1 = *(const LAS bf16x8*)(kr1 + uo);
                      p0 = MF32(k0, qf[d0], p0); p1 = MF32(k1, qf[d0], p1);
                      if ((d0 & 3) == 3) __builtin_amdgcn_sched_barrier(0); } }
                float rm = p0[0];
#pragma unroll
                for (int i = 0; i < 16; ++i) { rm = fmaxf(rm, p0[i]); rm = fmaxf(rm, p1[i]); }
                rm = fmaxf(rm, __shfl_xor(rm, 32));
                if (__any(rm > mrun + 8.0f)) {
                    const float mn = fmaxf(mrun, rm); const float al = __builtin_amdgcn_exp2f(mrun - mn); lrun *= al; mrun = mn;
#pragma unroll
                    for (int db = 0; db < NDB; ++db) O[db] = O[db] * al;
                }
                float sum = 0.f;
#pragma unroll
                for (int i = 0; i < 16; ++i) { p0[i] = __builtin_amdgcn_exp2f(p0[i] - mrun); p1[i] = __builtin_amdgcn_exp2f(p1[i] - mrun); sum += p0[i] + p1[i]; }
                lrun += sum;
                u32x4 w;
                w.x = cvt_pk_bf16(p0[0], p0[1]); w.y = cvt_pk_bf16(p0[2], p0[3]); w.z = cvt_pk_bf16(p0[4], p0[5]); w.w = cvt_pk_bf16(p0[6], p0[7]); pf[0] = __builtin_bit_cast(bf16x8, w);
                w.x = cvt_pk_bf16(p0[8], p0[9]); w.y = cvt_pk_bf16(p0[10], p0[11]); w.z = cvt_pk_bf16(p0[12], p0[13]); w.w = cvt_pk_bf16(p0[14], p0[15]); pf[1] = __builtin_bit_cast(bf16x8, w);
                w.x = cvt_pk_bf16(p1[0], p1[1]); w.y = cvt_pk_bf16(p1[2], p1[3]); w.z = cvt_pk_bf16(p1[4], p1[5]); w.w = cvt_pk_bf16(p1[6], p1[7]); pf[2] = __builtin_bit_cast(bf16x8, w);
                w.x = cvt_pk_bf16(p1[8], p1[9]); w.y = cvt_pk_bf16(p1[10], p1[11]); w.z = cvt_pk_bf16(p1[12], p1[13]); w.w = cvt_pk_bf16(p1[14], p1[15]); pf[3] = __builtin_bit_cast(bf16x8, w);
            } else {
#pragma unroll
                for (int blk = 0; blk < 2; ++blk) {
                    f32x16 p;
#pragma unroll
                    for (int i = 0; i < 16; ++i) p[i] = 0.f;
                    const LAS unsigned char* kr = Kb + (32 * blk + r) * 512;
#pragma unroll
                    for (int d0 = 0; d0 < NKS; ++d0) { const int uo = ((2 * d0 + hh) ^ r15v) << 4;
                        const bf16x8 k0 = *(const LAS bf16x8*)(kr + uo); p = MF32(k0, qf[d0], p);
                        if ((d0 & 3) == 3) __builtin_amdgcn_sched_barrier(0); }
                    const int kb = t * 64 + 32 * blk + 4 * hh;
#pragma unroll
                    for (int i = 0; i < 16; ++i) { const int kv = kb + (i & 3) + 8 * (i >> 2);
                        p[i] *= __builtin_amdgcn_exp2f(lgam * fabsf((float)(qrow - kv)) - 4.0f); }
                    u32x4 w;
                    w.x = cvt_pk_bf16(p[0], p[1]); w.y = cvt_pk_bf16(p[2], p[3]); w.z = cvt_pk_bf16(p[4], p[5]); w.w = cvt_pk_bf16(p[6], p[7]); pf[2 * blk] = __builtin_bit_cast(bf16x8, w);
                    w.x = cvt_pk_bf16(p[8], p[9]); w.y = cvt_pk_bf16(p[10], p[11]); w.z = cvt_pk_bf16(p[12], p[13]); w.w = cvt_pk_bf16(p[14], p[15]); pf[2 * blk + 1] = __builtin_bit_cast(bf16x8, w);
                    __builtin_amdgcn_sched_barrier(0);
                }
            }
            const LAS unsigned char* vb = Vb + vlane;
            __builtin_amdgcn_sched_barrier(0);
#pragma unroll
            for (int db = 0; db < NDB; ++db) {
                const int dunit = vh * 16 + 4 * db;
                const LAS unsigned char* vp = vb + ((dunit ^ q4v) << 4);
#pragma unroll
                for (int ks = 0; ks < 4; ++ks) {
                    const int kvb = 32 * (ks >> 1) + 16 * (ks & 1);
                    const s16x4 lo = vtr(vp + kvb * 512), hi = vtr(vp + (kvb + 8) * 512);
                    const bf16x8 vf = __builtin_shufflevector(lo, hi, 0, 1, 2, 3, 4, 5, 6, 7);
                    O[db] = MF32(vf, pf[ks], O[db]);
                }
                __builtin_amdgcn_sched_barrier(0);
            }
        }
        AT_BAR();
    }
    const size_t orow = rowbase + qrow;
    LAS float* SS = (LAS float*)(lds + 131072);
    if constexpr (MODE) {
        const float l = lrun + __shfl_xor(lrun, 32); const float inv = 1.0f / l;
        LAS float* X = (LAS float*)(lds + (wid & 3) * 16384);
        if (cc == 1) {
#pragma unroll
            for (int db = 0; db < NDB; ++db)
#pragma unroll
                for (int i = 0; i < 16; ++i) X[(db * 16 + i) * 64 + lane] = O[db][i] * inv;
        }
        AT_BAR();
        float ss = 0.f;
        if (cc == 0) {
#pragma unroll
            for (int db = 0; db < NDB; ++db)
#pragma unroll
                for (int i = 0; i < 16; ++i) { const float o = O[db][i] * inv - lam * X[(db * 16 + i) * 64 + lane]; O[db][i] = o; ss += o * o; }
        }
        ss += __shfl_xor(ss, 32);
        if (hh == 0) SS[wid * 32 + r] = ss;
        AT_BAR();
        if (cc == 0) {
            ss += SS[(wid ^ 2) * 32 + r];
            const float rs = (1.0f - LAMBDA_INIT) / sqrtf(ss * (1.0f / 256.0f) + EPS);
            bf16_t* op = outp + orow * DM + h * 256 + vh * 128 + 4 * hh;
            const float* slp = subln + vh * 128 + 4 * hh;
#pragma unroll
            for (int db = 0; db < NDB; ++db)
#pragma unroll
                for (int i4 = 0; i4 < 4; ++i4) { const int d = 32 * db + 8 * i4;
                    const f32x4 sl = *(const f32x4*)(slp + d);
                    u32x2 w; w.x = cvt_pk_bf16(O[db][4 * i4] * rs * sl[0], O[db][4 * i4 + 1] * rs * sl[1]); w.y = cvt_pk_bf16(O[db][4 * i4 + 2] * rs * sl[2], O[db][4 * i4 + 3] * rs * sl[3]);
                    *(u32x2*)(op + d) = w; }
        }
        AT_BAR();
    } else {
        float ss = 0.f;
#pragma unroll
        for (int db = 0; db < NDB; ++db)
#pragma unroll
            for (int i = 0; i < 16; ++i) ss += O[db][i] * O[db][i];
        ss += __shfl_xor(ss, 32);
        if (hh == 0) SS[wid * 32 + r] = ss;
        AT_BAR();
        ss += SS[(wid ^ 4) * 32 + r];
        const float rs = 1.0f / sqrtf(ss * (1.0f / 256.0f) + EPS);
        const bf16_t* gp = gsrc + orow * PW + 3072 + h * 256 + vh * 128 + 4 * hh;
        bf16_t* op = outp + orow * DM + h * 256 + vh * 128 + 4 * hh;
#pragma unroll
        for (int db = 0; db < NDB; ++db)
#pragma unroll
            for (int i4 = 0; i4 < 4; ++i4) { const int d = 32 * db + 8 * i4;
                const u32x2 gg = *(const u32x2*)(gp + d);
                u32x2 w; w.x = cvt_pk_bf16(O[db][4 * i4] * rs * silu_f(bflo(gg.x)), O[db][4 * i4 + 1] * rs * silu_f(bfhi(gg.x)));
                w.y = cvt_pk_bf16(O[db][4 * i4 + 2] * rs * silu_f(bflo(gg.y)), O[db][4 * i4 + 3] * rs * silu_f(bfhi(gg.y)));
                *(u32x2*)(op + d) = w; }
        AT_BAR();
    }
#undef AT_ISSUE
}

template <int MODE>
__device__ __forceinline__ void attn_phase(LAS unsigned char* lds, const bf16_t* src, int pitch, int kcol0, int vcol0, int nheads, bf16_t* outp, const bf16_t* gsrc, const float* subln, float lam, int vcu, int G) {
    constexpr int NU = MODE ? 32 : 16;
    const int npairs = 16 * nheads * (NU / 2);
    for (int pr = vcu; pr < npairs; pr += G) {
        const int bh = pr / (NU / 2), p = pr % (NU / 2), b = bh / nheads, h = bh % nheads;
        attn_unit<MODE>(lds, src, pitch, kcol0 + h * 256, vcol0 + h * 256, b, h, NU - 1 - p, outp, gsrc, subln, lam);
        attn_unit<MODE>(lds, src, pitch, kcol0 + h * 256, vcol0 + h * 256, b, h, p, outp, gsrc, subln, lam);
    }
}

struct Params { const float* in[26]; float* out; unsigned char* ws; int lo, hi; };
constexpr int NPHASE = 22;

__global__ void __launch_bounds__(512) fwd_megakernel(Params P) {
    extern __shared__ __attribute__((aligned(16))) unsigned char lds_raw[];
    LAS unsigned char* lds = (LAS unsigned char*)lds_raw;
    const int tid = threadIdx.x, lane = tid & 63, wave = __builtin_amdgcn_readfirstlane(tid >> 6);
    const int G = gridDim.x, bx = blockIdx.x;
    const int vcu = (G % 8 == 0) ? (bx % 8) * (G / 8) + bx / 8 : bx;
    const int gw = vcu * 8 + wave, NGW = G * 8;
    unsigned char* ws = P.ws;
    float* out = P.out;
    bf16_t* Wgu = (bf16_t*)(ws + WS_WGU); bf16_t* Wd = (bf16_t*)(ws + WS_WD); bf16_t* Win = (bf16_t*)(ws + WS_WIN); bf16_t* Wout = (bf16_t*)(ws + WS_WOUT);
    bf16_t* Wglu = (bf16_t*)(ws + WS_WGLU); bf16_t* Wqkv = (bf16_t*)(ws + WS_WQKV); bf16_t* Wco = (bf16_t*)(ws + WS_WCO);
    bf16_t* XN = (bf16_t*)(ws + WS_XN); bf16_t* BIG = (bf16_t*)(ws + WS_BIG); bf16_t* ZB = (bf16_t*)(ws + WS_Z);
    const float* x = P.in[0]; const float* ffn_norm = P.in[1]; const float* mix_norm = P.in[5];
#if MK_PER_PHASE
#define SYNC(k) do { } while (0)
#else
    cg::grid_group grid = cg::this_grid();
#define SYNC(k) do { if (P.lo <= (k) && (k) + 1 < P.hi) grid.sync(); } while (0)
#endif
#define IN(k) (P.lo <= (k) && (k) < P.hi)

    if (IN(0)) {
        LAS float* scr = (LAS float*)(lds + wave * 16384);
        const size_t gsz = (size_t)DM * DFF;
#pragma unroll 1
        for (int i = 0; i < 4; ++i) {
            conv_matrix(P.in[2] + i * gsz, Wgu + (size_t)i * NGU * DM, DM, DFF, 1, scr, gw, NGW, lane);
            conv_matrix(P.in[3] + i * gsz, Wgu + (size_t)i * NGU * DM, DM, DFF, 2, scr, gw, NGW, lane);
            conv_matrix(P.in[4] + i * gsz, Wd + (size_t)i * DM * DFF, DFF, DM, 0, scr, gw, NGW, lane);
        }
        conv_matrix(P.in[6], Win, DM, PW, 0, scr, gw, NGW, lane);
        conv_matrix(P.in[7], Wout, DM, DM, 0, scr, gw, NGW, lane);
        conv_matrix(P.in[16], Wglu, 1024, 1024, 0, scr, gw, NGW, lane);
        conv_matrix(P.in[18], Wqkv, DM, QW, 0, scr, gw, NGW, lane);
        conv_matrix(P.in[19], Wco, DM, DM, 0, scr, gw, NGW, lane);
        tables_phase(ws, nullptr, P.in[8], P.in[9], P.in[10], P.in[11], P.in[12], P.in[20], P.in[21], P.in[22], P.in[23], vcu * 512 + tid, G * 512);
        rmsnorm_phase<true>(x, ffn_norm, XN, nullptr, gw, NGW, lane);
    }
    SYNC(0);
    if (IN(1)) run_gemm(lds, XN, Wgu, TT, NGU, DM, EpiSwiglu{BIG, DFF});
    SYNC(1);
    if (IN(2)) run_gemm(lds, BIG, Wd, TT, DM, DFF, EpiResid{x, out, DM, 0.5f});
    SYNC(2);
    if (IN(3)) rmsnorm_phase<true>(out, mix_norm, XN, nullptr, gw, NGW, lane);
    SYNC(3);
    if (IN(4)) run_gemm(lds, XN, Win, TT, PW, DM, EpiWin{BIG, (const float*)(ws + WS_RCOS), (const float*)(ws + WS_RSIN)});
    SYNC(4);
    if (IN(5)) {
#ifndef NO_A0
        attn_phase<0>(lds, BIG, PW, 1024, 2048, 4, XN, BIG, nullptr, 0.f, vcu, G);
#endif
#ifndef NO_S5
        s5_phase(lds, ws, BIG, P.in[13], P.in[14], P.in[15], ZB, vcu, G, wave, lane);
#endif
    }
    SYNC(5);
    if (IN(6)) run_gemm(lds, ZB, Wglu, TT, 1024, 1024, EpiGlu{ZB, P.in[17], XN});
    SYNC(6);
    if (IN(7)) run_gemm(lds, XN, Wout, TT, DM, DM, EpiResid{out, out, DM, 1.0f});
    SYNC(7);
    if (IN(8)) rmsnorm_phase<true>(out, ffn_norm + DM, XN, nullptr, gw, NGW, lane);
    SYNC(8);
    if (IN(9)) run_gemm(lds, XN, Wgu + (size_t)1 * NGU * DM, TT, NGU, DM, EpiSwiglu{BIG, DFF});
    SYNC(9);
    if (IN(10)) run_gemm(lds, BIG, Wd + (size_t)1 * DM * DFF, TT, DM, DFF, EpiResid{out, out, DM, 0.5f});
    SYNC(10);
    if (IN(11)) rmsnorm_phase<true>(out, ffn_norm + 2 * DM, XN, nullptr, gw, NGW, lane);
    SYNC(11);
    if (IN(12)) run_gemm(lds, XN, Wgu + (size_t)2 * NGU * DM, TT, NGU, DM, EpiSwiglu{BIG, DFF});
    SYNC(12);
    if (IN(13)) run_gemm(lds, BIG, Wd + (size_t)2 * DM * DFF, TT, DM, DFF, EpiResid{out, out, DM, 0.5f});
    SYNC(13);
    if (IN(14)) rmsnorm_phase<true>(out, mix_norm + DM, XN, nullptr, gw, NGW, lane);
    SYNC(14);
    if (IN(15)) run_gemm(lds, XN, Wqkv, TT, QW, DM, EpiQkv{BIG, (const float*)(ws + WS_ACOS), (const float*)(ws + WS_ASIN)});
    SYNC(15);
#ifndef NO_A1
    if (IN(16)) { const float lam = ((const float*)(ws + WS_CTL))[0]; attn_phase<1>(lds, BIG, QW, 2048, 4096, 8, XN, nullptr, P.in[24], lam, vcu, G); }
#endif
    SYNC(16);
    if (IN(17)) run_gemm(lds, XN, Wco, TT, DM, DM, EpiResid{out, out, DM, 1.0f});
    SYNC(17);
    if (IN(18)) rmsnorm_phase<true>(out, ffn_norm + 3 * DM, XN, nullptr, gw, NGW, lane);
    SYNC(18);
    if (IN(19)) run_gemm(lds, XN, Wgu + (size_t)3 * NGU * DM, TT, NGU, DM, EpiSwiglu{BIG, DFF});
    SYNC(19);
    if (IN(20)) run_gemm(lds, BIG, Wd + (size_t)3 * DM * DFF, TT, DM, DFF, EpiResid{out, out, DM, 0.5f});
    SYNC(20);
    if (IN(21)) rmsnorm_phase<false>(out, P.in[25], nullptr, out, gw, NGW, lane);
#undef IN
#undef SYNC
}

extern "C" void kernel_launch(void* const* d_in, const int* in_sizes, int n_in, void* d_out, int out_size, void* d_ws, size_t ws_size, hipStream_t stream) {
    static int grid = 0;
    if (grid == 0) {
        if (n_in != 26 || out_size != TT * DM || ws_size < WS_END) { fprintf(stderr, "kernel_launch: unexpected shapes (n_in %d, out %d, ws %zu < %zu)\n", n_in, out_size, ws_size, (size_t)WS_END); grid = -1; return; }
        int dev = 0, cus = 0, per_cu = 0;
        hipGetDevice(&dev); hipDeviceGetAttribute(&cus, hipDeviceAttributeMultiprocessorCount, dev);
        if (hipFuncSetAttribute((const void*)fwd_megakernel, hipFuncAttributeMaxDynamicSharedMemorySize, LDS_BYTES) != hipSuccess) { fprintf(stderr, "kernel_launch: hipFuncSetAttribute failed\n"); grid = -1; return; }
        if (hipOccupancyMaxActiveBlocksPerMultiprocessor(&per_cu, (const void*)fwd_megakernel, 512, LDS_BYTES) != hipSuccess || per_cu < 1) { fprintf(stderr, "kernel_launch: occupancy query says %d\n", per_cu); per_cu = 1; }
        (void)hipGetLastError();
        grid = cus * per_cu;
        fprintf(stderr, "kernel_launch: grid %d (cus %d x %d)\n", grid, cus, per_cu);
    }
    if (grid < 0) return;
    Params p{};
    for (int i = 0; i < 26; ++i) p.in[i] = (const float*)d_in[i];
    p.out = (float*)d_out; p.ws = (unsigned char*)d_ws;
#if MK_PER_PHASE
    for (int k = 0; k < NPHASE; ++k) { p.lo = k; p.hi = k + 1; hipLaunchKernelGGL(fwd_megakernel, dim3(grid), dim3(512), LDS_BYTES, stream, p); }
#else
    p.lo = 0; p.hi = NPHASE;
    void* args[] = {&p};
    hipError_t e = hipLaunchCooperativeKernel((const void*)fwd_megakernel, dim3(grid), dim3(512), args, LDS_BYTES, stream);
    if (e != hipSuccess) fprintf(stderr, "cooperative launch failed: %s (grid %d)\n", hipGetErrorString(e), grid);
#endif
}
```

```cpp
#include <hip/hip_runtime.h>
#include <hip/hip_cooperative_groups.h>
#include <cstdio>
#include <cstdint>
namespace cg = cooperative_groups;

#define LAS __attribute__((address_space(3)))
typedef unsigned short bf16_t;
typedef unsigned long long u64_t;
constexpr float SSQ_FIX = 16777216.0f, SSQ_INV = 1.0f / 16777216.0f;
typedef short bf16x8 __attribute__((ext_vector_type(8)));
typedef short s16x4 __attribute__((ext_vector_type(4)));
typedef float f32x4 __attribute__((ext_vector_type(4)));
typedef float f32x16 __attribute__((ext_vector_type(16)));
typedef unsigned u32x4 __attribute__((ext_vector_type(4)));
typedef unsigned u32x2 __attribute__((ext_vector_type(2)));

#ifndef MK_PER_PHASE
#define MK_PER_PHASE 0
#endif

constexpr int TT = 32768, SEQ = 2048, DM = 2048, DFF = 5504, NGU = 2 * DFF;
constexpr int PW = 5120, QW = 6144;
constexpr float EPS = 1e-6f;
constexpr float LAMBDA_INIT = 0.35550906759f;
constexpr float QSCALE = 0.08838834764831845f * 1.4426950408889634f;

constexpr size_t MiB = 1u << 20;
constexpr size_t WS_CTL = 0;
constexpr size_t WS_RCOS = 1 * MiB, WS_RSIN = 2 * MiB, WS_ACOS = 3 * MiB, WS_ASIN = 3 * MiB + 128 * 1024, WS_S5A = 3 * MiB + 512 * 1024, WS_S5BB = 4 * MiB;
constexpr size_t WS_W = 8 * MiB;
constexpr size_t SZ_WGU = (size_t)NGU * DM * 2, SZ_WD = (size_t)DM * DFF * 2;
constexpr size_t WS_WGU = WS_W, WS_WD = WS_WGU + 4 * SZ_WGU, WS_WIN = WS_WD + 4 * SZ_WD, WS_WOUT = WS_WIN + (size_t)PW * DM * 2,
                 WS_WGLU = WS_WOUT + (size_t)DM * DM * 2, WS_WQKV = WS_WGLU + (size_t)1024 * 1024 * 2, WS_WCO = WS_WQKV + (size_t)QW * DM * 2,
                 WS_WEND = WS_WCO + (size_t)DM * DM * 2;
constexpr size_t WS_XN = 328 * MiB;
constexpr size_t WS_BIG = 456 * MiB;
constexpr size_t WS_Z = WS_BIG + (size_t)TT * PW * 2;
constexpr size_t WS_YC = WS_BIG + (size_t)TT * QW * 2;
constexpr size_t WS_END = WS_YC + (size_t)TT * DM * 2;
constexpr size_t WS_SSQ = 5 * MiB;
static_assert(WS_WEND <= WS_XN && WS_XN + (size_t)TT * DM * 2 <= WS_BIG && WS_Z + (size_t)TT * 1024 * 2 <= WS_END, "ws map");

constexpr int LDS_BYTES = 147456;

namespace pg8 {
constexpr int BM = 256, BK = 64, HALF = 128, HTB = HALF * BK * 2, STAGE_BYTES = 8 * HTB, NXCD = 8, WGM = 8;
__host__ __device__ __forceinline__ int lds_byte(int r, int c) { const int st = (r >> 4) * 2 + (c >> 5), rr = r & 15, cc = c & 31, ob = rr * 64 + cc * 2; return st * 1024 + (ob ^ (((ob >> 9) & 1) << 5)); }
__host__ __device__ __forceinline__ void stage_rc(int b, int& R, int& C) { const int st = b / 1024, sb = b % 1024, swz = sb ^ (((sb >> 9) & 1) << 5); R = (st >> 1) * 16 + swz / 64; C = (st & 1) * 32 + (swz % 64) / 2; }
__host__ __device__ __forceinline__ int perm32(int rho) { const int n = rho >> 4, i = rho & 15; return 8 * (i >> 2) + 4 * n + (i & 3); }
struct Unit { int pm, pn; };
struct Gemm { const bf16_t* A; const bf16_t* Bt; int M, N, K; };
struct StaticOrder {
    int nM, nN, nwg, G, c;
    __host__ __device__ void init(int M, int N, int G_, int c_) { nM = M / BM; nN = N / BM; nwg = nM * nN; G = G_; c = c_; }
    __host__ __device__ bool next(int i, Unit& u) const {
        const long L = (long)i * G + c; if (L >= nwg) return false;
        int wgid = (int)L; { const int q = nwg / NXCD, r = nwg % NXCD, xcd = wgid % NXCD, off = wgid / NXCD; wgid = (xcd < r ? xcd * (q + 1) : r * (q + 1) + (xcd - r) * q) + off; }
        const int nig = WGM * nN, gid = wgid / nig, fm = gid * WGM, gsz = (nM - fm) < WGM ? (nM - fm) : WGM;
        u.pm = fm + ((wgid % nig) % gsz); u.pn = (wgid % nig) / gsz; return true;
    }
    __device__ __forceinline__ void a_ready(const Unit&) const {}
    __device__ __forceinline__ void done(const Unit&) const {}
};
__device__ __forceinline__ unsigned cvt_pk_bf16(float lo, float hi) { unsigned r; asm volatile("v_cvt_pk_bf16_f32 %0, %1, %2" : "=v"(r) : "v"(lo), "v"(hi)); return r; }

template <class Epi, class Sched, bool ALIGN_EPI = false, bool SP2 = false>
__device__ __forceinline__ void gemm_phase(LAS unsigned char* lds, const Gemm g, const Sched S, const Epi E) {
    const int tid = threadIdx.x, wid = __builtin_amdgcn_readfirstlane(tid >> 6), lane = tid & 63, wr = wid >> 2, wc = wid & 3, fr = lane & 15, fq = lane >> 4;
    const int K = g.K, nt = K / BK;
    unsigned voffA[2], voffB[2];
#pragma unroll
    for (int i = 0; i < 2; ++i) { int R, C; stage_rc(tid * 16 + i * 8192, R, C); const int Rb = Epi::PERM ? ((R & ~31) + perm32(R & 31)) : R;
        voffA[i] = (unsigned)(R * K + C) * 2u; voffB[i] = (unsigned)(Rb * K + C) * 2u; }
    const size_t kstep = (size_t)(BK * 2);
    const size_t hstep = (size_t)HALF * K * 2;
    const size_t tstep = 2 * hstep;
    const unsigned ldsw = (unsigned)wid * 1024u;
    const int aoff = lds_byte(wr * 64 + fr, fq * 8), boff = lds_byte(wc * 32 + fr, fq * 8);
#define PG8_SA(b, h) (((b) * 2 + (h)) * HTB)
#define PG8_SB(b, h) ((4 + (b) * 2 + (h)) * HTB)
#define PG8_STAGE(bufoff, gbase, voff) do { _Pragma("unroll") for (int _i = 0; _i < 2; ++_i) \
        __builtin_amdgcn_global_load_lds((const unsigned*)((const char*)(gbase) + (voff)[_i]), (LAS unsigned*)(lds + (bufoff) + ldsw + _i * 8192), 16, 0, 0); } while (0)
#define PG8_LDA(dst, b, h) do { _Pragma("unroll") for (int m = 0; m < 4; ++m) _Pragma("unroll") for (int k = 0; k < 2; ++k) dst[m][k] = *(const LAS bf16x8*)(lds + PG8_SA(b, h) + aoff + m * 2048 + k * 1024); } while (0)
#define PG8_LDB(dst, b, h) do { _Pragma("unroll") for (int n = 0; n < 2; ++n) _Pragma("unroll") for (int k = 0; k < 2; ++k) dst[n][k] = *(const LAS bf16x8*)(lds + PG8_SB(b, h) + boff + n * 2048 + k * 1024); } while (0)
#define PG8_MMA(ai, bj, At, Bt) do { __builtin_amdgcn_s_setprio(1); _Pragma("unroll") for (int m = 0; m < 4; ++m) _Pragma("unroll") for (int n = 0; n < 2; ++n) _Pragma("unroll") for (int k = 0; k < 2; ++k) \
        acc[ai][bj][m][n] = __builtin_amdgcn_mfma_f32_16x16x32_bf16(Bt[n][k], At[m][k], acc[ai][bj][m][n], 0, 0, 0); __builtin_amdgcn_s_setprio(0); } while (0)
#define PG8_WAIT_V(n) asm volatile("s_waitcnt vmcnt(" #n ")" ::: "memory")
#define PG8_WAIT_L(n) asm volatile("s_waitcnt lgkmcnt(" #n ")" ::: "memory")
#define PG8_BAR __builtin_amdgcn_s_barrier()
#define PG8_SCHED __builtin_amdgcn_sched_barrier(0)
    Unit cur, nxt; int ui = 0;
    if (!S.next(0, cur)) return;
    f32x4 acc[2][2][4][2];
#pragma unroll
    for (int a = 0; a < 2; ++a)
#pragma unroll
        for (int b = 0; b < 2; ++b)
#pragma unroll
            for (int m = 0; m < 4; ++m)
#pragma unroll
                for (int n = 0; n < 2; ++n) acc[a][b][m][n] = (f32x4){0.f, 0.f, 0.f, 0.f};
    bf16x8 At[4][2], B0[2][2], B1[2][2];
    const char* cA = (const char*)g.A + (size_t)cur.pm * tstep; const char* cB = (const char*)g.Bt + (size_t)cur.pn * tstep;
    S.a_ready(cur);
    if constexpr (SP2) {
        PG8_STAGE(PG8_SB(0, 0), cB, voffB); PG8_STAGE(PG8_SB(0, 1), cB + hstep, voffB); PG8_STAGE(PG8_SA(0, 0), cA, voffA); PG8_STAGE(PG8_SA(0, 1), cA + hstep, voffA);
        if (wr == 1) PG8_BAR;
        PG8_WAIT_V(2); PG8_BAR;
        PG8_STAGE(PG8_SB(1, 0), cB + kstep, voffB); PG8_STAGE(PG8_SA(1, 0), cA + kstep, voffA); PG8_STAGE(PG8_SB(1, 1), cB + hstep + kstep, voffB);
        PG8_WAIT_V(6); PG8_BAR;
    } else {
        PG8_STAGE(PG8_SB(0, 0), cB, voffB); PG8_STAGE(PG8_SA(0, 0), cA, voffA); PG8_STAGE(PG8_SB(0, 1), cB + hstep, voffB); PG8_STAGE(PG8_SA(0, 1), cA + hstep, voffA);
        if (wr == 1) PG8_BAR;
        PG8_WAIT_V(4); PG8_BAR;
        PG8_STAGE(PG8_SB(1, 0), cB + kstep, voffB); PG8_STAGE(PG8_SA(1, 0), cA + kstep, voffA); PG8_STAGE(PG8_SB(1, 1), cB + hstep + kstep, voffB);
        PG8_WAIT_V(6); PG8_BAR;
    }
    for (;;) {
        const bool has_next = S.next(ui + 1, nxt);
        const char* nA = has_next ? (const char*)g.A + (size_t)nxt.pm * tstep : cA; const char* nB = has_next ? (const char*)g.Bt + (size_t)nxt.pn * tstep : cB;
        for (int t = 0; t < nt; t += 2) {
            const bool last = (t == nt - 2);
            const char* a1 = cA + (size_t)(t + 1) * kstep;
            const char* a2 = last ? nA : cA + (size_t)(t + 2) * kstep; const char* b2 = last ? nB : cB + (size_t)(t + 2) * kstep;
            const char* a3 = a2 + kstep; const char* b3 = b2 + kstep;
            if (last && has_next) S.a_ready(nxt);
            if constexpr (SP2) {
            PG8_LDB(B0, 0, 0); PG8_LDB(B1, 0, 1); PG8_SCHED; PG8_LDA(At, 0, 0); PG8_STAGE(PG8_SA(1, 1), a1 + hstep, voffA);
            PG8_WAIT_V(8); PG8_WAIT_L(0); PG8_BAR; PG8_MMA(0, 0, At, B0); PG8_MMA(0, 1, At, B1); PG8_BAR; PG8_SCHED;
            PG8_LDA(At, 0, 1); PG8_STAGE(PG8_SB(0, 0), b2, voffB); PG8_STAGE(PG8_SB(0, 1), b2 + hstep, voffB); PG8_STAGE(PG8_SA(0, 0), a2, voffA);
            PG8_WAIT_V(8); PG8_WAIT_L(0); PG8_BAR; PG8_MMA(1, 0, At, B0); PG8_MMA(1, 1, At, B1); PG8_BAR; PG8_SCHED;
            PG8_LDB(B0, 1, 0); PG8_LDB(B1, 1, 1); PG8_SCHED; PG8_LDA(At, 1, 0); PG8_STAGE(PG8_SA(0, 1), a2 + hstep, voffA);
            PG8_WAIT_V(8); PG8_WAIT_L(0); PG8_BAR; PG8_MMA(0, 0, At, B0); PG8_MMA(0, 1, At, B1); PG8_BAR; PG8_SCHED;
            PG8_LDA(At, 1, 1); PG8_STAGE(PG8_SB(1, 0), b3, voffB); PG8_STAGE(PG8_SB(1, 1), b3 + hstep, voffB); PG8_STAGE(PG8_SA(1, 0), a3, voffA);
            PG8_WAIT_V(8); PG8_WAIT_L(0); PG8_BAR; PG8_MMA(1, 0, At, B0); PG8_MMA(1, 1, At, B1); PG8_BAR; PG8_SCHED;
            } else {
            PG8_LDB(B0, 0, 0); PG8_SCHED; PG8_LDA(At, 0, 0); PG8_STAGE(PG8_SA(1, 1), a1 + hstep, voffA);
            PG8_WAIT_L(8); PG8_BAR; PG8_WAIT_L(0); PG8_MMA(0, 0, At, B0); PG8_BAR; PG8_SCHED;
            PG8_LDB(B1, 0, 1); PG8_STAGE(PG8_SB(0, 0), b2, voffB);
            PG8_BAR; PG8_WAIT_L(0); PG8_MMA(0, 1, At, B1); PG8_BAR;
            PG8_LDA(At, 0, 1); PG8_STAGE(PG8_SA(0, 0), a2, voffA);
            PG8_BAR; PG8_WAIT_L(0); PG8_MMA(1, 0, At, B0); PG8_BAR; PG8_SCHED;
            PG8_STAGE(PG8_SB(0, 1), b2 + hstep, voffB);
            PG8_WAIT_V(6); PG8_BAR; PG8_MMA(1, 1, At, B1); PG8_BAR;
            PG8_LDB(B0, 1, 0); PG8_SCHED; PG8_LDA(At, 1, 0); PG8_STAGE(PG8_SA(0, 1), a2 + hstep, voffA);
            PG8_WAIT_L(8); PG8_BAR; PG8_WAIT_L(0); PG8_MMA(0, 0, At, B0); PG8_BAR; PG8_SCHED;
            PG8_LDB(B1, 1, 1); PG8_STAGE(PG8_SB(1, 0), b3, voffB);
            PG8_BAR; PG8_WAIT_L(0); PG8_MMA(0, 1, At, B1); PG8_BAR;
            PG8_LDA(At, 1, 1); PG8_STAGE(PG8_SA(1, 0), a3, voffA);
            PG8_BAR; PG8_WAIT_L(0); PG8_MMA(1, 0, At, B0); PG8_BAR; PG8_SCHED;
            PG8_STAGE(PG8_SB(1, 1), b3 + hstep, voffB);
            PG8_WAIT_V(6); PG8_BAR; PG8_MMA(1, 1, At, B1); PG8_BAR;
            }
        }
        if constexpr (ALIGN_EPI) { if (wr == 0) PG8_BAR; }
        if constexpr (!Epi::AFTER_DRAIN) { E(acc, cur, wr, wc, fr, fq); S.done(cur); }
        if (!has_next) break;
#pragma unroll
        for (int a = 0; a < 2; ++a)
#pragma unroll
            for (int b = 0; b < 2; ++b)
#pragma unroll
                for (int m = 0; m < 4; ++m)
#pragma unroll
                    for (int n = 0; n < 2; ++n) acc[a][b][m][n] = (f32x4){0.f, 0.f, 0.f, 0.f};
        cur = nxt; cA = nA; cB = nB; ++ui;
        if constexpr (ALIGN_EPI) { if (wr == 1) PG8_BAR; }
    }
    PG8_WAIT_V(0);
    if constexpr (!ALIGN_EPI) { if (wr == 0) PG8_BAR; }
    PG8_BAR;
#undef PG8_SA
#undef PG8_SB
#undef PG8_STAGE
#undef PG8_LDA
#undef PG8_LDB
#undef PG8_MMA
#undef PG8_WAIT_V
#undef PG8_WAIT_L
#undef PG8_BAR
#undef PG8_SCHED
}
}

__device__ __forceinline__ unsigned f2bf(float f) { unsigned u = __builtin_bit_cast(unsigned, f); return (u + 0x7fffu + ((u >> 16) & 1u)) >> 16; }
__device__ __forceinline__ unsigned pk2(float lo, float hi) { return f2bf(lo) | (f2bf(hi) << 16); }
__device__ __forceinline__ float bf2f(unsigned short b) { return __builtin_bit_cast(float, (unsigned)b << 16); }
__device__ __forceinline__ float bflo(unsigned w) { return __builtin_bit_cast(float, w << 16); }
__device__ __forceinline__ float bfhi(unsigned w) { return __builtin_bit_cast(float, w & 0xffff0000u); }
__device__ __forceinline__ float fast_sigmoid(float x) { return __builtin_amdgcn_rcpf(1.0f + __builtin_amdgcn_exp2f(-1.4426950408889634f * x)); }
__device__ __forceinline__ float silu_f(float x) { return x * fast_sigmoid(x); }
__device__ __forceinline__ float gelu_tanh_f(float y) { return y * fast_sigmoid(1.5957691216057308f * (y + 0.044715f * y * y * y)); }
__device__ __forceinline__ float wave_sum(float v) {
#pragma unroll
    for (int o = 1; o < 64; o <<= 1) v += __shfl_xor(v, o);
    return v;
}
__device__ __forceinline__ void sincos_d(double a, double& s, double& c) {
    const double k = rint(a * 0.15915494309189535);
    const double r = fma(-k, 6.283185307179586, a), r2 = r * r;
    double ts = r, tc = 1.0; s = r; c = 1.0;
    for (int n = 1; n <= 13; ++n) { tc *= -r2 / (double)((2 * n - 1) * (2 * n)); c += tc; ts *= -r2 / (double)((2 * n) * (2 * n + 1)); s += ts; }
}

using pg8::Unit; using pg8::cvt_pk_bf16;
struct EpiSwiglu {
    static constexpr bool PERM = true, AFTER_DRAIN = false;
    bf16_t* O; int ldo; const u64_t* ssq;
    __device__ __forceinline__ void operator()(const f32x4 (&acc)[2][2][4][2], const Unit& u, int wr, int wc, int fr, int fq) const {
        const int row0 = u.pm * 256 + wr * 64 + fr, col0 = u.pn * 128 + wc * 32 + 8 * fq;
        float rsv[2][4];
#pragma unroll
        for (int ai = 0; ai < 2; ++ai)
#pragma unroll
            for (int m = 0; m < 4; ++m) rsv[ai][m] = (float)ssq[row0 + ai * 128 + m * 16] * SSQ_INV;
#pragma unroll
        for (int ai = 0; ai < 2; ++ai)
#pragma unroll
            for (int m = 0; m < 4; ++m) {
                const int row = row0 + ai * 128 + m * 16;
                const float rs = __builtin_amdgcn_rsqf(rsv[ai][m] * (1.0f / DM) + EPS);
                bf16_t* rowp = O + (size_t)row * ldo + col0;
                const f32x4 g0 = acc[ai][0][m][0] * rs, g1 = acc[ai][0][m][1] * rs, u0 = acc[ai][1][m][0] * rs, u1 = acc[ai][1][m][1] * rs;
                u32x4 w;
                w.x = cvt_pk_bf16(silu_f(g0[0]) * u0[0], silu_f(g0[1]) * u0[1]); w.y = cvt_pk_bf16(silu_f(g0[2]) * u0[2], silu_f(g0[3]) * u0[3]);
                w.z = cvt_pk_bf16(silu_f(g1[0]) * u1[0], silu_f(g1[1]) * u1[1]); w.w = cvt_pk_bf16(silu_f(g1[2]) * u1[2], silu_f(g1[3]) * u1[3]);
                *(u32x4*)rowp = w;
            }
    }
};
template <bool BASE_F32, bool OUT_F32, int SCALE> struct EpiResid {
    static constexpr bool PERM = false, AFTER_DRAIN = false;
    const float* basef; float* outf; bf16_t* xb; u64_t* ssq;
    __device__ __forceinline__ void operator()(const f32x4 (&acc)[2][2][4][2], const Unit& u, int wr, int wc, int fr, int fq) const {
        const int col0 = u.pn * 256 + wc * 32 + 4 * fq;
        constexpr float sc = (SCALE == 2 ? 0.0f : SCALE == 1 ? 0.5f : 1.0f);
#pragma unroll
        for (int ai = 0; ai < 2; ++ai) {
            f32x4 pre[4][2][2];
#pragma unroll
            for (int m = 0; m < 4; ++m) { const size_t off = (size_t)(u.pm * 256 + ai * 128 + wr * 64 + m * 16 + fr) * DM + col0;
#pragma unroll
                for (int bj = 0; bj < 2; ++bj)
#pragma unroll
                    for (int n = 0; n < 2; ++n) {
                        if constexpr (BASE_F32) pre[m][bj][n] = *(const f32x4*)(basef + off + bj * 128 + n * 16);
                        else { const u32x2 w = *(const u32x2*)(xb + off + bj * 128 + n * 16); pre[m][bj][n] = (f32x4){bflo(w.x), bfhi(w.x), bflo(w.y), bfhi(w.y)}; } } }
#pragma unroll
            for (int m = 0; m < 4; ++m) {
                const int row = u.pm * 256 + ai * 128 + wr * 64 + m * 16 + fr;
                const size_t off = (size_t)row * DM + col0;
                float sq = 0.f;
#pragma unroll
                for (int bj = 0; bj < 2; ++bj)
#pragma unroll
                    for (int n = 0; n < 2; ++n) { const f32x4 v = pre[m][bj][n] + acc[ai][bj][m][n] * sc;
                        if constexpr (OUT_F32) *(f32x4*)(outf + off + bj * 128 + n * 16) = v;
                        else { u32x2 w; w.x = cvt_pk_bf16(v[0], v[1]); w.y = cvt_pk_bf16(v[2], v[3]); *(u32x2*)(xb + off + bj * 128 + n * 16) = w;
                               sq += (v[0] * v[0] + v[1] * v[1]) + (v[2] * v[2] + v[3] * v[3]); } }
                if constexpr (!OUT_F32 && SCALE != 2) { sq += __shfl_xor(sq, 16); sq += __shfl_xor(sq, 32); if (fq == 0) atomicAdd(ssq + row, (u64_t)(sq * SSQ_FIX)); }
            }
        }
    }
};
struct EpiWin {
    static constexpr bool PERM = true, AFTER_DRAIN = false;
    bf16_t* O; const float* cs; const float* sn; const u64_t* ssq;
    __device__ __forceinline__ void operator()(const f32x4 (&acc)[2][2][4][2], const Unit& u, int wr, int wc, int fr, int fq) const {
        const int row0 = u.pm * 256 + wr * 64 + fr, col0 = u.pn * 256 + wc * 32 + 8 * fq;
        const bool rot = u.pn < 8;
        float rsv[2][4];
#pragma unroll
        for (int ai = 0; ai < 2; ++ai)
#pragma unroll
            for (int m = 0; m < 4; ++m) rsv[ai][m] = (float)ssq[row0 + ai * 128 + m * 16] * SSQ_INV;
#pragma unroll
        for (int ai = 0; ai < 2; ++ai) {
            f32x4 cc[4][2], sv[4][2];
#pragma unroll
            for (int m = 0; m < 4; ++m) {
                if (rot) { const int pos = (row0 + ai * 128 + m * 16) & (SEQ - 1);
                    const float* cp = cs + pos * 128 + wc * 32 + 8 * fq; const float* sp = sn + pos * 128 + wc * 32 + 8 * fq;
                    cc[m][0] = *(const f32x4*)cp; cc[m][1] = *(const f32x4*)(cp + 4); sv[m][0] = *(const f32x4*)sp; sv[m][1] = *(const f32x4*)(sp + 4); }
                else { cc[m][0] = cc[m][1] = (f32x4){1.f, 1.f, 1.f, 1.f}; sv[m][0] = sv[m][1] = (f32x4){0.f, 0.f, 0.f, 0.f}; }
            }
#pragma unroll
            for (int m = 0; m < 4; ++m) {
                const int row = row0 + ai * 128 + m * 16;
                const float rs = __builtin_amdgcn_rsqf(rsv[ai][m] * (1.0f / DM) + EPS);
                const f32x4 a0 = acc[ai][0][m][0] * rs, a1 = acc[ai][0][m][1] * rs, b0 = acc[ai][1][m][0] * rs, b1 = acc[ai][1][m][1] * rs;
                const f32x4 na0 = a0 * cc[m][0] - b0 * sv[m][0], nb0 = b0 * cc[m][0] + a0 * sv[m][0], na1 = a1 * cc[m][1] - b1 * sv[m][1], nb1 = b1 * cc[m][1] + a1 * sv[m][1];
                bf16_t* rowp = O + (size_t)row * PW + col0;
                u32x4 w; w.x = cvt_pk_bf16(na0[0], na0[1]); w.y = cvt_pk_bf16(na0[2], na0[3]); w.z = cvt_pk_bf16(na1[0], na1[1]); w.w = cvt_pk_bf16(na1[2], na1[3]);
                *(u32x4*)rowp = w;
                u32x4 v; v.x = cvt_pk_bf16(nb0[0], nb0[1]); v.y = cvt_pk_bf16(nb0[2], nb0[3]); v.z = cvt_pk_bf16(nb1[0], nb1[1]); v.w = cvt_pk_bf16(nb1[2], nb1[3]);
                *(u32x4*)(rowp + 128) = v;
            }
        }
    }
};
struct EpiQkv {
    static constexpr bool PERM = false, AFTER_DRAIN = false;
    bf16_t* O; const float* cs; const float* sn; const u64_t* ssq;
    __device__ __forceinline__ void operator()(const f32x4 (&acc)[2][2][4][2], const Unit& u, int wr, int wc, int fr, int fq) const {
        const int col0 = u.pn * 256 + wc * 32 + 4 * fq;
        const bool rot = (u.pn < 16) && (wc == 0);
        const float sc0 = (u.pn < 8) ? QSCALE : 1.0f;
        float rsv[2][4]; f32x4 cv[2][4], sv[2][4];
#pragma unroll
        for (int ai = 0; ai < 2; ++ai)
#pragma unroll
            for (int m = 0; m < 4; ++m) { const int row = u.pm * 256 + ai * 128 + wr * 64 + m * 16 + fr; rsv[ai][m] = (float)ssq[row] * SSQ_INV;
                if (rot) { const int pos = row & (SEQ - 1); cv[ai][m] = *(const f32x4*)(cs + pos * 16 + 4 * fq); sv[ai][m] = *(const f32x4*)(sn + pos * 16 + 4 * fq); }
                else { cv[ai][m] = (f32x4){1.f, 1.f, 1.f, 1.f}; sv[ai][m] = (f32x4){0.f, 0.f, 0.f, 0.f}; } }
#pragma unroll
        for (int ai = 0; ai < 2; ++ai)
#pragma unroll
            for (int m = 0; m < 4; ++m) {
                const int row = u.pm * 256 + ai * 128 + wr * 64 + m * 16 + fr;
                const float sc = sc0 * __builtin_amdgcn_rsqf(rsv[ai][m] * (1.0f / DM) + EPS);
                const f32x4 c = cv[ai][m], s = sv[ai][m];
#pragma unroll
                for (int bj = 0; bj < 2; ++bj) {
                    const f32x4 x0 = acc[ai][bj][m][0], x1 = acc[ai][bj][m][1];
                    const f32x4 n0 = (x0 * c - x1 * s) * sc, n1 = (x1 * c + x0 * s) * sc;
                    bf16_t* p = O + (size_t)row * QW + col0 + bj * 128;
                    u32x2 w0; w0.x = cvt_pk_bf16(n0[0], n0[1]); w0.y = cvt_pk_bf16(n0[2], n0[3]); *(u32x2*)p = w0;
                    u32x2 w1; w1.x = cvt_pk_bf16(n1[0], n1[1]); w1.y = cvt_pk_bf16(n1[2], n1[3]); *(u32x2*)(p + 16) = w1;
                }
            }
    }
};
struct EpiGlu {
    static constexpr bool PERM = true, AFTER_DRAIN = false;
    const bf16_t* Z; const float* bias; bf16_t* Y;
    __device__ __forceinline__ void operator()(const f32x4 (&acc)[2][2][4][2], const Unit& u, int wr, int wc, int fr, int fq) const {
        const int row0 = u.pm * 256 + wr * 64 + fr, col0 = u.pn * 256 + wc * 32 + 8 * fq;
#pragma unroll
        for (int bj = 0; bj < 2; ++bj) {
            const f32x4 bv0 = *(const f32x4*)(bias + col0 + bj * 128), bv1 = *(const f32x4*)(bias + col0 + bj * 128 + 4);
            u32x4 zz[2][4];
#pragma unroll
            for (int ai = 0; ai < 2; ++ai)
#pragma unroll
                for (int m = 0; m < 4; ++m) zz[ai][m] = *(const u32x4*)(Z + (size_t)(row0 + ai * 128 + m * 16) * 1024 + col0 + bj * 128);
#pragma unroll
            for (int ai = 0; ai < 2; ++ai)
#pragma unroll
                for (int m = 0; m < 4; ++m) {
                    const int row = row0 + ai * 128 + m * 16;
                    const u32x4 z4 = zz[ai][m];
                    const f32x4 v0 = acc[ai][bj][m][0] + bv0, v1 = acc[ai][bj][m][1] + bv1;
                    u32x4 w;
                    w.x = cvt_pk_bf16(bflo(z4.x) * fast_sigmoid(v0[0]), bfhi(z4.x) * fast_sigmoid(v0[1]));
                    w.y = cvt_pk_bf16(bflo(z4.y) * fast_sigmoid(v0[2]), bfhi(z4.y) * fast_sigmoid(v0[3]));
                    w.z = cvt_pk_bf16(bflo(z4.z) * fast_sigmoid(v1[0]), bfhi(z4.z) * fast_sigmoid(v1[1]));
                    w.w = cvt_pk_bf16(bflo(z4.w) * fast_sigmoid(v1[2]), bfhi(z4.w) * fast_sigmoid(v1[3]));
                    *(u32x4*)(Y + (size_t)row * DM + 1024 + col0 + bj * 128) = w;
                }
        }
    }
};

template <class Epi>
__device__ __forceinline__ void run_gemm(LAS unsigned char* lds, const bf16_t* A, const bf16_t* Bt, int M, int N, int K, const Epi E) {
    pg8::Gemm g{A, Bt, M, N, K}; pg8::StaticOrder S; S.init(M, N, (int)gridDim.x, (int)blockIdx.x);
    pg8::gemm_phase<Epi, pg8::StaticOrder, true, true>(lds, g, S, E);
}

__device__ __forceinline__ void conv_matrix(const float* __restrict__ W, bf16_t* __restrict__ WT, int K, int N, int mode, const float* __restrict__ gain, LAS float* scr, int gw, int NGW, int lane) {
    const int nblk = N / 32, nitems = (K / 64) * nblk;
    for (int item = gw; item < nitems; item += NGW) {
        const int kb = item / nblk, nb = item % nblk, k0 = 64 * kb, n0 = 32 * nb;
#pragma unroll 8
        for (int i = 0; i < 32; ++i) { const int kk = 2 * i + (lane >> 5); const float gk = gain ? gain[k0 + kk] : 1.0f; scr[kk * 33 + (lane & 31)] = W[(size_t)(k0 + kk) * N + n0 + (lane & 31)] * gk; }
        asm volatile("s_waitcnt lgkmcnt(0)" ::: "memory");
        const int c = lane & 7;
        const int rbase = (mode == 0) ? n0 : ((n0 >> 7) * 256 + (n0 & 127) + (mode == 2 ? 128 : 0));
#pragma unroll
        for (int j = 0; j < 4; ++j) { const int n = (lane >> 3) + 8 * j; const LAS float* s = scr + (8 * c) * 33 + n;
            u32x4 o; o.x = pk2(s[0 * 33], s[1 * 33]); o.y = pk2(s[2 * 33], s[3 * 33]); o.z = pk2(s[4 * 33], s[5 * 33]); o.w = pk2(s[6 * 33], s[7 * 33]);
            *(u32x4*)(WT + (size_t)(rbase + n) * K + k0 + 8 * c) = o; }
        asm volatile("s_waitcnt lgkmcnt(0)" ::: "memory");
    }
}

template <bool TO_BF16>
__device__ __forceinline__ void rmsnorm_phase(const float* in, const float* __restrict__ g, bf16_t* outb, float* outf, int gw, int NGW, int lane) {
    f32x4 gv[8];
#pragma unroll
    for (int j = 0; j < 8; ++j) gv[j] = ((const f32x4*)g)[lane + 64 * j];
    for (int row = gw; row < TT; row += NGW) {
        const f32x4* xr = (const f32x4*)(in + (size_t)row * DM) + lane;
        f32x4 v[8]; float ss = 0.f;
#pragma unroll
        for (int j = 0; j < 8; ++j) { v[j] = xr[64 * j]; ss += (v[j][0] * v[j][0] + v[j][1] * v[j][1]) + (v[j][2] * v[j][2] + v[j][3] * v[j][3]); }
        const float rs = 1.0f / sqrtf(wave_sum(ss) * (1.0f / DM) + EPS);
#pragma unroll
        for (int j = 0; j < 8; ++j) {
            const f32x4 y = v[j] * rs * gv[j];
            if constexpr (TO_BF16) { u32x2 w; w.x = pk2(y[0], y[1]); w.y = pk2(y[2], y[3]); *((u32x2*)(outb + (size_t)row * DM) + lane + 64 * j) = w; }
            else { *((f32x4*)(outf + (size_t)row * DM) + lane + 64 * j) = y; }
        }
    }
}

__device__ __forceinline__ void cast_phase(const float* in, bf16_t* outb, u64_t* ssq, int gw, int NGW, int lane) {
    for (int row = gw; row < TT; row += NGW) {
        const f32x4* xr = (const f32x4*)(in + (size_t)row * DM) + lane;
        f32x4 v[8]; float ss = 0.f;
#pragma unroll
        for (int j = 0; j < 8; ++j) { v[j] = xr[64 * j]; ss += (v[j][0] * v[j][0] + v[j][1] * v[j][1]) + (v[j][2] * v[j][2] + v[j][3] * v[j][3]); }
        ss = wave_sum(ss);
        if (lane == 0) ssq[row] = (u64_t)(ss * SSQ_FIX);
#pragma unroll
        for (int j = 0; j < 8; ++j) { u32x2 w; w.x = pk2(v[j][0], v[j][1]); w.y = pk2(v[j][2], v[j][3]); *((u32x2*)(outb + (size_t)row * DM) + lane + 64 * j) = w; }
    }
}

__device__ __forceinline__ void tables_phase(unsigned char* ws, const float* const* in_unused, const float* lam_re, const float* lam_im, const float* log_step, const float* b_re, const float* b_im,
                                             const float* lq1, const float* lk1, const float* lq2, const float* lk2, int gtid, int NT_) {
    float* rcos = (float*)(ws + WS_RCOS); float* rsin = (float*)(ws + WS_RSIN); float* acos_ = (float*)(ws + WS_ACOS); float* asin_ = (float*)(ws + WS_ASIN);
    float* s5a = (float*)(ws + WS_S5A); float* s5bb = (float*)(ws + WS_S5BB);
    for (int i = gtid; i < SEQ * 128; i += NT_) {
        const int pos = i >> 7, f = i & 127;
        const float inv = (float)exp2(-((double)(2 * f) / 256.0) * 13.287712379549449);
        const float ang = (float)pos * inv; double s, c; sincos_d((double)ang, s, c); rcos[i] = (float)c; rsin[i] = (float)s;
    }
    for (int i = gtid; i < SEQ * 16; i += NT_) {
        const int pos = i >> 4, f = i & 15;
        const float inv = (float)exp2(-((double)(2 * f) / 32.0) * 18.931568569324174);
        const float ang = (float)pos * inv; double s, c; sincos_d((double)ang, s, c); acos_[i] = (float)c; asin_[i] = (float)s;
    }
    for (int i = gtid; i < 64 * 64; i += NT_) {
        const int g = i >> 6;
        const double step = exp((double)log_step[g]), lr = (double)lam_re[i], li = (double)lam_im[i];
        const double mag = exp(lr * step); double s, c; sincos_d(li * step, s, c);
        const double are = mag * c, aim = mag * s, den = lr * lr + li * li, nr = are - 1.0;
        const double fre = (nr * lr + aim * li) / den, fim = (aim * lr - nr * li) / den;
        s5a[2 * i] = (float)are; s5a[2 * i + 1] = (float)aim;
        for (int p = 0; p < 16; ++p) { const double br = (double)b_re[i * 16 + p], bi = (double)b_im[i * 16 + p];
            s5bb[(size_t)i * 32 + p] = (float)(fre * br - fim * bi); s5bb[(size_t)i * 32 + 16 + p] = (float)(fre * bi + fim * br); }
    }
    if (gtid == 0) { float s1 = 0.f, s2 = 0.f; for (int i = 0; i < 128; ++i) { s1 += lq1[i] * lk1[i]; s2 += lq2[i] * lk2[i]; }
        ((float*)(ws + WS_CTL))[0] = expf(s1) - expf(s2) + LAMBDA_INIT; }
}

__device__ __forceinline__ void s5_phase(LAS unsigned char* lds, const unsigned char* ws, const bf16_t* proj, const float* c_re, const float* c_im, const float* dskip, bf16_t* z,
                                         int vcu, int G, int wave, int lane) {
    if (wave >= 4) return;
    const float* s5a = (const float*)(ws + WS_S5A); const float* s5bb = (const float*)(ws + WS_S5BB);
    LAS bf16_t* Hc = (LAS bf16_t*)(lds + wave * 8704);
    const int fr = lane & 15, fq = lane >> 4;
    for (int seq = vcu * 4 + wave; seq < 1024; seq += G * 4) {
        const int b = seq >> 6, g = seq & 63, n = lane;
        float bbre[16], bbim[16];
#pragma unroll
        for (int p = 0; p < 16; ++p) { bbre[p] = s5bb[(size_t)(g * 64 + n) * 32 + p]; bbim[p] = s5bb[(size_t)(g * 64 + n) * 32 + 16 + p]; }
        const float are = s5a[2 * (g * 64 + n)], aim = s5a[2 * (g * 64 + n) + 1];
        bf16x8 cf[4];
#pragma unroll
        for (int ks = 0; ks < 4; ++ks) { u32x4 w; unsigned* wp = (unsigned*)&w;
#pragma unroll
            for (int j2 = 0; j2 < 4; ++j2) { float v[2];
#pragma unroll
                for (int e = 0; e < 2; ++e) { const int k = 32 * ks + 8 * fq + 2 * j2 + e; v[e] = (k < 64) ? c_re[(size_t)(g * 16 + fr) * 64 + k] : -c_im[(size_t)(g * 16 + fr) * 64 + (k - 64)]; }
                wp[j2] = pk2(v[0], v[1]); }
            cf[ks] = __builtin_bit_cast(bf16x8, w); }
        const float dsk = dskip[g * 16 + fr];
        float hre = 0.f, him = 0.f;
        for (int ch = 0; ch < SEQ / 32; ++ch) {
            const size_t row0 = (size_t)b * SEQ + ch * 32;
            const bf16_t* up = proj + (row0 + (lane & 31)) * PW + 4096 + g * 16;
            const u32x4 ua = *(const u32x4*)up, ub = *(const u32x4*)(up + 8);
            float uf[16];
            uf[0] = bflo(ua.x); uf[1] = bfhi(ua.x); uf[2] = bflo(ua.y); uf[3] = bfhi(ua.y); uf[4] = bflo(ua.z); uf[5] = bfhi(ua.z); uf[6] = bflo(ua.w); uf[7] = bfhi(ua.w);
            uf[8] = bflo(ub.x); uf[9] = bfhi(ub.x); uf[10] = bflo(ub.y); uf[11] = bfhi(ub.y); uf[12] = bflo(ub.z); uf[13] = bfhi(ub.z); uf[14] = bflo(ub.w); uf[15] = bfhi(ub.w);
#pragma unroll
            for (int k = 0; k < 32; ++k) {
                float xr = 0.f, xi = 0.f;
#pragma unroll
                for (int p = 0; p < 16; ++p) { const float su = __builtin_bit_cast(float, __builtin_amdgcn_readlane(__builtin_bit_cast(int, uf[p]), k)); xr = fmaf(su, bbre[p], xr); xi = fmaf(su, bbim[p], xi); }
                const float nr = are * hre - aim * him + xr, ni = are * him + aim * hre + xi; hre = nr; him = ni;
                Hc[k * 136 + n] = (bf16_t)f2bf(hre); Hc[k * 136 + 64 + n] = (bf16_t)f2bf(him);
            }
#pragma unroll
            for (int sb = 0; sb < 2; ++sb) {
                f32x4 y = (f32x4){0.f, 0.f, 0.f, 0.f};
#pragma unroll
                for (int ks = 0; ks < 4; ++ks) { const bf16x8 hf = *(const LAS bf16x8*)(Hc + (16 * sb + fr) * 136 + 32 * ks + 8 * fq); y = __builtin_amdgcn_mfma_f32_16x16x32_bf16(hf, cf[ks], y, 0, 0, 0); }
#pragma unroll
                for (int i = 0; i < 4; ++i) { const size_t row = row0 + 16 * sb + 4 * fq + i;
                    const float uu = bf2f(proj[row * PW + 4096 + g * 16 + fr]); const float yy = y[i] + dsk * uu;
                    z[row * 1024 + g * 16 + fr] = (bf16_t)f2bf(gelu_tanh_f(yy)); }
            }
        }
    }
}

#define MF32(a, b, c) __builtin_amdgcn_mfma_f32_32x32x16_bf16((a), (b), (c), 0, 0, 0)
#define AT_WAITV(n) asm volatile("s_waitcnt vmcnt(" #n ")" ::: "memory")
#define AT_BAR() asm volatile("s_waitcnt lgkmcnt(0)\n\ts_barrier" ::: "memory")
__device__ __forceinline__ s16x4 vtr(const LAS unsigned char* p) { typedef short v4i16_t __attribute__((ext_vector_type(4))); return __builtin_bit_cast(s16x4, __builtin_amdgcn_ds_read_tr16_b64_v4i16((LAS v4i16_t*)p)); }
__device__ __forceinline__ int crow(int i, int h) { return (i & 3) + 8 * (i >> 2) + 4 * h; }

template <int MODE>
__device__ __forceinline__ void attn_unit(LAS unsigned char* lds, const bf16_t* src, const int pitch, const int kcol, const int vcol, const int b, const int h, const int ub,
                                          bf16_t* outp, const bf16_t* gsrc, const float* subln, const float lam) {
    constexpr int NKS = MODE ? 8 : 16, NDB = 4, ROWS = MODE ? 64 : 128;
    const int tid = threadIdx.x, lane = tid & 63, r = lane & 31, hh = lane >> 5;
    const int wid = __builtin_amdgcn_readfirstlane(tid >> 6);
    const int rg = MODE ? (wid & 1) : (wid & 3), vh = MODE ? ((wid >> 1) & 1) : (wid >> 2), cc = MODE ? (wid >> 2) : 0;
    const size_t rowbase = (size_t)b * SEQ; const int q0 = ub * ROWS, NT = MODE ? (ub + 1) : (2 * ub + 2);
    const int qrow = q0 + rg * 32 + r;
    AT_WAITV(0);
#define AT_ISSUE(t, buf) do { const bf16_t* gk_ = src + (rowbase + (size_t)(t) * 64) * pitch; int rv_ = r; asm volatile("" : "+v"(rv_)); \
        _Pragma("unroll") for (int i_ = 0; i_ < 4; ++i_) { const int c_ = wid * 4 + i_; const int row_ = c_ * 2 + hh; \
            const unsigned ok_ = (unsigned)(row_ * pitch + kcol + ((rv_ ^ (row_ & 15)) << 3)); \
            __builtin_amdgcn_global_load_lds((const unsigned*)(gk_ + ok_), (LAS unsigned*)(lds + (buf) * 65536 + c_ * 1024), 16, 0, 0); \
            const unsigned ov_ = (unsigned)(row_ * pitch + vcol + ((rv_ ^ ((row_ & 3) << 2)) << 3)); \
            __builtin_amdgcn_global_load_lds((const unsigned*)(gk_ + ov_), (LAS unsigned*)(lds + (buf) * 65536 + 32768 + c_ * 1024), 16, 0, 0); } } while (0)
    AT_ISSUE(0, 0);
    bf16x8 qf[NKS];
    { const bf16_t* qp = src + (rowbase + qrow) * pitch + h * 256 + cc * 128 + 8 * hh;
#pragma unroll
      for (int d0 = 0; d0 < NKS; ++d0) qf[d0] = *(const bf16x8*)(qp + 16 * d0); }
    f32x16 O[NDB];
#pragma unroll
    for (int db = 0; db < NDB; ++db)
#pragma unroll
        for (int i = 0; i < 16; ++i) O[db][i] = 0.f;
    float mrun = -1e30f, lrun = 0.f;
    const float lgam = __builtin_log2f(1.0f - __builtin_amdgcn_exp2f(-5.0f - (float)h));
    const int r15 = r & 15;
    const int kunit0 = cc * 16;
    const int q4 = (lane & 15) >> 2, p4 = lane & 3, blk16 = (lane >> 4) & 1;
    const int vlane = (4 * hh + q4) * 512 + ((2 * blk16 + (p4 >> 1)) << 4) + 8 * (p4 & 1);
    for (int t = 0; t < NT; ++t) {
        if (t + 1 < NT) { AT_ISSUE(t + 1, (t + 1) & 1); AT_WAITV(8); } else { AT_WAITV(0); }
        AT_BAR();
        const bool active = MODE ? true : !(t == NT - 1 && rg < 2);
        if (active) {
            const LAS unsigned char* Kb = lds + (t & 1) * 65536; const LAS unsigned char* Vb = Kb + 32768;
            int r15v = r15 ^ hh ^ kunit0, q4v = q4 << 2; asm volatile("" : "+v"(r15v), "+v"(q4v));
            bf16x8 pf[4];
            if constexpr (MODE) {
                f32x16 p0, p1;
#pragma unroll
                for (int i = 0; i < 16; ++i) { p0[i] = 0.f; p1[i] = 0.f; }
                { const LAS unsigned char* kr0 = Kb + r * 512; const LAS unsigned char* kr1 = Kb + (32 + r) * 512;
#pragma unroll
                  for (int d0 = 0; d0 < NKS; ++d0) { const int uo = ((2 * d0) ^ r15v) << 4;
                      const bf16x8 k0 = *(const LAS bf16x8*)(kr0 + uo); const bf16x8 k1 = *(const LAS bf16x8*)(kr1 + uo);
                      p0 = MF32(k0, qf[d0], p0); p1 = MF32(k1, qf[d0], p1);
                      if ((d0 & 3) == 3) __builtin_amdgcn_sched_barrier(0); } }
                float rm = p0[0];
#pragma unroll
                for (int i = 0; i < 16; ++i) { rm = fmaxf(rm, p0[i]); rm = fmaxf(rm, p1[i]); }
                rm = fmaxf(rm, __shfl_xor(rm, 32));
                if (__any(rm > mrun + 8.0f)) {
                    const float mn = fmaxf(mrun, rm); const float al = __builtin_amdgcn_exp2f(mrun - mn); lrun *= al; mrun = mn;
#pragma unroll
                    for (int db = 0; db < NDB; ++db) O[db] = O[db] * al;
                }
                float sum = 0.f;
#pragma unroll
                for (int i = 0; i < 16; ++i) { p0[i] = __builtin_amdgcn_exp2f(p0[i] - mrun); p1[i] = __builtin_amdgcn_exp2f(p1[i] - mrun); sum += p0[i] + p1[i]; }
                lrun += sum;
                u32x4 w;
                w.x = cvt_pk_bf16(p0[0], p0[1]); w.y = cvt_pk_bf16(p0[2], p0[3]); w.z = cvt_pk_bf16(p0[4], p0[5]); w.w = cvt_pk_bf16(p0[6], p0[7]); pf[0] = __builtin_bit_cast(bf16x8, w);
                w.x = cvt_pk_bf16(p0[8], p0[9]); w.y = cvt_pk_bf16(p0[10], p0[11]); w.z = cvt_pk_bf16(p0[12], p0[13]); w.w = cvt_pk_bf16(p0[14], p0[15]); pf[1] = __builtin_bit_cast(bf16x8, w);
                w.x = cvt_pk_bf16(p1[0], p1[1]); w.y = cvt_pk_bf16(p1[2], p1[3]); w.z = cvt_pk_bf16(p1[4], p1[5]); w.w = cvt_pk_bf16(p1[6], p1[7]); pf[2] = __builtin_bit_cast(bf16x8, w);
                w.x = cvt_pk_bf16(p1[8], p1[9]); w.y = cvt_pk_bf16(p1[10], p1[11]); w.z = cvt_pk_bf16(p1[12], p1[13]); w.w = cvt_pk_bf16(p1[14], p1[15]); pf[3] = __builtin_bit_cast(bf16x8, w);
            } else {
#pragma unroll
                for (int blk = 0; blk < 2; ++blk) {
                    f32x16 p;
#pragma unroll
                    for (int i = 0; i < 16; ++i) p[i] = 0.f;
                    const LAS unsigned char* kr = Kb + (32 * blk + r) * 512;
#pragma unroll
                    for (int d0 = 0; d0 < NKS; ++d0) { const int uo = ((2 * d0) ^ r15v) << 4;
                        const bf16x8 k0 = *(const LAS bf16x8*)(kr + uo); p = MF32(k0, qf[d0], p);
                        if ((d0 & 3) == 3) __builtin_amdgcn_sched_barrier(0); }
                    const int kb = t * 64 + 32 * blk + 4 * hh;
#pragma unroll
                    for (int i = 0; i < 16; ++i) { const int kv = kb + (i & 3) + 8 * (i >> 2);
                        p[i] *= __builtin_amdgcn_exp2f(lgam * fabsf((float)(qrow - kv)) - 4.0f); }
                    u32x4 w;
                    w.x = cvt_pk_bf16(p[0], p[1]); w.y = cvt_pk_bf16(p[2], p[3]); w.z = cvt_pk_bf16(p[4], p[5]); w.w = cvt_pk_bf16(p[6], p[7]); pf[2 * blk] = __builtin_bit_cast(bf16x8, w);
                    w.x = cvt_pk_bf16(p[8], p[9]); w.y = cvt_pk_bf16(p[10], p[11]); w.z = cvt_pk_bf16(p[12], p[13]); w.w = cvt_pk_bf16(p[14], p[15]); pf[2 * blk + 1] = __builtin_bit_cast(bf16x8, w);
                    __builtin_amdgcn_sched_barrier(0);
                }
            }
            const LAS unsigned char* vb = Vb + vlane;
            __builtin_amdgcn_sched_barrier(0);
#pragma unroll
            for (int db = 0; db < NDB; ++db) {
                const int dunit = vh * 16 + 4 * db;
                const LAS unsigned char* vp = vb + ((dunit ^ q4v) << 4);
#pragma unroll
                for (int ks = 0; ks < 4; ++ks) {
                    const int kvb = 32 * (ks >> 1) + 16 * (ks & 1);
                    const s16x4 lo = vtr(vp + kvb * 512), hi = vtr(vp + (kvb + 8) * 512);
                    const bf16x8 vf = __builtin_shufflevector(lo, hi, 0, 1, 2, 3, 4, 5, 6, 7);
                    O[db] = MF32(vf, pf[ks], O[db]);
                }
                __builtin_amdgcn_sched_barrier(0);
            }
        }
        AT_BAR();
    }
    const size_t orow = rowbase + qrow;
    LAS float* SS = (LAS float*)(lds + 131072);
    if constexpr (MODE) {
        const float l = lrun + __shfl_xor(lrun, 32); const float inv = 1.0f / l;
        LAS float* X = (LAS float*)(lds + (wid & 3) * 16384);
        if (cc == 1) {
#pragma unroll
            for (int db = 0; db < NDB; ++db)
#pragma unroll
                for (int i = 0; i < 16; ++i) X[(db * 16 + i) * 64 + lane] = O[db][i] * inv;
        }
        AT_BAR();
        float ss = 0.f;
        if (cc == 0) {
#pragma unroll
            for (int db = 0; db < NDB; ++db)
#pragma unroll
                for (int i = 0; i < 16; ++i) { const float o = O[db][i] * inv - lam * X[(db * 16 + i) * 64 + lane]; O[db][i] = o; ss += o * o; }
        }
        ss += __shfl_xor(ss, 32);
        if (hh == 0) SS[wid * 32 + r] = ss;
        AT_BAR();
        if (cc == 0) {
            ss += SS[(wid ^ 2) * 32 + r];
            const float rs = (1.0f - LAMBDA_INIT) / sqrtf(ss * (1.0f / 256.0f) + EPS);
            bf16_t* op = outp + orow * DM + h * 256 + vh * 128 + 4 * hh;
            const float* slp = subln + vh * 128 + 4 * hh;
#pragma unroll
            for (int db = 0; db < NDB; ++db)
#pragma unroll
                for (int i4 = 0; i4 < 4; ++i4) { const int d = 32 * db + 8 * i4;
                    const f32x4 sl = *(const f32x4*)(slp + d);
                    u32x2 w; w.x = cvt_pk_bf16(O[db][4 * i4] * rs * sl[0], O[db][4 * i4 + 1] * rs * sl[1]); w.y = cvt_pk_bf16(O[db][4 * i4 + 2] * rs * sl[2], O[db][4 * i4 + 3] * rs * sl[3]);
                    *(u32x2*)(op + d) = w; }
        }
        AT_BAR();
    } else {
        float ss = 0.f;
#pragma unroll
        for (int db = 0; db < NDB; ++db)
#pragma unroll
            for (int i = 0; i < 16; ++i) ss += O[db][i] * O[db][i];
        ss += __shfl_xor(ss, 32);
        if (hh == 0) SS[wid * 32 + r] = ss;
        AT_BAR();
        ss += SS[(wid ^ 4) * 32 + r];
        const float rs = 1.0f / sqrtf(ss * (1.0f / 256.0f) + EPS);
        const bf16_t* gp = gsrc + orow * PW + 3072 + h * 256 + vh * 128 + 4 * hh;
        bf16_t* op = outp + orow * DM + h * 256 + vh * 128 + 4 * hh;
#pragma unroll
        for (int db = 0; db < NDB; ++db)
#pragma unroll
            for (int i4 = 0; i4 < 4; ++i4) { const int d = 32 * db + 8 * i4;
                const u32x2 gg = *(const u32x2*)(gp + d);
                u32x2 w; w.x = cvt_pk_bf16(O[db][4 * i4] * rs * silu_f(bflo(gg.x)), O[db][4 * i4 + 1] * rs * silu_f(bfhi(gg.x)));
                w.y = cvt_pk_bf16(O[db][4 * i4 + 2] * rs * silu_f(bflo(gg.y)), O[db][4 * i4 + 3] * rs * silu_f(bfhi(gg.y)));
                *(u32x2*)(op + d) = w; }
        AT_BAR();
    }
#undef AT_ISSUE
}

template <int MODE>
__device__ __forceinline__ void attn_phase(LAS unsigned char* lds, const bf16_t* src, int pitch, int kcol0, int vcol0, int nheads, bf16_t* outp, const bf16_t* gsrc, const float* subln, float lam, int vcu, int G) {
    constexpr int NU = MODE ? 32 : 16;
    const int npairs = 16 * nheads * (NU / 2);
    for (int pr = vcu; pr < npairs; pr += G) {
        const int bh = pr / (NU / 2), p = pr % (NU / 2), b = bh / nheads, h = bh % nheads;
        attn_unit<MODE>(lds, src, pitch, kcol0 + h * 256, vcol0 + h * 256, b, h, NU - 1 - p, outp, gsrc, subln, lam);
        attn_unit<MODE>(lds, src, pitch, kcol0 + h * 256, vcol0 + h * 256, b, h, p, outp, gsrc, subln, lam);
    }
}

struct Params { const float* in[26]; float* out; unsigned char* ws; int lo, hi; };
constexpr int NPHASE = 17;

__global__ void __launch_bounds__(512) fwd_megakernel(Params P) {
    extern __shared__ __attribute__((aligned(16))) unsigned char lds_raw[];
    LAS unsigned char* lds = (LAS unsigned char*)lds_raw;
    const int tid = threadIdx.x, lane = tid & 63, wave = __builtin_amdgcn_readfirstlane(tid >> 6);
    const int G = gridDim.x, bx = blockIdx.x;
    const int vcu = (G % 8 == 0) ? (bx % 8) * (G / 8) + bx / 8 : bx;
    const int gw = vcu * 8 + wave, NGW = G * 8;
    unsigned char* ws = P.ws;
    float* out = P.out;
    bf16_t* Wgu = (bf16_t*)(ws + WS_WGU); bf16_t* Wd = (bf16_t*)(ws + WS_WD); bf16_t* Win = (bf16_t*)(ws + WS_WIN); bf16_t* Wout = (bf16_t*)(ws + WS_WOUT);
    bf16_t* Wglu = (bf16_t*)(ws + WS_WGLU); bf16_t* Wqkv = (bf16_t*)(ws + WS_WQKV); bf16_t* Wco = (bf16_t*)(ws + WS_WCO);
    bf16_t* XN = (bf16_t*)(ws + WS_XN); bf16_t* BIG = (bf16_t*)(ws + WS_BIG); bf16_t* ZB = (bf16_t*)(ws + WS_Z);
    const float* x = P.in[0]; const float* ffn_norm = P.in[1]; const float* mix_norm = P.in[5];
#if MK_PER_PHASE
#define SYNC(k) do { } while (0)
#else
    cg::grid_group grid = cg::this_grid();
#define SYNC(k) do { if (P.lo <= (k) && (k) + 1 < P.hi) grid.sync(); } while (0)
#endif
#ifndef DUPMASK
#define DUPMASK 0u
#endif
#define IN(k) (P.lo <= (k) && (k) < P.hi)
#define REP(k) for (int rep_ = 0; rep_ < (((DUPMASK >> (k)) & 1u) ? 2 : 1); ++rep_)

    u64_t* SSQ = (u64_t*)(ws + WS_SSQ);
    bf16_t* YC = (bf16_t*)(ws + WS_YC);
    const float* rcos = (const float*)(ws + WS_RCOS); const float* rsin = (const float*)(ws + WS_RSIN);
    const float* acos_ = (const float*)(ws + WS_ACOS); const float* asin_ = (const float*)(ws + WS_ASIN);
    if (IN(0)) REP(0) {
        LAS float* scr = (LAS float*)(lds + wave * 16384);
        const size_t gsz = (size_t)DM * DFF;
#pragma unroll 1
        for (int i = 0; i < 4; ++i) {
            conv_matrix(P.in[2] + i * gsz, Wgu + (size_t)i * NGU * DM, DM, DFF, 1, ffn_norm + i * DM, scr, gw, NGW, lane);
            conv_matrix(P.in[3] + i * gsz, Wgu + (size_t)i * NGU * DM, DM, DFF, 2, ffn_norm + i * DM, scr, gw, NGW, lane);
            conv_matrix(P.in[4] + i * gsz, Wd + (size_t)i * DM * DFF, DFF, DM, 0, nullptr, scr, gw, NGW, lane);
        }
        conv_matrix(P.in[6], Win, DM, PW, 0, mix_norm, scr, gw, NGW, lane);
        conv_matrix(P.in[7], Wout, DM, DM, 0, nullptr, scr, gw, NGW, lane);
        conv_matrix(P.in[16], Wglu, 1024, 1024, 0, nullptr, scr, gw, NGW, lane);
        conv_matrix(P.in[18], Wqkv, DM, QW, 0, mix_norm + DM, scr, gw, NGW, lane);
        conv_matrix(P.in[19], Wco, DM, DM, 0, nullptr, scr, gw, NGW, lane);
        tables_phase(ws, nullptr, P.in[8], P.in[9], P.in[10], P.in[11], P.in[12], P.in[20], P.in[21], P.in[22], P.in[23], vcu * 512 + tid, G * 512);
        for (int i = vcu * 512 + tid; i < 5 * TT; i += G * 512) SSQ[TT + i] = 0ull;
        cast_phase(x, XN, SSQ, gw, NGW, lane);
    }
    SYNC(0);
    if (IN(1)) { run_gemm(lds, XN, Wgu, TT, NGU, DM, EpiSwiglu{BIG, DFF, SSQ}); if ((DUPMASK >> 1) & 1u) { run_gemm(lds, XN, Wgu, TT, NGU, DM, EpiSwiglu{BIG, DFF, SSQ}); } }
    SYNC(1);
    if (IN(2)) run_gemm(lds, BIG, Wd, TT, DM, DFF, EpiResid<true, false, 1>{x, nullptr, XN, SSQ + 1 * TT});
    if (IN(2) && ((DUPMASK >> 2) & 1u)) run_gemm(lds, BIG, Wd, TT, DM, DFF, EpiResid<false, false, 2>{nullptr, nullptr, XN, nullptr});
    SYNC(2);
    if (IN(3)) { run_gemm(lds, XN, Win, TT, PW, DM, EpiWin{BIG, rcos, rsin, SSQ + 1 * TT}); if ((DUPMASK >> 3) & 1u) { run_gemm(lds, XN, Win, TT, PW, DM, EpiWin{BIG, rcos, rsin, SSQ + 1 * TT}); } }
    SYNC(3);
    if (IN(4)) REP(4) {
#ifndef NO_A0
        attn_phase<0>(lds, BIG, PW, 1024, 2048, 4, YC, BIG, nullptr, 0.f, vcu, G);
#endif
#ifndef NO_S5
        s5_phase(lds, ws, BIG, P.in[13], P.in[14], P.in[15], ZB, vcu, G, wave, lane);
#endif
    }
    SYNC(4);
    if (IN(5)) run_gemm(lds, ZB, Wglu, TT, 1024, 1024, EpiGlu{ZB, P.in[17], YC});
    SYNC(5);
    if (IN(6)) run_gemm(lds, YC, Wout, TT, DM, DM, EpiResid<false, false, 0>{nullptr, nullptr, XN, SSQ + 2 * TT});
    if (IN(6) && ((DUPMASK >> 6) & 1u)) run_gemm(lds, YC, Wout, TT, DM, DM, EpiResid<false, false, 2>{nullptr, nullptr, XN, nullptr});
    SYNC(6);
    if (IN(7)) { run_gemm(lds, XN, Wgu + (size_t)1 * NGU * DM, TT, NGU, DM, EpiSwiglu{BIG, DFF, SSQ + 2 * TT}); if ((DUPMASK >> 7) & 1u) { run_gemm(lds, XN, Wgu + (size_t)1 * NGU * DM, TT, NGU, DM, EpiSwiglu{BIG, DFF, SSQ + 2 * TT}); } }
    SYNC(7);
    if (IN(8)) run_gemm(lds, BIG, Wd + (size_t)1 * DM * DFF, TT, DM, DFF, EpiResid<false, false, 1>{nullptr, nullptr, XN, SSQ + 3 * TT});
    if (IN(8) && ((DUPMASK >> 8) & 1u)) run_gemm(lds, BIG, Wd + (size_t)1 * DM * DFF, TT, DM, DFF, EpiResid<false, false, 2>{nullptr, nullptr, XN, nullptr});
    SYNC(8);
    if (IN(9)) { run_gemm(lds, XN, Wgu + (size_t)2 * NGU * DM, TT, NGU, DM, EpiSwiglu{BIG, DFF, SSQ + 3 * TT}); if ((DUPMASK >> 9) & 1u) { run_gemm(lds, XN, Wgu + (size_t)2 * NGU * DM, TT, NGU, DM, EpiSwiglu{BIG, DFF, SSQ + 3 * TT}); } }
    SYNC(9);
    if (IN(10)) run_gemm(lds, BIG, Wd + (size_t)2 * DM * DFF, TT, DM, DFF, EpiResid<false, false, 1>{nullptr, nullptr, XN, SSQ + 4 * TT});
    if (IN(10) && ((DUPMASK >> 10) & 1u)) run_gemm(lds, BIG, Wd + (size_t)2 * DM * DFF, TT, DM, DFF, EpiResid<false, false, 2>{nullptr, nullptr, XN, nullptr});
    SYNC(10);
    if (IN(11)) { run_gemm(lds, XN, Wqkv, TT, QW, DM, EpiQkv{BIG, acos_, asin_, SSQ + 4 * TT}); if ((DUPMASK >> 11) & 1u) { run_gemm(lds, XN, Wqkv, TT, QW, DM, EpiQkv{BIG, acos_, asin_, SSQ + 4 * TT}); } }
    SYNC(11);
#ifndef NO_A1
    if (IN(12)) REP(12) { const float lam = ((const float*)(ws + WS_CTL))[0]; attn_phase<1>(lds, BIG, QW, 2048, 4096, 8, YC, nullptr, P.in[24], lam, vcu, G); }
#endif
    SYNC(12);
    if (IN(13)) run_gemm(lds, YC, Wco, TT, DM, DM, EpiResid<false, false, 0>{nullptr, nullptr, XN, SSQ + 5 * TT});
    if (IN(13) && ((DUPMASK >> 13) & 1u)) run_gemm(lds, YC, Wco, TT, DM, DM, EpiResid<false, false, 2>{nullptr, nullptr, XN, nullptr});
    SYNC(13);
    if (IN(14)) { run_gemm(lds, XN, Wgu + (size_t)3 * NGU * DM, TT, NGU, DM, EpiSwiglu{BIG, DFF, SSQ + 5 * TT}); if ((DUPMASK >> 14) & 1u) { run_gemm(lds, XN, Wgu + (size_t)3 * NGU * DM, TT, NGU, DM, EpiSwiglu{BIG, DFF, SSQ + 5 * TT}); } }
    SYNC(14);
    if (IN(15)) run_gemm(lds, BIG, Wd + (size_t)3 * DM * DFF, TT, DM, DFF, EpiResid<false, true, 1>{nullptr, out, XN, nullptr});
    if (IN(15) && ((DUPMASK >> 15) & 1u)) run_gemm(lds, BIG, Wd + (size_t)3 * DM * DFF, TT, DM, DFF, EpiResid<false, false, 2>{nullptr, nullptr, XN, nullptr});
    SYNC(15);
    if (IN(16)) rmsnorm_phase<false>(out, P.in[25], nullptr, out, gw, NGW, lane);
#undef IN
#undef SYNC
}

extern "C" void kernel_launch(void* const* d_in, const int* in_sizes, int n_in, void* d_out, int out_size, void* d_ws, size_t ws_size, hipStream_t stream) {
    static int grid = 0;
    if (grid == 0) {
        if (n_in != 26 || out_size != TT * DM || ws_size < WS_END) { fprintf(stderr, "kernel_launch: unexpected shapes (n_in %d, out %d, ws %zu < %zu)\n", n_in, out_size, ws_size, (size_t)WS_END); grid = -1; return; }
        int dev = 0, cus = 0, per_cu = 0;
        hipGetDevice(&dev); hipDeviceGetAttribute(&cus, hipDeviceAttributeMultiprocessorCount, dev);
        if (hipFuncSetAttribute((const void*)fwd_megakernel, hipFuncAttributeMaxDynamicSharedMemorySize, LDS_BYTES) != hipSuccess) { fprintf(stderr, "kernel_launch: hipFuncSetAttribute failed\n"); grid = -1; return; }
        if (hipOccupancyMaxActiveBlocksPerMultiprocessor(&per_cu, (const void*)fwd_megakernel, 512, LDS_BYTES) != hipSuccess || per_cu < 1) { fprintf(stderr, "kernel_launch: occupancy query says %d\n", per_cu); per_cu = 1; }
        (void)hipGetLastError();
        grid = cus * per_cu;
        fprintf(stderr, "kernel_launch: grid %d (cus %d x %d)\n", grid, cus, per_cu);
    }
    if (grid < 0) return;
    Params p{};
    for (int i = 0; i < 26; ++i) p.in[i] = (const float*)d_in[i];
    p.out = (float*)d_out; p.ws = (unsigned char*)d_ws;
#if MK_PER_PHASE
    for (int k = 0; k < NPHASE; ++k) { p.lo = k; p.hi = k + 1; hipLaunchKernelGGL(fwd_megakernel, dim3(grid), dim3(512), LDS_BYTES, stream, p); }
#else
    p.lo = 0; p.hi = NPHASE;
    void* args[] = {&p};
    hipError_t e = hipLaunchCooperativeKernel((const void*)fwd_megakernel, dim3(grid), dim3(512), args, LDS_BYTES, stream);
    if (e != hipSuccess) fprintf(stderr, "cooperative launch failed: %s (grid %d)\n", hipGetErrorString(e), grid);
#endif
}
```

```cpp
#include <hip/hip_runtime.h>
#include <hip/hip_cooperative_groups.h>
#include <cstdio>
#include <cstdint>
namespace cg = cooperative_groups;

#define LAS __attribute__((address_space(3)))
typedef unsigned short bf16_t;
typedef unsigned long long u64_t;
constexpr float SSQ_FIX = 16777216.0f, SSQ_INV = 1.0f / 16777216.0f;
typedef short bf16x8 __attribute__((ext_vector_type(8)));
typedef short s16x4 __attribute__((ext_vector_type(4)));
typedef float f32x4 __attribute__((ext_vector_type(4)));
typedef float f32x2 __attribute__((ext_vector_type(2)));
typedef float f32x16 __attribute__((ext_vector_type(16)));
typedef unsigned u32x4 __attribute__((ext_vector_type(4)));
typedef unsigned u32x2 __attribute__((ext_vector_type(2)));

#ifndef MK_PER_PHASE
#define MK_PER_PHASE 0
#endif

constexpr int TT = 32768, SEQ = 2048, DM = 2048, DFF = 5504, NGU = 2 * DFF;
constexpr int PW = 5120, QW = 6144;
constexpr float EPS = 1e-6f;
constexpr float LAMBDA_INIT = 0.35550906759f;
constexpr float QSCALE = 0.08838834764831845f * 1.4426950408889634f;

constexpr size_t MiB = 1u << 20;
constexpr size_t WS_CTL = 0, WS_BAR = 4096, BAR_BYTES = 16384;
constexpr size_t WS_RCOS = 1 * MiB, WS_RSIN = 2 * MiB, WS_ACOS = 3 * MiB, WS_ASIN = 3 * MiB + 128 * 1024, WS_S5A = 3 * MiB + 512 * 1024, WS_S5BB = 4 * MiB;
constexpr size_t WS_W = 8 * MiB;
constexpr size_t SZ_WGU = (size_t)NGU * DM * 2, SZ_WD = (size_t)DM * DFF * 2;
constexpr size_t WS_WGU = WS_W, WS_WD = WS_WGU + 4 * SZ_WGU, WS_WIN = WS_WD + 4 * SZ_WD, WS_WOUT = WS_WIN + (size_t)PW * DM * 2,
                 WS_WGLU = WS_WOUT + (size_t)DM * DM * 2, WS_WQKV = WS_WGLU + (size_t)1024 * 1024 * 2, WS_WCO = WS_WQKV + (size_t)QW * DM * 2,
                 WS_WEND = WS_WCO + (size_t)DM * DM * 2;
constexpr size_t WS_XN = 328 * MiB;
constexpr size_t WS_BIG = 456 * MiB;
constexpr size_t WS_Z = WS_BIG + (size_t)TT * PW * 2;
constexpr size_t WS_YC = WS_BIG + (size_t)TT * QW * 2;
constexpr size_t WS_END = WS_YC + (size_t)TT * DM * 2;
constexpr size_t WS_SSQ = 5 * MiB;
static_assert(WS_WEND <= WS_XN && WS_XN + (size_t)TT * DM * 2 <= WS_BIG && WS_Z + (size_t)TT * 1024 * 2 <= WS_END, "ws map");

constexpr int LDS_BYTES = 147456;

namespace pg8 {
constexpr int BM = 256, BK = 64, HALF = 128, HTB = HALF * BK * 2, STAGE_BYTES = 8 * HTB, NXCD = 8, WGM = 8;
__host__ __device__ __forceinline__ int lds_byte(int r, int c) { const int st = (r >> 4) * 2 + (c >> 5), rr = r & 15, cc = c & 31, ob = rr * 64 + cc * 2; return st * 1024 + (ob ^ (((ob >> 9) & 1) << 5)); }
__host__ __device__ __forceinline__ void stage_rc(int b, int& R, int& C) { const int st = b / 1024, sb = b % 1024, swz = sb ^ (((sb >> 9) & 1) << 5); R = (st >> 1) * 16 + swz / 64; C = (st & 1) * 32 + (swz % 64) / 2; }
__host__ __device__ __forceinline__ int perm32(int rho) { const int n = rho >> 4, i = rho & 15; return 8 * (i >> 2) + 4 * n + (i & 3); }
struct Unit { int pm, pn; };
struct Gemm { const bf16_t* A; const bf16_t* Bt; int M, N, K; };
struct StaticOrder {
    int nM, nN, nwg, G, c;
    __host__ __device__ void init(int M, int N, int G_, int c_) { nM = M / BM; nN = N / BM; nwg = nM * nN; G = G_; c = c_; }
    __host__ __device__ bool next(int i, Unit& u) const {
        const long L = (long)i * G + c; if (L >= nwg) return false;
        int wgid = (int)L; { const int q = nwg / NXCD, r = nwg % NXCD, xcd = wgid % NXCD, off = wgid / NXCD; wgid = (xcd < r ? xcd * (q + 1) : r * (q + 1) + (xcd - r) * q) + off; }
        const int nig = WGM * nN, gid = wgid / nig, fm = gid * WGM, gsz = (nM - fm) < WGM ? (nM - fm) : WGM;
        u.pm = fm + ((wgid % nig) % gsz); u.pn = (wgid % nig) / gsz; return true;
    }
    __device__ __forceinline__ void a_ready(const Unit&) const {}
    __device__ __forceinline__ void done(const Unit&) const {}
};
__device__ __forceinline__ unsigned cvt_pk_bf16(float lo, float hi) { unsigned r; asm volatile("v_cvt_pk_bf16_f32 %0, %1, %2" : "=v"(r) : "v"(lo), "v"(hi)); return r; }

template <class Epi, class Sched, bool ALIGN_EPI = false, bool SP2 = false>
__device__ __forceinline__ void gemm_phase(LAS unsigned char* lds, const Gemm g, const Sched S, const Epi E) {
    const int tid = threadIdx.x, wid = __builtin_amdgcn_readfirstlane(tid >> 6), lane = tid & 63, wr = wid >> 2, wc = wid & 3, fr = lane & 15, fq = lane >> 4;
    const int K = g.K, nt = K / BK;
    unsigned voffA[2], voffB[2];
#pragma unroll
    for (int i = 0; i < 2; ++i) { int R, C; stage_rc(tid * 16 + i * 8192, R, C); const int Rb = Epi::PERM ? ((R & ~31) + perm32(R & 31)) : R;
        voffA[i] = (unsigned)(R * K + C) * 2u; voffB[i] = (unsigned)(Rb * K + C) * 2u; }
    const size_t kstep = (size_t)(BK * 2);
    const size_t hstep = (size_t)HALF * K * 2;
    const size_t tstep = 2 * hstep;
    const unsigned ldsw = (unsigned)wid * 1024u;
    const int aoff = lds_byte(wr * 64 + fr, fq * 8), boff = lds_byte(wc * 32 + fr, fq * 8);
#define PG8_SA(b, h) (((b) * 2 + (h)) * HTB)
#define PG8_SB(b, h) ((4 + (b) * 2 + (h)) * HTB)
#define PG8_STAGE(bufoff, gbase, voff) do { _Pragma("unroll") for (int _i = 0; _i < 2; ++_i) \
        __builtin_amdgcn_global_load_lds((const unsigned*)((const char*)(gbase) + (voff)[_i]), (LAS unsigned*)(lds + (bufoff) + ldsw + _i * 8192), 16, 0, 0); } while (0)
#define PG8_LDA(dst, b, h) do { _Pragma("unroll") for (int m = 0; m < 4; ++m) _Pragma("unroll") for (int k = 0; k < 2; ++k) dst[m][k] = *(const LAS bf16x8*)(lds + PG8_SA(b, h) + aoff + m * 2048 + k * 1024); } while (0)
#define PG8_LDB(dst, b, h) do { _Pragma("unroll") for (int n = 0; n < 2; ++n) _Pragma("unroll") for (int k = 0; k < 2; ++k) dst[n][k] = *(const LAS bf16x8*)(lds + PG8_SB(b, h) + boff + n * 2048 + k * 1024); } while (0)
#define PG8_MMA(ai, bj, At, Bt) do { __builtin_amdgcn_s_setprio(1); _Pragma("unroll") for (int m = 0; m < 4; ++m) _Pragma("unroll") for (int n = 0; n < 2; ++n) _Pragma("unroll") for (int k = 0; k < 2; ++k) \
        acc[ai][bj][m][n] = __builtin_amdgcn_mfma_f32_16x16x32_bf16(Bt[n][k], At[m][k], acc[ai][bj][m][n], 0, 0, 0); __builtin_amdgcn_s_setprio(0); } while (0)
#define PG8_WAIT_V(n) asm volatile("s_waitcnt vmcnt(" #n ")" ::: "memory")
#define PG8_WAIT_L(n) asm volatile("s_waitcnt lgkmcnt(" #n ")" ::: "memory")
#define PG8_BAR __builtin_amdgcn_s_barrier()
#define PG8_SCHED __builtin_amdgcn_sched_barrier(0)
    Unit cur, nxt; int ui = 0;
    if (!S.next(0, cur)) return;
    f32x4 acc[2][2][4][2];
#pragma unroll
    for (int a = 0; a < 2; ++a)
#pragma unroll
        for (int b = 0; b < 2; ++b)
#pragma unroll
            for (int m = 0; m < 4; ++m)
#pragma unroll
                for (int n = 0; n < 2; ++n) acc[a][b][m][n] = (f32x4){0.f, 0.f, 0.f, 0.f};
    bf16x8 At[4][2], B0[2][2], B1[2][2];
    const char* cA = (const char*)g.A + (size_t)cur.pm * tstep; const char* cB = (const char*)g.Bt + (size_t)cur.pn * tstep;
    S.a_ready(cur);
    if constexpr (SP2) {
        PG8_STAGE(PG8_SB(0, 0), cB, voffB); PG8_STAGE(PG8_SB(0, 1), cB + hstep, voffB); PG8_STAGE(PG8_SA(0, 0), cA, voffA); PG8_STAGE(PG8_SA(0, 1), cA + hstep, voffA);
        if (wr == 1) PG8_BAR;
        PG8_WAIT_V(2); PG8_BAR;
        PG8_STAGE(PG8_SB(1, 0), cB + kstep, voffB); PG8_STAGE(PG8_SA(1, 0), cA + kstep, voffA); PG8_STAGE(PG8_SB(1, 1), cB + hstep + kstep, voffB);
        PG8_WAIT_V(6); PG8_BAR;
    } else {
        PG8_STAGE(PG8_SB(0, 0), cB, voffB); PG8_STAGE(PG8_SA(0, 0), cA, voffA); PG8_STAGE(PG8_SB(0, 1), cB + hstep, voffB); PG8_STAGE(PG8_SA(0, 1), cA + hstep, voffA);
        if (wr == 1) PG8_BAR;
        PG8_WAIT_V(4); PG8_BAR;
        PG8_STAGE(PG8_SB(1, 0), cB + kstep, voffB); PG8_STAGE(PG8_SA(1, 0), cA + kstep, voffA); PG8_STAGE(PG8_SB(1, 1), cB + hstep + kstep, voffB);
        PG8_WAIT_V(6); PG8_BAR;
    }
    for (;;) {
        const bool has_next = S.next(ui + 1, nxt);
        const char* nA = has_next ? (const char*)g.A + (size_t)nxt.pm * tstep : cA; const char* nB = has_next ? (const char*)g.Bt + (size_t)nxt.pn * tstep : cB;
        for (int t = 0; t < nt; t += 2) {
            const bool last = (t == nt - 2);
            const char* a1 = cA + (size_t)(t + 1) * kstep;
            const char* a2 = last ? nA : cA + (size_t)(t + 2) * kstep; const char* b2 = last ? nB : cB + (size_t)(t + 2) * kstep;
            const char* a3 = a2 + kstep; const char* b3 = b2 + kstep;
            if (last && has_next) S.a_ready(nxt);
            if constexpr (SP2) {
            PG8_LDB(B0, 0, 0); PG8_LDB(B1, 0, 1); PG8_SCHED; PG8_LDA(At, 0, 0); PG8_STAGE(PG8_SA(1, 1), a1 + hstep, voffA);
            PG8_WAIT_V(8); PG8_WAIT_L(0); PG8_BAR; PG8_MMA(0, 0, At, B0); PG8_MMA(0, 1, At, B1); PG8_BAR; PG8_SCHED;
            PG8_LDA(At, 0, 1); PG8_STAGE(PG8_SB(0, 0), b2, voffB); PG8_STAGE(PG8_SB(0, 1), b2 + hstep, voffB); PG8_STAGE(PG8_SA(0, 0), a2, voffA);
            PG8_WAIT_V(8); PG8_WAIT_L(0); PG8_BAR; PG8_MMA(1, 0, At, B0); PG8_MMA(1, 1, At, B1); PG8_BAR; PG8_SCHED;
            PG8_LDB(B0, 1, 0); PG8_LDB(B1, 1, 1); PG8_SCHED; PG8_LDA(At, 1, 0); PG8_STAGE(PG8_SA(0, 1), a2 + hstep, voffA);
            PG8_WAIT_V(8); PG8_WAIT_L(0); PG8_BAR; PG8_MMA(0, 0, At, B0); PG8_MMA(0, 1, At, B1); PG8_BAR; PG8_SCHED;
            PG8_LDA(At, 1, 1); PG8_STAGE(PG8_SB(1, 0), b3, voffB); PG8_STAGE(PG8_SB(1, 1), b3 + hstep, voffB); PG8_STAGE(PG8_SA(1, 0), a3, voffA);
            PG8_WAIT_V(8); PG8_WAIT_L(0); PG8_BAR; PG8_MMA(1, 0, At, B0); PG8_MMA(1, 1, At, B1); PG8_BAR; PG8_SCHED;
            } else {
            PG8_LDB(B0, 0, 0); PG8_SCHED; PG8_LDA(At, 0, 0); PG8_STAGE(PG8_SA(1, 1), a1 + hstep, voffA);
            PG8_WAIT_L(8); PG8_BAR; PG8_WAIT_L(0); PG8_MMA(0, 0, At, B0); PG8_BAR; PG8_SCHED;
            PG8_LDB(B1, 0, 1); PG8_STAGE(PG8_SB(0, 0), b2, voffB);
            PG8_BAR; PG8_WAIT_L(0); PG8_MMA(0, 1, At, B1); PG8_BAR;
            PG8_LDA(At, 0, 1); PG8_STAGE(PG8_SA(0, 0), a2, voffA);
            PG8_BAR; PG8_WAIT_L(0); PG8_MMA(1, 0, At, B0); PG8_BAR; PG8_SCHED;
            PG8_STAGE(PG8_SB(0, 1), b2 + hstep, voffB);
            PG8_WAIT_V(6); PG8_BAR; PG8_MMA(1, 1, At, B1); PG8_BAR;
            PG8_LDB(B0, 1, 0); PG8_SCHED; PG8_LDA(At, 1, 0); PG8_STAGE(PG8_SA(0, 1), a2 + hstep, voffA);
            PG8_WAIT_L(8); PG8_BAR; PG8_WAIT_L(0); PG8_MMA(0, 0, At, B0); PG8_BAR; PG8_SCHED;
            PG8_LDB(B1, 1, 1); PG8_STAGE(PG8_SB(1, 0), b3, voffB);
            PG8_BAR; PG8_WAIT_L(0); PG8_MMA(0, 1, At, B1); PG8_BAR;
            PG8_LDA(At, 1, 1); PG8_STAGE(PG8_SA(1, 0), a3, voffA);
            PG8_BAR; PG8_WAIT_L(0); PG8_MMA(1, 0, At, B0); PG8_BAR; PG8_SCHED;
            PG8_STAGE(PG8_SB(1, 1), b3 + hstep, voffB);
            PG8_WAIT_V(6); PG8_BAR; PG8_MMA(1, 1, At, B1); PG8_BAR;
            }
        }
        if constexpr (ALIGN_EPI) { if (wr == 0) PG8_BAR; }
        if constexpr (!Epi::AFTER_DRAIN) { E(acc, cur, wr, wc, fr, fq); S.done(cur); }
        if (!has_next) break;
#pragma unroll
        for (int a = 0; a < 2; ++a)
#pragma unroll
            for (int b = 0; b < 2; ++b)
#pragma unroll
                for (int m = 0; m < 4; ++m)
#pragma unroll
                    for (int n = 0; n < 2; ++n) acc[a][b][m][n] = (f32x4){0.f, 0.f, 0.f, 0.f};
        cur = nxt; cA = nA; cB = nB; ++ui;
        if constexpr (ALIGN_EPI) { if (wr == 1) PG8_BAR; }
    }
    PG8_WAIT_V(0);
    if constexpr (!ALIGN_EPI) { if (wr == 0) PG8_BAR; }
    PG8_BAR;
#undef PG8_SA
#undef PG8_SB
#undef PG8_STAGE
#undef PG8_LDA
#undef PG8_LDB
#undef PG8_MMA
#undef PG8_WAIT_V
#undef PG8_WAIT_L
#undef PG8_BAR
#undef PG8_SCHED
}
}

__device__ __forceinline__ unsigned f2bf(float f) { unsigned u = __builtin_bit_cast(unsigned, f); return (u + 0x7fffu + ((u >> 16) & 1u)) >> 16; }
__device__ __forceinline__ unsigned pk2(float lo, float hi) { return f2bf(lo) | (f2bf(hi) << 16); }
__device__ __forceinline__ float bf2f(unsigned short b) { return __builtin_bit_cast(float, (unsigned)b << 16); }
__device__ __forceinline__ float bflo(unsigned w) { return __builtin_bit_cast(float, w << 16); }
__device__ __forceinline__ float bfhi(unsigned w) { return __builtin_bit_cast(float, w & 0xffff0000u); }
__device__ __forceinline__ float fast_sigmoid(float x) { return __builtin_amdgcn_rcpf(1.0f + __builtin_amdgcn_exp2f(-1.4426950408889634f * x)); }
__device__ __forceinline__ float silu_f(float x) { return x * fast_sigmoid(x); }
__device__ __forceinline__ float gelu_tanh_f(float y) { return y * fast_sigmoid(1.5957691216057308f * (y + 0.044715f * y * y * y)); }
__device__ __forceinline__ float wave_sum(float v) {
#pragma unroll
    for (int o = 1; o < 64; o <<= 1) v += __shfl_xor(v, o);
    return v;
}
__device__ __forceinline__ void sincos_d(double a, double& s, double& c) {
    const double k = rint(a * 0.15915494309189535);
    const double r = fma(-k, 6.283185307179586, a), r2 = r * r;
    double ts = r, tc = 1.0; s = r; c = 1.0;
    for (int n = 1; n <= 13; ++n) { tc *= -r2 / (double)((2 * n - 1) * (2 * n)); c += tc; ts *= -r2 / (double)((2 * n) * (2 * n + 1)); s += ts; }
}

using pg8::Unit; using pg8::cvt_pk_bf16;
struct EpiSwiglu {
    static constexpr bool PERM = true, AFTER_DRAIN = false;
    bf16_t* O; int ldo; const u64_t* ssq;
    __device__ __forceinline__ void operator()(const f32x4 (&acc)[2][2][4][2], const Unit& u, int wr, int wc, int fr, int fq) const {
        const int row0 = u.pm * 256 + wr * 64 + fr, col0 = u.pn * 128 + wc * 32 + 8 * fq;
        float rsv[2][4];
#pragma unroll
        for (int ai = 0; ai < 2; ++ai)
#pragma unroll
            for (int m = 0; m < 4; ++m) rsv[ai][m] = (float)ssq[row0 + ai * 128 + m * 16] * SSQ_INV;
#pragma unroll
        for (int ai = 0; ai < 2; ++ai)
#pragma unroll
            for (int m = 0; m < 4; ++m) {
                const int row = row0 + ai * 128 + m * 16;
                const float rs = __builtin_amdgcn_rsqf(rsv[ai][m] * (1.0f / DM) + EPS);
                bf16_t* rowp = O + (size_t)row * ldo + col0;
                const f32x4 g0 = acc[ai][0][m][0] * rs, g1 = acc[ai][0][m][1] * rs, u0 = acc[ai][1][m][0] * rs, u1 = acc[ai][1][m][1] * rs;
                u32x4 w;
                w.x = cvt_pk_bf16(silu_f(g0[0]) * u0[0], silu_f(g0[1]) * u0[1]); w.y = cvt_pk_bf16(silu_f(g0[2]) * u0[2], silu_f(g0[3]) * u0[3]);
                w.z = cvt_pk_bf16(silu_f(g1[0]) * u1[0], silu_f(g1[1]) * u1[1]); w.w = cvt_pk_bf16(silu_f(g1[2]) * u1[2], silu_f(g1[3]) * u1[3]);
                *(u32x4*)rowp = w;
            }
    }
};
template <bool BASE_F32, bool OUT_F32, int SCALE> struct EpiResid {
    static constexpr bool PERM = false, AFTER_DRAIN = false;
    const float* basef; float* outf; bf16_t* xb; u64_t* ssq;
    __device__ __forceinline__ void operator()(const f32x4 (&acc)[2][2][4][2], const Unit& u, int wr, int wc, int fr, int fq) const {
        const int col0 = u.pn * 256 + wc * 32 + 4 * fq;
        constexpr float sc = (SCALE == 2 ? 0.0f : SCALE == 1 ? 0.5f : 1.0f);
#pragma unroll
        for (int ai = 0; ai < 2; ++ai) {
            f32x4 pre[4][2][2];
#pragma unroll
            for (int m = 0; m < 4; ++m) { const size_t off = (size_t)(u.pm * 256 + ai * 128 + wr * 64 + m * 16 + fr) * DM + col0;
#pragma unroll
                for (int bj = 0; bj < 2; ++bj)
#pragma unroll
                    for (int n = 0; n < 2; ++n) {
                        if constexpr (BASE_F32) pre[m][bj][n] = *(const f32x4*)(basef + off + bj * 128 + n * 16);
                        else { const u32x2 w = *(const u32x2*)(xb + off + bj * 128 + n * 16); pre[m][bj][n] = (f32x4){bflo(w.x), bfhi(w.x), bflo(w.y), bfhi(w.y)}; } } }
#pragma unroll
            for (int m = 0; m < 4; ++m) {
                const int row = u.pm * 256 + ai * 128 + wr * 64 + m * 16 + fr;
                const size_t off = (size_t)row * DM + col0;
                float sq = 0.f;
#pragma unroll
                for (int bj = 0; bj < 2; ++bj)
#pragma unroll
                    for (int n = 0; n < 2; ++n) { const f32x4 v = pre[m][bj][n] + acc[ai][bj][m][n] * sc;
                        if constexpr (OUT_F32) *(f32x4*)(outf + off + bj * 128 + n * 16) = v;
                        else { u32x2 w; w.x = cvt_pk_bf16(v[0], v[1]); w.y = cvt_pk_bf16(v[2], v[3]); *(u32x2*)(xb + off + bj * 128 + n * 16) = w;
                               sq += (v[0] * v[0] + v[1] * v[1]) + (v[2] * v[2] + v[3] * v[3]); } }
                if constexpr (!OUT_F32 && SCALE != 2) { sq += __shfl_xor(sq, 16); sq += __shfl_xor(sq, 32); if (fq == 0) atomicAdd(ssq + row, (u64_t)(sq * SSQ_FIX)); }
            }
        }
    }
};
struct EpiWin {
    static constexpr bool PERM = true, AFTER_DRAIN = false;
    bf16_t* O; const float* cs; const float* sn; const u64_t* ssq;
    __device__ __forceinline__ void operator()(const f32x4 (&acc)[2][2][4][2], const Unit& u, int wr, int wc, int fr, int fq) const {
        const int row0 = u.pm * 256 + wr * 64 + fr, col0 = u.pn * 256 + wc * 32 + 8 * fq;
        const bool rot = u.pn < 8;
        float rsv[2][4];
#pragma unroll
        for (int ai = 0; ai < 2; ++ai)
#pragma unroll
            for (int m = 0; m < 4; ++m) rsv[ai][m] = (float)ssq[row0 + ai * 128 + m * 16] * SSQ_INV;
#pragma unroll
        for (int ai = 0; ai < 2; ++ai) {
            f32x4 cc[4][2], sv[4][2];
#pragma unroll
            for (int m = 0; m < 4; ++m) {
                if (rot) { const int pos = (row0 + ai * 128 + m * 16) & (SEQ - 1);
                    const float* cp = cs + pos * 128 + wc * 32 + 8 * fq; const float* sp = sn + pos * 128 + wc * 32 + 8 * fq;
                    cc[m][0] = *(const f32x4*)cp; cc[m][1] = *(const f32x4*)(cp + 4); sv[m][0] = *(const f32x4*)sp; sv[m][1] = *(const f32x4*)(sp + 4); }
                else { cc[m][0] = cc[m][1] = (f32x4){1.f, 1.f, 1.f, 1.f}; sv[m][0] = sv[m][1] = (f32x4){0.f, 0.f, 0.f, 0.f}; }
            }
#pragma unroll
            for (int m = 0; m < 4; ++m) {
                const int row = row0 + ai * 128 + m * 16;
                const float rs = __builtin_amdgcn_rsqf(rsv[ai][m] * (1.0f / DM) + EPS);
                const f32x4 a0 = acc[ai][0][m][0] * rs, a1 = acc[ai][0][m][1] * rs, b0 = acc[ai][1][m][0] * rs, b1 = acc[ai][1][m][1] * rs;
                const f32x4 na0 = a0 * cc[m][0] - b0 * sv[m][0], nb0 = b0 * cc[m][0] + a0 * sv[m][0], na1 = a1 * cc[m][1] - b1 * sv[m][1], nb1 = b1 * cc[m][1] + a1 * sv[m][1];
                bf16_t* rowp = O + (size_t)row * PW + col0;
                u32x4 w; w.x = cvt_pk_bf16(na0[0], na0[1]); w.y = cvt_pk_bf16(na0[2], na0[3]); w.z = cvt_pk_bf16(na1[0], na1[1]); w.w = cvt_pk_bf16(na1[2], na1[3]);
                *(u32x4*)rowp = w;
                u32x4 v; v.x = cvt_pk_bf16(nb0[0], nb0[1]); v.y = cvt_pk_bf16(nb0[2], nb0[3]); v.z = cvt_pk_bf16(nb1[0], nb1[1]); v.w = cvt_pk_bf16(nb1[2], nb1[3]);
                *(u32x4*)(rowp + 128) = v;
            }
        }
    }
};
struct EpiQkv {
    static constexpr bool PERM = false, AFTER_DRAIN = false;
    bf16_t* O; const float* cs; const float* sn; const u64_t* ssq;
    __device__ __forceinline__ void operator()(const f32x4 (&acc)[2][2][4][2], const Unit& u, int wr, int wc, int fr, int fq) const {
        const int col0 = u.pn * 256 + wc * 32 + 4 * fq;
        const bool rot = (u.pn < 16) && (wc == 0);
        const float sc0 = (u.pn < 8) ? QSCALE : 1.0f;
        float rsv[2][4]; f32x4 cv[2][4], sv[2][4];
#pragma unroll
        for (int ai = 0; ai < 2; ++ai)
#pragma unroll
            for (int m = 0; m < 4; ++m) { const int row = u.pm * 256 + ai * 128 + wr * 64 + m * 16 + fr; rsv[ai][m] = (float)ssq[row] * SSQ_INV;
                if (rot) { const int pos = row & (SEQ - 1); cv[ai][m] = *(const f32x4*)(cs + pos * 16 + 4 * fq); sv[ai][m] = *(const f32x4*)(sn + pos * 16 + 4 * fq); }
                else { cv[ai][m] = (f32x4){1.f, 1.f, 1.f, 1.f}; sv[ai][m] = (f32x4){0.f, 0.f, 0.f, 0.f}; } }
#pragma unroll
        for (int ai = 0; ai < 2; ++ai)
#pragma unroll
            for (int m = 0; m < 4; ++m) {
                const int row = u.pm * 256 + ai * 128 + wr * 64 + m * 16 + fr;
                const float sc = sc0 * __builtin_amdgcn_rsqf(rsv[ai][m] * (1.0f / DM) + EPS);
                const f32x4 c = cv[ai][m], s = sv[ai][m];
#pragma unroll
                for (int bj = 0; bj < 2; ++bj) {
                    const f32x4 x0 = acc[ai][bj][m][0], x1 = acc[ai][bj][m][1];
                    const f32x4 n0 = (x0 * c - x1 * s) * sc, n1 = (x1 * c + x0 * s) * sc;
                    bf16_t* p = O + (size_t)row * QW + col0 + bj * 128;
                    u32x2 w0; w0.x = cvt_pk_bf16(n0[0], n0[1]); w0.y = cvt_pk_bf16(n0[2], n0[3]); *(u32x2*)p = w0;
                    u32x2 w1; w1.x = cvt_pk_bf16(n1[0], n1[1]); w1.y = cvt_pk_bf16(n1[2], n1[3]); *(u32x2*)(p + 16) = w1;
                }
            }
    }
};
struct EpiGlu {
    static constexpr bool PERM = true, AFTER_DRAIN = false;
    const bf16_t* Z; const float* bias; bf16_t* Y;
    __device__ __forceinline__ void operator()(const f32x4 (&acc)[2][2][4][2], const Unit& u, int wr, int wc, int fr, int fq) const {
        const int row0 = u.pm * 256 + wr * 64 + fr, col0 = u.pn * 256 + wc * 32 + 8 * fq;
#pragma unroll
        for (int bj = 0; bj < 2; ++bj) {
            const f32x4 bv0 = *(const f32x4*)(bias + col0 + bj * 128), bv1 = *(const f32x4*)(bias + col0 + bj * 128 + 4);
            u32x4 zz[2][4];
#pragma unroll
            for (int ai = 0; ai < 2; ++ai)
#pragma unroll
                for (int m = 0; m < 4; ++m) zz[ai][m] = *(const u32x4*)(Z + (size_t)(row0 + ai * 128 + m * 16) * 1024 + col0 + bj * 128);
#pragma unroll
            for (int ai = 0; ai < 2; ++ai)
#pragma unroll
                for (int m = 0; m < 4; ++m) {
                    const int row = row0 + ai * 128 + m * 16;
                    const u32x4 z4 = zz[ai][m];
                    const f32x4 v0 = acc[ai][bj][m][0] + bv0, v1 = acc[ai][bj][m][1] + bv1;
                    u32x4 w;
                    w.x = cvt_pk_bf16(bflo(z4.x) * fast_sigmoid(v0[0]), bfhi(z4.x) * fast_sigmoid(v0[1]));
                    w.y = cvt_pk_bf16(bflo(z4.y) * fast_sigmoid(v0[2]), bfhi(z4.y) * fast_sigmoid(v0[3]));
                    w.z = cvt_pk_bf16(bflo(z4.z) * fast_sigmoid(v1[0]), bfhi(z4.z) * fast_sigmoid(v1[1]));
                    w.w = cvt_pk_bf16(bflo(z4.w) * fast_sigmoid(v1[2]), bfhi(z4.w) * fast_sigmoid(v1[3]));
                    *(u32x4*)(Y + (size_t)row * DM + 1024 + col0 + bj * 128) = w;
                }
        }
    }
};

template <class Epi>
__device__ __forceinline__ void run_gemm(LAS unsigned char* lds, const bf16_t* A, const bf16_t* Bt, int M, int N, int K, const Epi E) {
    pg8::Gemm g{A, Bt, M, N, K}; pg8::StaticOrder S; S.init(M, N, (int)gridDim.x, (int)blockIdx.x);
    pg8::gemm_phase<Epi, pg8::StaticOrder, true, true>(lds, g, S, E);
}

__device__ __forceinline__ void conv_matrix(const float* __restrict__ W, bf16_t* __restrict__ WT, int K, int N, int mode, const float* __restrict__ gain, LAS float* scr, int gw, int NGW, int lane) {
    const int nblk = N / 64, nitems = (K / 64) * nblk;
    for (int item = gw; item < nitems; item += NGW) {
        const int kb = item / nblk, nb = item % nblk, k0 = 64 * kb, n0 = 64 * nb;
        const float gv = gain ? gain[k0 + lane] : 1.0f;
        const float* wp = W + (size_t)k0 * N + n0 + lane;
#pragma unroll
        for (int i = 0; i < 64; ++i) { const float v = wp[(size_t)i * N];
            scr[i * 65 + lane] = v * __builtin_bit_cast(float, __builtin_amdgcn_readlane(__builtin_bit_cast(int, gv), i)); }
        asm volatile("s_waitcnt lgkmcnt(0)" ::: "memory");
        const int c = lane & 7, ns = lane >> 3;
        const int rbase = (mode == 0) ? n0 : ((n0 >> 7) * 256 + (n0 & 127) + (mode == 2 ? 128 : 0));
#pragma unroll
        for (int j = 0; j < 8; ++j) { const int n = ns + 8 * j; const LAS float* sp = scr + (8 * c) * 65 + n;
            u32x4 o; o.x = pk2(sp[0 * 65], sp[1 * 65]); o.y = pk2(sp[2 * 65], sp[3 * 65]); o.z = pk2(sp[4 * 65], sp[5 * 65]); o.w = pk2(sp[6 * 65], sp[7 * 65]);
            *(u32x4*)(WT + (size_t)(rbase + n) * K + k0 + 8 * c) = o; }
        asm volatile("s_waitcnt lgkmcnt(0)" ::: "memory");
    }
}

template <bool TO_BF16>
__device__ __forceinline__ void rmsnorm_phase(const float* in, const float* __restrict__ g, bf16_t* outb, float* outf, int gw, int NGW, int lane) {
    f32x4 gv[8];
#pragma unroll
    for (int j = 0; j < 8; ++j) gv[j] = ((const f32x4*)g)[lane + 64 * j];
    for (int row = gw; row < TT; row += NGW) {
        const f32x4* xr = (const f32x4*)(in + (size_t)row * DM) + lane;
        f32x4 v[8]; float ss = 0.f;
#pragma unroll
        for (int j = 0; j < 8; ++j) { v[j] = xr[64 * j]; ss += (v[j][0] * v[j][0] + v[j][1] * v[j][1]) + (v[j][2] * v[j][2] + v[j][3] * v[j][3]); }
        const float rs = 1.0f / sqrtf(wave_sum(ss) * (1.0f / DM) + EPS);
#pragma unroll
        for (int j = 0; j < 8; ++j) {
            const f32x4 y = v[j] * rs * gv[j];
            if constexpr (TO_BF16) { u32x2 w; w.x = pk2(y[0], y[1]); w.y = pk2(y[2], y[3]); *((u32x2*)(outb + (size_t)row * DM) + lane + 64 * j) = w; }
            else { *((f32x4*)(outf + (size_t)row * DM) + lane + 64 * j) = y; }
        }
    }
}

__device__ __forceinline__ void cast_phase(const float* in, bf16_t* outb, u64_t* ssq, int gw, int NGW, int lane) {
    for (int row = gw; row < TT; row += NGW) {
        const f32x4* xr = (const f32x4*)(in + (size_t)row * DM) + lane;
        f32x4 v[8]; float ss = 0.f;
#pragma unroll
        for (int j = 0; j < 8; ++j) { v[j] = xr[64 * j]; ss += (v[j][0] * v[j][0] + v[j][1] * v[j][1]) + (v[j][2] * v[j][2] + v[j][3] * v[j][3]); }
        ss = wave_sum(ss);
        if (lane == 0) ssq[row] = (u64_t)(ss * SSQ_FIX);
#pragma unroll
        for (int j = 0; j < 8; ++j) { u32x2 w; w.x = pk2(v[j][0], v[j][1]); w.y = pk2(v[j][2], v[j][3]); *((u32x2*)(outb + (size_t)row * DM) + lane + 64 * j) = w; }
    }
}

__device__ __forceinline__ void tables_phase(unsigned char* ws, const float* const* in_unused, const float* lam_re, const float* lam_im, const float* log_step, const float* b_re, const float* b_im,
                                             const float* lq1, const float* lk1, const float* lq2, const float* lk2, int gtid, int NT_) {
    float* rcos = (float*)(ws + WS_RCOS); float* rsin = (float*)(ws + WS_RSIN); float* acos_ = (float*)(ws + WS_ACOS); float* asin_ = (float*)(ws + WS_ASIN);
    float* s5a = (float*)(ws + WS_S5A); float* s5bb = (float*)(ws + WS_S5BB);
    for (int i = gtid; i < SEQ * 128; i += NT_) {
        const int pos = i >> 7, f = i & 127;
        const float inv = (float)exp2(-((double)(2 * f) / 256.0) * 13.287712379549449);
        const float ang = (float)pos * inv; double s, c; sincos_d((double)ang, s, c); rcos[i] = (float)c; rsin[i] = (float)s;
    }
    for (int i = gtid; i < SEQ * 16; i += NT_) {
        const int pos = i >> 4, f = i & 15;
        const float inv = (float)exp2(-((double)(2 * f) / 32.0) * 18.931568569324174);
        const float ang = (float)pos * inv; double s, c; sincos_d((double)ang, s, c); acos_[i] = (float)c; asin_[i] = (float)s;
    }
    for (int i = gtid; i < 64 * 64; i += NT_) {
        const int g = i >> 6;
        const double step = exp((double)log_step[g]), lr = (double)lam_re[i], li = (double)lam_im[i];
        const double mag = exp(lr * step); double s, c; sincos_d(li * step, s, c);
        const double are = mag * c, aim = mag * s, den = lr * lr + li * li, nr = are - 1.0;
        const double fre = (nr * lr + aim * li) / den, fim = (aim * lr - nr * li) / den;
        s5a[2 * i] = (float)are; s5a[2 * i + 1] = (float)aim;
        for (int p = 0; p < 16; ++p) { const double br = (double)b_re[i * 16 + p], bi = (double)b_im[i * 16 + p];
            s5bb[(size_t)i * 32 + p] = (float)(fre * br - fim * bi); s5bb[(size_t)i * 32 + 16 + p] = (float)(fre * bi + fim * br); }
    }
    if (gtid == 0) { float s1 = 0.f, s2 = 0.f; for (int i = 0; i < 128; ++i) { s1 += lq1[i] * lk1[i]; s2 += lq2[i] * lk2[i]; }
        ((float*)(ws + WS_CTL))[0] = expf(s1) - expf(s2) + LAMBDA_INIT; }
}

__device__ __forceinline__ void s5_phase(LAS unsigned char* lds, const unsigned char* ws, const bf16_t* proj, const float* c_re, const float* c_im, const float* dskip, bf16_t* z,
                                         int vcu, int G, int wave, int lane) {
    if (wave >= 4) return;
    const float* s5a = (const float*)(ws + WS_S5A); const float* s5bb = (const float*)(ws + WS_S5BB);
    LAS bf16_t* Hc = (LAS bf16_t*)(lds + wave * 8704);
    const int fr = lane & 15, fq = lane >> 4;
    for (int seq = vcu * 4 + wave; seq < 1024; seq += G * 4) {
        const int b = seq >> 6, g = seq & 63, n = lane;
        float bbre[16], bbim[16];
#pragma unroll
        for (int p = 0; p < 16; ++p) { bbre[p] = s5bb[(size_t)(g * 64 + n) * 32 + p]; bbim[p] = s5bb[(size_t)(g * 64 + n) * 32 + 16 + p]; }
        const float are = s5a[2 * (g * 64 + n)], aim = s5a[2 * (g * 64 + n) + 1];
        bf16x8 cf[4];
#pragma unroll
        for (int ks = 0; ks < 4; ++ks) { u32x4 w; unsigned* wp = (unsigned*)&w;
#pragma unroll
            for (int j2 = 0; j2 < 4; ++j2) { float v[2];
#pragma unroll
                for (int e = 0; e < 2; ++e) { const int k = 32 * ks + 8 * fq + 2 * j2 + e; v[e] = (k < 64) ? c_re[(size_t)(g * 16 + fr) * 64 + k] : -c_im[(size_t)(g * 16 + fr) * 64 + (k - 64)]; }
                wp[j2] = pk2(v[0], v[1]); }
            cf[ks] = __builtin_bit_cast(bf16x8, w); }
        const float dsk = dskip[g * 16 + fr];
        float hre = 0.f, him = 0.f;
        for (int ch = 0; ch < SEQ / 32; ++ch) {
            const size_t row0 = (size_t)b * SEQ + ch * 32;
            const bf16_t* up = proj + (row0 + (lane & 31)) * PW + 4096 + g * 16;
            const u32x4 ua = *(const u32x4*)up, ub = *(const u32x4*)(up + 8);
            float uf[16];
            uf[0] = bflo(ua.x); uf[1] = bfhi(ua.x); uf[2] = bflo(ua.y); uf[3] = bfhi(ua.y); uf[4] = bflo(ua.z); uf[5] = bfhi(ua.z); uf[6] = bflo(ua.w); uf[7] = bfhi(ua.w);
            uf[8] = bflo(ub.x); uf[9] = bfhi(ub.x); uf[10] = bflo(ub.y); uf[11] = bfhi(ub.y); uf[12] = bflo(ub.z); uf[13] = bfhi(ub.z); uf[14] = bflo(ub.w); uf[15] = bfhi(ub.w);
#pragma unroll
            for (int k = 0; k < 32; ++k) {
                f32x2 xx = (f32x2){0.f, 0.f};
#pragma unroll
                for (int p = 0; p < 16; ++p) { const float su = __builtin_bit_cast(float, __builtin_amdgcn_readlane(__builtin_bit_cast(int, uf[p]), k));
                    xx = __builtin_elementwise_fma((f32x2){su, su}, (f32x2){bbre[p], bbim[p]}, xx); }
                const float nr = are * hre - aim * him + xx[0], ni = are * him + aim * hre + xx[1]; hre = nr; him = ni;
                Hc[k * 136 + n] = (bf16_t)f2bf(hre); Hc[k * 136 + 64 + n] = (bf16_t)f2bf(him);
            }
#pragma unroll
            for (int sb = 0; sb < 2; ++sb) {
                f32x4 y = (f32x4){0.f, 0.f, 0.f, 0.f};
#pragma unroll
                for (int ks = 0; ks < 4; ++ks) { const bf16x8 hf = *(const LAS bf16x8*)(Hc + (16 * sb + fr) * 136 + 32 * ks + 8 * fq); y = __builtin_amdgcn_mfma_f32_16x16x32_bf16(hf, cf[ks], y, 0, 0, 0); }
#pragma unroll
                for (int i = 0; i < 4; ++i) { const size_t row = row0 + 16 * sb + 4 * fq + i;
                    const float uu = bf2f(proj[row * PW + 4096 + g * 16 + fr]); const float yy = y[i] + dsk * uu;
                    z[row * 1024 + g * 16 + fr] = (bf16_t)f2bf(gelu_tanh_f(yy)); }
            }
        }
    }
}

#define MF32(a, b, c) __builtin_amdgcn_mfma_f32_32x32x16_bf16((a), (b), (c), 0, 0, 0)
#define AT_WAITV(n) asm volatile("s_waitcnt vmcnt(" #n ")" ::: "memory")
#define AT_BAR() asm volatile("s_waitcnt lgkmcnt(0)\n\ts_barrier" ::: "memory")
__device__ __forceinline__ s16x4 vtr(const LAS unsigned char* p) { typedef short v4i16_t __attribute__((ext_vector_type(4))); return __builtin_bit_cast(s16x4, __builtin_amdgcn_ds_read_tr16_b64_v4i16((LAS v4i16_t*)p)); }
__device__ __forceinline__ int crow(int i, int h) { return (i & 3) + 8 * (i >> 2) + 4 * h; }

template <int MODE>
__device__ __forceinline__ void attn_unit(LAS unsigned char* lds, const bf16_t* src, const int pitch, const int kcol, const int vcol, const int b, const int h, const int ub,
                                          bf16_t* outp, const bf16_t* gsrc, const float* subln, const float lam) {
    constexpr int NKS = MODE ? 8 : 16, NDB = 4, ROWS = MODE ? 64 : 128;
    const int tid = threadIdx.x, lane = tid & 63, r = lane & 31, hh = lane >> 5;
    const int wid = __builtin_amdgcn_readfirstlane(tid >> 6);
    const int rg = MODE ? (wid & 1) : (wid & 3), vh = MODE ? ((wid >> 1) & 1) : (wid >> 2), cc = MODE ? (wid >> 2) : 0;
    const size_t rowbase = (size_t)b * SEQ; const int q0 = ub * ROWS, NT = MODE ? (ub + 1) : (2 * ub + 2);
    const int qrow = q0 + rg * 32 + r;
    AT_WAITV(0);
#define AT_ISSUE(t, buf) do { const bf16_t* gk_ = src + (rowbase + (size_t)(t) * 64) * pitch; int rv_ = r; asm volatile("" : "+v"(rv_)); \
        _Pragma("unroll") for (int i_ = 0; i_ < 4; ++i_) { const int c_ = wid * 4 + i_; const int row_ = c_ * 2 + hh; \
            const unsigned ok_ = (unsigned)(row_ * pitch + kcol + ((rv_ ^ (row_ & 15)) << 3)); \
            __builtin_amdgcn_global_load_lds((const unsigned*)(gk_ + ok_), (LAS unsigned*)(lds + (buf) * 65536 + c_ * 1024), 16, 0, 0); \
            const unsigned ov_ = (unsigned)(row_ * pitch + vcol + ((rv_ ^ ((row_ & 3) << 2)) << 3)); \
            __builtin_amdgcn_global_load_lds((const unsigned*)(gk_ + ov_), (LAS unsigned*)(lds + (buf) * 65536 + 32768 + c_ * 1024), 16, 0, 0); } } while (0)
    AT_ISSUE(0, 0);
    bf16x8 qf[NKS];
    { const bf16_t* qp = src + (rowbase + qrow) * pitch + h * 256 + cc * 128 + 8 * hh;
#pragma unroll
      for (int d0 = 0; d0 < NKS; ++d0) qf[d0] = *(const bf16x8*)(qp + 16 * d0); }
    f32x16 O[NDB];
#pragma unroll
    for (int db = 0; db < NDB; ++db)
#pragma unroll
        for (int i = 0; i < 16; ++i) O[db][i] = 0.f;
    float mrun = -1e30f, lrun = 0.f;
    const float lgam = __builtin_log2f(1.0f - __builtin_amdgcn_exp2f(-5.0f - (float)h));
    const int r15 = r & 15;
    const int kunit0 = cc * 16;
    const int q4 = (lane & 15) >> 2, p4 = lane & 3, blk16 = (lane >> 4) & 1;
    const int vlane = (4 * hh + q4) * 512 + ((2 * blk16 + (p4 >> 1)) << 4) + 8 * (p4 & 1);
    for (int t = 0; t < NT; ++t) {
        if (t + 1 < NT) { AT_ISSUE(t + 1, (t + 1) & 1); AT_WAITV(8); } else { AT_WAITV(0); }
        AT_BAR();
        const bool active = MODE ? true : !(t == NT - 1 && rg < 2);
        if (active) {
            const LAS unsigned char* Kb = lds + (t & 1) * 65536; const LAS unsigned char* Vb = Kb + 32768;
            int r15v = r15 ^ hh ^ kunit0, q4v = q4 << 2; asm volatile("" : "+v"(r15v), "+v"(q4v));
            bf16x8 pf[4];
            if constexpr (MODE) {
                f32x16 p0, p1;
#pragma unroll
                for (int i = 0; i < 16; ++i) { p0[i] = 0.f; p1[i] = 0.f; }
                { const LAS unsigned char* kr0 = Kb + r * 512; const LAS unsigned char* kr1 = Kb + (32 + r) * 512;
#pragma unroll
                  for (int d0 = 0; d0 < NKS; ++d0) { const int uo = ((2 * d0) ^ r15v) << 4;
                      const bf16x8 k0 = *(const LAS bf16x8*)(kr0 + uo); const bf16x8 k1 = *(const LAS bf16x8*)(kr1 + uo);
                      p0 = MF32(k0, qf[d0], p0); p1 = MF32(k1, qf[d0], p1);
                      if ((d0 & 3) == 3) __builtin_amdgcn_sched_barrier(0); } }
                float rm = p0[0];
#pragma unroll
                for (int i = 0; i < 16; ++i) { rm = fmaxf(rm, p0[i]); rm = fmaxf(rm, p1[i]); }
                rm = fmaxf(rm, __shfl_xor(rm, 32));
                if (__any(rm > mrun + 8.0f)) {
                    const float mn = fmaxf(mrun, rm); const float al = __builtin_amdgcn_exp2f(mrun - mn); lrun *= al; mrun = mn;
#pragma unroll
                    for (int db = 0; db < NDB; ++db) O[db] = O[db] * al;
                }
                float sum = 0.f;
#pragma unroll
                for (int i = 0; i < 16; ++i) { p0[i] = __builtin_amdgcn_exp2f(p0[i] - mrun); p1[i] = __builtin_amdgcn_exp2f(p1[i] - mrun); sum += p0[i] + p1[i]; }
                lrun += sum;
                u32x4 w;
                w.x = cvt_pk_bf16(p0[0], p0[1]); w.y = cvt_pk_bf16(p0[2], p0[3]); w.z = cvt_pk_bf16(p0[4], p0[5]); w.w = cvt_pk_bf16(p0[6], p0[7]); pf[0] = __builtin_bit_cast(bf16x8, w);
                w.x = cvt_pk_bf16(p0[8], p0[9]); w.y = cvt_pk_bf16(p0[10], p0[11]); w.z = cvt_pk_bf16(p0[12], p0[13]); w.w = cvt_pk_bf16(p0[14], p0[15]); pf[1] = __builtin_bit_cast(bf16x8, w);
                w.x = cvt_pk_bf16(p1[0], p1[1]); w.y = cvt_pk_bf16(p1[2], p1[3]); w.z = cvt_pk_bf16(p1[4], p1[5]); w.w = cvt_pk_bf16(p1[6], p1[7]); pf[2] = __builtin_bit_cast(bf16x8, w);
                w.x = cvt_pk_bf16(p1[8], p1[9]); w.y = cvt_pk_bf16(p1[10], p1[11]); w.z = cvt_pk_bf16(p1[12], p1[13]); w.w = cvt_pk_bf16(p1[14], p1[15]); pf[3] = __builtin_bit_cast(bf16x8, w);
            } else {
#pragma unroll
                for (int blk = 0; blk < 2; ++blk) {
                    f32x16 p;
#pragma unroll
                    for (int i = 0; i < 16; ++i) p[i] = 0.f;
                    const LAS unsigned char* kr = Kb + (32 * blk + r) * 512;
#pragma unroll
                    for (int d0 = 0; d0 < NKS; ++d0) { const int uo = ((2 * d0) ^ r15v) << 4;
                        const bf16x8 k0 = *(const LAS bf16x8*)(kr + uo); p = MF32(k0, qf[d0], p);
                        if ((d0 & 3) == 3) __builtin_amdgcn_sched_barrier(0); }
                    const int kb = t * 64 + 32 * blk + 4 * hh;
#pragma unroll
                    for (int i = 0; i < 16; ++i) { const int kv = kb + (i & 3) + 8 * (i >> 2);
                        p[i] *= __builtin_amdgcn_exp2f(lgam * fabsf((float)(qrow - kv)) - 4.0f); }
                    u32x4 w;
                    w.x = cvt_pk_bf16(p[0], p[1]); w.y = cvt_pk_bf16(p[2], p[3]); w.z = cvt_pk_bf16(p[4], p[5]); w.w = cvt_pk_bf16(p[6], p[7]); pf[2 * blk] = __builtin_bit_cast(bf16x8, w);
                    w.x = cvt_pk_bf16(p[8], p[9]); w.y = cvt_pk_bf16(p[10], p[11]); w.z = cvt_pk_bf16(p[12], p[13]); w.w = cvt_pk_bf16(p[14], p[15]); pf[2 * blk + 1] = __builtin_bit_cast(bf16x8, w);
                    __builtin_amdgcn_sched_barrier(0);
                }
            }
            const LAS unsigned char* vb = Vb + vlane;
            __builtin_amdgcn_sched_barrier(0);
#pragma unroll
            for (int db = 0; db < NDB; ++db) {
                const int dunit = vh * 16 + 4 * db;
                const LAS unsigned char* vp = vb + ((dunit ^ q4v) << 4);
#pragma unroll
                for (int ks = 0; ks < 4; ++ks) {
                    const int kvb = 32 * (ks >> 1) + 16 * (ks & 1);
                    const s16x4 lo = vtr(vp + kvb * 512), hi = vtr(vp + (kvb + 8) * 512);
                    const bf16x8 vf = __builtin_shufflevector(lo, hi, 0, 1, 2, 3, 4, 5, 6, 7);
                    O[db] = MF32(vf, pf[ks], O[db]);
                }
                __builtin_amdgcn_sched_barrier(0);
            }
        }
        AT_BAR();
    }
    const size_t orow = rowbase + qrow;
    LAS float* SS = (LAS float*)(lds + 131072);
    if constexpr (MODE) {
        const float l = lrun + __shfl_xor(lrun, 32); const float inv = 1.0f / l;
        LAS float* X = (LAS float*)(lds + (wid & 3) * 16384);
        if (cc == 1) {
#pragma unroll
            for (int db = 0; db < NDB; ++db)
#pragma unroll
                for (int i = 0; i < 16; ++i) X[(db * 16 + i) * 64 + lane] = O[db][i] * inv;
        }
        AT_BAR();
        float ss = 0.f;
        if (cc == 0) {
#pragma unroll
            for (int db = 0; db < NDB; ++db)
#pragma unroll
                for (int i = 0; i < 16; ++i) { const float o = O[db][i] * inv - lam * X[(db * 16 + i) * 64 + lane]; O[db][i] = o; ss += o * o; }
        }
        ss += __shfl_xor(ss, 32);
        if (hh == 0) SS[wid * 32 + r] = ss;
        AT_BAR();
        if (cc == 0) {
            ss += SS[(wid ^ 2) * 32 + r];
            const float rs = (1.0f - LAMBDA_INIT) / sqrtf(ss * (1.0f / 256.0f) + EPS);
            bf16_t* op = outp + orow * DM + h * 256 + vh * 128 + 4 * hh;
            const float* slp = subln + vh * 128 + 4 * hh;
#pragma unroll
            for (int db = 0; db < NDB; ++db)
#pragma unroll
                for (int i4 = 0; i4 < 4; ++i4) { const int d = 32 * db + 8 * i4;
                    const f32x4 sl = *(const f32x4*)(slp + d);
                    u32x2 w; w.x = cvt_pk_bf16(O[db][4 * i4] * rs * sl[0], O[db][4 * i4 + 1] * rs * sl[1]); w.y = cvt_pk_bf16(O[db][4 * i4 + 2] * rs * sl[2], O[db][4 * i4 + 3] * rs * sl[3]);
                    *(u32x2*)(op + d) = w; }
        }
        AT_BAR();
    } else {
        float ss = 0.f;
#pragma unroll
        for (int db = 0; db < NDB; ++db)
#pragma unroll
            for (int i = 0; i < 16; ++i) ss += O[db][i] * O[db][i];
        ss += __shfl_xor(ss, 32);
        if (hh == 0) SS[wid * 32 + r] = ss;
        AT_BAR();
        ss += SS[(wid ^ 4) * 32 + r];
        const float rs = 1.0f / sqrtf(ss * (1.0f / 256.0f) + EPS);
        const bf16_t* gp = gsrc + orow * PW + 3072 + h * 256 + vh * 128 + 4 * hh;
        bf16_t* op = outp + orow * DM + h * 256 + vh * 128 + 4 * hh;
#pragma unroll
        for (int db = 0; db < NDB; ++db)
#pragma unroll
            for (int i4 = 0; i4 < 4; ++i4) { const int d = 32 * db + 8 * i4;
                const u32x2 gg = *(const u32x2*)(gp + d);
                u32x2 w; w.x = cvt_pk_bf16(O[db][4 * i4] * rs * silu_f(bflo(gg.x)), O[db][4 * i4 + 1] * rs * silu_f(bfhi(gg.x)));
                w.y = cvt_pk_bf16(O[db][4 * i4 + 2] * rs * silu_f(bflo(gg.y)), O[db][4 * i4 + 3] * rs * silu_f(bfhi(gg.y)));
                *(u32x2*)(op + d) = w; }
        AT_BAR();
    }
#undef AT_ISSUE
}

template <int MODE>
__device__ __forceinline__ void attn_phase(LAS unsigned char* lds, const bf16_t* src, int pitch, int kcol0, int vcol0, int nheads, bf16_t* outp, const bf16_t* gsrc, const float* subln, float lam, int vcu, int G) {
    constexpr int NU = MODE ? 32 : 16;
    const int npairs = 16 * nheads * (NU / 2);
    for (int pr = vcu; pr < npairs; pr += G) {
        const int bh = pr / (NU / 2), p = pr % (NU / 2), b = bh / nheads, h = bh % nheads;
        attn_unit<MODE>(lds, src, pitch, kcol0 + h * 256, vcol0 + h * 256, b, h, NU - 1 - p, outp, gsrc, subln, lam);
        attn_unit<MODE>(lds, src, pitch, kcol0 + h * 256, vcol0 + h * 256, b, h, p, outp, gsrc, subln, lam);
    }
}

#define XB_TMO      128
#define XB_XCNT(j)  (256  + 64 * (j))
#define XB_XSUB(j)  (1280 + 64 * (j))
#define XB_XGEN(j)  (2304 + 64 * (j))
#define XB_TOP      3328
#define XB_TOPGEN   3392
#define XCD_BAR_WORDS 3456
#define XB_SPIN_CAP (1u << 18)
__device__ __forceinline__ unsigned xb_ld(unsigned* p)              { return __hip_atomic_load(p, __ATOMIC_RELAXED, __HIP_MEMORY_SCOPE_AGENT); }
__device__ __forceinline__ unsigned xb_add(unsigned* p, unsigned v) { return __hip_atomic_fetch_add(p, v, __ATOMIC_RELAXED, __HIP_MEMORY_SCOPE_AGENT); }
__device__ __forceinline__ unsigned xb_xcc_id() { return (unsigned)__builtin_amdgcn_s_getreg((3 << 11) | 20) & 0xFu; }
#define XB_SPIN(cond, bar) do { unsigned _sp = 0; while (cond) { __builtin_amdgcn_s_sleep(1); \
    if ((++_sp & 255u) == 0u) { if (xb_ld(&(bar)[XB_TMO])) break; if (_sp > XB_SPIN_CAP) { atomicAdd(&(bar)[XB_TMO], 1u); break; } } } } while (0)
struct XcdBarrier { unsigned* bar; unsigned x; volatile LAS unsigned* st; };
__device__ __forceinline__ XcdBarrier xcd_barrier_post(unsigned* bar, volatile LAS unsigned* st) {
    XcdBarrier b; b.bar = bar; b.x = xb_xcc_id(); b.st = st;
    if (threadIdx.x == 0) (void)xb_add(&bar[XB_XCNT(b.x)], 1u);
    return b;
}
__device__ __forceinline__ void xcd_barrier_complete(unsigned* bar, unsigned x, unsigned& nloc, unsigned& nx) {
    const unsigned G = gridDim.x * gridDim.y * gridDim.z;
    unsigned sum, cnt, mine, sp = 0u;
    for (;;) {
        sum = 0u; cnt = 0u; mine = 0u;
#pragma unroll
        for (unsigned j = 0; j < 16; ++j) { const unsigned c = xb_ld(&bar[XB_XCNT(j)]); sum += c; cnt += (c > 0u) ? 1u : 0u; mine = (j == x) ? c : mine; }
        if (sum == G) break;
        __builtin_amdgcn_s_sleep(1);
        if ((++sp & 255u) == 0u) { if (xb_ld(&bar[XB_TMO])) break; if (sp > XB_SPIN_CAP) { atomicAdd(&bar[XB_TMO], 1u); break; } }
    }
    nloc = mine > 0u ? mine : 1u; nx = cnt > 0u ? cnt : 1u;
}
__device__ __forceinline__ void xcd_barrier(const XcdBarrier& b) {
    asm volatile("s_waitcnt vmcnt(0)" ::: "memory");
    __syncthreads();
    if (threadIdx.x == 0) {
        unsigned* bar = b.bar;
        __builtin_amdgcn_s_waitcnt(0);
        unsigned nloc = b.st[0], nx = b.st[1];
        if (nloc == 0u) { xcd_barrier_complete(bar, b.x, nloc, nx); b.st[0] = nloc; b.st[1] = nx; }
        const unsigned old = xb_add(&bar[XB_XSUB(b.x)], 1u);
        const unsigned gen = old / nloc;
        if (old + 1u == (gen + 1u) * nloc) {
            __builtin_amdgcn_fence(__ATOMIC_RELEASE, "agent");
            asm volatile("s_waitcnt vmcnt(0)" ::: "memory");
            const unsigned og = xb_add(&bar[XB_TOP], 1u);
            const unsigned tg = og / nx;
            if (og + 1u == (tg + 1u) * nx) xb_add(&bar[XB_TOPGEN], 1u);
            else XB_SPIN(xb_ld(&bar[XB_TOPGEN]) == tg, bar);
            __builtin_amdgcn_fence(__ATOMIC_ACQUIRE, "agent");
            xb_add(&bar[XB_XGEN(b.x)], 1u);
            asm volatile("s_waitcnt vmcnt(0)" ::: "memory");
        } else {
            XB_SPIN(xb_ld(&bar[XB_XGEN(b.x)]) == gen, bar);
            __builtin_amdgcn_fence(__ATOMIC_ACQUIRE, "agent");
            asm volatile("s_waitcnt vmcnt(0)" ::: "memory");
        }
    }
    __syncthreads();
}

struct Params { const float* in[26]; float* out; unsigned char* ws; int lo, hi; };
constexpr int NPHASE = 17;

__global__ void __launch_bounds__(512) fwd_megakernel(Params P) {
    extern __shared__ __attribute__((aligned(16))) unsigned char lds_raw[];
    LAS unsigned char* lds = (LAS unsigned char*)lds_raw;
    const int tid = threadIdx.x, lane = tid & 63, wave = __builtin_amdgcn_readfirstlane(tid >> 6);
    const int G = gridDim.x, bx = blockIdx.x;
    const int vcu = (G % 8 == 0) ? (bx % 8) * (G / 8) + bx / 8 : bx;
    const int gw = vcu * 8 + wave, NGW = G * 8;
    unsigned char* ws = P.ws;
    float* out = P.out;
    bf16_t* Wgu = (bf16_t*)(ws + WS_WGU); bf16_t* Wd = (bf16_t*)(ws + WS_WD); bf16_t* Win = (bf16_t*)(ws + WS_WIN); bf16_t* Wout = (bf16_t*)(ws + WS_WOUT);
    bf16_t* Wglu = (bf16_t*)(ws + WS_WGLU); bf16_t* Wqkv = (bf16_t*)(ws + WS_WQKV); bf16_t* Wco = (bf16_t*)(ws + WS_WCO);
    bf16_t* XN = (bf16_t*)(ws + WS_XN); bf16_t* BIG = (bf16_t*)(ws + WS_BIG); bf16_t* ZB = (bf16_t*)(ws + WS_Z);
    const float* x = P.in[0]; const float* ffn_norm = P.in[1]; const float* mix_norm = P.in[5];
#if MK_PER_PHASE
#define SYNC(k) do { } while (0)
#else
    cg::grid_group grid = cg::this_grid();
    { volatile LAS unsigned* st0 = (volatile LAS unsigned*)(lds + 139264); if (tid < 2) st0[tid] = 0u; }
    __syncthreads();
    const XcdBarrier xbar = xcd_barrier_post((unsigned*)(ws + WS_BAR), (volatile LAS unsigned*)(lds + 139264));
#define SYNC(k) do { if (P.lo <= (k) && (k) + 1 < P.hi) { if ((k) == 0) grid.sync(); else xcd_barrier(xbar); } } while (0)
#endif
#ifndef DUPMASK
#define DUPMASK 0u
#endif
#define IN(k) (P.lo <= (k) && (k) < P.hi)
#define REP(k) for (int rep_ = 0; rep_ < (((DUPMASK >> (k)) & 1u) ? 2 : 1); ++rep_)

    u64_t* SSQ = (u64_t*)(ws + WS_SSQ);
    bf16_t* YC = (bf16_t*)(ws + WS_YC);
    const float* rcos = (const float*)(ws + WS_RCOS); const float* rsin = (const float*)(ws + WS_RSIN);
    const float* acos_ = (const float*)(ws + WS_ACOS); const float* asin_ = (const float*)(ws + WS_ASIN);
    if (IN(0)) REP(0) {
        LAS float* scr = (LAS float*)(lds + wave * 16640);
        const size_t gsz = (size_t)DM * DFF;
#pragma unroll 1
        for (int i = 0; i < 4; ++i) {
            conv_matrix(P.in[2] + i * gsz, Wgu + (size_t)i * NGU * DM, DM, DFF, 1, ffn_norm + i * DM, scr, gw, NGW, lane);
            conv_matrix(P.in[3] + i * gsz, Wgu + (size_t)i * NGU * DM, DM, DFF, 2, ffn_norm + i * DM, scr, gw, NGW, lane);
            conv_matrix(P.in[4] + i * gsz, Wd + (size_t)i * DM * DFF, DFF, DM, 0, nullptr, scr, gw, NGW, lane);
        }
        conv_matrix(P.in[6], Win, DM, PW, 0, mix_norm, scr, gw, NGW, lane);
        conv_matrix(P.in[7], Wout, DM, DM, 0, nullptr, scr, gw, NGW, lane);
        conv_matrix(P.in[16], Wglu, 1024, 1024, 0, nullptr, scr, gw, NGW, lane);
        conv_matrix(P.in[18], Wqkv, DM, QW, 0, mix_norm + DM, scr, gw, NGW, lane);
        conv_matrix(P.in[19], Wco, DM, DM, 0, nullptr, scr, gw, NGW, lane);
        tables_phase(ws, nullptr, P.in[8], P.in[9], P.in[10], P.in[11], P.in[12], P.in[20], P.in[21], P.in[22], P.in[23], vcu * 512 + tid, G * 512);
        for (int i = vcu * 512 + tid; i < 5 * TT; i += G * 512) SSQ[TT + i] = 0ull;
        cast_phase(x, XN, SSQ, gw, NGW, lane);
    }
    SYNC(0);
#if !MK_PER_PHASE
    if ((DUPMASK >> 20) & 1u) { for (int q_ = 0; q_ < 32; ++q_) grid.sync(); }
#endif
    if (IN(1)) { run_gemm(lds, XN, Wgu, TT, NGU, DM, EpiSwiglu{BIG, DFF, SSQ}); if ((DUPMASK >> 1) & 1u) { run_gemm(lds, XN, Wgu, TT, NGU, DM, EpiSwiglu{BIG, DFF, SSQ}); } }
    SYNC(1);
    if (IN(2)) run_gemm(lds, BIG, Wd, TT, DM, DFF, EpiResid<true, false, 1>{x, nullptr, XN, SSQ + 1 * TT});
    if (IN(2) && ((DUPMASK >> 2) & 1u)) run_gemm(lds, BIG, Wd, TT, DM, DFF, EpiResid<false, false, 2>{nullptr, nullptr, XN, nullptr});
    SYNC(2);
    if (IN(3)) { run_gemm(lds, XN, Win, TT, PW, DM, EpiWin{BIG, rcos, rsin, SSQ + 1 * TT}); if ((DUPMASK >> 3) & 1u) { run_gemm(lds, XN, Win, TT, PW, DM, EpiWin{BIG, rcos, rsin, SSQ + 1 * TT}); } }
    SYNC(3);
    if (IN(4)) REP(4) {
#ifndef NO_A0
        attn_phase<0>(lds, BIG, PW, 1024, 2048, 4, YC, BIG, nullptr, 0.f, vcu, G);
#endif
#ifndef NO_S5
        s5_phase(lds, ws, BIG, P.in[13], P.in[14], P.in[15], ZB, vcu, G, wave, lane);
#endif
    }
    SYNC(4);
    if (IN(5)) run_gemm(lds, ZB, Wglu, TT, 1024, 1024, EpiGlu{ZB, P.in[17], YC});
    SYNC(5);
    if (IN(6)) run_gemm(lds, YC, Wout, TT, DM, DM, EpiResid<false, false, 0>{nullptr, nullptr, XN, SSQ + 2 * TT});
    if (IN(6) && ((DUPMASK >> 6) & 1u)) run_gemm(lds, YC, Wout, TT, DM, DM, EpiResid<false, false, 2>{nullptr, nullptr, XN, nullptr});
    SYNC(6);
    if (IN(7)) { run_gemm(lds, XN, Wgu + (size_t)1 * NGU * DM, TT, NGU, DM, EpiSwiglu{BIG, DFF, SSQ + 2 * TT}); if ((DUPMASK >> 7) & 1u) { run_gemm(lds, XN, Wgu + (size_t)1 * NGU * DM, TT, NGU, DM, EpiSwiglu{BIG, DFF, SSQ + 2 * TT}); } }
    SYNC(7);
    if (IN(8)) run_gemm(lds, BIG, Wd + (size_t)1 * DM * DFF, TT, DM, DFF, EpiResid<false, false, 1>{nullptr, nullptr, XN, SSQ + 3 * TT});
    if (IN(8) && ((DUPMASK >> 8) & 1u)) run_gemm(lds, BIG, Wd + (size_t)1 * DM * DFF, TT, DM, DFF, EpiResid<false, false, 2>{nullptr, nullptr, XN, nullptr});
    SYNC(8);
    if (IN(9)) { run_gemm(lds, XN, Wgu + (size_t)2 * NGU * DM, TT, NGU, DM, EpiSwiglu{BIG, DFF, SSQ + 3 * TT}); if ((DUPMASK >> 9) & 1u) { run_gemm(lds, XN, Wgu + (size_t)2 * NGU * DM, TT, NGU, DM, EpiSwiglu{BIG, DFF, SSQ + 3 * TT}); } }
    SYNC(9);
    if (IN(10)) run_gemm(lds, BIG, Wd + (size_t)2 * DM * DFF, TT, DM, DFF, EpiResid<false, false, 1>{nullptr, nullptr, XN, SSQ + 4 * TT});
    if (IN(10) && ((DUPMASK >> 10) & 1u)) run_gemm(lds, BIG, Wd + (size_t)2 * DM * DFF, TT, DM, DFF, EpiResid<false, false, 2>{nullptr, nullptr, XN, nullptr});
    SYNC(10);
    if (IN(11)) { run_gemm(lds, XN, Wqkv, TT, QW, DM, EpiQkv{BIG, acos_, asin_, SSQ + 4 * TT}); if ((DUPMASK >> 11) & 1u) { run_gemm(lds, XN, Wqkv, TT, QW, DM, EpiQkv{BIG, acos_, asin_, SSQ + 4 * TT}); } }
    SYNC(11);
#ifndef NO_A1
    if (IN(12)) REP(12) { const float lam = ((const float*)(ws + WS_CTL))[0]; attn_phase<1>(lds, BIG, QW, 2048, 4096, 8, YC, nullptr, P.in[24], lam, vcu, G); }
#endif
    SYNC(12);
    if (IN(13)) run_gemm(lds, YC, Wco, TT, DM, DM, EpiResid<false, false, 0>{nullptr, nullptr, XN, SSQ + 5 * TT});
    if (IN(13) && ((DUPMASK >> 13) & 1u)) run_gemm(lds, YC, Wco, TT, DM, DM, EpiResid<false, false, 2>{nullptr, nullptr, XN, nullptr});
    SYNC(13);
    if (IN(14)) { run_gemm(lds, XN, Wgu + (size_t)3 * NGU * DM, TT, NGU, DM, EpiSwiglu{BIG, DFF, SSQ + 5 * TT}); if ((DUPMASK >> 14) & 1u) { run_gemm(lds, XN, Wgu + (size_t)3 * NGU * DM, TT, NGU, DM, EpiSwiglu{BIG, DFF, SSQ + 5 * TT}); } }
    SYNC(14);
    if (IN(15)) run_gemm(lds, BIG, Wd + (size_t)3 * DM * DFF, TT, DM, DFF, EpiResid<false, true, 1>{nullptr, out, XN, nullptr});
    if (IN(15) && ((DUPMASK >> 15) & 1u)) run_gemm(lds, BIG, Wd + (size_t)3 * DM * DFF, TT, DM, DFF, EpiResid<false, false, 2>{nullptr, nullptr, XN, nullptr});
    SYNC(15);
    if (IN(16)) rmsnorm_phase<false>(out, P.in[25], nullptr, out, gw, NGW, lane);
#undef IN
#undef SYNC
}

extern "C" void kernel_launch(void* const* d_in, const int* in_sizes, int n_in, void* d_out, int out_size, void* d_ws, size_t ws_size, hipStream_t stream) {
    static int grid = 0;
    if (grid == 0) {
        if (n_in != 26 || out_size != TT * DM || ws_size < WS_END) { fprintf(stderr, "kernel_launch: unexpected shapes (n_in %d, out %d, ws %zu < %zu)\n", n_in, out_size, ws_size, (size_t)WS_END); grid = -1; return; }
        int dev = 0, cus = 0, per_cu = 0;
        hipGetDevice(&dev); hipDeviceGetAttribute(&cus, hipDeviceAttributeMultiprocessorCount, dev);
        if (hipFuncSetAttribute((const void*)fwd_megakernel, hipFuncAttributeMaxDynamicSharedMemorySize, LDS_BYTES) != hipSuccess) { fprintf(stderr, "kernel_launch: hipFuncSetAttribute failed\n"); grid = -1; return; }
        if (hipOccupancyMaxActiveBlocksPerMultiprocessor(&per_cu, (const void*)fwd_megakernel, 512, LDS_BYTES) != hipSuccess || per_cu < 1) { fprintf(stderr, "kernel_launch: occupancy query says %d\n", per_cu); per_cu = 1; }
        (void)hipGetLastError();
        grid = cus * per_cu;
        fprintf(stderr, "kernel_launch: grid %d (cus %d x %d)\n", grid, cus, per_cu);
    }
    if (grid < 0) return;
    if (hipMemsetAsync((char*)d_ws + WS_BAR, 0, BAR_BYTES, stream) != hipSuccess) { fprintf(stderr, "kernel_launch: hipMemsetAsync failed\n"); return; }
    Params p{};
    for (int i = 0; i < 26; ++i) p.in[i] = (const float*)d_in[i];
    p.out = (float*)d_out; p.ws = (unsigned char*)d_ws;
#if MK_PER_PHASE
    for (int k = 0; k < NPHASE; ++k) { p.lo = k; p.hi = k + 1; hipLaunchKernelGGL(fwd_megakernel, dim3(grid), dim3(512), LDS_BYTES, stream, p); }
#else
    p.lo = 0; p.hi = NPHASE;
    void* args[] = {&p};
    hipError_t e = hipLaunchCooperativeKernel((const void*)fwd_megakernel, dim3(grid), dim3(512), args, LDS_BYTES, stream);
    if (e != hipSuccess) fprintf(stderr, "cooperative launch failed: %s (grid %d)\n", hipGetErrorString(e), grid);
#endif
}
```

```cpp
#include <hip/hip_runtime.h>
#include <hip/hip_cooperative_groups.h>
#include <cstdio>
#include <cstdint>
namespace cg = cooperative_groups;

#define LAS __attribute__((address_space(3)))
typedef unsigned short bf16_t;
typedef unsigned long long u64_t;
constexpr float SSQ_FIX = 16777216.0f, SSQ_INV = 1.0f / 16777216.0f;
typedef short bf16x8 __attribute__((ext_vector_type(8)));
typedef short s16x4 __attribute__((ext_vector_type(4)));
typedef float f32x4 __attribute__((ext_vector_type(4)));
typedef float f32x2 __attribute__((ext_vector_type(2)));
typedef float f32x16 __attribute__((ext_vector_type(16)));
typedef unsigned u32x4 __attribute__((ext_vector_type(4)));
typedef unsigned u32x2 __attribute__((ext_vector_type(2)));

#ifndef MK_PER_PHASE
#define MK_PER_PHASE 0
#endif

constexpr int TT = 32768, SEQ = 2048, DM = 2048, DFF = 5504, NGU = 2 * DFF;
constexpr int PW = 5120, QW = 6144;
constexpr float EPS = 1e-6f;
constexpr float LAMBDA_INIT = 0.35550906759f;
constexpr float QSCALE = 0.08838834764831845f * 1.4426950408889634f;

constexpr size_t MiB = 1u << 20;
constexpr size_t WS_CTL = 0, WS_BAR = 4096, BAR_BYTES = 16384;
constexpr size_t WS_RCOS = 1 * MiB, WS_RSIN = 2 * MiB, WS_ACOS = 3 * MiB, WS_ASIN = 3 * MiB + 128 * 1024, WS_S5A = 3 * MiB + 512 * 1024, WS_S5BB = 4 * MiB;
constexpr size_t WS_W = 8 * MiB;
constexpr size_t SZ_WGU = (size_t)NGU * DM * 2, SZ_WD = (size_t)DM * DFF * 2;
constexpr size_t WS_WGU = WS_W, WS_WD = WS_WGU + 4 * SZ_WGU, WS_WIN = WS_WD + 4 * SZ_WD, WS_WOUT = WS_WIN + (size_t)PW * DM * 2,
                 WS_WGLU = WS_WOUT + (size_t)DM * DM * 2, WS_WQKV = WS_WGLU + (size_t)1024 * 1024 * 2, WS_WCO = WS_WQKV + (size_t)QW * DM * 2,
                 WS_WEND = WS_WCO + (size_t)DM * DM * 2;
constexpr size_t WS_XN = 328 * MiB;
constexpr size_t WS_BIG = 456 * MiB;
constexpr size_t WS_Z = WS_BIG + (size_t)TT * PW * 2;
constexpr size_t WS_YC = WS_BIG + (size_t)TT * QW * 2;
constexpr size_t WS_END = WS_YC + (size_t)TT * DM * 2;
constexpr size_t WS_SSQ = 5 * MiB;
static_assert(WS_WEND <= WS_XN && WS_XN + (size_t)TT * DM * 2 <= WS_BIG && WS_Z + (size_t)TT * 1024 * 2 <= WS_END, "ws map");

constexpr int LDS_BYTES = 147456;

namespace pg8 {
constexpr int BM = 256, BK = 64, HALF = 128, HTB = HALF * BK * 2, STAGE_BYTES = 8 * HTB, NXCD = 8, WGM = 8;
__host__ __device__ __forceinline__ int lds_byte(int r, int c) { const int st = (r >> 4) * 2 + (c >> 5), rr = r & 15, cc = c & 31, ob = rr * 64 + cc * 2; return st * 1024 + (ob ^ (((ob >> 9) & 1) << 5)); }
__host__ __device__ __forceinline__ void stage_rc(int b, int& R, int& C) { const int st = b / 1024, sb = b % 1024, swz = sb ^ (((sb >> 9) & 1) << 5); R = (st >> 1) * 16 + swz / 64; C = (st & 1) * 32 + (swz % 64) / 2; }
__host__ __device__ __forceinline__ int perm32(int rho) { const int n = rho >> 4, i = rho & 15; return 8 * (i >> 2) + 4 * n + (i & 3); }
struct Unit { int pm, pn; };
struct Gemm { const bf16_t* A; const bf16_t* Bt; int M, N, K; };
struct StaticOrder {
    int nM, nN, nwg, G, c;
    __host__ __device__ void init(int M, int N, int G_, int c_) { nM = M / BM; nN = N / BM; nwg = nM * nN; G = G_; c = c_; }
    __host__ __device__ bool next(int i, Unit& u) const {
        const long L = (long)i * G + c; if (L >= nwg) return false;
        int wgid = (int)L; { const int q = nwg / NXCD, r = nwg % NXCD, xcd = wgid % NXCD, off = wgid / NXCD; wgid = (xcd < r ? xcd * (q + 1) : r * (q + 1) + (xcd - r) * q) + off; }
        const int nig = WGM * nN, gid = wgid / nig, fm = gid * WGM, gsz = (nM - fm) < WGM ? (nM - fm) : WGM;
        u.pm = fm + ((wgid % nig) % gsz); u.pn = (wgid % nig) / gsz; return true;
    }
    __device__ __forceinline__ void a_ready(const Unit&) const {}
    __device__ __forceinline__ void done(const Unit&) const {}
};
__device__ __forceinline__ unsigned cvt_pk_bf16(float lo, float hi) { unsigned r; asm volatile("v_cvt_pk_bf16_f32 %0, %1, %2" : "=v"(r) : "v"(lo), "v"(hi)); return r; }

template <class Epi, class Sched, bool ALIGN_EPI = false, bool SP2 = false>
__device__ __forceinline__ void gemm_phase(LAS unsigned char* lds, const Gemm g, const Sched S, const Epi E) {
    const int tid = threadIdx.x, wid = __builtin_amdgcn_readfirstlane(tid >> 6), lane = tid & 63, wr = wid >> 2, wc = wid & 3, fr = lane & 15, fq = lane >> 4;
    const int K = g.K, nt = K / BK;
    unsigned voffA[2], voffB[2];
#pragma unroll
    for (int i = 0; i < 2; ++i) { int R, C; stage_rc(tid * 16 + i * 8192, R, C); const int Rb = Epi::PERM ? ((R & ~31) + perm32(R & 31)) : R;
        voffA[i] = (unsigned)(R * K + C) * 2u; voffB[i] = (unsigned)(Rb * K + C) * 2u; }
    const size_t kstep = (size_t)(BK * 2);
    const size_t hstep = (size_t)HALF * K * 2;
    const size_t tstep = 2 * hstep;
    const unsigned ldsw = (unsigned)wid * 1024u;
    const int aoff = lds_byte(wr * 64 + fr, fq * 8), boff = lds_byte(wc * 32 + fr, fq * 8);
#define PG8_SA(b, h) (((b) * 2 + (h)) * HTB)
#define PG8_SB(b, h) ((4 + (b) * 2 + (h)) * HTB)
#define PG8_STAGE(bufoff, gbase, voff) do { _Pragma("unroll") for (int _i = 0; _i < 2; ++_i) \
        __builtin_amdgcn_global_load_lds((const unsigned*)((const char*)(gbase) + (voff)[_i]), (LAS unsigned*)(lds + (bufoff) + ldsw + _i * 8192), 16, 0, 0); } while (0)
#define PG8_LDA(dst, b, h) do { _Pragma("unroll") for (int m = 0; m < 4; ++m) _Pragma("unroll") for (int k = 0; k < 2; ++k) dst[m][k] = *(const LAS bf16x8*)(lds + PG8_SA(b, h) + aoff + m * 2048 + k * 1024); } while (0)
#define PG8_LDB(dst, b, h) do { _Pragma("unroll") for (int n = 0; n < 2; ++n) _Pragma("unroll") for (int k = 0; k < 2; ++k) dst[n][k] = *(const LAS bf16x8*)(lds + PG8_SB(b, h) + boff + n * 2048 + k * 1024); } while (0)
#define PG8_MMA(ai, bj, At, Bt) do { __builtin_amdgcn_s_setprio(1); _Pragma("unroll") for (int m = 0; m < 4; ++m) _Pragma("unroll") for (int n = 0; n < 2; ++n) _Pragma("unroll") for (int k = 0; k < 2; ++k) \
        acc[ai][bj][m][n] = __builtin_amdgcn_mfma_f32_16x16x32_bf16(Bt[n][k], At[m][k], acc[ai][bj][m][n], 0, 0, 0); __builtin_amdgcn_s_setprio(0); } while (0)
#define PG8_WAIT_V(n) asm volatile("s_waitcnt vmcnt(" #n ")" ::: "memory")
#define PG8_WAIT_L(n) asm volatile("s_waitcnt lgkmcnt(" #n ")" ::: "memory")
#define PG8_BAR __builtin_amdgcn_s_barrier()
#define PG8_SCHED __builtin_amdgcn_sched_barrier(0)
    Unit cur, nxt; int ui = 0;
    if (!S.next(0, cur)) return;
    f32x4 acc[2][2][4][2];
#pragma unroll
    for (int a = 0; a < 2; ++a)
#pragma unroll
        for (int b = 0; b < 2; ++b)
#pragma unroll
            for (int m = 0; m < 4; ++m)
#pragma unroll
                for (int n = 0; n < 2; ++n) acc[a][b][m][n] = (f32x4){0.f, 0.f, 0.f, 0.f};
    bf16x8 At[4][2], B0[2][2], B1[2][2];
    const char* cA = (const char*)g.A + (size_t)cur.pm * tstep; const char* cB = (const char*)g.Bt + (size_t)cur.pn * tstep;
    S.a_ready(cur);
    if constexpr (SP2) {
        PG8_STAGE(PG8_SB(0, 0), cB, voffB); PG8_STAGE(PG8_SB(0, 1), cB + hstep, voffB); PG8_STAGE(PG8_SA(0, 0), cA, voffA); PG8_STAGE(PG8_SA(0, 1), cA + hstep, voffA);
        if (wr == 1) PG8_BAR;
        PG8_WAIT_V(2); PG8_BAR;
        PG8_STAGE(PG8_SB(1, 0), cB + kstep, voffB); PG8_STAGE(PG8_SA(1, 0), cA + kstep, voffA); PG8_STAGE(PG8_SB(1, 1), cB + hstep + kstep, voffB);
        PG8_WAIT_V(6); PG8_BAR;
    } else {
        PG8_STAGE(PG8_SB(0, 0), cB, voffB); PG8_STAGE(PG8_SA(0, 0), cA, voffA); PG8_STAGE(PG8_SB(0, 1), cB + hstep, voffB); PG8_STAGE(PG8_SA(0, 1), cA + hstep, voffA);
        if (wr == 1) PG8_BAR;
        PG8_WAIT_V(4); PG8_BAR;
        PG8_STAGE(PG8_SB(1, 0), cB + kstep, voffB); PG8_STAGE(PG8_SA(1, 0), cA + kstep, voffA); PG8_STAGE(PG8_SB(1, 1), cB + hstep + kstep, voffB);
        PG8_WAIT_V(6); PG8_BAR;
    }
    for (;;) {
        const bool has_next = S.next(ui + 1, nxt);
        const char* nA = has_next ? (const char*)g.A + (size_t)nxt.pm * tstep : cA; const char* nB = has_next ? (const char*)g.Bt + (size_t)nxt.pn * tstep : cB;
        for (int t = 0; t < nt; t += 2) {
            const bool last = (t == nt - 2);
            const char* a1 = cA + (size_t)(t + 1) * kstep;
            const char* a2 = last ? nA : cA + (size_t)(t + 2) * kstep; const char* b2 = last ? nB : cB + (size_t)(t + 2) * kstep;
            const char* a3 = a2 + kstep; const char* b3 = b2 + kstep;
            if (last && has_next) S.a_ready(nxt);
            if constexpr (SP2) {
            PG8_LDB(B0, 0, 0); PG8_LDB(B1, 0, 1); PG8_SCHED; PG8_LDA(At, 0, 0); PG8_STAGE(PG8_SA(1, 1), a1 + hstep, voffA);
            PG8_WAIT_V(8); PG8_WAIT_L(0); PG8_BAR; PG8_MMA(0, 0, At, B0); PG8_MMA(0, 1, At, B1); PG8_BAR; PG8_SCHED;
            PG8_LDA(At, 0, 1); PG8_STAGE(PG8_SB(0, 0), b2, voffB); PG8_STAGE(PG8_SB(0, 1), b2 + hstep, voffB); PG8_STAGE(PG8_SA(0, 0), a2, voffA);
            PG8_WAIT_V(8); PG8_WAIT_L(0); PG8_BAR; PG8_MMA(1, 0, At, B0); PG8_MMA(1, 1, At, B1); PG8_BAR; PG8_SCHED;
            PG8_LDB(B0, 1, 0); PG8_LDB(B1, 1, 1); PG8_SCHED; PG8_LDA(At, 1, 0); PG8_STAGE(PG8_SA(0, 1), a2 + hstep, voffA);
            PG8_WAIT_V(8); PG8_WAIT_L(0); PG8_BAR; PG8_MMA(0, 0, At, B0); PG8_MMA(0, 1, At, B1); PG8_BAR; PG8_SCHED;
            PG8_LDA(At, 1, 1); PG8_STAGE(PG8_SB(1, 0), b3, voffB); PG8_STAGE(PG8_SB(1, 1), b3 + hstep, voffB); PG8_STAGE(PG8_SA(1, 0), a3, voffA);
            PG8_WAIT_V(8); PG8_WAIT_L(0); PG8_BAR; PG8_MMA(1, 0, At, B0); PG8_MMA(1, 1, At, B1); PG8_BAR; PG8_SCHED;
            } else {
            PG8_LDB(B0, 0, 0); PG8_SCHED; PG8_LDA(At, 0, 0); PG8_STAGE(PG8_SA(1, 1), a1 + hstep, voffA);
            PG8_WAIT_L(8); PG8_BAR; PG8_WAIT_L(0); PG8_MMA(0, 0, At, B0); PG8_BAR; PG8_SCHED;
            PG8_LDB(B1, 0, 1); PG8_STAGE(PG8_SB(0, 0), b2, voffB);
            PG8_BAR; PG8_WAIT_L(0); PG8_MMA(0, 1, At, B1); PG8_BAR;
            PG8_LDA(At, 0, 1); PG8_STAGE(PG8_SA(0, 0), a2, voffA);
            PG8_BAR; PG8_WAIT_L(0); PG8_MMA(1, 0, At, B0); PG8_BAR; PG8_SCHED;
            PG8_STAGE(PG8_SB(0, 1), b2 + hstep, voffB);
            PG8_WAIT_V(6); PG8_BAR; PG8_MMA(1, 1, At, B1); PG8_BAR;
            PG8_LDB(B0, 1, 0); PG8_SCHED; PG8_LDA(At, 1, 0); PG8_STAGE(PG8_SA(0, 1), a2 + hstep, voffA);
            PG8_WAIT_L(8); PG8_BAR; PG8_WAIT_L(0); PG8_MMA(0, 0, At, B0); PG8_BAR; PG8_SCHED;
            PG8_LDB(B1, 1, 1); PG8_STAGE(PG8_SB(1, 0), b3, voffB);
            PG8_BAR; PG8_WAIT_L(0); PG8_MMA(0, 1, At, B1); PG8_BAR;
            PG8_LDA(At, 1, 1); PG8_STAGE(PG8_SA(1, 0), a3, voffA);
            PG8_BAR; PG8_WAIT_L(0); PG8_MMA(1, 0, At, B0); PG8_BAR; PG8_SCHED;
            PG8_STAGE(PG8_SB(1, 1), b3 + hstep, voffB);
            PG8_WAIT_V(6); PG8_BAR; PG8_MMA(1, 1, At, B1); PG8_BAR;
            }
        }
        if constexpr (ALIGN_EPI) { if (wr == 0) PG8_BAR; }
        if constexpr (!Epi::AFTER_DRAIN) { E(acc, cur, wr, wc, fr, fq); S.done(cur); }
        if (!has_next) break;
#pragma unroll
        for (int a = 0; a < 2; ++a)
#pragma unroll
            for (int b = 0; b < 2; ++b)
#pragma unroll
                for (int m = 0; m < 4; ++m)
#pragma unroll
                    for (int n = 0; n < 2; ++n) acc[a][b][m][n] = (f32x4){0.f, 0.f, 0.f, 0.f};
        cur = nxt; cA = nA; cB = nB; ++ui;
        if constexpr (ALIGN_EPI) { if (wr == 1) PG8_BAR; }
    }
    PG8_WAIT_V(0);
    if constexpr (!ALIGN_EPI) { if (wr == 0) PG8_BAR; }
    PG8_BAR;
#undef PG8_SA
#undef PG8_SB
#undef PG8_STAGE
#undef PG8_LDA
#undef PG8_LDB
#undef PG8_MMA
#undef PG8_WAIT_V
#undef PG8_WAIT_L
#undef PG8_BAR
#undef PG8_SCHED
}
}

__device__ __forceinline__ unsigned f2bf(float f) { unsigned u = __builtin_bit_cast(unsigned, f); return (u + 0x7fffu + ((u >> 16) & 1u)) >> 16; }
__device__ __forceinline__ unsigned pk2(float lo, float hi) { return f2bf(lo) | (f2bf(hi) << 16); }
__device__ __forceinline__ float bf2f(unsigned short b) { return __builtin_bit_cast(float, (unsigned)b << 16); }
__device__ __forceinline__ float bflo(unsigned w) { return __builtin_bit_cast(float, w << 16); }
__device__ __forceinline__ float bfhi(unsigned w) { return __builtin_bit_cast(float, w & 0xffff0000u); }
__device__ __forceinline__ float fast_sigmoid(float x) { return __builtin_amdgcn_rcpf(1.0f + __builtin_amdgcn_exp2f(-1.4426950408889634f * x)); }
__device__ __forceinline__ float silu_f(float x) { return x * fast_sigmoid(x); }
__device__ __forceinline__ float gelu_tanh_f(float y) { return y * fast_sigmoid(1.5957691216057308f * (y + 0.044715f * y * y * y)); }
__device__ __forceinline__ float wave_sum(float v) {
#pragma unroll
    for (int o = 1; o < 64; o <<= 1) v += __shfl_xor(v, o);
    return v;
}
__device__ __forceinline__ void sincos_d(double a, double& s, double& c) {
    const double k = rint(a * 0.15915494309189535);
    const double r = fma(-k, 6.283185307179586, a), r2 = r * r;
    double ts = r, tc = 1.0; s = r; c = 1.0;
    for (int n = 1; n <= 13; ++n) { tc *= -r2 / (double)((2 * n - 1) * (2 * n)); c += tc; ts *= -r2 / (double)((2 * n) * (2 * n + 1)); s += ts; }
}

using pg8::Unit; using pg8::cvt_pk_bf16;
struct EpiSwiglu {
    static constexpr bool PERM = true, AFTER_DRAIN = false;
    bf16_t* O; int ldo; const u64_t* ssq;
    __device__ __forceinline__ void operator()(const f32x4 (&acc)[2][2][4][2], const Unit& u, int wr, int wc, int fr, int fq) const {
        const int row0 = u.pm * 256 + wr * 64 + fr, col0 = u.pn * 128 + wc * 32 + 8 * fq;
        float rsv[2][4];
#pragma unroll
        for (int ai = 0; ai < 2; ++ai)
#pragma unroll
            for (int m = 0; m < 4; ++m) rsv[ai][m] = (float)ssq[row0 + ai * 128 + m * 16] * SSQ_INV;
#pragma unroll
        for (int ai = 0; ai < 2; ++ai)
#pragma unroll
            for (int m = 0; m < 4; ++m) {
                const int row = row0 + ai * 128 + m * 16;
                const float rs = __builtin_amdgcn_rsqf(rsv[ai][m] * (1.0f / DM) + EPS);
                bf16_t* rowp = O + (size_t)row * ldo + col0;
                const f32x4 g0 = acc[ai][0][m][0] * rs, g1 = acc[ai][0][m][1] * rs, u0 = acc[ai][1][m][0] * rs, u1 = acc[ai][1][m][1] * rs;
                u32x4 w;
                w.x = cvt_pk_bf16(silu_f(g0[0]) * u0[0], silu_f(g0[1]) * u0[1]); w.y = cvt_pk_bf16(silu_f(g0[2]) * u0[2], silu_f(g0[3]) * u0[3]);
                w.z = cvt_pk_bf16(silu_f(g1[0]) * u1[0], silu_f(g1[1]) * u1[1]); w.w = cvt_pk_bf16(silu_f(g1[2]) * u1[2], silu_f(g1[3]) * u1[3]);
                *(u32x4*)rowp = w;
            }
    }
};
template <bool BASE_F32, bool OUT_F32, int SCALE> struct EpiResid {
    static constexpr bool PERM = false, AFTER_DRAIN = false;
    const float* basef; float* outf; bf16_t* xb; u64_t* ssq;
    __device__ __forceinline__ void operator()(const f32x4 (&acc)[2][2][4][2], const Unit& u, int wr, int wc, int fr, int fq) const {
        const int col0 = u.pn * 256 + wc * 32 + 4 * fq;
        constexpr float sc = (SCALE == 2 ? 0.0f : SCALE == 1 ? 0.5f : 1.0f);
#pragma unroll
        for (int ai = 0; ai < 2; ++ai) {
            f32x4 pre[4][2][2];
#pragma unroll
            for (int m = 0; m < 4; ++m) { const size_t off = (size_t)(u.pm * 256 + ai * 128 + wr * 64 + m * 16 + fr) * DM + col0;
#pragma unroll
                for (int bj = 0; bj < 2; ++bj)
#pragma unroll
                    for (int n = 0; n < 2; ++n) {
                        if constexpr (BASE_F32) pre[m][bj][n] = *(const f32x4*)(basef + off + bj * 128 + n * 16);
                        else { const u32x2 w = *(const u32x2*)(xb + off + bj * 128 + n * 16); pre[m][bj][n] = (f32x4){bflo(w.x), bfhi(w.x), bflo(w.y), bfhi(w.y)}; } } }
#pragma unroll
            for (int m = 0; m < 4; ++m) {
                const int row = u.pm * 256 + ai * 128 + wr * 64 + m * 16 + fr;
                const size_t off = (size_t)row * DM + col0;
                float sq = 0.f;
#pragma unroll
                for (int bj = 0; bj < 2; ++bj)
#pragma unroll
                    for (int n = 0; n < 2; ++n) { const f32x4 v = pre[m][bj][n] + acc[ai][bj][m][n] * sc;
                        if constexpr (OUT_F32) *(f32x4*)(outf + off + bj * 128 + n * 16) = v;
                        else { u32x2 w; w.x = cvt_pk_bf16(v[0], v[1]); w.y = cvt_pk_bf16(v[2], v[3]); *(u32x2*)(xb + off + bj * 128 + n * 16) = w;
                               sq += (v[0] * v[0] + v[1] * v[1]) + (v[2] * v[2] + v[3] * v[3]); } }
                if constexpr (!OUT_F32 && SCALE != 2) { sq += __shfl_xor(sq, 16); sq += __shfl_xor(sq, 32); if (fq == 0) atomicAdd(ssq + row, (u64_t)(sq * SSQ_FIX)); }
            }
        }
    }
};
struct EpiWin {
    static constexpr bool PERM = true, AFTER_DRAIN = false;
    bf16_t* O; const float* cs; const float* sn; const u64_t* ssq;
    __device__ __forceinline__ void operator()(const f32x4 (&acc)[2][2][4][2], const Unit& u, int wr, int wc, int fr, int fq) const {
        const int row0 = u.pm * 256 + wr * 64 + fr, col0 = u.pn * 256 + wc * 32 + 8 * fq;
        const bool rot = u.pn < 8;
        float rsv[2][4];
#pragma unroll
        for (int ai = 0; ai < 2; ++ai)
#pragma unroll
            for (int m = 0; m < 4; ++m) rsv[ai][m] = (float)ssq[row0 + ai * 128 + m * 16] * SSQ_INV;
#pragma unroll
        for (int ai = 0; ai < 2; ++ai) {
            f32x4 cc[4][2], sv[4][2];
#pragma unroll
            for (int m = 0; m < 4; ++m) {
                if (rot) { const int pos = (row0 + ai * 128 + m * 16) & (SEQ - 1);
                    const float* cp = cs + pos * 128 + wc * 32 + 8 * fq; const float* sp = sn + pos * 128 + wc * 32 + 8 * fq;
                    cc[m][0] = *(const f32x4*)cp; cc[m][1] = *(const f32x4*)(cp + 4); sv[m][0] = *(const f32x4*)sp; sv[m][1] = *(const f32x4*)(sp + 4); }
                else { cc[m][0] = cc[m][1] = (f32x4){1.f, 1.f, 1.f, 1.f}; sv[m][0] = sv[m][1] = (f32x4){0.f, 0.f, 0.f, 0.f}; }
            }
#pragma unroll
            for (int m = 0; m < 4; ++m) {
                const int row = row0 + ai * 128 + m * 16;
                const float rs = __builtin_amdgcn_rsqf(rsv[ai][m] * (1.0f / DM) + EPS);
                const f32x4 a0 = acc[ai][0][m][0] * rs, a1 = acc[ai][0][m][1] * rs, b0 = acc[ai][1][m][0] * rs, b1 = acc[ai][1][m][1] * rs;
                const f32x4 na0 = a0 * cc[m][0] - b0 * sv[m][0], nb0 = b0 * cc[m][0] + a0 * sv[m][0], na1 = a1 * cc[m][1] - b1 * sv[m][1], nb1 = b1 * cc[m][1] + a1 * sv[m][1];
                bf16_t* rowp = O + (size_t)row * PW + col0;
                u32x4 w; w.x = cvt_pk_bf16(na0[0], na0[1]); w.y = cvt_pk_bf16(na0[2], na0[3]); w.z = cvt_pk_bf16(na1[0], na1[1]); w.w = cvt_pk_bf16(na1[2], na1[3]);
                *(u32x4*)rowp = w;
                u32x4 v; v.x = cvt_pk_bf16(nb0[0], nb0[1]); v.y = cvt_pk_bf16(nb0[2], nb0[3]); v.z = cvt_pk_bf16(nb1[0], nb1[1]); v.w = cvt_pk_bf16(nb1[2], nb1[3]);
                *(u32x4*)(rowp + 128) = v;
            }
        }
    }
};
struct EpiQkv {
    static constexpr bool PERM = false, AFTER_DRAIN = false;
    bf16_t* O; const float* cs; const float* sn; const u64_t* ssq;
    __device__ __forceinline__ void operator()(const f32x4 (&acc)[2][2][4][2], const Unit& u, int wr, int wc, int fr, int fq) const {
        const int col0 = u.pn * 256 + wc * 32 + 4 * fq;
        const bool rot = (u.pn < 16) && (wc == 0);
        const float sc0 = (u.pn < 8) ? QSCALE : 1.0f;
        float rsv[2][4]; f32x4 cv[2][4], sv[2][4];
#pragma unroll
        for (int ai = 0; ai < 2; ++ai)
#pragma unroll
            for (int m = 0; m < 4; ++m) { const int row = u.pm * 256 + ai * 128 + wr * 64 + m * 16 + fr; rsv[ai][m] = (float)ssq[row] * SSQ_INV;
                if (rot) { const int pos = row & (SEQ - 1); cv[ai][m] = *(const f32x4*)(cs + pos * 16 + 4 * fq); sv[ai][m] = *(const f32x4*)(sn + pos * 16 + 4 * fq); }
                else { cv[ai][m] = (f32x4){1.f, 1.f, 1.f, 1.f}; sv[ai][m] = (f32x4){0.f, 0.f, 0.f, 0.f}; } }
#pragma unroll
        for (int ai = 0; ai < 2; ++ai)
#pragma unroll
            for (int m = 0; m < 4; ++m) {
                const int row = u.pm * 256 + ai * 128 + wr * 64 + m * 16 + fr;
                const float sc = sc0 * __builtin_amdgcn_rsqf(rsv[ai][m] * (1.0f / DM) + EPS);
                const f32x4 c = cv[ai][m], s = sv[ai][m];
#pragma unroll
                for (int bj = 0; bj < 2; ++bj) {
                    const f32x4 x0 = acc[ai][bj][m][0], x1 = acc[ai][bj][m][1];
                    const f32x4 n0 = (x0 * c - x1 * s) * sc, n1 = (x1 * c + x0 * s) * sc;
                    bf16_t* p = O + (size_t)row * QW + col0 + bj * 128;
                    u32x2 w0; w0.x = cvt_pk_bf16(n0[0], n0[1]); w0.y = cvt_pk_bf16(n0[2], n0[3]); *(u32x2*)p = w0;
                    u32x2 w1; w1.x = cvt_pk_bf16(n1[0], n1[1]); w1.y = cvt_pk_bf16(n1[2], n1[3]); *(u32x2*)(p + 16) = w1;
                }
            }
    }
};
struct EpiGlu {
    static constexpr bool PERM = true, AFTER_DRAIN = false;
    const bf16_t* Z; const float* bias; bf16_t* Y;
    __device__ __forceinline__ void operator()(const f32x4 (&acc)[2][2][4][2], const Unit& u, int wr, int wc, int fr, int fq) const {
        const int row0 = u.pm * 256 + wr * 64 + fr, col0 = u.pn * 256 + wc * 32 + 8 * fq;
#pragma unroll
        for (int bj = 0; bj < 2; ++bj) {
            const f32x4 bv0 = *(const f32x4*)(bias + col0 + bj * 128), bv1 = *(const f32x4*)(bias + col0 + bj * 128 + 4);
            u32x4 zz[2][4];
#pragma unroll
            for (int ai = 0; ai < 2; ++ai)
#pragma unroll
                for (int m = 0; m < 4; ++m) zz[ai][m] = *(const u32x4*)(Z + (size_t)(row0 + ai * 128 + m * 16) * 1024 + col0 + bj * 128);
#pragma unroll
            for (int ai = 0; ai < 2; ++ai)
#pragma unroll
                for (int m = 0; m < 4; ++m) {
                    const int row = row0 + ai * 128 + m * 16;
                    const u32x4 z4 = zz[ai][m];
                    const f32x4 v0 = acc[ai][bj][m][0] + bv0, v1 = acc[ai][bj][m][1] + bv1;
                    u32x4 w;
                    w.x = cvt_pk_bf16(bflo(z4.x) * fast_sigmoid(v0[0]), bfhi(z4.x) * fast_sigmoid(v0[1]));
                    w.y = cvt_pk_bf16(bflo(z4.y) * fast_sigmoid(v0[2]), bfhi(z4.y) * fast_sigmoid(v0[3]));
                    w.z = cvt_pk_bf16(bflo(z4.z) * fast_sigmoid(v1[0]), bfhi(z4.z) * fast_sigmoid(v1[1]));
                    w.w = cvt_pk_bf16(bflo(z4.w) * fast_sigmoid(v1[2]), bfhi(z4.w) * fast_sigmoid(v1[3]));
                    *(u32x4*)(Y + (size_t)row * DM + 1024 + col0 + bj * 128) = w;
                }
        }
    }
};

template <class Epi>
__device__ __forceinline__ void run_gemm(LAS unsigned char* lds, const bf16_t* A, const bf16_t* Bt, int M, int N, int K, const Epi E) {
    pg8::Gemm g{A, Bt, M, N, K}; pg8::StaticOrder S; S.init(M, N, (int)gridDim.x, (int)blockIdx.x);
    pg8::gemm_phase<Epi, pg8::StaticOrder, true, true>(lds, g, S, E);
}

__device__ __forceinline__ void conv_matrix(const float* __restrict__ W, bf16_t* __restrict__ WT, int K, int N, int mode, const float* __restrict__ gain, LAS float* scr, int gw, int NGW, int lane) {
    const int nblk = N / 64, nitems = (K / 64) * nblk;
    for (int item = gw; item < nitems; item += NGW) {
        const int kb = item / nblk, nb = item % nblk, k0 = 64 * kb, n0 = 64 * nb;
        const float gv = gain ? gain[k0 + lane] : 1.0f;
        const float* wp = W + (size_t)k0 * N + n0 + lane;
#pragma unroll
        for (int i = 0; i < 64; ++i) { const float v = wp[(size_t)i * N];
            scr[i * 65 + lane] = v * __builtin_bit_cast(float, __builtin_amdgcn_readlane(__builtin_bit_cast(int, gv), i)); }
        asm volatile("s_waitcnt lgkmcnt(0)" ::: "memory");
        const int c = lane & 7, ns = lane >> 3;
        const int rbase = (mode == 0) ? n0 : ((n0 >> 7) * 256 + (n0 & 127) + (mode == 2 ? 128 : 0));
#pragma unroll
        for (int j = 0; j < 8; ++j) { const int n = ns + 8 * j; const LAS float* sp = scr + (8 * c) * 65 + n;
            u32x4 o; o.x = pk2(sp[0 * 65], sp[1 * 65]); o.y = pk2(sp[2 * 65], sp[3 * 65]); o.z = pk2(sp[4 * 65], sp[5 * 65]); o.w = pk2(sp[6 * 65], sp[7 * 65]);
            *(u32x4*)(WT + (size_t)(rbase + n) * K + k0 + 8 * c) = o; }
        asm volatile("s_waitcnt lgkmcnt(0)" ::: "memory");
    }
}

template <bool TO_BF16>
__device__ __forceinline__ void rmsnorm_phase(const float* in, const float* __restrict__ g, bf16_t* outb, float* outf, int gw, int NGW, int lane) {
    f32x4 gv[8];
#pragma unroll
    for (int j = 0; j < 8; ++j) gv[j] = ((const f32x4*)g)[lane + 64 * j];
    for (int row = gw; row < TT; row += NGW) {
        const f32x4* xr = (const f32x4*)(in + (size_t)row * DM) + lane;
        f32x4 v[8]; float ss = 0.f;
#pragma unroll
        for (int j = 0; j < 8; ++j) { v[j] = xr[64 * j]; ss += (v[j][0] * v[j][0] + v[j][1] * v[j][1]) + (v[j][2] * v[j][2] + v[j][3] * v[j][3]); }
        const float rs = 1.0f / sqrtf(wave_sum(ss) * (1.0f / DM) + EPS);
#pragma unroll
        for (int j = 0; j < 8; ++j) {
            const f32x4 y = v[j] * rs * gv[j];
            if constexpr (TO_BF16) { u32x2 w; w.x = pk2(y[0], y[1]); w.y = pk2(y[2], y[3]); *((u32x2*)(outb + (size_t)row * DM) + lane + 64 * j) = w; }
            else { *((f32x4*)(outf + (size_t)row * DM) + lane + 64 * j) = y; }
        }
    }
}

__device__ __forceinline__ void cast_phase(const float* in, bf16_t* outb, u64_t* ssq, int gw, int NGW, int lane) {
    for (int row = gw; row < TT; row += NGW) {
        const f32x4* xr = (const f32x4*)(in + (size_t)row * DM) + lane;
        f32x4 v[8]; float ss = 0.f;
#pragma unroll
        for (int j = 0; j < 8; ++j) { v[j] = xr[64 * j]; ss += (v[j][0] * v[j][0] + v[j][1] * v[j][1]) + (v[j][2] * v[j][2] + v[j][3] * v[j][3]); }
        ss = wave_sum(ss);
        if (lane == 0) ssq[row] = (u64_t)(ss * SSQ_FIX);
#pragma unroll
        for (int j = 0; j < 8; ++j) { u32x2 w; w.x = pk2(v[j][0], v[j][1]); w.y = pk2(v[j][2], v[j][3]); *((u32x2*)(outb + (size_t)row * DM) + lane + 64 * j) = w; }
    }
}

__device__ __forceinline__ void tables_phase(unsigned char* ws, const float* const* in_unused, const float* lam_re, const float* lam_im, const float* log_step, const float* b_re, const float* b_im,
                                             const float* lq1, const float* lk1, const float* lq2, const float* lk2, int gtid, int NT_) {
    float* rcos = (float*)(ws + WS_RCOS); float* rsin = (float*)(ws + WS_RSIN); float* acos_ = (float*)(ws + WS_ACOS); float* asin_ = (float*)(ws + WS_ASIN);
    float* s5a = (float*)(ws + WS_S5A); float* s5bb = (float*)(ws + WS_S5BB);
    for (int i = gtid; i < SEQ * 128; i += NT_) {
        const int pos = i >> 7, f = i & 127;
        const float inv = (float)exp2(-((double)(2 * f) / 256.0) * 13.287712379549449);
        const float ang = (float)pos * inv; double s, c; sincos_d((double)ang, s, c); rcos[i] = (float)c; rsin[i] = (float)s;
    }
    for (int i = gtid; i < SEQ * 16; i += NT_) {
        const int pos = i >> 4, f = i & 15;
        const float inv = (float)exp2(-((double)(2 * f) / 32.0) * 18.931568569324174);
        const float ang = (float)pos * inv; double s, c; sincos_d((double)ang, s, c); acos_[i] = (float)c; asin_[i] = (float)s;
    }
    for (int i = gtid; i < 64 * 64; i += NT_) {
        const int g = i >> 6;
        const double step = exp((double)log_step[g]), lr = (double)lam_re[i], li = (double)lam_im[i];
        const double mag = exp(lr * step); double s, c; sincos_d(li * step, s, c);
        const double are = mag * c, aim = mag * s, den = lr * lr + li * li, nr = are - 1.0;
        const double fre = (nr * lr + aim * li) / den, fim = (aim * lr - nr * li) / den;
        s5a[2 * i] = (float)are; s5a[2 * i + 1] = (float)aim;
        for (int p = 0; p < 16; ++p) { const double br = (double)b_re[i * 16 + p], bi = (double)b_im[i * 16 + p];
            s5bb[(size_t)i * 32 + p] = (float)(fre * br - fim * bi); s5bb[(size_t)i * 32 + 16 + p] = (float)(fre * bi + fim * br); }
    }
    if (gtid == 0) { float s1 = 0.f, s2 = 0.f; for (int i = 0; i < 128; ++i) { s1 += lq1[i] * lk1[i]; s2 += lq2[i] * lk2[i]; }
        ((float*)(ws + WS_CTL))[0] = expf(s1) - expf(s2) + LAMBDA_INIT; }
}

__device__ __forceinline__ void s5_phase(LAS unsigned char* lds, const unsigned char* ws, const bf16_t* proj, const float* c_re, const float* c_im, const float* dskip, bf16_t* z,
                                         int vcu, int G, int wave, int lane) {
    if (wave >= 4) return;
    const float* s5a = (const float*)(ws + WS_S5A); const float* s5bb = (const float*)(ws + WS_S5BB);
    LAS bf16_t* Hc = (LAS bf16_t*)(lds + wave * 8704);
    const int fr = lane & 15, fq = lane >> 4;
    for (int seq = vcu * 4 + wave; seq < 1024; seq += G * 4) {
        const int b = seq >> 6, g = seq & 63, n = lane;
        float bbre[16], bbim[16];
#pragma unroll
        for (int p = 0; p < 16; ++p) { bbre[p] = s5bb[(size_t)(g * 64 + n) * 32 + p]; bbim[p] = s5bb[(size_t)(g * 64 + n) * 32 + 16 + p]; }
        const float are = s5a[2 * (g * 64 + n)], aim = s5a[2 * (g * 64 + n) + 1];
        bf16x8 cf[4];
#pragma unroll
        for (int ks = 0; ks < 4; ++ks) { u32x4 w; unsigned* wp = (unsigned*)&w;
#pragma unroll
            for (int j2 = 0; j2 < 4; ++j2) { float v[2];
#pragma unroll
                for (int e = 0; e < 2; ++e) { const int k = 32 * ks + 8 * fq + 2 * j2 + e; v[e] = (k < 64) ? c_re[(size_t)(g * 16 + fr) * 64 + k] : -c_im[(size_t)(g * 16 + fr) * 64 + (k - 64)]; }
                wp[j2] = pk2(v[0], v[1]); }
            cf[ks] = __builtin_bit_cast(bf16x8, w); }
        const float dsk = dskip[g * 16 + fr];
        float hre = 0.f, him = 0.f;
        for (int ch = 0; ch < SEQ / 32; ++ch) {
            const size_t row0 = (size_t)b * SEQ + ch * 32;
            const bf16_t* up = proj + (row0 + (lane & 31)) * PW + 4096 + g * 16;
            const u32x4 ua = *(const u32x4*)up, ub = *(const u32x4*)(up + 8);
            float uf[16];
            uf[0] = bflo(ua.x); uf[1] = bfhi(ua.x); uf[2] = bflo(ua.y); uf[3] = bfhi(ua.y); uf[4] = bflo(ua.z); uf[5] = bfhi(ua.z); uf[6] = bflo(ua.w); uf[7] = bfhi(ua.w);
            uf[8] = bflo(ub.x); uf[9] = bfhi(ub.x); uf[10] = bflo(ub.y); uf[11] = bfhi(ub.y); uf[12] = bflo(ub.z); uf[13] = bfhi(ub.z); uf[14] = bflo(ub.w); uf[15] = bfhi(ub.w);
#pragma unroll
            for (int k = 0; k < 32; ++k) {
                f32x2 xx = (f32x2){0.f, 0.f};
#pragma unroll
                for (int p = 0; p < 16; ++p) { const float su = __builtin_bit_cast(float, __builtin_amdgcn_readlane(__builtin_bit_cast(int, uf[p]), k));
                    xx = __builtin_elementwise_fma((f32x2){su, su}, (f32x2){bbre[p], bbim[p]}, xx); }
                const float nr = are * hre - aim * him + xx[0], ni = are * him + aim * hre + xx[1]; hre = nr; him = ni;
                Hc[k * 136 + n] = (bf16_t)f2bf(hre); Hc[k * 136 + 64 + n] = (bf16_t)f2bf(him);
            }
#pragma unroll
            for (int sb = 0; sb < 2; ++sb) {
                f32x4 y = (f32x4){0.f, 0.f, 0.f, 0.f};
#pragma unroll
                for (int ks = 0; ks < 4; ++ks) { const bf16x8 hf = *(const LAS bf16x8*)(Hc + (16 * sb + fr) * 136 + 32 * ks + 8 * fq); y = __builtin_amdgcn_mfma_f32_16x16x32_bf16(hf, cf[ks], y, 0, 0, 0); }
#pragma unroll
                for (int i = 0; i < 4; ++i) { const size_t row = row0 + 16 * sb + 4 * fq + i;
                    const float uu = bf2f(proj[row * PW + 4096 + g * 16 + fr]); const float yy = y[i] + dsk * uu;
                    z[row * 1024 + g * 16 + fr] = (bf16_t)f2bf(gelu_tanh_f(yy)); }
            }
        }
    }
}

#define MF32(a, b, c) __builtin_amdgcn_mfma_f32_32x32x16_bf16((a), (b), (c), 0, 0, 0)
#define AT_WAITV(n) asm volatile("s_waitcnt vmcnt(" #n ")" ::: "memory")
#define AT_BAR() asm volatile("s_waitcnt lgkmcnt(0)\n\ts_barrier" ::: "memory")
__device__ __forceinline__ s16x4 vtr(const LAS unsigned char* p) { typedef short v4i16_t __attribute__((ext_vector_type(4))); return __builtin_bit_cast(s16x4, __builtin_amdgcn_ds_read_tr16_b64_v4i16((LAS v4i16_t*)p)); }
__device__ __forceinline__ int crow(int i, int h) { return (i & 3) + 8 * (i >> 2) + 4 * h; }

template <int MODE>
__device__ __forceinline__ void attn_unit(LAS unsigned char* lds, const bf16_t* src, const int pitch, const int kcol, const int vcol, const int b, const int h, const int ub,
                                          bf16_t* outp, const bf16_t* gsrc, const float* subln, const float lam) {
    constexpr int NKS = MODE ? 8 : 16, NDB = 4, ROWS = MODE ? 64 : 128;
    const int tid = threadIdx.x, lane = tid & 63, r = lane & 31, hh = lane >> 5;
    const int wid = __builtin_amdgcn_readfirstlane(tid >> 6);
    const int rg = MODE ? (wid & 1) : (wid & 3), vh = MODE ? ((wid >> 1) & 1) : (wid >> 2), cc = MODE ? (wid >> 2) : 0;
    const size_t rowbase = (size_t)b * SEQ; const int q0 = ub * ROWS, NT = MODE ? (ub + 1) : (2 * ub + 2);
    const int qrow = q0 + rg * 32 + r;
    AT_WAITV(0);
#define AT_ISSUE(t, buf) do { const bf16_t* gk_ = src + (rowbase + (size_t)(t) * 64) * pitch; int rv_ = r; asm volatile("" : "+v"(rv_)); \
        _Pragma("unroll") for (int i_ = 0; i_ < 4; ++i_) { const int c_ = wid * 4 + i_; const int row_ = c_ * 2 + hh; \
            const unsigned ok_ = (unsigned)(row_ * pitch + kcol + ((rv_ ^ (row_ & 15)) << 3)); \
            __builtin_amdgcn_global_load_lds((const unsigned*)(gk_ + ok_), (LAS unsigned*)(lds + (buf) * 65536 + c_ * 1024), 16, 0, 0); \
            const unsigned ov_ = (unsigned)(row_ * pitch + vcol + ((rv_ ^ ((row_ & 3) << 2)) << 3)); \
            __builtin_amdgcn_global_load_lds((const unsigned*)(gk_ + ov_), (LAS unsigned*)(lds + (buf) * 65536 + 32768 + c_ * 1024), 16, 0, 0); } } while (0)
    AT_ISSUE(0, 0);
    bf16x8 qf[NKS];
    { const bf16_t* qp = src + (rowbase + qrow) * pitch + h * 256 + cc * 128 + 8 * hh;
#pragma unroll
      for (int d0 = 0; d0 < NKS; ++d0) qf[d0] = *(const bf16x8*)(qp + 16 * d0); }
    f32x16 O[NDB];
#pragma unroll
    for (int db = 0; db < NDB; ++db)
#pragma unroll
        for (int i = 0; i < 16; ++i) O[db][i] = 0.f;
    float mrun = 0.f, lrun = 0.f;
    const float lgam = __builtin_log2f(1.0f - __builtin_amdgcn_exp2f(-5.0f - (float)h));
    const int r15 = r & 15;
    const int kunit0 = cc * 16;
    const int q4 = (lane & 15) >> 2, p4 = lane & 3, blk16 = (lane >> 4) & 1;
    const int vlane = (4 * hh + q4) * 512 + ((2 * blk16 + (p4 >> 1)) << 4) + 8 * (p4 & 1);
    for (int t = 0; t < NT; ++t) {
        if (t + 1 < NT) { AT_ISSUE(t + 1, (t + 1) & 1); AT_WAITV(8); } else { AT_WAITV(0); }
        AT_BAR();
        const bool active = MODE ? true : !(t == NT - 1 && rg < 2);
        if (active) {
            const LAS unsigned char* Kb = lds + (t & 1) * 65536; const LAS unsigned char* Vb = Kb + 32768;
            int r15v = r15 ^ hh ^ kunit0, q4v = q4 << 2; asm volatile("" : "+v"(r15v), "+v"(q4v));
            bf16x8 pf[4];
            if constexpr (MODE) {
                f32x16 p0, p1;
#pragma unroll
                for (int i = 0; i < 16; ++i) { p0[i] = -mrun; p1[i] = -mrun; }
                { const LAS unsigned char* kr0 = Kb + r * 512; const LAS unsigned char* kr1 = Kb + (32 + r) * 512;
#pragma unroll
                  for (int d0 = 0; d0 < NKS; ++d0) { const int uo = ((2 * d0) ^ r15v) << 4;
                      const bf16x8 k0 = *(const LAS bf16x8*)(kr0 + uo); const bf16x8 k1 = *(const LAS bf16x8*)(kr1 + uo);
                      p0 = MF32(k0, qf[d0], p0); p1 = MF32(k1, qf[d0], p1);
                      if ((d0 & 3) == 3) __builtin_amdgcn_sched_barrier(0); } }
                float rm = p0[0];
#pragma unroll
                for (int i = 0; i < 16; ++i) { rm = fmaxf(rm, p0[i]); rm = fmaxf(rm, p1[i]); }
                rm = fmaxf(rm, __shfl_xor(rm, 32));
                if (t == 0 || __any(rm > 8.0f)) {
                    const float dl = (t == 0) ? rm : fmaxf(rm, 0.f); const float al = (t == 0) ? 1.0f : __builtin_amdgcn_exp2f(-dl); lrun *= al; mrun += dl;
#pragma unroll
                    for (int i = 0; i < 16; ++i) { p0[i] -= dl; p1[i] -= dl; }
#pragma unroll
                    for (int db = 0; db < NDB; ++db) O[db] = O[db] * al;
                }
                float sum = 0.f;
#pragma unroll
                for (int i = 0; i < 16; ++i) { p0[i] = __builtin_amdgcn_exp2f(p0[i]); p1[i] = __builtin_amdgcn_exp2f(p1[i]); sum += p0[i] + p1[i]; }
                lrun += sum;
                u32x4 w;
                w.x = cvt_pk_bf16(p0[0], p0[1]); w.y = cvt_pk_bf16(p0[2], p0[3]); w.z = cvt_pk_bf16(p0[4], p0[5]); w.w = cvt_pk_bf16(p0[6], p0[7]); pf[0] = __builtin_bit_cast(bf16x8, w);
                w.x = cvt_pk_bf16(p0[8], p0[9]); w.y = cvt_pk_bf16(p0[10], p0[11]); w.z = cvt_pk_bf16(p0[12], p0[13]); w.w = cvt_pk_bf16(p0[14], p0[15]); pf[1] = __builtin_bit_cast(bf16x8, w);
                w.x = cvt_pk_bf16(p1[0], p1[1]); w.y = cvt_pk_bf16(p1[2], p1[3]); w.z = cvt_pk_bf16(p1[4], p1[5]); w.w = cvt_pk_bf16(p1[6], p1[7]); pf[2] = __builtin_bit_cast(bf16x8, w);
                w.x = cvt_pk_bf16(p1[8], p1[9]); w.y = cvt_pk_bf16(p1[10], p1[11]); w.z = cvt_pk_bf16(p1[12], p1[13]); w.w = cvt_pk_bf16(p1[14], p1[15]); pf[3] = __builtin_bit_cast(bf16x8, w);
            } else {
#pragma unroll
                for (int blk = 0; blk < 2; ++blk) {
                    f32x16 p;
#pragma unroll
                    for (int i = 0; i < 16; ++i) p[i] = 0.f;
                    const LAS unsigned char* kr = Kb + (32 * blk + r) * 512;
#pragma unroll
                    for (int d0 = 0; d0 < NKS; ++d0) { const int uo = ((2 * d0) ^ r15v) << 4;
                        const bf16x8 k0 = *(const LAS bf16x8*)(kr + uo); p = MF32(k0, qf[d0], p);
                        if ((d0 & 3) == 3) __builtin_amdgcn_sched_barrier(0); }
                    const int kb = t * 64 + 32 * blk + 4 * hh;
#pragma unroll
                    for (int i = 0; i < 16; ++i) { const int kv = kb + (i & 3) + 8 * (i >> 2);
                        p[i] *= __builtin_amdgcn_exp2f(lgam * fabsf((float)(qrow - kv)) - 4.0f); }
                    u32x4 w;
                    w.x = cvt_pk_bf16(p[0], p[1]); w.y = cvt_pk_bf16(p[2], p[3]); w.z = cvt_pk_bf16(p[4], p[5]); w.w = cvt_pk_bf16(p[6], p[7]); pf[2 * blk] = __builtin_bit_cast(bf16x8, w);
                    w.x = cvt_pk_bf16(p[8], p[9]); w.y = cvt_pk_bf16(p[10], p[11]); w.z = cvt_pk_bf16(p[12], p[13]); w.w = cvt_pk_bf16(p[14], p[15]); pf[2 * blk + 1] = __builtin_bit_cast(bf16x8, w);
                    __builtin_amdgcn_sched_barrier(0);
                }
            }
            const LAS unsigned char* vb = Vb + vlane;
            __builtin_amdgcn_sched_barrier(0);
#pragma unroll
            for (int db = 0; db < NDB; ++db) {
                const int dunit = vh * 16 + 4 * db;
                const LAS unsigned char* vp = vb + ((dunit ^ q4v) << 4);
#pragma unroll
                for (int ks = 0; ks < 4; ++ks) {
                    const int kvb = 32 * (ks >> 1) + 16 * (ks & 1);
                    const s16x4 lo = vtr(vp + kvb * 512), hi = vtr(vp + (kvb + 8) * 512);
                    const bf16x8 vf = __builtin_shufflevector(lo, hi, 0, 1, 2, 3, 4, 5, 6, 7);
                    O[db] = MF32(vf, pf[ks], O[db]);
                }
                __builtin_amdgcn_sched_barrier(0);
            }
        }
        AT_BAR();
    }
    const size_t orow = rowbase + qrow;
    LAS float* SS = (LAS float*)(lds + 131072);
    if constexpr (MODE) {
        const float l = lrun + __shfl_xor(lrun, 32); const float inv = 1.0f / l;
        LAS float* X = (LAS float*)(lds + (wid & 3) * 16384);
        if (cc == 1) {
#pragma unroll
            for (int db = 0; db < NDB; ++db)
#pragma unroll
                for (int i = 0; i < 16; ++i) X[(db * 16 + i) * 64 + lane] = O[db][i] * inv;
        }
        AT_BAR();
        float ss = 0.f;
        if (cc == 0) {
#pragma unroll
            for (int db = 0; db < NDB; ++db)
#pragma unroll
                for (int i = 0; i < 16; ++i) { const float o = O[db][i] * inv - lam * X[(db * 16 + i) * 64 + lane]; O[db][i] = o; ss += o * o; }
        }
        ss += __shfl_xor(ss, 32);
        if (hh == 0) SS[wid * 32 + r] = ss;
        AT_BAR();
        if (cc == 0) {
            ss += SS[(wid ^ 2) * 32 + r];
            const float rs = (1.0f - LAMBDA_INIT) / sqrtf(ss * (1.0f / 256.0f) + EPS);
            bf16_t* op = outp + orow * DM + h * 256 + vh * 128 + 4 * hh;
            const float* slp = subln + vh * 128 + 4 * hh;
#pragma unroll
            for (int db = 0; db < NDB; ++db)
#pragma unroll
                for (int i4 = 0; i4 < 4; ++i4) { const int d = 32 * db + 8 * i4;
                    const f32x4 sl = *(const f32x4*)(slp + d);
                    u32x2 w; w.x = cvt_pk_bf16(O[db][4 * i4] * rs * sl[0], O[db][4 * i4 + 1] * rs * sl[1]); w.y = cvt_pk_bf16(O[db][4 * i4 + 2] * rs * sl[2], O[db][4 * i4 + 3] * rs * sl[3]);
                    *(u32x2*)(op + d) = w; }
        }
        AT_BAR();
    } else {
        float ss = 0.f;
#pragma unroll
        for (int db = 0; db < NDB; ++db)
#pragma unroll
            for (int i = 0; i < 16; ++i) ss += O[db][i] * O[db][i];
        ss += __shfl_xor(ss, 32);
        if (hh == 0) SS[wid * 32 + r] = ss;
        AT_BAR();
        ss += SS[(wid ^ 4) * 32 + r];
        const float rs = 1.0f / sqrtf(ss * (1.0f / 256.0f) + EPS);
        const bf16_t* gp = gsrc + orow * PW + 3072 + h * 256 + vh * 128 + 4 * hh;
        bf16_t* op = outp + orow * DM + h * 256 + vh * 128 + 4 * hh;
#pragma unroll
        for (int db = 0; db < NDB; ++db)
#pragma unroll
            for (int i4 = 0; i4 < 4; ++i4) { const int d = 32 * db + 8 * i4;
                const u32x2 gg = *(const u32x2*)(gp + d);
                u32x2 w; w.x = cvt_pk_bf16(O[db][4 * i4] * rs * silu_f(bflo(gg.x)), O[db][4 * i4 + 1] * rs * silu_f(bfhi(gg.x)));
                w.y = cvt_pk_bf16(O[db][4 * i4 + 2] * rs * silu_f(bflo(gg.y)), O[db][4 * i4 + 3] * rs * silu_f(bfhi(gg.y)));
                *(u32x2*)(op + d) = w; }
        AT_BAR();
    }
#undef AT_ISSUE
}

template <int MODE>
__device__ __forceinline__ void attn_phase(LAS unsigned char* lds, const bf16_t* src, int pitch, int kcol0, int vcol0, int nheads, bf16_t* outp, const bf16_t* gsrc, const float* subln, float lam, int vcu, int G) {
    constexpr int NU = MODE ? 32 : 16;
    const int npairs = 16 * nheads * (NU / 2);
    for (int pr = vcu; pr < npairs; pr += G) {
        const int bh = pr / (NU / 2), p = pr % (NU / 2), b = bh / nheads, h = bh % nheads;
        attn_unit<MODE>(lds, src, pitch, kcol0 + h * 256, vcol0 + h * 256, b, h, NU - 1 - p, outp, gsrc, subln, lam);
        attn_unit<MODE>(lds, src, pitch, kcol0 + h * 256, vcol0 + h * 256, b, h, p, outp, gsrc, subln, lam);
    }
}

#define XB_TMO      128
#define XB_XCNT(j)  (256  + 64 * (j))
#define XB_XSUB(j)  (1280 + 64 * (j))
#define XB_XGEN(j)  (2304 + 64 * (j))
#define XB_TOP      3328
#define XB_TOPGEN   3392
#define XCD_BAR_WORDS 3456
#define XB_SPIN_CAP (1u << 18)
__device__ __forceinline__ unsigned xb_ld(unsigned* p)              { return __hip_atomic_load(p, __ATOMIC_RELAXED, __HIP_MEMORY_SCOPE_AGENT); }
__device__ __forceinline__ unsigned xb_add(unsigned* p, unsigned v) { return __hip_atomic_fetch_add(p, v, __ATOMIC_RELAXED, __HIP_MEMORY_SCOPE_AGENT); }
__device__ __forceinline__ unsigned xb_xcc_id() { return (unsigned)__builtin_amdgcn_s_getreg((3 << 11) | 20) & 0xFu; }
#define XB_SPIN(cond, bar) do { unsigned _sp = 0; while (cond) { __builtin_amdgcn_s_sleep(1); \
    if ((++_sp & 255u) == 0u) { if (xb_ld(&(bar)[XB_TMO])) break; if (_sp > XB_SPIN_CAP) { atomicAdd(&(bar)[XB_TMO], 1u); break; } } } } while (0)
struct XcdBarrier { unsigned* bar; unsigned x; volatile LAS unsigned* st; };
__device__ __forceinline__ XcdBarrier xcd_barrier_post(unsigned* bar, volatile LAS unsigned* st) {
    XcdBarrier b; b.bar = bar; b.x = xb_xcc_id(); b.st = st;
    if (threadIdx.x == 0) (void)xb_add(&bar[XB_XCNT(b.x)], 1u);
    return b;
}
__device__ __forceinline__ void xcd_barrier_complete(unsigned* bar, unsigned x, unsigned& nloc, unsigned& nx) {
    const unsigned G = gridDim.x * gridDim.y * gridDim.z;
    unsigned sum, cnt, mine, sp = 0u;
    for (;;) {
        sum = 0u; cnt = 0u; mine = 0u;
#pragma unroll
        for (unsigned j = 0; j < 16; ++j) { const unsigned c = xb_ld(&bar[XB_XCNT(j)]); sum += c; cnt += (c > 0u) ? 1u : 0u; mine = (j == x) ? c : mine; }
        if (sum == G) break;
        __builtin_amdgcn_s_sleep(1);
        if ((++sp & 255u) == 0u) { if (xb_ld(&bar[XB_TMO])) break; if (sp > XB_SPIN_CAP) { atomicAdd(&bar[XB_TMO], 1u); break; } }
    }
    nloc = mine > 0u ? mine : 1u; nx = cnt > 0u ? cnt : 1u;
}
__device__ __forceinline__ void xcd_barrier(const XcdBarrier& b) {
    asm volatile("s_waitcnt vmcnt(0)" ::: "memory");
    __syncthreads();
    if (threadIdx.x == 0) {
        unsigned* bar = b.bar;
        __builtin_amdgcn_s_waitcnt(0);
        unsigned nloc = b.st[0], nx = b.st[1];
        if (nloc == 0u) { xcd_barrier_complete(bar, b.x, nloc, nx); b.st[0] = nloc; b.st[1] = nx; }
        const unsigned old = xb_add(&bar[XB_XSUB(b.x)], 1u);
        const unsigned gen = old / nloc;
        if (old + 1u == (gen + 1u) * nloc) {
            __builtin_amdgcn_fence(__ATOMIC_RELEASE, "agent");
            asm volatile("s_waitcnt vmcnt(0)" ::: "memory");
            const unsigned og = xb_add(&bar[XB_TOP], 1u);
            const unsigned tg = og / nx;
            if (og + 1u == (tg + 1u) * nx) xb_add(&bar[XB_TOPGEN], 1u);
            else XB_SPIN(xb_ld(&bar[XB_TOPGEN]) == tg, bar);
            __builtin_amdgcn_fence(__ATOMIC_ACQUIRE, "agent");
            xb_add(&bar[XB_XGEN(b.x)], 1u);
            asm volatile("s_waitcnt vmcnt(0)" ::: "memory");
        } else {
            XB_SPIN(xb_ld(&bar[XB_XGEN(b.x)]) == gen, bar);
            __builtin_amdgcn_fence(__ATOMIC_ACQUIRE, "agent");
            asm volatile("s_waitcnt vmcnt(0)" ::: "memory");
        }
    }
    __syncthreads();
}

struct Params { const float* in[26]; float* out; unsigned char* ws; int lo, hi; };
constexpr int NPHASE = 17;

__global__ void __launch_bounds__(512) fwd_megakernel(Params P) {
    extern __shared__ __attribute__((aligned(16))) unsigned char lds_raw[];
    LAS unsigned char* lds = (LAS unsigned char*)lds_raw;
    const int tid = threadIdx.x, lane = tid & 63, wave = __builtin_amdgcn_readfirstlane(tid >> 6);
    const int G = gridDim.x, bx = blockIdx.x;
    const int vcu = (G % 8 == 0) ? (bx % 8) * (G / 8) + bx / 8 : bx;
    const int gw = vcu * 8 + wave, NGW = G * 8;
    unsigned char* ws = P.ws;
    float* out = P.out;
    bf16_t* Wgu = (bf16_t*)(ws + WS_WGU); bf16_t* Wd = (bf16_t*)(ws + WS_WD); bf16_t* Win = (bf16_t*)(ws + WS_WIN); bf16_t* Wout = (bf16_t*)(ws + WS_WOUT);
    bf16_t* Wglu = (bf16_t*)(ws + WS_WGLU); bf16_t* Wqkv = (bf16_t*)(ws + WS_WQKV); bf16_t* Wco = (bf16_t*)(ws + WS_WCO);
    bf16_t* XN = (bf16_t*)(ws + WS_XN); bf16_t* BIG = (bf16_t*)(ws + WS_BIG); bf16_t* ZB = (bf16_t*)(ws + WS_Z);
    const float* x = P.in[0]; const float* ffn_norm = P.in[1]; const float* mix_norm = P.in[5];
#if MK_PER_PHASE
#define SYNC(k) do { } while (0)
#else
    cg::grid_group grid = cg::this_grid();
    { volatile LAS unsigned* st0 = (volatile LAS unsigned*)(lds + 139264); if (tid < 2) st0[tid] = 0u; }
    __syncthreads();
    const XcdBarrier xbar = xcd_barrier_post((unsigned*)(ws + WS_BAR), (volatile LAS unsigned*)(lds + 139264));
#define SYNC(k) do { if (P.lo <= (k) && (k) + 1 < P.hi) { if ((k) == 0) grid.sync(); else xcd_barrier(xbar); } } while (0)
#endif
#ifndef DUPMASK
#define DUPMASK 0u
#endif
#define IN(k) (P.lo <= (k) && (k) < P.hi)
#define REP(k) for (int rep_ = 0; rep_ < (((DUPMASK >> (k)) & 1u) ? 2 : 1); ++rep_)

    u64_t* SSQ = (u64_t*)(ws + WS_SSQ);
    bf16_t* YC = (bf16_t*)(ws + WS_YC);
    const float* rcos = (const float*)(ws + WS_RCOS); const float* rsin = (const float*)(ws + WS_RSIN);
    const float* acos_ = (const float*)(ws + WS_ACOS); const float* asin_ = (const float*)(ws + WS_ASIN);
    if (IN(0)) REP(0) {
        LAS float* scr = (LAS float*)(lds + wave * 16640);
        const size_t gsz = (size_t)DM * DFF;
#pragma unroll 1
        for (int i = 0; i < 4; ++i) {
            conv_matrix(P.in[2] + i * gsz, Wgu + (size_t)i * NGU * DM, DM, DFF, 1, ffn_norm + i * DM, scr, gw, NGW, lane);
            conv_matrix(P.in[3] + i * gsz, Wgu + (size_t)i * NGU * DM, DM, DFF, 2, ffn_norm + i * DM, scr, gw, NGW, lane);
            conv_matrix(P.in[4] + i * gsz, Wd + (size_t)i * DM * DFF, DFF, DM, 0, nullptr, scr, gw, NGW, lane);
        }
        conv_matrix(P.in[6], Win, DM, PW, 0, mix_norm, scr, gw, NGW, lane);
        conv_matrix(P.in[7], Wout, DM, DM, 0, nullptr, scr, gw, NGW, lane);
        conv_matrix(P.in[16], Wglu, 1024, 1024, 0, nullptr, scr, gw, NGW, lane);
        conv_matrix(P.in[18], Wqkv, DM, QW, 0, mix_norm + DM, scr, gw, NGW, lane);
        conv_matrix(P.in[19], Wco, DM, DM, 0, nullptr, scr, gw, NGW, lane);
        tables_phase(ws, nullptr, P.in[8], P.in[9], P.in[10], P.in[11], P.in[12], P.in[20], P.in[21], P.in[22], P.in[23], vcu * 512 + tid, G * 512);
        for (int i = vcu * 512 + tid; i < 5 * TT; i += G * 512) SSQ[TT + i] = 0ull;
        cast_phase(x, XN, SSQ, gw, NGW, lane);
    }
    SYNC(0);
#if !MK_PER_PHASE
    if ((DUPMASK >> 20) & 1u) { for (int q_ = 0; q_ < 32; ++q_) grid.sync(); }
#endif
    if (IN(1)) { run_gemm(lds, XN, Wgu, TT, NGU, DM, EpiSwiglu{BIG, DFF, SSQ}); if ((DUPMASK >> 1) & 1u) { run_gemm(lds, XN, Wgu, TT, NGU, DM, EpiSwiglu{BIG, DFF, SSQ}); } }
    SYNC(1);
    if (IN(2)) run_gemm(lds, BIG, Wd, TT, DM, DFF, EpiResid<true, false, 1>{x, nullptr, XN, SSQ + 1 * TT});
    if (IN(2) && ((DUPMASK >> 2) & 1u)) run_gemm(lds, BIG, Wd, TT, DM, DFF, EpiResid<false, false, 2>{nullptr, nullptr, XN, nullptr});
    SYNC(2);
    if (IN(3)) { run_gemm(lds, XN, Win, TT, PW, DM, EpiWin{BIG, rcos, rsin, SSQ + 1 * TT}); if ((DUPMASK >> 3) & 1u) { run_gemm(lds, XN, Win, TT, PW, DM, EpiWin{BIG, rcos, rsin, SSQ + 1 * TT}); } }
    SYNC(3);
    if (IN(4)) REP(4) {
#ifndef NO_A0
        attn_phase<0>(lds, BIG, PW, 1024, 2048, 4, YC, BIG, nullptr, 0.f, vcu, G);
#endif
#ifndef NO_S5
        s5_phase(lds, ws, BIG, P.in[13], P.in[14], P.in[15], ZB, vcu, G, wave, lane);
#endif
    }
    SYNC(4);
    if (IN(5)) run_gemm(lds, ZB, Wglu, TT, 1024, 1024, EpiGlu{ZB, P.in[17], YC});
    SYNC(5);
    if (IN(6)) run_gemm(lds, YC, Wout, TT, DM, DM, EpiResid<false, false, 0>{nullptr, nullptr, XN, SSQ + 2 * TT});
    if (IN(6) && ((DUPMASK >> 6) & 1u)) run_gemm(lds, YC, Wout, TT, DM, DM, EpiResid<false, false, 2>{nullptr, nullptr, XN, nullptr});
    SYNC(6);
    if (IN(7)) { run_gemm(lds, XN, Wgu + (size_t)1 * NGU * DM, TT, NGU, DM, EpiSwiglu{BIG, DFF, SSQ + 2 * TT}); if ((DUPMASK >> 7) & 1u) { run_gemm(lds, XN, Wgu + (size_t)1 * NGU * DM, TT, NGU, DM, EpiSwiglu{BIG, DFF, SSQ + 2 * TT}); } }
    SYNC(7);
    if (IN(8)) run_gemm(lds, BIG, Wd + (size_t)1 * DM * DFF, TT, DM, DFF, EpiResid<false, false, 1>{nullptr, nullptr, XN, SSQ + 3 * TT});
    if (IN(8) && ((DUPMASK >> 8) & 1u)) run_gemm(lds, BIG, Wd + (size_t)1 * DM * DFF, TT, DM, DFF, EpiResid<false, false, 2>{nullptr, nullptr, XN, nullptr});
    SYNC(8);
    if (IN(9)) { run_gemm(lds, XN, Wgu + (size_t)2 * NGU * DM, TT, NGU, DM, EpiSwiglu{BIG, DFF, SSQ + 3 * TT}); if ((DUPMASK >> 9) & 1u) { run_gemm(lds, XN, Wgu + (size_t)2 * NGU * DM, TT, NGU, DM, EpiSwiglu{BIG, DFF, SSQ + 3 * TT}); } }
    SYNC(9);
    if (IN(10)) run_gemm(lds, BIG, Wd + (size_t)2 * DM * DFF, TT, DM, DFF, EpiResid<false, false, 1>{nullptr, nullptr, XN, SSQ + 4 * TT});
    if (IN(10) && ((DUPMASK >> 10) & 1u)) run_gemm(lds, BIG, Wd + (size_t)2 * DM * DFF, TT, DM, DFF, EpiResid<false, false, 2>{nullptr, nullptr, XN, nullptr});
    SYNC(10);
    if (IN(11)) { run_gemm(lds, XN, Wqkv, TT, QW, DM, EpiQkv{BIG, acos_, asin_, SSQ + 4 * TT}); if ((DUPMASK >> 11) & 1u) { run_gemm(lds, XN, Wqkv, TT, QW, DM, EpiQkv{BIG, acos_, asin_, SSQ + 4 * TT}); } }
    SYNC(11);
#ifndef NO_A1
    if (IN(12)) REP(12) { const float lam = ((const float*)(ws + WS_CTL))[0]; attn_phase<1>(lds, BIG, QW, 2048, 4096, 8, YC, nullptr, P.in[24], lam, vcu, G); }
#endif
    SYNC(12);
    if (IN(13)) run_gemm(lds, YC, Wco, TT, DM, DM, EpiResid<false, false, 0>{nullptr, nullptr, XN, SSQ + 5 * TT});
    if (IN(13) && ((DUPMASK >> 13) & 1u)) run_gemm(lds, YC, Wco, TT, DM, DM, EpiResid<false, false, 2>{nullptr, nullptr, XN, nullptr});
    SYNC(13);
    if (IN(14)) { run_gemm(lds, XN, Wgu + (size_t)3 * NGU * DM, TT, NGU, DM, EpiSwiglu{BIG, DFF, SSQ + 5 * TT}); if ((DUPMASK >> 14) & 1u) { run_gemm(lds, XN, Wgu + (size_t)3 * NGU * DM, TT, NGU, DM, EpiSwiglu{BIG, DFF, SSQ + 5 * TT}); } }
    SYNC(14);
    if (IN(15)) run_gemm(lds, BIG, Wd + (size_t)3 * DM * DFF, TT, DM, DFF, EpiResid<false, true, 1>{nullptr, out, XN, nullptr});
    if (IN(15) && ((DUPMASK >> 15) & 1u)) run_gemm(lds, BIG, Wd + (size_t)3 * DM * DFF, TT, DM, DFF, EpiResid<false, false, 2>{nullptr, nullptr, XN, nullptr});
    SYNC(15);
    if (IN(16)) rmsnorm_phase<false>(out, P.in[25], nullptr, out, gw, NGW, lane);
#undef IN
#undef SYNC
}

extern "C" void kernel_launch(void* const* d_in, const int* in_sizes, int n_in, void* d_out, int out_size, void* d_ws, size_t ws_size, hipStream_t stream) {
    static int grid = 0;
    if (grid == 0) {
        if (n_in != 26 || out_size != TT * DM || ws_size < WS_END) { fprintf(stderr, "kernel_launch: unexpected shapes (n_in %d, out %d, ws %zu < %zu)\n", n_in, out_size, ws_size, (size_t)WS_END); grid = -1; return; }
        int dev = 0, cus = 0, per_cu = 0;
        hipGetDevice(&dev); hipDeviceGetAttribute(&cus, hipDeviceAttributeMultiprocessorCount, dev);
        if (hipFuncSetAttribute((const void*)fwd_megakernel, hipFuncAttributeMaxDynamicSharedMemorySize, LDS_BYTES) != hipSuccess) { fprintf(stderr, "kernel_launch: hipFuncSetAttribute failed\n"); grid = -1; return; }
        if (hipOccupancyMaxActiveBlocksPerMultiprocessor(&per_cu, (const void*)fwd_megakernel, 512, LDS_BYTES) != hipSuccess || per_cu < 1) { fprintf(stderr, "kernel_launch: occupancy query says %d\n", per_cu); per_cu = 1; }
        (void)hipGetLastError();
        grid = cus * per_cu;
        fprintf(stderr, "kernel_launch: grid %d (cus %d x %d)\n", grid, cus, per_cu);
    }
    if (grid < 0) return;
    if (hipMemsetAsync((char*)d_ws + WS_BAR, 0, BAR_BYTES, stream) != hipSuccess) { fprintf(stderr, "kernel_launch: hipMemsetAsync failed\n"); return; }
    Params p{};
    for (int i = 0; i < 26; ++i) p.in[i] = (const float*)d_in[i];
    p.out = (float*)d_out; p.ws = (unsigned char*)d_ws;
#if MK_PER_PHASE
    for (int k = 0; k < NPHASE; ++k) { p.lo = k; p.hi = k + 1; hipLaunchKernelGGL(fwd_megakernel, dim3(grid), dim3(512), LDS_BYTES, stream, p); }
#else
    p.lo = 0; p.hi = NPHASE;
    void* args[] = {&p};
    hipError_t e = hipLaunchCooperativeKernel((const void*)fwd_megakernel, dim3(grid), dim3(512), args, LDS_BYTES, stream);
    if (e != hipSuccess) fprintf(stderr, "cooperative launch failed: %s (grid %d)\n", hipGetErrorString(e), grid);
#endif
}
```

```cpp
#include <hip/hip_runtime.h>
#include <hip/hip_cooperative_groups.h>
#include <cstdio>
#include <cstdint>
namespace cg = cooperative_groups;

#define LAS __attribute__((address_space(3)))
typedef unsigned short bf16_t;
typedef unsigned long long u64_t;
constexpr float SSQ_FIX = 16777216.0f, SSQ_INV = 1.0f / 16777216.0f;
typedef short bf16x8 __attribute__((ext_vector_type(8)));
typedef short s16x4 __attribute__((ext_vector_type(4)));
typedef float f32x4 __attribute__((ext_vector_type(4)));
typedef float f32x2 __attribute__((ext_vector_type(2)));
typedef float f32x16 __attribute__((ext_vector_type(16)));
typedef unsigned u32x4 __attribute__((ext_vector_type(4)));
typedef unsigned u32x2 __attribute__((ext_vector_type(2)));

#ifndef MK_PER_PHASE
#define MK_PER_PHASE 0
#endif

constexpr int TT = 32768, SEQ = 2048, DM = 2048, DFF = 5504, NGU = 2 * DFF;
constexpr int PW = 5120, QW = 6144;
constexpr float EPS = 1e-6f;
constexpr float LAMBDA_INIT = 0.35550906759f;
constexpr float QSCALE = 0.08838834764831845f * 1.4426950408889634f;

constexpr size_t MiB = 1u << 20;
constexpr size_t WS_CTL = 0, WS_BAR = 4096, BAR_BYTES = 16384;
constexpr size_t WS_RCOS = 1 * MiB, WS_RSIN = 2 * MiB, WS_ACOS = 3 * MiB, WS_ASIN = 3 * MiB + 128 * 1024, WS_S5A = 3 * MiB + 512 * 1024, WS_S5BB = 4 * MiB;
constexpr size_t WS_W = 8 * MiB;
constexpr size_t SZ_WGU = (size_t)NGU * DM * 2, SZ_WD = (size_t)DM * DFF * 2;
constexpr size_t WS_WGU = WS_W, WS_WD = WS_WGU + 4 * SZ_WGU, WS_WIN = WS_WD + 4 * SZ_WD, WS_WOUT = WS_WIN + (size_t)PW * DM * 2,
                 WS_WGLU = WS_WOUT + (size_t)DM * DM * 2, WS_WQKV = WS_WGLU + (size_t)1024 * 1024 * 2, WS_WCO = WS_WQKV + (size_t)QW * DM * 2,
                 WS_WEND = WS_WCO + (size_t)DM * DM * 2;
constexpr size_t WS_XN = 328 * MiB;
constexpr size_t WS_BIG = 456 * MiB;
constexpr size_t WS_Z = WS_BIG + (size_t)TT * PW * 2;
constexpr size_t WS_YC = WS_BIG + (size_t)TT * QW * 2;
constexpr size_t WS_END = WS_YC + (size_t)TT * DM * 2;
constexpr size_t WS_SSQ = 5 * MiB;
static_assert(WS_WEND <= WS_XN && WS_XN + (size_t)TT * DM * 2 <= WS_BIG && WS_Z + (size_t)TT * 1024 * 2 <= WS_END, "ws map");

constexpr int LDS_BYTES = 147456;

namespace pg8 {
constexpr int BM = 256, BK = 64, HALF = 128, HTB = HALF * BK * 2, STAGE_BYTES = 8 * HTB, NXCD = 8, WGM = 8;
__host__ __device__ __forceinline__ int lds_byte(int r, int c) { const int st = (r >> 4) * 2 + (c >> 5), rr = r & 15, cc = c & 31, ob = rr * 64 + cc * 2; return st * 1024 + (ob ^ (((ob >> 9) & 1) << 5)); }
__host__ __device__ __forceinline__ void stage_rc(int b, int& R, int& C) { const int st = b / 1024, sb = b % 1024, swz = sb ^ (((sb >> 9) & 1) << 5); R = (st >> 1) * 16 + swz / 64; C = (st & 1) * 32 + (swz % 64) / 2; }
__host__ __device__ __forceinline__ int perm32(int rho) { const int n = rho >> 4, i = rho & 15; return 8 * (i >> 2) + 4 * n + (i & 3); }
struct Unit { int pm, pn; };
struct Gemm { const bf16_t* A; const bf16_t* Bt; int M, N, K; };
struct StaticOrder {
    int nM, nN, nwg, G, c;
    __host__ __device__ void init(int M, int N, int G_, int c_) { nM = M / BM; nN = N / BM; nwg = nM * nN; G = G_; c = c_; }
    __host__ __device__ bool next(int i, Unit& u) const {
        const long L = (long)i * G + c; if (L >= nwg) return false;
        int wgid = (int)L; { const int q = nwg / NXCD, r = nwg % NXCD, xcd = wgid % NXCD, off = wgid / NXCD; wgid = (xcd < r ? xcd * (q + 1) : r * (q + 1) + (xcd - r) * q) + off; }
        const int nig = WGM * nN, gid = wgid / nig, fm = gid * WGM, gsz = (nM - fm) < WGM ? (nM - fm) : WGM;
        u.pm = fm + ((wgid % nig) % gsz); u.pn = (wgid % nig) / gsz; return true;
    }
    __device__ __forceinline__ void a_ready(const Unit&) const {}
    __device__ __forceinline__ void done(const Unit&) const {}
};
__device__ __forceinline__ unsigned cvt_pk_bf16(float lo, float hi) { unsigned r; asm volatile("v_cvt_pk_bf16_f32 %0, %1, %2" : "=v"(r) : "v"(lo), "v"(hi)); return r; }

template <class Epi, class Sched, bool ALIGN_EPI = false, bool SP2 = false>
__device__ __forceinline__ void gemm_phase(LAS unsigned char* lds, const Gemm g, const Sched S, const Epi E) {
    const int tid = threadIdx.x, wid = __builtin_amdgcn_readfirstlane(tid >> 6), lane = tid & 63, wr = wid >> 2, wc = wid & 3, fr = lane & 15, fq = lane >> 4;
    const int K = g.K, nt = K / BK;
    unsigned voffA[2], voffB[2];
#pragma unroll
    for (int i = 0; i < 2; ++i) { int R, C; stage_rc(tid * 16 + i * 8192, R, C); const int Rb = Epi::PERM ? ((R & ~31) + perm32(R & 31)) : R;
        voffA[i] = (unsigned)(R * K + C) * 2u; voffB[i] = (unsigned)(Rb * K + C) * 2u; }
    const size_t kstep = (size_t)(BK * 2);
    const size_t hstep = (size_t)HALF * K * 2;
    const size_t tstep = 2 * hstep;
    const unsigned ldsw = (unsigned)wid * 1024u;
    const int aoff = lds_byte(wr * 64 + fr, fq * 8), boff = lds_byte(wc * 32 + fr, fq * 8);
#define PG8_SA(b, h) (((b) * 2 + (h)) * HTB)
#define PG8_SB(b, h) ((4 + (b) * 2 + (h)) * HTB)
#define PG8_STAGE(bufoff, gbase, voff) do { _Pragma("unroll") for (int _i = 0; _i < 2; ++_i) \
        __builtin_amdgcn_global_load_lds((const unsigned*)((const char*)(gbase) + (voff)[_i]), (LAS unsigned*)(lds + (bufoff) + ldsw + _i * 8192), 16, 0, 0); } while (0)
#define PG8_LDA(dst, b, h) do { _Pragma("unroll") for (int m = 0; m < 4; ++m) _Pragma("unroll") for (int k = 0; k < 2; ++k) dst[m][k] = *(const LAS bf16x8*)(lds + PG8_SA(b, h) + aoff + m * 2048 + k * 1024); } while (0)
#define PG8_LDB(dst, b, h) do { _Pragma("unroll") for (int n = 0; n < 2; ++n) _Pragma("unroll") for (int k = 0; k < 2; ++k) dst[n][k] = *(const LAS bf16x8*)(lds + PG8_SB(b, h) + boff + n * 2048 + k * 1024); } while (0)
#define PG8_MMA(ai, bj, At, Bt) do { __builtin_amdgcn_s_setprio(1); _Pragma("unroll") for (int m = 0; m < 4; ++m) _Pragma("unroll") for (int n = 0; n < 2; ++n) _Pragma("unroll") for (int k = 0; k < 2; ++k) \
        acc[ai][bj][m][n] = __builtin_amdgcn_mfma_f32_16x16x32_bf16(Bt[n][k], At[m][k], acc[ai][bj][m][n], 0, 0, 0); __builtin_amdgcn_s_setprio(0); } while (0)
#define PG8_WAIT_V(n) asm volatile("s_waitcnt vmcnt(" #n ")" ::: "memory")
#define PG8_WAIT_L(n) asm volatile("s_waitcnt lgkmcnt(" #n ")" ::: "memory")
#define PG8_BAR __builtin_amdgcn_s_barrier()
#define PG8_SCHED __builtin_amdgcn_sched_barrier(0)
    Unit cur, nxt; int ui = 0;
    if (!S.next(0, cur)) return;
    f32x4 acc[2][2][4][2];
#pragma unroll
    for (int a = 0; a < 2; ++a)
#pragma unroll
        for (int b = 0; b < 2; ++b)
#pragma unroll
            for (int m = 0; m < 4; ++m)
#pragma unroll
                for (int n = 0; n < 2; ++n) acc[a][b][m][n] = (f32x4){0.f, 0.f, 0.f, 0.f};
    bf16x8 At[4][2], B0[2][2], B1[2][2];
    const char* cA = (const char*)g.A + (size_t)cur.pm * tstep; const char* cB = (const char*)g.Bt + (size_t)cur.pn * tstep;
    S.a_ready(cur);
    if constexpr (SP2) {
        PG8_STAGE(PG8_SB(0, 0), cB, voffB); PG8_STAGE(PG8_SB(0, 1), cB + hstep, voffB); PG8_STAGE(PG8_SA(0, 0), cA, voffA); PG8_STAGE(PG8_SA(0, 1), cA + hstep, voffA);
        if (wr == 1) PG8_BAR;
        PG8_WAIT_V(2); PG8_BAR;
        PG8_STAGE(PG8_SB(1, 0), cB + kstep, voffB); PG8_STAGE(PG8_SA(1, 0), cA + kstep, voffA); PG8_STAGE(PG8_SB(1, 1), cB + hstep + kstep, voffB);
        PG8_WAIT_V(6); PG8_BAR;
    } else {
        PG8_STAGE(PG8_SB(0, 0), cB, voffB); PG8_STAGE(PG8_SA(0, 0), cA, voffA); PG8_STAGE(PG8_SB(0, 1), cB + hstep, voffB); PG8_STAGE(PG8_SA(0, 1), cA + hstep, voffA);
        if (wr == 1) PG8_BAR;
        PG8_WAIT_V(4); PG8_BAR;
        PG8_STAGE(PG8_SB(1, 0), cB + kstep, voffB); PG8_STAGE(PG8_SA(1, 0), cA + kstep, voffA); PG8_STAGE(PG8_SB(1, 1), cB + hstep + kstep, voffB);
        PG8_WAIT_V(6); PG8_BAR;
    }
    for (;;) {
        const bool has_next = S.next(ui + 1, nxt);
        const char* nA = has_next ? (const char*)g.A + (size_t)nxt.pm * tstep : cA; const char* nB = has_next ? (const char*)g.Bt + (size_t)nxt.pn * tstep : cB;
        for (int t = 0; t < nt; t += 2) {
            const bool last = (t == nt - 2);
            const char* a1 = cA + (size_t)(t + 1) * kstep;
            const char* a2 = last ? nA : cA + (size_t)(t + 2) * kstep; const char* b2 = last ? nB : cB + (size_t)(t + 2) * kstep;
            const char* a3 = a2 + kstep; const char* b3 = b2 + kstep;
            if (last && has_next) S.a_ready(nxt);
            if constexpr (SP2) {
            PG8_LDB(B0, 0, 0); PG8_LDB(B1, 0, 1); PG8_SCHED; PG8_LDA(At, 0, 0); PG8_STAGE(PG8_SA(1, 1), a1 + hstep, voffA);
            PG8_WAIT_V(8); PG8_WAIT_L(0); PG8_BAR; PG8_MMA(0, 0, At, B0); PG8_MMA(0, 1, At, B1); PG8_BAR; PG8_SCHED;
            PG8_LDA(At, 0, 1); PG8_STAGE(PG8_SB(0, 0), b2, voffB); PG8_STAGE(PG8_SB(0, 1), b2 + hstep, voffB); PG8_STAGE(PG8_SA(0, 0), a2, voffA);
            PG8_WAIT_V(8); PG8_WAIT_L(0); PG8_BAR; PG8_MMA(1, 0, At, B0); PG8_MMA(1, 1, At, B1); PG8_BAR; PG8_SCHED;
            PG8_LDB(B0, 1, 0); PG8_LDB(B1, 1, 1); PG8_SCHED; PG8_LDA(At, 1, 0); PG8_STAGE(PG8_SA(0, 1), a2 + hstep, voffA);
            PG8_WAIT_V(8); PG8_WAIT_L(0); PG8_BAR; PG8_MMA(0, 0, At, B0); PG8_MMA(0, 1, At, B1); PG8_BAR; PG8_SCHED;
            PG8_LDA(At, 1, 1); PG8_STAGE(PG8_SB(1, 0), b3, voffB); PG8_STAGE(PG8_SB(1, 1), b3 + hstep, voffB); PG8_STAGE(PG8_SA(1, 0), a3, voffA);
            PG8_WAIT_V(8); PG8_WAIT_L(0); PG8_BAR; PG8_MMA(1, 0, At, B0); PG8_MMA(1, 1, At, B1); PG8_BAR; PG8_SCHED;
            } else {
            PG8_LDB(B0, 0, 0); PG8_SCHED; PG8_LDA(At, 0, 0); PG8_STAGE(PG8_SA(1, 1), a1 + hstep, voffA);
            PG8_WAIT_L(8); PG8_BAR; PG8_WAIT_L(0); PG8_MMA(0, 0, At, B0); PG8_BAR; PG8_SCHED;
            PG8_LDB(B1, 0, 1); PG8_STAGE(PG8_SB(0, 0), b2, voffB);
            PG8_BAR; PG8_WAIT_L(0); PG8_MMA(0, 1, At, B1); PG8_BAR;
            PG8_LDA(At, 0, 1); PG8_STAGE(PG8_SA(0, 0), a2, voffA);
            PG8_BAR; PG8_WAIT_L(0); PG8_MMA(1, 0, At, B0); PG8_BAR; PG8_SCHED;
            PG8_STAGE(PG8_SB(0, 1), b2 + hstep, voffB);
            PG8_WAIT_V(6); PG8_BAR; PG8_MMA(1, 1, At, B1); PG8_BAR;
            PG8_LDB(B0, 1, 0); PG8_SCHED; PG8_LDA(At, 1, 0); PG8_STAGE(PG8_SA(0, 1), a2 + hstep, voffA);
            PG8_WAIT_L(8); PG8_BAR; PG8_WAIT_L(0); PG8_MMA(0, 0, At, B0); PG8_BAR; PG8_SCHED;
            PG8_LDB(B1, 1, 1); PG8_STAGE(PG8_SB(1, 0), b3, voffB);
            PG8_BAR; PG8_WAIT_L(0); PG8_MMA(0, 1, At, B1); PG8_BAR;
            PG8_LDA(At, 1, 1); PG8_STAGE(PG8_SA(1, 0), a3, voffA);
            PG8_BAR; PG8_WAIT_L(0); PG8_MMA(1, 0, At, B0); PG8_BAR; PG8_SCHED;
            PG8_STAGE(PG8_SB(1, 1), b3 + hstep, voffB);
            PG8_WAIT_V(6); PG8_BAR; PG8_MMA(1, 1, At, B1); PG8_BAR;
            }
        }
        if constexpr (ALIGN_EPI) { if (wr == 0) PG8_BAR; }
        if constexpr (!Epi::AFTER_DRAIN) { E(acc, cur, wr, wc, fr, fq); S.done(cur); }
        if (!has_next) break;
#pragma unroll
        for (int a = 0; a < 2; ++a)
#pragma unroll
            for (int b = 0; b < 2; ++b)
#pragma unroll
                for (int m = 0; m < 4; ++m)
#pragma unroll
                    for (int n = 0; n < 2; ++n) acc[a][b][m][n] = (f32x4){0.f, 0.f, 0.f, 0.f};
        cur = nxt; cA = nA; cB = nB; ++ui;
        if constexpr (ALIGN_EPI) { if (wr == 1) PG8_BAR; }
    }
    PG8_WAIT_V(0);
    if constexpr (!ALIGN_EPI) { if (wr == 0) PG8_BAR; }
    PG8_BAR;
#undef PG8_SA
#undef PG8_SB
#undef PG8_STAGE
#undef PG8_LDA
#undef PG8_LDB
#undef PG8_MMA
#undef PG8_WAIT_V
#undef PG8_WAIT_L
#undef PG8_BAR
#undef PG8_SCHED
}
}

__device__ __forceinline__ unsigned f2bf(float f) { unsigned u = __builtin_bit_cast(unsigned, f); return (u + 0x7fffu + ((u >> 16) & 1u)) >> 16; }
__device__ __forceinline__ unsigned pk2(float lo, float hi) { return f2bf(lo) | (f2bf(hi) << 16); }
__device__ __forceinline__ float bf2f(unsigned short b) { return __builtin_bit_cast(float, (unsigned)b << 16); }
__device__ __forceinline__ float bflo(unsigned w) { return __builtin_bit_cast(float, w << 16); }
__device__ __forceinline__ float bfhi(unsigned w) { return __builtin_bit_cast(float, w & 0xffff0000u); }
__device__ __forceinline__ float fast_sigmoid(float x) { return __builtin_amdgcn_rcpf(1.0f + __builtin_amdgcn_exp2f(-1.4426950408889634f * x)); }
__device__ __forceinline__ float silu_f(float x) { return x * fast_sigmoid(x); }
__device__ __forceinline__ float gelu_tanh_f(float y) { return y * fast_sigmoid(1.5957691216057308f * (y + 0.044715f * y * y * y)); }
__device__ __forceinline__ float wave_sum(float v) {
#pragma unroll
    for (int o = 1; o < 64; o <<= 1) v += __shfl_xor(v, o);
    return v;
}
__device__ __forceinline__ void sincos_d(double a, double& s, double& c) {
    const double k = rint(a * 0.15915494309189535);
    const double r = fma(-k, 6.283185307179586, a), r2 = r * r;
    double ts = r, tc = 1.0; s = r; c = 1.0;
    for (int n = 1; n <= 13; ++n) { tc *= -r2 / (double)((2 * n - 1) * (2 * n)); c += tc; ts *= -r2 / (double)((2 * n) * (2 * n + 1)); s += ts; }
}

using pg8::Unit; using pg8::cvt_pk_bf16;
struct EpiSwiglu {
    static constexpr bool PERM = true, AFTER_DRAIN = false;
    bf16_t* O; int ldo; const u64_t* ssq;
    __device__ __forceinline__ void operator()(const f32x4 (&acc)[2][2][4][2], const Unit& u, int wr, int wc, int fr, int fq) const {
        const int row0 = u.pm * 256 + wr * 64 + fr, col0 = u.pn * 128 + wc * 32 + 8 * fq;
        float rsv[2][4];
#pragma unroll
        for (int ai = 0; ai < 2; ++ai)
#pragma unroll
            for (int m = 0; m < 4; ++m) rsv[ai][m] = (float)ssq[row0 + ai * 128 + m * 16] * SSQ_INV;
#pragma unroll
        for (int ai = 0; ai < 2; ++ai)
#pragma unroll
            for (int m = 0; m < 4; ++m) {
                const int row = row0 + ai * 128 + m * 16;
                const float rs = __builtin_amdgcn_rsqf(rsv[ai][m] * (1.0f / DM) + EPS);
                bf16_t* rowp = O + (size_t)row * ldo + col0;
                const f32x4 g0 = acc[ai][0][m][0] * rs, g1 = acc[ai][0][m][1] * rs, u0 = acc[ai][1][m][0] * rs, u1 = acc[ai][1][m][1] * rs;
                u32x4 w;
                w.x = cvt_pk_bf16(silu_f(g0[0]) * u0[0], silu_f(g0[1]) * u0[1]); w.y = cvt_pk_bf16(silu_f(g0[2]) * u0[2], silu_f(g0[3]) * u0[3]);
                w.z = cvt_pk_bf16(silu_f(g1[0]) * u1[0], silu_f(g1[1]) * u1[1]); w.w = cvt_pk_bf16(silu_f(g1[2]) * u1[2], silu_f(g1[3]) * u1[3]);
                *(u32x4*)rowp = w;
            }
    }
};
template <bool BASE_F32, bool OUT_F32, int SCALE> struct EpiResid {
    static constexpr bool PERM = false, AFTER_DRAIN = false;
    const float* basef; float* outf; bf16_t* xb; u64_t* ssq;
    __device__ __forceinline__ void operator()(const f32x4 (&acc)[2][2][4][2], const Unit& u, int wr, int wc, int fr, int fq) const {
        const int col0 = u.pn * 256 + wc * 32 + 4 * fq;
        constexpr float sc = (SCALE == 2 ? 0.0f : SCALE == 1 ? 0.5f : 1.0f);
#pragma unroll
        for (int ai = 0; ai < 2; ++ai) {
            f32x4 pre[4][2][2];
#pragma unroll
            for (int m = 0; m < 4; ++m) { const size_t off = (size_t)(u.pm * 256 + ai * 128 + wr * 64 + m * 16 + fr) * DM + col0;
#pragma unroll
                for (int bj = 0; bj < 2; ++bj)
#pragma unroll
                    for (int n = 0; n < 2; ++n) {
                        if constexpr (BASE_F32) pre[m][bj][n] = *(const f32x4*)(basef + off + bj * 128 + n * 16);
                        else { const u32x2 w = *(const u32x2*)(xb + off + bj * 128 + n * 16); pre[m][bj][n] = (f32x4){bflo(w.x), bfhi(w.x), bflo(w.y), bfhi(w.y)}; } } }
#pragma unroll
            for (int m = 0; m < 4; ++m) {
                const int row = u.pm * 256 + ai * 128 + wr * 64 + m * 16 + fr;
                const size_t off = (size_t)row * DM + col0;
                float sq = 0.f;
#pragma unroll
                for (int bj = 0; bj < 2; ++bj)
#pragma unroll
                    for (int n = 0; n < 2; ++n) { const f32x4 v = pre[m][bj][n] + acc[ai][bj][m][n] * sc;
                        if constexpr (OUT_F32) *(f32x4*)(outf + off + bj * 128 + n * 16) = v;
                        else { u32x2 w; w.x = cvt_pk_bf16(v[0], v[1]); w.y = cvt_pk_bf16(v[2], v[3]); *(u32x2*)(xb + off + bj * 128 + n * 16) = w;
                               sq += (v[0] * v[0] + v[1] * v[1]) + (v[2] * v[2] + v[3] * v[3]); } }
                if constexpr (!OUT_F32 && SCALE != 2) { sq += __shfl_xor(sq, 16); sq += __shfl_xor(sq, 32); if (fq == 0) atomicAdd(ssq + row, (u64_t)(sq * SSQ_FIX)); }
            }
        }
    }
};
struct EpiWin {
    static constexpr bool PERM = true, AFTER_DRAIN = false;
    bf16_t* O; const float* cs; const float* sn; const u64_t* ssq;
    __device__ __forceinline__ void operator()(const f32x4 (&acc)[2][2][4][2], const Unit& u, int wr, int wc, int fr, int fq) const {
        const int row0 = u.pm * 256 + wr * 64 + fr, col0 = u.pn * 256 + wc * 32 + 8 * fq;
        const bool rot = u.pn < 8;
        float rsv[2][4];
#pragma unroll
        for (int ai = 0; ai < 2; ++ai)
#pragma unroll
            for (int m = 0; m < 4; ++m) rsv[ai][m] = (float)ssq[row0 + ai * 128 + m * 16] * SSQ_INV;
#pragma unroll
        for (int ai = 0; ai < 2; ++ai) {
            f32x4 cc[4][2], sv[4][2];
#pragma unroll
            for (int m = 0; m < 4; ++m) {
                if (rot) { const int pos = (row0 + ai * 128 + m * 16) & (SEQ - 1);
                    const float* cp = cs + pos * 128 + wc * 32 + 8 * fq; const float* sp = sn + pos * 128 + wc * 32 + 8 * fq;
                    cc[m][0] = *(const f32x4*)cp; cc[m][1] = *(const f32x4*)(cp + 4); sv[m][0] = *(const f32x4*)sp; sv[m][1] = *(const f32x4*)(sp + 4); }
                else { cc[m][0] = cc[m][1] = (f32x4){1.f, 1.f, 1.f, 1.f}; sv[m][0] = sv[m][1] = (f32x4){0.f, 0.f, 0.f, 0.f}; }
            }
#pragma unroll
            for (int m = 0; m < 4; ++m) {
                const int row = row0 + ai * 128 + m * 16;
                const float rs = __builtin_amdgcn_rsqf(rsv[ai][m] * (1.0f / DM) + EPS);
                const f32x4 a0 = acc[ai][0][m][0] * rs, a1 = acc[ai][0][m][1] * rs, b0 = acc[ai][1][m][0] * rs, b1 = acc[ai][1][m][1] * rs;
                const f32x4 na0 = a0 * cc[m][0] - b0 * sv[m][0], nb0 = b0 * cc[m][0] + a0 * sv[m][0], na1 = a1 * cc[m][1] - b1 * sv[m][1], nb1 = b1 * cc[m][1] + a1 * sv[m][1];
                bf16_t* rowp = O + (size_t)row * PW + col0;
                u32x4 w; w.x = cvt_pk_bf16(na0[0], na0[1]); w.y = cvt_pk_bf16(na0[2], na0[3]); w.z = cvt_pk_bf16(na1[0], na1[1]); w.w = cvt_pk_bf16(na1[2], na1[3]);
                *(u32x4*)rowp = w;
                u32x4 v; v.x = cvt_pk_bf16(nb0[0], nb0[1]); v.y = cvt_pk_bf16(nb0[2], nb0[3]); v.z = cvt_pk_bf16(nb1[0], nb1[1]); v.w = cvt_pk_bf16(nb1[2], nb1[3]);
                *(u32x4*)(rowp + 128) = v;
            }
        }
    }
};
struct EpiQkv {
    static constexpr bool PERM = false, AFTER_DRAIN = false;
    bf16_t* O; const float* cs; const float* sn; const u64_t* ssq;
    __device__ __forceinline__ void operator()(const f32x4 (&acc)[2][2][4][2], const Unit& u, int wr, int wc, int fr, int fq) const {
        const int col0 = u.pn * 256 + wc * 32 + 4 * fq;
        const bool rot = (u.pn < 16) && (wc == 0);
        const float sc0 = (u.pn < 8) ? QSCALE : 1.0f;
        float rsv[2][4]; f32x4 cv[2][4], sv[2][4];
#pragma unroll
        for (int ai = 0; ai < 2; ++ai)
#pragma unroll
            for (int m = 0; m < 4; ++m) { const int row = u.pm * 256 + ai * 128 + wr * 64 + m * 16 + fr; rsv[ai][m] = (float)ssq[row] * SSQ_INV;
                if (rot) { const int pos = row & (SEQ - 1); cv[ai][m] = *(const f32x4*)(cs + pos * 16 + 4 * fq); sv[ai][m] = *(const f32x4*)(sn + pos * 16 + 4 * fq); }
                else { cv[ai][m] = (f32x4){1.f, 1.f, 1.f, 1.f}; sv[ai][m] = (f32x4){0.f, 0.f, 0.f, 0.f}; } }
#pragma unroll
        for (int ai = 0; ai < 2; ++ai)
#pragma unroll
            for (int m = 0; m < 4; ++m) {
                const int row = u.pm * 256 + ai * 128 + wr * 64 + m * 16 + fr;
                const float sc = sc0 * __builtin_amdgcn_rsqf(rsv[ai][m] * (1.0f / DM) + EPS);
                const f32x4 c = cv[ai][m], s = sv[ai][m];
#pragma unroll
                for (int bj = 0; bj < 2; ++bj) {
                    const f32x4 x0 = acc[ai][bj][m][0], x1 = acc[ai][bj][m][1];
                    const f32x4 n0 = (x0 * c - x1 * s) * sc, n1 = (x1 * c + x0 * s) * sc;
                    bf16_t* p = O + (size_t)row * QW + col0 + bj * 128;
                    u32x2 w0; w0.x = cvt_pk_bf16(n0[0], n0[1]); w0.y = cvt_pk_bf16(n0[2], n0[3]); *(u32x2*)p = w0;
                    u32x2 w1; w1.x = cvt_pk_bf16(n1[0], n1[1]); w1.y = cvt_pk_bf16(n1[2], n1[3]); *(u32x2*)(p + 16) = w1;
                }
            }
    }
};
struct EpiGlu {
    static constexpr bool PERM = true, AFTER_DRAIN = false;
    const bf16_t* Z; const float* bias; bf16_t* Y;
    __device__ __forceinline__ void operator()(const f32x4 (&acc)[2][2][4][2], const Unit& u, int wr, int wc, int fr, int fq) const {
        const int row0 = u.pm * 256 + wr * 64 + fr, col0 = u.pn * 256 + wc * 32 + 8 * fq;
#pragma unroll
        for (int bj = 0; bj < 2; ++bj) {
            const f32x4 bv0 = *(const f32x4*)(bias + col0 + bj * 128), bv1 = *(const f32x4*)(bias + col0 + bj * 128 + 4);
            u32x4 zz[2][4];
#pragma unroll
            for (int ai = 0; ai < 2; ++ai)
#pragma unroll
                for (int m = 0; m < 4; ++m) zz[ai][m] = *(const u32x4*)(Z + (size_t)(row0 + ai * 128 + m * 16) * 1024 + col0 + bj * 128);
#pragma unroll
            for (int ai = 0; ai < 2; ++ai)
#pragma unroll
                for (int m = 0; m < 4; ++m) {
                    const int row = row0 + ai * 128 + m * 16;
                    const u32x4 z4 = zz[ai][m];
                    const f32x4 v0 = acc[ai][bj][m][0] + bv0, v1 = acc[ai][bj][m][1] + bv1;
                    u32x4 w;
                    w.x = cvt_pk_bf16(bflo(z4.x) * fast_sigmoid(v0[0]), bfhi(z4.x) * fast_sigmoid(v0[1]));
                    w.y = cvt_pk_bf16(bflo(z4.y) * fast_sigmoid(v0[2]), bfhi(z4.y) * fast_sigmoid(v0[3]));
                    w.z = cvt_pk_bf16(bflo(z4.z) * fast_sigmoid(v1[0]), bfhi(z4.z) * fast_sigmoid(v1[1]));
                    w.w = cvt_pk_bf16(bflo(z4.w) * fast_sigmoid(v1[2]), bfhi(z4.w) * fast_sigmoid(v1[3]));
                    *(u32x4*)(Y + (size_t)row * DM + 1024 + col0 + bj * 128) = w;
                }
        }
    }
};

template <class Epi>
__device__ __forceinline__ void run_gemm(LAS unsigned char* lds, const bf16_t* A, const bf16_t* Bt, int M, int N, int K, const Epi E) {
    pg8::Gemm g{A, Bt, M, N, K}; pg8::StaticOrder S; S.init(M, N, (int)gridDim.x, (int)blockIdx.x);
    pg8::gemm_phase<Epi, pg8::StaticOrder, true, true>(lds, g, S, E);
}

__device__ __forceinline__ void conv_matrix(const float* __restrict__ W, bf16_t* __restrict__ WT, int K, int N, int mode, const float* __restrict__ gain, LAS float* scr, int gw, int NGW, int lane) {
    const int nblk = N / 64, nitems = (K / 64) * nblk;
    for (int item = gw; item < nitems; item += NGW) {
        const int kb = item / nblk, nb = item % nblk, k0 = 64 * kb, n0 = 64 * nb;
        const float gv = gain ? gain[k0 + lane] : 1.0f;
        const float* wp = W + (size_t)k0 * N + n0 + lane;
#pragma unroll
        for (int i = 0; i < 64; ++i) { const float v = wp[(size_t)i * N];
            scr[i * 65 + lane] = v * __builtin_bit_cast(float, __builtin_amdgcn_readlane(__builtin_bit_cast(int, gv), i)); }
        asm volatile("s_waitcnt lgkmcnt(0)" ::: "memory");
        const int c = lane & 7, ns = lane >> 3;
        const int rbase = (mode == 0) ? n0 : ((n0 >> 7) * 256 + (n0 & 127) + (mode == 2 ? 128 : 0));
#pragma unroll
        for (int j = 0; j < 8; ++j) { const int n = ns + 8 * j; const LAS float* sp = scr + (8 * c) * 65 + n;
            u32x4 o; o.x = pk2(sp[0 * 65], sp[1 * 65]); o.y = pk2(sp[2 * 65], sp[3 * 65]); o.z = pk2(sp[4 * 65], sp[5 * 65]); o.w = pk2(sp[6 * 65], sp[7 * 65]);
            *(u32x4*)(WT + (size_t)(rbase + n) * K + k0 + 8 * c) = o; }
        asm volatile("s_waitcnt lgkmcnt(0)" ::: "memory");
    }
}

template <bool TO_BF16>
__device__ __forceinline__ void rmsnorm_phase(const float* in, const float* __restrict__ g, bf16_t* outb, float* outf, int gw, int NGW, int lane) {
    f32x4 gv[8];
#pragma unroll
    for (int j = 0; j < 8; ++j) gv[j] = ((const f32x4*)g)[lane + 64 * j];
    for (int row = gw; row < TT; row += NGW) {
        const f32x4* xr = (const f32x4*)(in + (size_t)row * DM) + lane;
        f32x4 v[8]; float ss = 0.f;
#pragma unroll
        for (int j = 0; j < 8; ++j) { v[j] = xr[64 * j]; ss += (v[j][0] * v[j][0] + v[j][1] * v[j][1]) + (v[j][2] * v[j][2] + v[j][3] * v[j][3]); }
        const float rs = 1.0f / sqrtf(wave_sum(ss) * (1.0f / DM) + EPS);
#pragma unroll
        for (int j = 0; j < 8; ++j) {
            const f32x4 y = v[j] * rs * gv[j];
            if constexpr (TO_BF16) { u32x2 w; w.x = pk2(y[0], y[1]); w.y = pk2(y[2], y[3]); *((u32x2*)(outb + (size_t)row * DM) + lane + 64 * j) = w; }
            else { *((f32x4*)(outf + (size_t)row * DM) + lane + 64 * j) = y; }
        }
    }
}

__device__ __forceinline__ void cast_phase(const float* in, bf16_t* outb, u64_t* ssq, int gw, int NGW, int lane) {
    for (int row = gw; row < TT; row += NGW) {
        const f32x4* xr = (const f32x4*)(in + (size_t)row * DM) + lane;
        f32x4 v[8]; float ss = 0.f;
#pragma unroll
        for (int j = 0; j < 8; ++j) { v[j] = xr[64 * j]; ss += (v[j][0] * v[j][0] + v[j][1] * v[j][1]) + (v[j][2] * v[j][2] + v[j][3] * v[j][3]); }
        ss = wave_sum(ss);
        if (lane == 0) ssq[row] = (u64_t)(ss * SSQ_FIX);
#pragma unroll
        for (int j = 0; j < 8; ++j) { u32x2 w; w.x = pk2(v[j][0], v[j][1]); w.y = pk2(v[j][2], v[j][3]); *((u32x2*)(outb + (size_t)row * DM) + lane + 64 * j) = w; }
    }
}

__device__ __forceinline__ void final_phase(const bf16_t* xb, const u64_t* ssq, const float* __restrict__ g, float* outf, int gw, int NGW, int lane) {
    f32x4 gv[4][2];
#pragma unroll
    for (int j = 0; j < 4; ++j) { gv[j][0] = *(const f32x4*)(g + 8 * (lane + 64 * j)); gv[j][1] = *(const f32x4*)(g + 8 * (lane + 64 * j) + 4); }
    for (int row = gw; row < TT; row += NGW) {
        const float rs = __builtin_amdgcn_rsqf((float)ssq[row] * SSQ_INV * (1.0f / DM) + EPS);
        const u32x4* xr = (const u32x4*)(xb + (size_t)row * DM) + lane;
        u32x4 v[4];
#pragma unroll
        for (int j = 0; j < 4; ++j) v[j] = xr[64 * j];
#pragma unroll
        for (int j = 0; j < 4; ++j) {
            float* op = outf + (size_t)row * DM + 8 * (lane + 64 * j);
            *(f32x4*)op = (f32x4){bflo(v[j].x), bfhi(v[j].x), bflo(v[j].y), bfhi(v[j].y)} * rs * gv[j][0];
            *(f32x4*)(op + 4) = (f32x4){bflo(v[j].z), bfhi(v[j].z), bflo(v[j].w), bfhi(v[j].w)} * rs * gv[j][1];
        }
    }
}

__device__ __forceinline__ void tables_phase(unsigned char* ws, const float* const* in_unused, const float* lam_re, const float* lam_im, const float* log_step, const float* b_re, const float* b_im,
                                             const float* lq1, const float* lk1, const float* lq2, const float* lk2, int gtid, int NT_) {
    float* rcos = (float*)(ws + WS_RCOS); float* rsin = (float*)(ws + WS_RSIN); float* acos_ = (float*)(ws + WS_ACOS); float* asin_ = (float*)(ws + WS_ASIN);
    float* s5a = (float*)(ws + WS_S5A); float* s5bb = (float*)(ws + WS_S5BB);
    for (int i = gtid; i < SEQ * 128; i += NT_) {
        const int pos = i >> 7, f = i & 127;
        const float inv = (float)exp2(-((double)(2 * f) / 256.0) * 13.287712379549449);
        const float ang = (float)pos * inv; double s, c; sincos_d((double)ang, s, c); rcos[i] = (float)c; rsin[i] = (float)s;
    }
    for (int i = gtid; i < SEQ * 16; i += NT_) {
        const int pos = i >> 4, f = i & 15;
        const float inv = (float)exp2(-((double)(2 * f) / 32.0) * 18.931568569324174);
        const float ang = (float)pos * inv; double s, c; sincos_d((double)ang, s, c); acos_[i] = (float)c; asin_[i] = (float)s;
    }
    for (int i = gtid; i < 64 * 64; i += NT_) {
        const int g = i >> 6;
        const double step = exp((double)log_step[g]), lr = (double)lam_re[i], li = (double)lam_im[i];
        const double mag = exp(lr * step); double s, c; sincos_d(li * step, s, c);
        const double are = mag * c, aim = mag * s, den = lr * lr + li * li, nr = are - 1.0;
        const double fre = (nr * lr + aim * li) / den, fim = (aim * lr - nr * li) / den;
        s5a[2 * i] = (float)are; s5a[2 * i + 1] = (float)aim;
        for (int p = 0; p < 16; ++p) { const double br = (double)b_re[i * 16 + p], bi = (double)b_im[i * 16 + p];
            s5bb[(size_t)i * 32 + p] = (float)(fre * br - fim * bi); s5bb[(size_t)i * 32 + 16 + p] = (float)(fre * bi + fim * br); }
    }
    if (gtid == 0) { float s1 = 0.f, s2 = 0.f; for (int i = 0; i < 128; ++i) { s1 += lq1[i] * lk1[i]; s2 += lq2[i] * lk2[i]; }
        ((float*)(ws + WS_CTL))[0] = expf(s1) - expf(s2) + LAMBDA_INIT; }
}

__device__ __forceinline__ void s5_phase(LAS unsigned char* lds, const unsigned char* ws, const bf16_t* proj, const float* c_re, const float* c_im, const float* dskip, bf16_t* z,
                                         int vcu, int G, int wave, int lane) {
    if (wave >= 4) return;
    const float* s5a = (const float*)(ws + WS_S5A); const float* s5bb = (const float*)(ws + WS_S5BB);
    LAS bf16_t* Hc = (LAS bf16_t*)(lds + wave * 8704);
    const int fr = lane & 15, fq = lane >> 4;
    for (int seq = vcu * 4 + wave; seq < 1024; seq += G * 4) {
        const int b = seq >> 6, g = seq & 63, n = lane;
        float bbre[16], bbim[16];
#pragma unroll
        for (int p = 0; p < 16; ++p) { bbre[p] = s5bb[(size_t)(g * 64 + n) * 32 + p]; bbim[p] = s5bb[(size_t)(g * 64 + n) * 32 + 16 + p]; }
        const float are = s5a[2 * (g * 64 + n)], aim = s5a[2 * (g * 64 + n) + 1];
        bf16x8 cf[4];
#pragma unroll
        for (int ks = 0; ks < 4; ++ks) { u32x4 w; unsigned* wp = (unsigned*)&w;
#pragma unroll
            for (int j2 = 0; j2 < 4; ++j2) { float v[2];
#pragma unroll
                for (int e = 0; e < 2; ++e) { const int k = 32 * ks + 8 * fq + 2 * j2 + e; v[e] = (k < 64) ? c_re[(size_t)(g * 16 + fr) * 64 + k] : -c_im[(size_t)(g * 16 + fr) * 64 + (k - 64)]; }
                wp[j2] = pk2(v[0], v[1]); }
            cf[ks] = __builtin_bit_cast(bf16x8, w); }
        const float dsk = dskip[g * 16 + fr];
        float hre = 0.f, him = 0.f;
        for (int ch = 0; ch < SEQ / 32; ++ch) {
            const size_t row0 = (size_t)b * SEQ + ch * 32;
            const bf16_t* up = proj + (row0 + (lane & 31)) * PW + 4096 + g * 16;
            const u32x4 ua = *(const u32x4*)up, ub = *(const u32x4*)(up + 8);
            float uf[16];
            uf[0] = bflo(ua.x); uf[1] = bfhi(ua.x); uf[2] = bflo(ua.y); uf[3] = bfhi(ua.y); uf[4] = bflo(ua.z); uf[5] = bfhi(ua.z); uf[6] = bflo(ua.w); uf[7] = bfhi(ua.w);
            uf[8] = bflo(ub.x); uf[9] = bfhi(ub.x); uf[10] = bflo(ub.y); uf[11] = bfhi(ub.y); uf[12] = bflo(ub.z); uf[13] = bfhi(ub.z); uf[14] = bflo(ub.w); uf[15] = bfhi(ub.w);
#pragma unroll
            for (int k = 0; k < 32; ++k) {
                f32x2 xx = (f32x2){0.f, 0.f};
#pragma unroll
                for (int p = 0; p < 16; ++p) { const float su = __builtin_bit_cast(float, __builtin_amdgcn_readlane(__builtin_bit_cast(int, uf[p]), k));
                    xx = __builtin_elementwise_fma((f32x2){su, su}, (f32x2){bbre[p], bbim[p]}, xx); }
                const float nr = are * hre - aim * him + xx[0], ni = are * him + aim * hre + xx[1]; hre = nr; him = ni;
                Hc[k * 136 + n] = (bf16_t)f2bf(hre); Hc[k * 136 + 64 + n] = (bf16_t)f2bf(him);
            }
#pragma unroll
            for (int sb = 0; sb < 2; ++sb) {
                f32x4 y = (f32x4){0.f, 0.f, 0.f, 0.f};
#pragma unroll
                for (int ks = 0; ks < 4; ++ks) { const bf16x8 hf = *(const LAS bf16x8*)(Hc + (16 * sb + fr) * 136 + 32 * ks + 8 * fq); y = __builtin_amdgcn_mfma_f32_16x16x32_bf16(hf, cf[ks], y, 0, 0, 0); }
#pragma unroll
                for (int i = 0; i < 4; ++i) { const size_t row = row0 + 16 * sb + 4 * fq + i;
                    const float uu = bf2f(proj[row * PW + 4096 + g * 16 + fr]); const float yy = y[i] + dsk * uu;
                    z[row * 1024 + g * 16 + fr] = (bf16_t)f2bf(gelu_tanh_f(yy)); }
            }
        }
    }
}

#define MF32(a, b, c) __builtin_amdgcn_mfma_f32_32x32x16_bf16((a), (b), (c), 0, 0, 0)
#define AT_WAITV(n) asm volatile("s_waitcnt vmcnt(" #n ")" ::: "memory")
#define AT_BAR() asm volatile("s_waitcnt lgkmcnt(0)\n\ts_barrier" ::: "memory")
__device__ __forceinline__ s16x4 vtr(const LAS unsigned char* p) { typedef short v4i16_t __attribute__((ext_vector_type(4))); return __builtin_bit_cast(s16x4, __builtin_amdgcn_ds_read_tr16_b64_v4i16((LAS v4i16_t*)p)); }
__device__ __forceinline__ int crow(int i, int h) { return (i & 3) + 8 * (i >> 2) + 4 * h; }

template <int MODE>
__device__ __forceinline__ void attn_unit(LAS unsigned char* lds, const bf16_t* src, const int pitch, const int kcol, const int vcol, const int b, const int h, const int ub,
                                          bf16_t* outp, const bf16_t* gsrc, const float* subln, const float lam) {
    constexpr int NKS = MODE ? 8 : 16, NDB = 4, ROWS = MODE ? 64 : 128;
    const int tid = threadIdx.x, lane = tid & 63, r = lane & 31, hh = lane >> 5;
    const int wid = __builtin_amdgcn_readfirstlane(tid >> 6);
    const int rg = MODE ? (wid & 1) : (wid & 3), vh = MODE ? ((wid >> 1) & 1) : (wid >> 2), cc = MODE ? (wid >> 2) : 0;
    const size_t rowbase = (size_t)b * SEQ; const int q0 = ub * ROWS, NT = MODE ? (ub + 1) : (2 * ub + 2);
    const int qrow = q0 + rg * 32 + r;
    AT_WAITV(0);
#define AT_ISSUE(t, buf) do { const bf16_t* gk_ = src + (rowbase + (size_t)(t) * 64) * pitch; int rv_ = r; asm volatile("" : "+v"(rv_)); \
        _Pragma("unroll") for (int i_ = 0; i_ < 4; ++i_) { const int c_ = wid * 4 + i_; const int row_ = c_ * 2 + hh; \
            const unsigned ok_ = (unsigned)(row_ * pitch + kcol + ((rv_ ^ (row_ & 15)) << 3)); \
            __builtin_amdgcn_global_load_lds((const unsigned*)(gk_ + ok_), (LAS unsigned*)(lds + (buf) * 65536 + c_ * 1024), 16, 0, 0); \
            const unsigned ov_ = (unsigned)(row_ * pitch + vcol + ((rv_ ^ ((row_ & 3) << 2)) << 3)); \
            __builtin_amdgcn_global_load_lds((const unsigned*)(gk_ + ov_), (LAS unsigned*)(lds + (buf) * 65536 + 32768 + c_ * 1024), 16, 0, 0); } } while (0)
    AT_ISSUE(0, 0);
    bf16x8 qf[NKS];
    { const bf16_t* qp = src + (rowbase + qrow) * pitch + h * 256 + cc * 128 + 8 * hh;
#pragma unroll
      for (int d0 = 0; d0 < NKS; ++d0) qf[d0] = *(const bf16x8*)(qp + 16 * d0); }
    f32x16 O[NDB];
#pragma unroll
    for (int db = 0; db < NDB; ++db)
#pragma unroll
        for (int i = 0; i < 16; ++i) O[db][i] = 0.f;
    float mrun = 0.f, lrun = 0.f;
    const float lgam = __builtin_log2f(1.0f - __builtin_amdgcn_exp2f(-5.0f - (float)h));
    const int r15 = r & 15;
    const int kunit0 = cc * 16;
    const int q4 = (lane & 15) >> 2, p4 = lane & 3, blk16 = (lane >> 4) & 1;
    const int vlane = (4 * hh + q4) * 512 + ((2 * blk16 + (p4 >> 1)) << 4) + 8 * (p4 & 1);
    for (int t = 0; t < NT; ++t) {
        if (t + 1 < NT) { AT_ISSUE(t + 1, (t + 1) & 1); AT_WAITV(8); } else { AT_WAITV(0); }
        AT_BAR();
        const bool active = MODE ? true : !(t == NT - 1 && rg < 2);
        if (active) {
            const LAS unsigned char* Kb = lds + (t & 1) * 65536; const LAS unsigned char* Vb = Kb + 32768;
            int r15v = r15 ^ hh ^ kunit0, q4v = q4 << 2; asm volatile("" : "+v"(r15v), "+v"(q4v));
            bf16x8 pf[4];
            if constexpr (MODE) {
                f32x16 p0, p1;
#pragma unroll
                for (int i = 0; i < 16; ++i) { p0[i] = -mrun; p1[i] = -mrun; }
                { const LAS unsigned char* kr0 = Kb + r * 512; const LAS unsigned char* kr1 = Kb + (32 + r) * 512;
#pragma unroll
                  for (int d0 = 0; d0 < NKS; ++d0) { const int uo = ((2 * d0) ^ r15v) << 4;
                      const bf16x8 k0 = *(const LAS bf16x8*)(kr0 + uo); const bf16x8 k1 = *(const LAS bf16x8*)(kr1 + uo);
                      p0 = MF32(k0, qf[d0], p0); p1 = MF32(k1, qf[d0], p1);
                      if ((d0 & 3) == 3) __builtin_amdgcn_sched_barrier(0); } }
                float rm = p0[0];
#pragma unroll
                for (int i = 0; i < 16; ++i) { rm = fmaxf(rm, p0[i]); rm = fmaxf(rm, p1[i]); }
                rm = fmaxf(rm, __shfl_xor(rm, 32));
                if (t == 0 || __any(rm > 8.0f)) {
                    const float dl = (t == 0) ? rm : fmaxf(rm, 0.f); const float al = (t == 0) ? 1.0f : __builtin_amdgcn_exp2f(-dl); lrun *= al; mrun += dl;
#pragma unroll
                    for (int i = 0; i < 16; ++i) { p0[i] -= dl; p1[i] -= dl; }
#pragma unroll
                    for (int db = 0; db < NDB; ++db) O[db] = O[db] * al;
                }
                float sum = 0.f;
#pragma unroll
                for (int i = 0; i < 16; ++i) { p0[i] = __builtin_amdgcn_exp2f(p0[i]); p1[i] = __builtin_amdgcn_exp2f(p1[i]); sum += p0[i] + p1[i]; }
                lrun += sum;
                u32x4 w;
                w.x = cvt_pk_bf16(p0[0], p0[1]); w.y = cvt_pk_bf16(p0[2], p0[3]); w.z = cvt_pk_bf16(p0[4], p0[5]); w.w = cvt_pk_bf16(p0[6], p0[7]); pf[0] = __builtin_bit_cast(bf16x8, w);
                w.x = cvt_pk_bf16(p0[8], p0[9]); w.y = cvt_pk_bf16(p0[10], p0[11]); w.z = cvt_pk_bf16(p0[12], p0[13]); w.w = cvt_pk_bf16(p0[14], p0[15]); pf[1] = __builtin_bit_cast(bf16x8, w);
                w.x = cvt_pk_bf16(p1[0], p1[1]); w.y = cvt_pk_bf16(p1[2], p1[3]); w.z = cvt_pk_bf16(p1[4], p1[5]); w.w = cvt_pk_bf16(p1[6], p1[7]); pf[2] = __builtin_bit_cast(bf16x8, w);
                w.x = cvt_pk_bf16(p1[8], p1[9]); w.y = cvt_pk_bf16(p1[10], p1[11]); w.z = cvt_pk_bf16(p1[12], p1[13]); w.w = cvt_pk_bf16(p1[14], p1[15]); pf[3] = __builtin_bit_cast(bf16x8, w);
            } else {
#pragma unroll
                for (int blk = 0; blk < 2; ++blk) {
                    f32x16 p;
#pragma unroll
                    for (int i = 0; i < 16; ++i) p[i] = 0.f;
                    const LAS unsigned char* kr = Kb + (32 * blk + r) * 512;
#pragma unroll
                    for (int d0 = 0; d0 < NKS; ++d0) { const int uo = ((2 * d0) ^ r15v) << 4;
                        const bf16x8 k0 = *(const LAS bf16x8*)(kr + uo); p = MF32(k0, qf[d0], p);
                        if ((d0 & 3) == 3) __builtin_amdgcn_sched_barrier(0); }
                    const int kb = t * 64 + 32 * blk + 4 * hh;
#pragma unroll
                    for (int i = 0; i < 16; ++i) { const int kv = kb + (i & 3) + 8 * (i >> 2);
                        p[i] *= __builtin_amdgcn_exp2f(lgam * fabsf((float)(qrow - kv)) - 4.0f); }
                    u32x4 w;
                    w.x = cvt_pk_bf16(p[0], p[1]); w.y = cvt_pk_bf16(p[2], p[3]); w.z = cvt_pk_bf16(p[4], p[5]); w.w = cvt_pk_bf16(p[6], p[7]); pf[2 * blk] = __builtin_bit_cast(bf16x8, w);
                    w.x = cvt_pk_bf16(p[8], p[9]); w.y = cvt_pk_bf16(p[10], p[11]); w.z = cvt_pk_bf16(p[12], p[13]); w.w = cvt_pk_bf16(p[14], p[15]); pf[2 * blk + 1] = __builtin_bit_cast(bf16x8, w);
                    __builtin_amdgcn_sched_barrier(0);
                }
            }
            const LAS unsigned char* vb = Vb + vlane;
            __builtin_amdgcn_sched_barrier(0);
#pragma unroll
            for (int db = 0; db < NDB; ++db) {
                const int dunit = vh * 16 + 4 * db;
                const LAS unsigned char* vp = vb + ((dunit ^ q4v) << 4);
#pragma unroll
                for (int ks = 0; ks < 4; ++ks) {
                    const int kvb = 32 * (ks >> 1) + 16 * (ks & 1);
                    const s16x4 lo = vtr(vp + kvb * 512), hi = vtr(vp + (kvb + 8) * 512);
                    const bf16x8 vf = __builtin_shufflevector(lo, hi, 0, 1, 2, 3, 4, 5, 6, 7);
                    O[db] = MF32(vf, pf[ks], O[db]);
                }
                __builtin_amdgcn_sched_barrier(0);
            }
        }
        AT_BAR();
    }
    const size_t orow = rowbase + qrow;
    LAS float* SS = (LAS float*)(lds + 131072);
    if constexpr (MODE) {
        const float l = lrun + __shfl_xor(lrun, 32); const float inv = 1.0f / l;
        LAS float* X = (LAS float*)(lds + (wid & 3) * 16384);
        if (cc == 1) {
#pragma unroll
            for (int db = 0; db < NDB; ++db)
#pragma unroll
                for (int i = 0; i < 16; ++i) X[(db * 16 + i) * 64 + lane] = O[db][i] * inv;
        }
        AT_BAR();
        float ss = 0.f;
        if (cc == 0) {
#pragma unroll
            for (int db = 0; db < NDB; ++db)
#pragma unroll
                for (int i = 0; i < 16; ++i) { const float o = O[db][i] * inv - lam * X[(db * 16 + i) * 64 + lane]; O[db][i] = o; ss += o * o; }
        }
        ss += __shfl_xor(ss, 32);
        if (hh == 0) SS[wid * 32 + r] = ss;
        AT_BAR();
        if (cc == 0) {
            ss += SS[(wid ^ 2) * 32 + r];
            const float rs = (1.0f - LAMBDA_INIT) / sqrtf(ss * (1.0f / 256.0f) + EPS);
            bf16_t* op = outp + orow * DM + h * 256 + vh * 128 + 4 * hh;
            const float* slp = subln + vh * 128 + 4 * hh;
#pragma unroll
            for (int db = 0; db < NDB; ++db)
#pragma unroll
                for (int i4 = 0; i4 < 4; ++i4) { const int d = 32 * db + 8 * i4;
                    const f32x4 sl = *(const f32x4*)(slp + d);
                    u32x2 w; w.x = cvt_pk_bf16(O[db][4 * i4] * rs * sl[0], O[db][4 * i4 + 1] * rs * sl[1]); w.y = cvt_pk_bf16(O[db][4 * i4 + 2] * rs * sl[2], O[db][4 * i4 + 3] * rs * sl[3]);
                    *(u32x2*)(op + d) = w; }
        }
        AT_BAR();
    } else {
        float ss = 0.f;
#pragma unroll
        for (int db = 0; db < NDB; ++db)
#pragma unroll
            for (int i = 0; i < 16; ++i) ss += O[db][i] * O[db][i];
        ss += __shfl_xor(ss, 32);
        if (hh == 0) SS[wid * 32 + r] = ss;
        AT_BAR();
        ss += SS[(wid ^ 4) * 32 + r];
        const float rs = 1.0f / sqrtf(ss * (1.0f / 256.0f) + EPS);
        const bf16_t* gp = gsrc + orow * PW + 3072 + h * 256 + vh * 128 + 4 * hh;
        bf16_t* op = outp + orow * DM + h * 256 + vh * 128 + 4 * hh;
#pragma unroll
        for (int db = 0; db < NDB; ++db)
#pragma unroll
            for (int i4 = 0; i4 < 4; ++i4) { const int d = 32 * db + 8 * i4;
                const u32x2 gg = *(const u32x2*)(gp + d);
                u32x2 w; w.x = cvt_pk_bf16(O[db][4 * i4] * rs * silu_f(bflo(gg.x)), O[db][4 * i4 + 1] * rs * silu_f(bfhi(gg.x)));
                w.y = cvt_pk_bf16(O[db][4 * i4 + 2] * rs * silu_f(bflo(gg.y)), O[db][4 * i4 + 3] * rs * silu_f(bfhi(gg.y)));
                *(u32x2*)(op + d) = w; }
        AT_BAR();
    }
#undef AT_ISSUE
}

template <int MODE>
__device__ __forceinline__ void attn_phase(LAS unsigned char* lds, const bf16_t* src, int pitch, int kcol0, int vcol0, int nheads, bf16_t* outp, const bf16_t* gsrc, const float* subln, float lam, int vcu, int G) {
    constexpr int NU = MODE ? 32 : 16;
    const int npairs = 16 * nheads * (NU / 2);
    for (int pr = vcu; pr < npairs; pr += G) {
        const int bh = pr / (NU / 2), p = pr % (NU / 2), b = bh / nheads, h = bh % nheads;
        attn_unit<MODE>(lds, src, pitch, kcol0 + h * 256, vcol0 + h * 256, b, h, NU - 1 - p, outp, gsrc, subln, lam);
        attn_unit<MODE>(lds, src, pitch, kcol0 + h * 256, vcol0 + h * 256, b, h, p, outp, gsrc, subln, lam);
    }
}

#define XB_TMO      128
#define XB_XCNT(j)  (256  + 64 * (j))
#define XB_XSUB(j)  (1280 + 64 * (j))
#define XB_XGEN(j)  (2304 + 64 * (j))
#define XB_TOP      3328
#define XB_TOPGEN   3392
#define XCD_BAR_WORDS 3456
#define XB_SPIN_CAP (1u << 18)
__device__ __forceinline__ unsigned xb_ld(unsigned* p)              { return __hip_atomic_load(p, __ATOMIC_RELAXED, __HIP_MEMORY_SCOPE_AGENT); }
__device__ __forceinline__ unsigned xb_add(unsigned* p, unsigned v) { return __hip_atomic_fetch_add(p, v, __ATOMIC_RELAXED, __HIP_MEMORY_SCOPE_AGENT); }
__device__ __forceinline__ unsigned xb_xcc_id() { return (unsigned)__builtin_amdgcn_s_getreg((3 << 11) | 20) & 0xFu; }
#define XB_SPIN(cond, bar) do { unsigned _sp = 0; while (cond) { __builtin_amdgcn_s_sleep(1); \
    if ((++_sp & 255u) == 0u) { if (xb_ld(&(bar)[XB_TMO])) break; if (_sp > XB_SPIN_CAP) { atomicAdd(&(bar)[XB_TMO], 1u); break; } } } } while (0)
struct XcdBarrier { unsigned* bar; unsigned x; volatile LAS unsigned* st; };
__device__ __forceinline__ XcdBarrier xcd_barrier_post(unsigned* bar, volatile LAS unsigned* st) {
    XcdBarrier b; b.bar = bar; b.x = xb_xcc_id(); b.st = st;
    if (threadIdx.x == 0) (void)xb_add(&bar[XB_XCNT(b.x)], 1u);
    return b;
}
__device__ __forceinline__ void xcd_barrier_complete(unsigned* bar, unsigned x, unsigned& nloc, unsigned& nx) {
    const unsigned G = gridDim.x * gridDim.y * gridDim.z;
    unsigned sum, cnt, mine, sp = 0u;
    for (;;) {
        sum = 0u; cnt = 0u; mine = 0u;
#pragma unroll
        for (unsigned j = 0; j < 16; ++j) { const unsigned c = xb_ld(&bar[XB_XCNT(j)]); sum += c; cnt += (c > 0u) ? 1u : 0u; mine = (j == x) ? c : mine; }
        if (sum == G) break;
        __builtin_amdgcn_s_sleep(1);
        if ((++sp & 255u) == 0u) { if (xb_ld(&bar[XB_TMO])) break; if (sp > XB_SPIN_CAP) { atomicAdd(&bar[XB_TMO], 1u); break; } }
    }
    nloc = mine > 0u ? mine : 1u; nx = cnt > 0u ? cnt : 1u;
}
__device__ __forceinline__ void xcd_barrier(const XcdBarrier& b) {
    asm volatile("s_waitcnt vmcnt(0)" ::: "memory");
    __syncthreads();
    if (threadIdx.x == 0) {
        unsigned* bar = b.bar;
        __builtin_amdgcn_s_waitcnt(0);
        unsigned nloc = b.st[0], nx = b.st[1];
        if (nloc == 0u) { xcd_barrier_complete(bar, b.x, nloc, nx); b.st[0] = nloc; b.st[1] = nx; }
        const unsigned old = xb_add(&bar[XB_XSUB(b.x)], 1u);
        const unsigned gen = old / nloc;
        if (old + 1u == (gen + 1u) * nloc) {
            __builtin_amdgcn_fence(__ATOMIC_RELEASE, "agent");
            asm volatile("s_waitcnt vmcnt(0)" ::: "memory");
            const unsigned og = xb_add(&bar[XB_TOP], 1u);
            const unsigned tg = og / nx;
            if (og + 1u == (tg + 1u) * nx) xb_add(&bar[XB_TOPGEN], 1u);
            else XB_SPIN(xb_ld(&bar[XB_TOPGEN]) == tg, bar);
            __builtin_amdgcn_fence(__ATOMIC_ACQUIRE, "agent");
            xb_add(&bar[XB_XGEN(b.x)], 1u);
            asm volatile("s_waitcnt vmcnt(0)" ::: "memory");
        } else {
            XB_SPIN(xb_ld(&bar[XB_XGEN(b.x)]) == gen, bar);
            __builtin_amdgcn_fence(__ATOMIC_ACQUIRE, "agent");
            asm volatile("s_waitcnt vmcnt(0)" ::: "memory");
        }
    }
    __syncthreads();
}

struct Params { const float* in[26]; float* out; unsigned char* ws; int lo, hi; };
constexpr int NPHASE = 17;

__global__ void __launch_bounds__(512) fwd_megakernel(Params P) {
    extern __shared__ __attribute__((aligned(16))) unsigned char lds_raw[];
    LAS unsigned char* lds = (LAS unsigned char*)lds_raw;
    const int tid = threadIdx.x, lane = tid & 63, wave = __builtin_amdgcn_readfirstlane(tid >> 6);
    const int G = gridDim.x, bx = blockIdx.x;
    const int vcu = (G % 8 == 0) ? (bx % 8) * (G / 8) + bx / 8 : bx;
    const int gw = vcu * 8 + wave, NGW = G * 8;
    unsigned char* ws = P.ws;
    float* out = P.out;
    bf16_t* Wgu = (bf16_t*)(ws + WS_WGU); bf16_t* Wd = (bf16_t*)(ws + WS_WD); bf16_t* Win = (bf16_t*)(ws + WS_WIN); bf16_t* Wout = (bf16_t*)(ws + WS_WOUT);
    bf16_t* Wglu = (bf16_t*)(ws + WS_WGLU); bf16_t* Wqkv = (bf16_t*)(ws + WS_WQKV); bf16_t* Wco = (bf16_t*)(ws + WS_WCO);
    bf16_t* XN = (bf16_t*)(ws + WS_XN); bf16_t* BIG = (bf16_t*)(ws + WS_BIG); bf16_t* ZB = (bf16_t*)(ws + WS_Z);
    const float* x = P.in[0]; const float* ffn_norm = P.in[1]; const float* mix_norm = P.in[5];
#if MK_PER_PHASE
#define SYNC(k) do { } while (0)
#else
    cg::grid_group grid = cg::this_grid();
    { volatile LAS unsigned* st0 = (volatile LAS unsigned*)(lds + 139264); if (tid < 2) st0[tid] = 0u; }
    __syncthreads();
    const XcdBarrier xbar = xcd_barrier_post((unsigned*)(ws + WS_BAR), (volatile LAS unsigned*)(lds + 139264));
#define SYNC(k) do { if (P.lo <= (k) && (k) + 1 < P.hi) { if ((k) == 0) grid.sync(); else xcd_barrier(xbar); } } while (0)
#endif
#ifndef DUPMASK
#define DUPMASK 0u
#endif
#define IN(k) (P.lo <= (k) && (k) < P.hi)
#define REP(k) for (int rep_ = 0; rep_ < (((DUPMASK >> (k)) & 1u) ? 2 : 1); ++rep_)

    u64_t* SSQ = (u64_t*)(ws + WS_SSQ);
    bf16_t* YC = (bf16_t*)(ws + WS_YC);
    const float* rcos = (const float*)(ws + WS_RCOS); const float* rsin = (const float*)(ws + WS_RSIN);
    const float* acos_ = (const float*)(ws + WS_ACOS); const float* asin_ = (const float*)(ws + WS_ASIN);
    if (IN(0)) REP(0) {
        LAS float* scr = (LAS float*)(lds + wave * 16640);
        const size_t gsz = (size_t)DM * DFF;
#pragma unroll 1
        for (int i = 0; i < 4; ++i) {
            conv_matrix(P.in[2] + i * gsz, Wgu + (size_t)i * NGU * DM, DM, DFF, 1, ffn_norm + i * DM, scr, gw, NGW, lane);
            conv_matrix(P.in[3] + i * gsz, Wgu + (size_t)i * NGU * DM, DM, DFF, 2, ffn_norm + i * DM, scr, gw, NGW, lane);
            conv_matrix(P.in[4] + i * gsz, Wd + (size_t)i * DM * DFF, DFF, DM, 0, nullptr, scr, gw, NGW, lane);
        }
        conv_matrix(P.in[6], Win, DM, PW, 0, mix_norm, scr, gw, NGW, lane);
        conv_matrix(P.in[7], Wout, DM, DM, 0, nullptr, scr, gw, NGW, lane);
        conv_matrix(P.in[16], Wglu, 1024, 1024, 0, nullptr, scr, gw, NGW, lane);
        conv_matrix(P.in[18], Wqkv, DM, QW, 0, mix_norm + DM, scr, gw, NGW, lane);
        conv_matrix(P.in[19], Wco, DM, DM, 0, nullptr, scr, gw, NGW, lane);
        tables_phase(ws, nullptr, P.in[8], P.in[9], P.in[10], P.in[11], P.in[12], P.in[20], P.in[21], P.in[22], P.in[23], vcu * 512 + tid, G * 512);
        for (int i = vcu * 512 + tid; i < 6 * TT; i += G * 512) SSQ[TT + i] = 0ull;
        cast_phase(x, XN, SSQ, gw, NGW, lane);
    }
    SYNC(0);
#if !MK_PER_PHASE
    if ((DUPMASK >> 20) & 1u) { for (int q_ = 0; q_ < 32; ++q_) grid.sync(); }
#endif
    if (IN(1)) { run_gemm(lds, XN, Wgu, TT, NGU, DM, EpiSwiglu{BIG, DFF, SSQ}); if ((DUPMASK >> 1) & 1u) { run_gemm(lds, XN, Wgu, TT, NGU, DM, EpiSwiglu{BIG, DFF, SSQ}); } }
    SYNC(1);
    if (IN(2)) run_gemm(lds, BIG, Wd, TT, DM, DFF, EpiResid<true, false, 1>{x, nullptr, XN, SSQ + 1 * TT});
    if (IN(2) && ((DUPMASK >> 2) & 1u)) run_gemm(lds, BIG, Wd, TT, DM, DFF, EpiResid<false, false, 2>{nullptr, nullptr, XN, nullptr});
    SYNC(2);
    if (IN(3)) { run_gemm(lds, XN, Win, TT, PW, DM, EpiWin{BIG, rcos, rsin, SSQ + 1 * TT}); if ((DUPMASK >> 3) & 1u) { run_gemm(lds, XN, Win, TT, PW, DM, EpiWin{BIG, rcos, rsin, SSQ + 1 * TT}); } }
    SYNC(3);
    if (IN(4)) REP(4) {
#ifndef NO_A0
        attn_phase<0>(lds, BIG, PW, 1024, 2048, 4, YC, BIG, nullptr, 0.f, vcu, G);
#endif
#ifndef NO_S5
        s5_phase(lds, ws, BIG, P.in[13], P.in[14], P.in[15], ZB, vcu, G, wave, lane);
#endif
    }
    SYNC(4);
    if (IN(5)) run_gemm(lds, ZB, Wglu, TT, 1024, 1024, EpiGlu{ZB, P.in[17], YC});
    SYNC(5);
    if (IN(6)) run_gemm(lds, YC, Wout, TT, DM, DM, EpiResid<false, false, 0>{nullptr, nullptr, XN, SSQ + 2 * TT});
    if (IN(6) && ((DUPMASK >> 6) & 1u)) run_gemm(lds, YC, Wout, TT, DM, DM, EpiResid<false, false, 2>{nullptr, nullptr, XN, nullptr});
    SYNC(6);
    if (IN(7)) { run_gemm(lds, XN, Wgu + (size_t)1 * NGU * DM, TT, NGU, DM, EpiSwiglu{BIG, DFF, SSQ + 2 * TT}); if ((DUPMASK >> 7) & 1u) { run_gemm(lds, XN, Wgu + (size_t)1 * NGU * DM, TT, NGU, DM, EpiSwiglu{BIG, DFF, SSQ + 2 * TT}); } }
    SYNC(7);
    if (IN(8)) run_gemm(lds, BIG, Wd + (size_t)1 * DM * DFF, TT, DM, DFF, EpiResid<false, false, 1>{nullptr, nullptr, XN, SSQ + 3 * TT});
    if (IN(8) && ((DUPMASK >> 8) & 1u)) run_gemm(lds, BIG, Wd + (size_t)1 * DM * DFF, TT, DM, DFF, EpiResid<false, false, 2>{nullptr, nullptr, XN, nullptr});
    SYNC(8);
    if (IN(9)) { run_gemm(lds, XN, Wgu + (size_t)2 * NGU * DM, TT, NGU, DM, EpiSwiglu{BIG, DFF, SSQ + 3 * TT}); if ((DUPMASK >> 9) & 1u) { run_gemm(lds, XN, Wgu + (size_t)2 * NGU * DM, TT, NGU, DM, EpiSwiglu{BIG, DFF, SSQ + 3 * TT}); } }
    SYNC(9);
    if (IN(10)) run_gemm(lds, BIG, Wd + (size_t)2 * DM * DFF, TT, DM, DFF, EpiResid<false, false, 1>{nullptr, nullptr, XN, SSQ + 4 * TT});
    if (IN(10) && ((DUPMASK >> 10) & 1u)) run_gemm(lds, BIG, Wd + (size_t)2 * DM * DFF, TT, DM, DFF, EpiResid<false, false, 2>{nullptr, nullptr, XN, nullptr});
    SYNC(10);
    if (IN(11)) { run_gemm(lds, XN, Wqkv, TT, QW, DM, EpiQkv{BIG, acos_, asin_, SSQ + 4 * TT}); if ((DUPMASK >> 11) & 1u) { run_gemm(lds, XN, Wqkv, TT, QW, DM, EpiQkv{BIG, acos_, asin_, SSQ + 4 * TT}); } }
    SYNC(11);
#ifndef NO_A1
    if (IN(12)) REP(12) { const float lam = ((const float*)(ws + WS_CTL))[0]; attn_phase<1>(lds, BIG, QW, 2048, 4096, 8, YC, nullptr, P.in[24], lam, vcu, G); }
#endif
    SYNC(12);
    if (IN(13)) run_gemm(lds, YC, Wco, TT, DM, DM, EpiResid<false, false, 0>{nullptr, nullptr, XN, SSQ + 5 * TT});
    if (IN(13) && ((DUPMASK >> 13) & 1u)) run_gemm(lds, YC, Wco, TT, DM, DM, EpiResid<false, false, 2>{nullptr, nullptr, XN, nullptr});
    SYNC(13);
    if (IN(14)) { run_gemm(lds, XN, Wgu + (size_t)3 * NGU * DM, TT, NGU, DM, EpiSwiglu{BIG, DFF, SSQ + 5 * TT}); if ((DUPMASK >> 14) & 1u) { run_gemm(lds, XN, Wgu + (size_t)3 * NGU * DM, TT, NGU, DM, EpiSwiglu{BIG, DFF, SSQ + 5 * TT}); } }
    SYNC(14);
    if (IN(15)) run_gemm(lds, BIG, Wd + (size_t)3 * DM * DFF, TT, DM, DFF, EpiResid<false, false, 1>{nullptr, nullptr, XN, SSQ + 6 * TT});
    if (IN(15) && ((DUPMASK >> 15) & 1u)) run_gemm(lds, BIG, Wd + (size_t)3 * DM * DFF, TT, DM, DFF, EpiResid<false, false, 2>{nullptr, nullptr, XN, nullptr});
    SYNC(15);
    if (IN(16)) final_phase(XN, SSQ + 6 * TT, P.in[25], out, gw, NGW, lane);
#undef IN
#undef SYNC
}

extern "C" void kernel_launch(void* const* d_in, const int* in_sizes, int n_in, void* d_out, int out_size, void* d_ws, size_t ws_size, hipStream_t stream) {
    static int grid = 0;
    if (grid == 0) {
        if (n_in != 26 || out_size != TT * DM || ws_size < WS_END) { fprintf(stderr, "kernel_launch: unexpected shapes (n_in %d, out %d, ws %zu < %zu)\n", n_in, out_size, ws_size, (size_t)WS_END); grid = -1; return; }
        int dev = 0, cus = 0, per_cu = 0;
        hipGetDevice(&dev); hipDeviceGetAttribute(&cus, hipDeviceAttributeMultiprocessorCount, dev);
        if (hipFuncSetAttribute((const void*)fwd_megakernel, hipFuncAttributeMaxDynamicSharedMemorySize, LDS_BYTES) != hipSuccess) { fprintf(stderr, "kernel_launch: hipFuncSetAttribute failed\n"); grid = -1; return; }
        if (hipOccupancyMaxActiveBlocksPerMultiprocessor(&per_cu, (const void*)fwd_megakernel, 512, LDS_BYTES) != hipSuccess || per_cu < 1) { fprintf(stderr, "kernel_launch: occupancy query says %d\n", per_cu); per_cu = 1; }
        (void)hipGetLastError();
        grid = cus * per_cu;
        fprintf(stderr, "kernel_launch: grid %d (cus %d x %d)\n", grid, cus, per_cu);
    }
    if (grid < 0) return;
    if (hipMemsetAsync((char*)d_ws + WS_BAR, 0, BAR_BYTES, stream) != hipSuccess) { fprintf(stderr, "kernel_launch: hipMemsetAsync failed\n"); return; }
    Params p{};
    for (int i = 0; i < 26; ++i) p.in[i] = (const float*)d_in[i];
    p.out = (float*)d_out; p.ws = (unsigned char*)d_ws;
#if MK_PER_PHASE
    for (int k = 0; k < NPHASE; ++k) { p.lo = k; p.hi = k + 1; hipLaunchKernelGGL(fwd_megakernel, dim3(grid), dim3(512), LDS_BYTES, stream, p); }
#else
    p.lo = 0; p.hi = NPHASE;
    void* args[] = {&p};
    hipError_t e = hipLaunchCooperativeKernel((const void*)fwd_megakernel, dim3(grid), dim3(512), args, LDS_BYTES, stream);
    if (e != hipSuccess) fprintf(stderr, "cooperative launch failed: %s (grid %d)\n", hipGetErrorString(e), grid);
#endif
}
```

```cpp
#include <hip/hip_runtime.h>
#include <hip/hip_cooperative_groups.h>
#include <cstdio>
#include <cstdint>
namespace cg = cooperative_groups;

#define LAS __attribute__((address_space(3)))
typedef unsigned short bf16_t;
typedef unsigned long long u64_t;
constexpr float SSQ_FIX = 16777216.0f, SSQ_INV = 1.0f / 16777216.0f;
typedef short bf16x8 __attribute__((ext_vector_type(8)));
typedef short s16x4 __attribute__((ext_vector_type(4)));
typedef float f32x4 __attribute__((ext_vector_type(4)));
typedef float f32x2 __attribute__((ext_vector_type(2)));
typedef float f32x16 __attribute__((ext_vector_type(16)));
typedef unsigned u32x4 __attribute__((ext_vector_type(4)));
typedef unsigned u32x2 __attribute__((ext_vector_type(2)));

#ifndef MK_PER_PHASE
#define MK_PER_PHASE 0
#endif

constexpr int TT = 32768, SEQ = 2048, DM = 2048, DFF = 5504, NGU = 2 * DFF;
constexpr int PW = 5120, QW = 6144;
constexpr float EPS = 1e-6f;
constexpr float LAMBDA_INIT = 0.35550906759f;
constexpr float QSCALE = 0.08838834764831845f * 1.4426950408889634f;

constexpr size_t MiB = 1u << 20;
constexpr size_t WS_CTL = 0, WS_BAR = 4096, BAR_BYTES = 16384;
constexpr size_t WS_RCOS = 1 * MiB, WS_RSIN = 2 * MiB, WS_ACOS = 3 * MiB, WS_ASIN = 3 * MiB + 128 * 1024, WS_S5A = 3 * MiB + 512 * 1024, WS_S5BB = 4 * MiB;
constexpr size_t WS_W = 8 * MiB;
constexpr size_t SZ_WGU = (size_t)NGU * DM * 2, SZ_WD = (size_t)DM * DFF * 2;
constexpr size_t WS_WGU = WS_W, WS_WD = WS_WGU + 4 * SZ_WGU, WS_WIN = WS_WD + 4 * SZ_WD, WS_WOUT = WS_WIN + (size_t)PW * DM * 2,
                 WS_WGLU = WS_WOUT + (size_t)DM * DM * 2, WS_WQKV = WS_WGLU + (size_t)1024 * 1024 * 2, WS_WCO = WS_WQKV + (size_t)QW * DM * 2,
                 WS_WEND = WS_WCO + (size_t)DM * DM * 2;
constexpr size_t WS_XN = 328 * MiB;
constexpr size_t WS_BIG = 456 * MiB;
constexpr size_t WS_Z = WS_BIG + (size_t)TT * PW * 2;
constexpr size_t WS_YC = WS_BIG + (size_t)TT * QW * 2;
constexpr size_t WS_END = WS_YC + (size_t)TT * DM * 2;
constexpr size_t WS_SSQ = 5 * MiB;
static_assert(WS_WEND <= WS_XN && WS_XN + (size_t)TT * DM * 2 <= WS_BIG && WS_Z + (size_t)TT * 1024 * 2 <= WS_END, "ws map");

constexpr int LDS_BYTES = 147456;

namespace pg8 {
constexpr int BM = 256, BK = 64, HALF = 128, HTB = HALF * BK * 2, STAGE_BYTES = 8 * HTB, NXCD = 8, WGM = 8;
__host__ __device__ __forceinline__ int lds_byte(int r, int c) { const int st = (r >> 4) * 2 + (c >> 5), rr = r & 15, cc = c & 31, ob = rr * 64 + cc * 2; return st * 1024 + (ob ^ (((ob >> 9) & 1) << 5)); }
__host__ __device__ __forceinline__ void stage_rc(int b, int& R, int& C) { const int st = b / 1024, sb = b % 1024, swz = sb ^ (((sb >> 9) & 1) << 5); R = (st >> 1) * 16 + swz / 64; C = (st & 1) * 32 + (swz % 64) / 2; }
__host__ __device__ __forceinline__ int perm32(int rho) { const int n = rho >> 4, i = rho & 15; return 8 * (i >> 2) + 4 * n + (i & 3); }
struct Unit { int pm, pn; };
struct Gemm { const bf16_t* A; const bf16_t* Bt; int M, N, K; };
struct StaticOrder {
    int nM, nN, nwg, G, c;
    __host__ __device__ void init(int M, int N, int G_, int c_) { nM = M / BM; nN = N / BM; nwg = nM * nN; G = G_; c = c_; }
    __host__ __device__ bool next(int i, Unit& u) const {
        const long L = (long)i * G + c; if (L >= nwg) return false;
        int wgid = (int)L; { const int q = nwg / NXCD, r = nwg % NXCD, xcd = wgid % NXCD, off = wgid / NXCD; wgid = (xcd < r ? xcd * (q + 1) : r * (q + 1) + (xcd - r) * q) + off; }
        const int nig = WGM * nN, gid = wgid / nig, fm = gid * WGM, gsz = (nM - fm) < WGM ? (nM - fm) : WGM;
        u.pm = fm + ((wgid % nig) % gsz); u.pn = (wgid % nig) / gsz; return true;
    }
    __device__ __forceinline__ void a_ready(const Unit&) const {}
    __device__ __forceinline__ void done(const Unit&) const {}
};
__device__ __forceinline__ unsigned cvt_pk_bf16(float lo, float hi) { unsigned r; asm volatile("v_cvt_pk_bf16_f32 %0, %1, %2" : "=v"(r) : "v"(lo), "v"(hi)); return r; }

template <class Epi, class Sched, bool ALIGN_EPI = false, bool SP2 = false>
__device__ __forceinline__ void gemm_phase(LAS unsigned char* lds, const Gemm g, const Sched S, const Epi E) {
    const int tid = threadIdx.x, wid = __builtin_amdgcn_readfirstlane(tid >> 6), lane = tid & 63, wr = wid >> 2, wc = wid & 3, fr = lane & 15, fq = lane >> 4;
    const int K = g.K, nt = K / BK;
    unsigned voffA[2], voffB[2];
#pragma unroll
    for (int i = 0; i < 2; ++i) { int R, C; stage_rc(tid * 16 + i * 8192, R, C); const int Rb = Epi::PERM ? ((R & ~31) + perm32(R & 31)) : R;
        voffA[i] = (unsigned)(R * K + C) * 2u; voffB[i] = (unsigned)(Rb * K + C) * 2u; }
    const size_t kstep = (size_t)(BK * 2);
    const size_t hstep = (size_t)HALF * K * 2;
    const size_t tstep = 2 * hstep;
    const unsigned ldsw = (unsigned)wid * 1024u;
    const int aoff = lds_byte(wr * 64 + fr, fq * 8), boff = lds_byte(wc * 32 + fr, fq * 8);
#define PG8_SA(b, h) (((b) * 2 + (h)) * HTB)
#define PG8_SB(b, h) ((4 + (b) * 2 + (h)) * HTB)
#define PG8_STAGE(bufoff, gbase, voff) do { _Pragma("unroll") for (int _i = 0; _i < 2; ++_i) \
        __builtin_amdgcn_global_load_lds((const unsigned*)((const char*)(gbase) + (voff)[_i]), (LAS unsigned*)(lds + (bufoff) + ldsw + _i * 8192), 16, 0, 0); } while (0)
#define PG8_LDA(dst, b, h) do { _Pragma("unroll") for (int m = 0; m < 4; ++m) _Pragma("unroll") for (int k = 0; k < 2; ++k) dst[m][k] = *(const LAS bf16x8*)(lds + PG8_SA(b, h) + aoff + m * 2048 + k * 1024); } while (0)
#define PG8_LDB(dst, b, h) do { _Pragma("unroll") for (int n = 0; n < 2; ++n) _Pragma("unroll") for (int k = 0; k < 2; ++k) dst[n][k] = *(const LAS bf16x8*)(lds + PG8_SB(b, h) + boff + n * 2048 + k * 1024); } while (0)
#define PG8_MMA(ai, bj, At, Bt) do { __builtin_amdgcn_s_setprio(1); _Pragma("unroll") for (int m = 0; m < 4; ++m) _Pragma("unroll") for (int n = 0; n < 2; ++n) _Pragma("unroll") for (int k = 0; k < 2; ++k) \
        acc[ai][bj][m][n] = __builtin_amdgcn_mfma_f32_16x16x32_bf16(Bt[n][k], At[m][k], acc[ai][bj][m][n], 0, 0, 0); __builtin_amdgcn_s_setprio(0); } while (0)
#define PG8_WAIT_V(n) asm volatile("s_waitcnt vmcnt(" #n ")" ::: "memory")
#define PG8_WAIT_L(n) asm volatile("s_waitcnt lgkmcnt(" #n ")" ::: "memory")
#define PG8_BAR __builtin_amdgcn_s_barrier()
#define PG8_SCHED __builtin_amdgcn_sched_barrier(0)
    Unit cur, nxt; int ui = 0;
    if (!S.next(0, cur)) return;
    f32x4 acc[2][2][4][2];
#pragma unroll
    for (int a = 0; a < 2; ++a)
#pragma unroll
        for (int b = 0; b < 2; ++b)
#pragma unroll
            for (int m = 0; m < 4; ++m)
#pragma unroll
                for (int n = 0; n < 2; ++n) acc[a][b][m][n] = (f32x4){0.f, 0.f, 0.f, 0.f};
    bf16x8 At[4][2], B0[2][2], B1[2][2];
    const char* cA = (const char*)g.A + (size_t)cur.pm * tstep; const char* cB = (const char*)g.Bt + (size_t)cur.pn * tstep;
    S.a_ready(cur);
    if constexpr (SP2) {
        PG8_STAGE(PG8_SB(0, 0), cB, voffB); PG8_STAGE(PG8_SB(0, 1), cB + hstep, voffB); PG8_STAGE(PG8_SA(0, 0), cA, voffA); PG8_STAGE(PG8_SA(0, 1), cA + hstep, voffA);
        if (wr == 1) PG8_BAR;
        PG8_WAIT_V(2); PG8_BAR;
        PG8_STAGE(PG8_SB(1, 0), cB + kstep, voffB); PG8_STAGE(PG8_SA(1, 0), cA + kstep, voffA); PG8_STAGE(PG8_SB(1, 1), cB + hstep + kstep, voffB);
        PG8_WAIT_V(6); PG8_BAR;
    } else {
        PG8_STAGE(PG8_SB(0, 0), cB, voffB); PG8_STAGE(PG8_SA(0, 0), cA, voffA); PG8_STAGE(PG8_SB(0, 1), cB + hstep, voffB); PG8_STAGE(PG8_SA(0, 1), cA + hstep, voffA);
        if (wr == 1) PG8_BAR;
        PG8_WAIT_V(4); PG8_BAR;
        PG8_STAGE(PG8_SB(1, 0), cB + kstep, voffB); PG8_STAGE(PG8_SA(1, 0), cA + kstep, voffA); PG8_STAGE(PG8_SB(1, 1), cB + hstep + kstep, voffB);
        PG8_WAIT_V(6); PG8_BAR;
    }
    for (;;) {
        const bool has_next = S.next(ui + 1, nxt);
        const char* nA = has_next ? (const char*)g.A + (size_t)nxt.pm * tstep : cA; const char* nB = has_next ? (const char*)g.Bt + (size_t)nxt.pn * tstep : cB;
        for (int t = 0; t < nt; t += 2) {
            const bool last = (t == nt - 2);
            const char* a1 = cA + (size_t)(t + 1) * kstep;
            const char* a2 = last ? nA : cA + (size_t)(t + 2) * kstep; const char* b2 = last ? nB : cB + (size_t)(t + 2) * kstep;
            const char* a3 = a2 + kstep; const char* b3 = b2 + kstep;
            if (last && has_next) S.a_ready(nxt);
            if constexpr (SP2) {
            PG8_LDB(B0, 0, 0); PG8_LDB(B1, 0, 1); PG8_SCHED; PG8_LDA(At, 0, 0); PG8_STAGE(PG8_SA(1, 1), a1 + hstep, voffA);
            PG8_WAIT_V(8); PG8_WAIT_L(0); PG8_BAR; PG8_MMA(0, 0, At, B0); PG8_MMA(0, 1, At, B1); PG8_BAR; PG8_SCHED;
            PG8_LDA(At, 0, 1); PG8_STAGE(PG8_SB(0, 0), b2, voffB); PG8_STAGE(PG8_SB(0, 1), b2 + hstep, voffB); PG8_STAGE(PG8_SA(0, 0), a2, voffA);
            PG8_WAIT_V(8); PG8_WAIT_L(0); PG8_BAR; PG8_MMA(1, 0, At, B0); PG8_MMA(1, 1, At, B1); PG8_BAR; PG8_SCHED;
            PG8_LDB(B0, 1, 0); PG8_LDB(B1, 1, 1); PG8_SCHED; PG8_LDA(At, 1, 0); PG8_STAGE(PG8_SA(0, 1), a2 + hstep, voffA);
            PG8_WAIT_V(8); PG8_WAIT_L(0); PG8_BAR; PG8_MMA(0, 0, At, B0); PG8_MMA(0, 1, At, B1); PG8_BAR; PG8_SCHED;
            PG8_LDA(At, 1, 1); PG8_STAGE(PG8_SB(1, 0), b3, voffB); PG8_STAGE(PG8_SB(1, 1), b3 + hstep, voffB); PG8_STAGE(PG8_SA(1, 0), a3, voffA);
            PG8_WAIT_V(8); PG8_WAIT_L(0); PG8_BAR; PG8_MMA(1, 0, At, B0); PG8_MMA(1, 1, At, B1); PG8_BAR; PG8_SCHED;
            } else {
            PG8_LDB(B0, 0, 0); PG8_SCHED; PG8_LDA(At, 0, 0); PG8_STAGE(PG8_SA(1, 1), a1 + hstep, voffA);
            PG8_WAIT_L(8); PG8_BAR; PG8_WAIT_L(0); PG8_MMA(0, 0, At, B0); PG8_BAR; PG8_SCHED;
            PG8_LDB(B1, 0, 1); PG8_STAGE(PG8_SB(0, 0), b2, voffB);
            PG8_BAR; PG8_WAIT_L(0); PG8_MMA(0, 1, At, B1); PG8_BAR;
            PG8_LDA(At, 0, 1); PG8_STAGE(PG8_SA(0, 0), a2, voffA);
            PG8_BAR; PG8_WAIT_L(0); PG8_MMA(1, 0, At, B0); PG8_BAR; PG8_SCHED;
            PG8_STAGE(PG8_SB(0, 1), b2 + hstep, voffB);
            PG8_WAIT_V(6); PG8_BAR; PG8_MMA(1, 1, At, B1); PG8_BAR;
            PG8_LDB(B0, 1, 0); PG8_SCHED; PG8_LDA(At, 1, 0); PG8_STAGE(PG8_SA(0, 1), a2 + hstep, voffA);
            PG8_WAIT_L(8); PG8_BAR; PG8_WAIT_L(0); PG8_MMA(0, 0, At, B0); PG8_BAR; PG8_SCHED;
            PG8_LDB(B1, 1, 1); PG8_STAGE(PG8_SB(1, 0), b3, voffB);
            PG8_BAR; PG8_WAIT_L(0); PG8_MMA(0, 1, At, B1); PG8_BAR;
            PG8_LDA(At, 1, 1); PG8_STAGE(PG8_SA(1, 0), a3, voffA);
            PG8_BAR; PG8_WAIT_L(0); PG8_MMA(1, 0, At, B0); PG8_BAR; PG8_SCHED;
            PG8_STAGE(PG8_SB(1, 1), b3 + hstep, voffB);
            PG8_WAIT_V(6); PG8_BAR; PG8_MMA(1, 1, At, B1); PG8_BAR;
            }
        }
        if constexpr (ALIGN_EPI) { if (wr == 0) PG8_BAR; }
        if constexpr (!Epi::AFTER_DRAIN) { E(acc, cur, wr, wc, fr, fq); S.done(cur); }
        if (!has_next) break;
#pragma unroll
        for (int a = 0; a < 2; ++a)
#pragma unroll
            for (int b = 0; b < 2; ++b)
#pragma unroll
                for (int m = 0; m < 4; ++m)
#pragma unroll
                    for (int n = 0; n < 2; ++n) acc[a][b][m][n] = (f32x4){0.f, 0.f, 0.f, 0.f};
        cur = nxt; cA = nA; cB = nB; ++ui;
        if constexpr (ALIGN_EPI) { if (wr == 1) PG8_BAR; }
    }
    PG8_WAIT_V(0);
    if constexpr (!ALIGN_EPI) { if (wr == 0) PG8_BAR; }
    PG8_BAR;
#undef PG8_SA
#undef PG8_SB
#undef PG8_STAGE
#undef PG8_LDA
#undef PG8_LDB
#undef PG8_MMA
#undef PG8_WAIT_V
#undef PG8_WAIT_L
#undef PG8_BAR
#undef PG8_SCHED
}
}

__device__ __forceinline__ unsigned f2bf(float f) { unsigned u = __builtin_bit_cast(unsigned, f); return (u + 0x7fffu + ((u >> 16) & 1u)) >> 16; }
__device__ __forceinline__ unsigned pk2(float lo, float hi) { return f2bf(lo) | (f2bf(hi) << 16); }
__device__ __forceinline__ float bf2f(unsigned short b) { return __builtin_bit_cast(float, (unsigned)b << 16); }
__device__ __forceinline__ float bflo(unsigned w) { return __builtin_bit_cast(float, w << 16); }
__device__ __forceinline__ float bfhi(unsigned w) { return __builtin_bit_cast(float, w & 0xffff0000u); }
__device__ __forceinline__ float fast_sigmoid(float x) { return __builtin_amdgcn_rcpf(1.0f + __builtin_amdgcn_exp2f(-1.4426950408889634f * x)); }
__device__ __forceinline__ float silu_f(float x) { return x * fast_sigmoid(x); }
__device__ __forceinline__ float gelu_tanh_f(float y) { return y * fast_sigmoid(1.5957691216057308f * (y + 0.044715f * y * y * y)); }
__device__ __forceinline__ float wave_sum(float v) {
#pragma unroll
    for (int o = 1; o < 64; o <<= 1) v += __shfl_xor(v, o);
    return v;
}
__device__ __forceinline__ void sincos_d(double a, double& s, double& c) {
    const double k = rint(a * 0.15915494309189535);
    const double r = fma(-k, 6.283185307179586, a), r2 = r * r;
    double ts = r, tc = 1.0; s = r; c = 1.0;
    for (int n = 1; n <= 13; ++n) { tc *= -r2 / (double)((2 * n - 1) * (2 * n)); c += tc; ts *= -r2 / (double)((2 * n) * (2 * n + 1)); s += ts; }
}

using pg8::Unit; using pg8::cvt_pk_bf16;
struct EpiSwiglu {
    static constexpr bool PERM = true, AFTER_DRAIN = false;
    bf16_t* O; int ldo; const u64_t* ssq;
    __device__ __forceinline__ void operator()(const f32x4 (&acc)[2][2][4][2], const Unit& u, int wr, int wc, int fr, int fq) const {
        const int row0 = u.pm * 256 + wr * 64 + fr, col0 = u.pn * 128 + wc * 32 + 8 * fq;
        float rsv[2][4];
#pragma unroll
        for (int ai = 0; ai < 2; ++ai)
#pragma unroll
            for (int m = 0; m < 4; ++m) rsv[ai][m] = (float)ssq[row0 + ai * 128 + m * 16] * SSQ_INV;
#pragma unroll
        for (int ai = 0; ai < 2; ++ai)
#pragma unroll
            for (int m = 0; m < 4; ++m) {
                const int row = row0 + ai * 128 + m * 16;
                const float rs = __builtin_amdgcn_rsqf(rsv[ai][m] * (1.0f / DM) + EPS);
                bf16_t* rowp = O + (size_t)row * ldo + col0;
                const f32x4 g0 = acc[ai][0][m][0] * rs, g1 = acc[ai][0][m][1] * rs, u0 = acc[ai][1][m][0] * rs, u1 = acc[ai][1][m][1] * rs;
                u32x4 w;
                w.x = cvt_pk_bf16(silu_f(g0[0]) * u0[0], silu_f(g0[1]) * u0[1]); w.y = cvt_pk_bf16(silu_f(g0[2]) * u0[2], silu_f(g0[3]) * u0[3]);
                w.z = cvt_pk_bf16(silu_f(g1[0]) * u1[0], silu_f(g1[1]) * u1[1]); w.w = cvt_pk_bf16(silu_f(g1[2]) * u1[2], silu_f(g1[3]) * u1[3]);
                *(u32x4*)rowp = w;
            }
    }
};
template <bool BASE_F32, bool OUT_F32, int SCALE> struct EpiResid {
    static constexpr bool PERM = false, AFTER_DRAIN = false;
    const float* basef; float* outf; bf16_t* xb; u64_t* ssq;
    __device__ __forceinline__ void operator()(const f32x4 (&acc)[2][2][4][2], const Unit& u, int wr, int wc, int fr, int fq) const {
        const int col0 = u.pn * 256 + wc * 32 + 4 * fq;
        constexpr float sc = (SCALE == 2 ? 0.0f : SCALE == 1 ? 0.5f : 1.0f);
#pragma unroll
        for (int ai = 0; ai < 2; ++ai) {
            f32x4 pre[4][2][2];
#pragma unroll
            for (int m = 0; m < 4; ++m) { const size_t off = (size_t)(u.pm * 256 + ai * 128 + wr * 64 + m * 16 + fr) * DM + col0;
#pragma unroll
                for (int bj = 0; bj < 2; ++bj)
#pragma unroll
                    for (int n = 0; n < 2; ++n) {
                        if constexpr (BASE_F32) pre[m][bj][n] = *(const f32x4*)(basef + off + bj * 128 + n * 16);
                        else { const u32x2 w = *(const u32x2*)(xb + off + bj * 128 + n * 16); pre[m][bj][n] = (f32x4){bflo(w.x), bfhi(w.x), bflo(w.y), bfhi(w.y)}; } } }
#pragma unroll
            for (int m = 0; m < 4; ++m) {
                const int row = u.pm * 256 + ai * 128 + wr * 64 + m * 16 + fr;
                const size_t off = (size_t)row * DM + col0;
                float sq = 0.f;
#pragma unroll
                for (int bj = 0; bj < 2; ++bj)
#pragma unroll
                    for (int n = 0; n < 2; ++n) { const f32x4 v = pre[m][bj][n] + acc[ai][bj][m][n] * sc;
                        if constexpr (OUT_F32) *(f32x4*)(outf + off + bj * 128 + n * 16) = v;
                        else { u32x2 w; w.x = cvt_pk_bf16(v[0], v[1]); w.y = cvt_pk_bf16(v[2], v[3]); *(u32x2*)(xb + off + bj * 128 + n * 16) = w;
                               sq += (v[0] * v[0] + v[1] * v[1]) + (v[2] * v[2] + v[3] * v[3]); } }
                if constexpr (!OUT_F32 && SCALE != 2) { sq += __shfl_xor(sq, 16); sq += __shfl_xor(sq, 32); if (fq == 0) atomicAdd(ssq + row, (u64_t)(sq * SSQ_FIX)); }
            }
        }
    }
};
struct EpiWin {
    static constexpr bool PERM = true, AFTER_DRAIN = false;
    bf16_t* O; const float* cs; const float* sn; const u64_t* ssq;
    __device__ __forceinline__ void operator()(const f32x4 (&acc)[2][2][4][2], const Unit& u, int wr, int wc, int fr, int fq) const {
        const int row0 = u.pm * 256 + wr * 64 + fr, col0 = u.pn * 256 + wc * 32 + 8 * fq;
        const bool rot = u.pn < 8;
        float rsv[2][4];
#pragma unroll
        for (int ai = 0; ai < 2; ++ai)
#pragma unroll
            for (int m = 0; m < 4; ++m) rsv[ai][m] = (float)ssq[row0 + ai * 128 + m * 16] * SSQ_INV;
#pragma unroll
        for (int ai = 0; ai < 2; ++ai) {
            f32x4 cc[4][2], sv[4][2];
#pragma unroll
            for (int m = 0; m < 4; ++m) {
                if (rot) { const int pos = (row0 + ai * 128 + m * 16) & (SEQ - 1);
                    const float* cp = cs + pos * 128 + wc * 32 + 8 * fq; const float* sp = sn + pos * 128 + wc * 32 + 8 * fq;
                    cc[m][0] = *(const f32x4*)cp; cc[m][1] = *(const f32x4*)(cp + 4); sv[m][0] = *(const f32x4*)sp; sv[m][1] = *(const f32x4*)(sp + 4); }
                else { cc[m][0] = cc[m][1] = (f32x4){1.f, 1.f, 1.f, 1.f}; sv[m][0] = sv[m][1] = (f32x4){0.f, 0.f, 0.f, 0.f}; }
            }
#pragma unroll
            for (int m = 0; m < 4; ++m) {
                const int row = row0 + ai * 128 + m * 16;
                const float rs = __builtin_amdgcn_rsqf(rsv[ai][m] * (1.0f / DM) + EPS);
                const f32x4 a0 = acc[ai][0][m][0] * rs, a1 = acc[ai][0][m][1] * rs, b0 = acc[ai][1][m][0] * rs, b1 = acc[ai][1][m][1] * rs;
                const f32x4 na0 = a0 * cc[m][0] - b0 * sv[m][0], nb0 = b0 * cc[m][0] + a0 * sv[m][0], na1 = a1 * cc[m][1] - b1 * sv[m][1], nb1 = b1 * cc[m][1] + a1 * sv[m][1];
                bf16_t* rowp = O + (size_t)row * PW + col0;
                u32x4 w; w.x = cvt_pk_bf16(na0[0], na0[1]); w.y = cvt_pk_bf16(na0[2], na0[3]); w.z = cvt_pk_bf16(na1[0], na1[1]); w.w = cvt_pk_bf16(na1[2], na1[3]);
                *(u32x4*)rowp = w;
                u32x4 v; v.x = cvt_pk_bf16(nb0[0], nb0[1]); v.y = cvt_pk_bf16(nb0[2], nb0[3]); v.z = cvt_pk_bf16(nb1[0], nb1[1]); v.w = cvt_pk_bf16(nb1[2], nb1[3]);
                *(u32x4*)(rowp + 128) = v;
            }
        }
    }
};
struct EpiQkv {
    static constexpr bool PERM = false, AFTER_DRAIN = false;
    bf16_t* O; const float* cs; const float* sn; const u64_t* ssq;
    __device__ __forceinline__ void operator()(const f32x4 (&acc)[2][2][4][2], const Unit& u, int wr, int wc, int fr, int fq) const {
        const int col0 = u.pn * 256 + wc * 32 + 4 * fq;
        const bool rot = (u.pn < 16) && (wc == 0);
        const float sc0 = (u.pn < 8) ? QSCALE : 1.0f;
        float rsv[2][4]; f32x4 cv[2][4], sv[2][4];
#pragma unroll
        for (int ai = 0; ai < 2; ++ai)
#pragma unroll
            for (int m = 0; m < 4; ++m) { const int row = u.pm * 256 + ai * 128 + wr * 64 + m * 16 + fr; rsv[ai][m] = (float)ssq[row] * SSQ_INV;
                if (rot) { const int pos = row & (SEQ - 1); cv[ai][m] = *(const f32x4*)(cs + pos * 16 + 4 * fq); sv[ai][m] = *(const f32x4*)(sn + pos * 16 + 4 * fq); }
                else { cv[ai][m] = (f32x4){1.f, 1.f, 1.f, 1.f}; sv[ai][m] = (f32x4){0.f, 0.f, 0.f, 0.f}; } }
#pragma unroll
        for (int ai = 0; ai < 2; ++ai)
#pragma unroll
            for (int m = 0; m < 4; ++m) {
                const int row = u.pm * 256 + ai * 128 + wr * 64 + m * 16 + fr;
                const float sc = sc0 * __builtin_amdgcn_rsqf(rsv[ai][m] * (1.0f / DM) + EPS);
                const f32x4 c = cv[ai][m], s = sv[ai][m];
#pragma unroll
                for (int bj = 0; bj < 2; ++bj) {
                    const f32x4 x0 = acc[ai][bj][m][0], x1 = acc[ai][bj][m][1];
                    const f32x4 n0 = (x0 * c - x1 * s) * sc, n1 = (x1 * c + x0 * s) * sc;
                    bf16_t* p = O + (size_t)row * QW + col0 + bj * 128;
                    u32x2 w0; w0.x = cvt_pk_bf16(n0[0], n0[1]); w0.y = cvt_pk_bf16(n0[2], n0[3]); *(u32x2*)p = w0;
                    u32x2 w1; w1.x = cvt_pk_bf16(n1[0], n1[1]); w1.y = cvt_pk_bf16(n1[2], n1[3]); *(u32x2*)(p + 16) = w1;
                }
            }
    }
};
struct EpiGlu {
    static constexpr bool PERM = true, AFTER_DRAIN = false;
    const bf16_t* Z; const float* bias; bf16_t* Y;
    __device__ __forceinline__ void operator()(const f32x4 (&acc)[2][2][4][2], const Unit& u, int wr, int wc, int fr, int fq) const {
        const int row0 = u.pm * 256 + wr * 64 + fr, col0 = u.pn * 256 + wc * 32 + 8 * fq;
#pragma unroll
        for (int bj = 0; bj < 2; ++bj) {
            const f32x4 bv0 = *(const f32x4*)(bias + col0 + bj * 128), bv1 = *(const f32x4*)(bias + col0 + bj * 128 + 4);
            u32x4 zz[2][4];
#pragma unroll
            for (int ai = 0; ai < 2; ++ai)
#pragma unroll
                for (int m = 0; m < 4; ++m) zz[ai][m] = *(const u32x4*)(Z + (size_t)(row0 + ai * 128 + m * 16) * 1024 + col0 + bj * 128);
#pragma unroll
            for (int ai = 0; ai < 2; ++ai)
#pragma unroll
                for (int m = 0; m < 4; ++m) {
                    const int row = row0 + ai * 128 + m * 16;
                    const u32x4 z4 = zz[ai][m];
                    const f32x4 v0 = acc[ai][bj][m][0] + bv0, v1 = acc[ai][bj][m][1] + bv1;
                    u32x4 w;
                    w.x = cvt_pk_bf16(bflo(z4.x) * fast_sigmoid(v0[0]), bfhi(z4.x) * fast_sigmoid(v0[1]));
                    w.y = cvt_pk_bf16(bflo(z4.y) * fast_sigmoid(v0[2]), bfhi(z4.y) * fast_sigmoid(v0[3]));
                    w.z = cvt_pk_bf16(bflo(z4.z) * fast_sigmoid(v1[0]), bfhi(z4.z) * fast_sigmoid(v1[1]));
                    w.w = cvt_pk_bf16(bflo(z4.w) * fast_sigmoid(v1[2]), bfhi(z4.w) * fast_sigmoid(v1[3]));
                    *(u32x4*)(Y + (size_t)row * DM + 1024 + col0 + bj * 128) = w;
                }
        }
    }
};

template <class Epi>
__device__ __forceinline__ void run_gemm(LAS unsigned char* lds, const bf16_t* A, const bf16_t* Bt, int M, int N, int K, const Epi E) {
    pg8::Gemm g{A, Bt, M, N, K}; pg8::StaticOrder S; S.init(M, N, (int)gridDim.x, (int)blockIdx.x);
    pg8::gemm_phase<Epi, pg8::StaticOrder, true, true>(lds, g, S, E);
}

__device__ __forceinline__ void conv_matrix(const float* __restrict__ W, bf16_t* __restrict__ WT, int K, int N, int mode, const float* __restrict__ gain, LAS float* scr, int gw, int NGW, int lane) {
    const int nblk = N / 64, nitems = (K / 64) * nblk;
    for (int item = gw; item < nitems; item += NGW) {
        const int kb = item / nblk, nb = item % nblk, k0 = 64 * kb, n0 = 64 * nb;
        const float gv = gain ? gain[k0 + lane] : 1.0f;
        const float* wp = W + (size_t)k0 * N + n0 + lane;
#pragma unroll
        for (int i = 0; i < 64; ++i) { const float v = wp[(size_t)i * N];
            scr[i * 65 + lane] = v * __builtin_bit_cast(float, __builtin_amdgcn_readlane(__builtin_bit_cast(int, gv), i)); }
        asm volatile("s_waitcnt lgkmcnt(0)" ::: "memory");
        const int c = lane & 7, ns = lane >> 3;
        const int rbase = (mode == 0) ? n0 : ((n0 >> 7) * 256 + (n0 & 127) + (mode == 2 ? 128 : 0));
#pragma unroll
        for (int j = 0; j < 8; ++j) { const int n = ns + 8 * j; const LAS float* sp = scr + (8 * c) * 65 + n;
            u32x4 o; o.x = pk2(sp[0 * 65], sp[1 * 65]); o.y = pk2(sp[2 * 65], sp[3 * 65]); o.z = pk2(sp[4 * 65], sp[5 * 65]); o.w = pk2(sp[6 * 65], sp[7 * 65]);
            *(u32x4*)(WT + (size_t)(rbase + n) * K + k0 + 8 * c) = o; }
        asm volatile("s_waitcnt lgkmcnt(0)" ::: "memory");
    }
}

template <bool TO_BF16>
__device__ __forceinline__ void rmsnorm_phase(const float* in, const float* __restrict__ g, bf16_t* outb, float* outf, int gw, int NGW, int lane) {
    f32x4 gv[8];
#pragma unroll
    for (int j = 0; j < 8; ++j) gv[j] = ((const f32x4*)g)[lane + 64 * j];
    for (int row = gw; row < TT; row += NGW) {
        const f32x4* xr = (const f32x4*)(in + (size_t)row * DM) + lane;
        f32x4 v[8]; float ss = 0.f;
#pragma unroll
        for (int j = 0; j < 8; ++j) { v[j] = xr[64 * j]; ss += (v[j][0] * v[j][0] + v[j][1] * v[j][1]) + (v[j][2] * v[j][2] + v[j][3] * v[j][3]); }
        const float rs = 1.0f / sqrtf(wave_sum(ss) * (1.0f / DM) + EPS);
#pragma unroll
        for (int j = 0; j < 8; ++j) {
            const f32x4 y = v[j] * rs * gv[j];
            if constexpr (TO_BF16) { u32x2 w; w.x = pk2(y[0], y[1]); w.y = pk2(y[2], y[3]); *((u32x2*)(outb + (size_t)row * DM) + lane + 64 * j) = w; }
            else { *((f32x4*)(outf + (size_t)row * DM) + lane + 64 * j) = y; }
        }
    }
}

__device__ __forceinline__ void cast_phase(const float* in, bf16_t* outb, u64_t* ssq, int gw, int NGW, int lane) {
    for (int row = gw; row < TT; row += NGW) {
        const f32x4* xr = (const f32x4*)(in + (size_t)row * DM) + lane;
        f32x4 v[8]; float ss = 0.f;
#pragma unroll
        for (int j = 0; j < 8; ++j) { v[j] = xr[64 * j]; ss += (v[j][0] * v[j][0] + v[j][1] * v[j][1]) + (v[j][2] * v[j][2] + v[j][3] * v[j][3]); }
        ss = wave_sum(ss);
        if (lane == 0) ssq[row] = (u64_t)(ss * SSQ_FIX);
#pragma unroll
        for (int j = 0; j < 8; ++j) { u32x2 w; w.x = pk2(v[j][0], v[j][1]); w.y = pk2(v[j][2], v[j][3]); *((u32x2*)(outb + (size_t)row * DM) + lane + 64 * j) = w; }
    }
}

__device__ __forceinline__ void final_phase(const bf16_t* xb, const u64_t* ssq, const float* __restrict__ g, float* outf, int gw, int NGW, int lane) {
    f32x4 gv[4][2];
#pragma unroll
    for (int j = 0; j < 4; ++j) { gv[j][0] = *(const f32x4*)(g + 8 * (lane + 64 * j)); gv[j][1] = *(const f32x4*)(g + 8 * (lane + 64 * j) + 4); }
    for (int row = gw; row < TT; row += NGW) {
        const float rs = __builtin_amdgcn_rsqf((float)ssq[row] * SSQ_INV * (1.0f / DM) + EPS);
        const u32x4* xr = (const u32x4*)(xb + (size_t)row * DM) + lane;
        u32x4 v[4];
#pragma unroll
        for (int j = 0; j < 4; ++j) v[j] = xr[64 * j];
#pragma unroll
        for (int j = 0; j < 4; ++j) {
            float* op = outf + (size_t)row * DM + 8 * (lane + 64 * j);
            *(f32x4*)op = (f32x4){bflo(v[j].x), bfhi(v[j].x), bflo(v[j].y), bfhi(v[j].y)} * rs * gv[j][0];
            *(f32x4*)(op + 4) = (f32x4){bflo(v[j].z), bfhi(v[j].z), bflo(v[j].w), bfhi(v[j].w)} * rs * gv[j][1];
        }
    }
}

__device__ __forceinline__ void tables_phase(unsigned char* ws, const float* const* in_unused, const float* lam_re, const float* lam_im, const float* log_step, const float* b_re, const float* b_im,
                                             const float* lq1, const float* lk1, const float* lq2, const float* lk2, int gtid, int NT_) {
    float* rcos = (float*)(ws + WS_RCOS); float* rsin = (float*)(ws + WS_RSIN); float* acos_ = (float*)(ws + WS_ACOS); float* asin_ = (float*)(ws + WS_ASIN);
    float* s5a = (float*)(ws + WS_S5A); float* s5bb = (float*)(ws + WS_S5BB);
    for (int i = gtid; i < SEQ * 128; i += NT_) {
        const int pos = i >> 7, f = i & 127;
        const float inv = (float)exp2(-((double)(2 * f) / 256.0) * 13.287712379549449);
        const float ang = (float)pos * inv; double s, c; sincos_d((double)ang, s, c); rcos[i] = (float)c; rsin[i] = (float)s;
    }
    for (int i = gtid; i < SEQ * 16; i += NT_) {
        const int pos = i >> 4, f = i & 15;
        const float inv = (float)exp2(-((double)(2 * f) / 32.0) * 18.931568569324174);
        const float ang = (float)pos * inv; double s, c; sincos_d((double)ang, s, c); acos_[i] = (float)c; asin_[i] = (float)s;
    }
    for (int i = gtid; i < 64 * 64; i += NT_) {
        const int g = i >> 6;
        const double step = exp((double)log_step[g]), lr = (double)lam_re[i], li = (double)lam_im[i];
        const double mag = exp(lr * step); double s, c; sincos_d(li * step, s, c);
        const double are = mag * c, aim = mag * s, den = lr * lr + li * li, nr = are - 1.0;
        const double fre = (nr * lr + aim * li) / den, fim = (aim * lr - nr * li) / den;
        s5a[2 * i] = (float)are; s5a[2 * i + 1] = (float)aim;
        for (int p = 0; p < 16; ++p) { const double br = (double)b_re[i * 16 + p], bi = (double)b_im[i * 16 + p];
            s5bb[(size_t)i * 32 + p] = (float)(fre * br - fim * bi); s5bb[(size_t)i * 32 + 16 + p] = (float)(fre * bi + fim * br); }
    }
    if (gtid == 0) { float s1 = 0.f, s2 = 0.f; for (int i = 0; i < 128; ++i) { s1 += lq1[i] * lk1[i]; s2 += lq2[i] * lk2[i]; }
        ((float*)(ws + WS_CTL))[0] = expf(s1) - expf(s2) + LAMBDA_INIT; }
}

__device__ __forceinline__ void s5_phase(LAS unsigned char* lds, const unsigned char* ws, const bf16_t* proj, const float* c_re, const float* c_im, const float* dskip, bf16_t* z,
                                         int vcu, int G, int wave, int lane) {
    const float* s5a = (const float*)(ws + WS_S5A); const float* s5bb = (const float*)(ws + WS_S5BB);
    LAS bf16_t* Hc = (LAS bf16_t*)(lds + wave * 8704);
    const int fr = lane & 15, fq = lane >> 4;
    for (int seq = vcu * 8 + wave; seq < 1024; seq += G * 8) {
        const int b = seq >> 6, g = seq & 63, n = lane;
        float bbre[16], bbim[16];
#pragma unroll
        for (int p = 0; p < 16; ++p) { bbre[p] = s5bb[(size_t)(g * 64 + n) * 32 + p]; bbim[p] = s5bb[(size_t)(g * 64 + n) * 32 + 16 + p]; }
        const float are = s5a[2 * (g * 64 + n)], aim = s5a[2 * (g * 64 + n) + 1];
        bf16x8 cf[4];
#pragma unroll
        for (int ks = 0; ks < 4; ++ks) { u32x4 w; unsigned* wp = (unsigned*)&w;
#pragma unroll
            for (int j2 = 0; j2 < 4; ++j2) { float v[2];
#pragma unroll
                for (int e = 0; e < 2; ++e) { const int k = 32 * ks + 8 * fq + 2 * j2 + e; v[e] = (k < 64) ? c_re[(size_t)(g * 16 + fr) * 64 + k] : -c_im[(size_t)(g * 16 + fr) * 64 + (k - 64)]; }
                wp[j2] = pk2(v[0], v[1]); }
            cf[ks] = __builtin_bit_cast(bf16x8, w); }
        const float dsk = dskip[g * 16 + fr];
        float hre = 0.f, him = 0.f;
        for (int ch = 0; ch < SEQ / 32; ++ch) {
            const size_t row0 = (size_t)b * SEQ + ch * 32;
            const bf16_t* up = proj + (row0 + (lane & 31)) * PW + 4096 + g * 16;
            const u32x4 ua = *(const u32x4*)up, ub = *(const u32x4*)(up + 8);
            float uf[16];
            uf[0] = bflo(ua.x); uf[1] = bfhi(ua.x); uf[2] = bflo(ua.y); uf[3] = bfhi(ua.y); uf[4] = bflo(ua.z); uf[5] = bfhi(ua.z); uf[6] = bflo(ua.w); uf[7] = bfhi(ua.w);
            uf[8] = bflo(ub.x); uf[9] = bfhi(ub.x); uf[10] = bflo(ub.y); uf[11] = bfhi(ub.y); uf[12] = bflo(ub.z); uf[13] = bfhi(ub.z); uf[14] = bflo(ub.w); uf[15] = bfhi(ub.w);
#pragma unroll
            for (int k = 0; k < 32; ++k) {
                f32x2 xx = (f32x2){0.f, 0.f};
#pragma unroll
                for (int p = 0; p < 16; ++p) { const float su = __builtin_bit_cast(float, __builtin_amdgcn_readlane(__builtin_bit_cast(int, uf[p]), k));
                    xx = __builtin_elementwise_fma((f32x2){su, su}, (f32x2){bbre[p], bbim[p]}, xx); }
                const float nr = are * hre - aim * him + xx[0], ni = are * him + aim * hre + xx[1]; hre = nr; him = ni;
                Hc[k * 136 + n] = (bf16_t)f2bf(hre); Hc[k * 136 + 64 + n] = (bf16_t)f2bf(him);
            }
#pragma unroll
            for (int sb = 0; sb < 2; ++sb) {
                f32x4 y = (f32x4){0.f, 0.f, 0.f, 0.f};
#pragma unroll
                for (int ks = 0; ks < 4; ++ks) { const bf16x8 hf = *(const LAS bf16x8*)(Hc + (16 * sb + fr) * 136 + 32 * ks + 8 * fq); y = __builtin_amdgcn_mfma_f32_16x16x32_bf16(hf, cf[ks], y, 0, 0, 0); }
#pragma unroll
                for (int i = 0; i < 4; ++i) { const size_t row = row0 + 16 * sb + 4 * fq + i;
                    const float uu = bf2f(proj[row * PW + 4096 + g * 16 + fr]); const float yy = y[i] + dsk * uu;
                    z[row * 1024 + g * 16 + fr] = (bf16_t)f2bf(gelu_tanh_f(yy)); }
            }
        }
    }
}

#define MF32(a, b, c) __builtin_amdgcn_mfma_f32_32x32x16_bf16((a), (b), (c), 0, 0, 0)
#define AT_WAITV(n) asm volatile("s_waitcnt vmcnt(" #n ")" ::: "memory")
#define AT_BAR() asm volatile("s_waitcnt lgkmcnt(0)\n\ts_barrier" ::: "memory")
__device__ __forceinline__ s16x4 vtr(const LAS unsigned char* p) { typedef short v4i16_t __attribute__((ext_vector_type(4))); return __builtin_bit_cast(s16x4, __builtin_amdgcn_ds_read_tr16_b64_v4i16((LAS v4i16_t*)p)); }
__device__ __forceinline__ int crow(int i, int h) { return (i & 3) + 8 * (i >> 2) + 4 * h; }

template <int MODE>
__device__ __forceinline__ void attn_unit(LAS unsigned char* lds, const bf16_t* src, const int pitch, const int kcol, const int vcol, const int b, const int h, const int ub,
                                          bf16_t* outp, const bf16_t* gsrc, const float* subln, const float lam) {
    constexpr int NKS = MODE ? 8 : 16, NDB = 4, ROWS = MODE ? 64 : 128;
    const int tid = threadIdx.x, lane = tid & 63, r = lane & 31, hh = lane >> 5;
    const int wid = __builtin_amdgcn_readfirstlane(tid >> 6);
    const int rg = MODE ? (wid & 1) : (wid & 3), vh = MODE ? ((wid >> 1) & 1) : (wid >> 2), cc = MODE ? (wid >> 2) : 0;
    const size_t rowbase = (size_t)b * SEQ; const int q0 = ub * ROWS, NT = MODE ? (ub + 1) : (2 * ub + 2);
    const int qrow = q0 + rg * 32 + r;
    AT_WAITV(0);
#define AT_ISSUE(t, buf) do { const bf16_t* gk_ = src + (rowbase + (size_t)(t) * 64) * pitch; int rv_ = r; asm volatile("" : "+v"(rv_)); \
        _Pragma("unroll") for (int i_ = 0; i_ < 4; ++i_) { const int c_ = wid * 4 + i_; const int row_ = c_ * 2 + hh; \
            const unsigned ok_ = (unsigned)(row_ * pitch + kcol + ((rv_ ^ (row_ & 15)) << 3)); \
            __builtin_amdgcn_global_load_lds((const unsigned*)(gk_ + ok_), (LAS unsigned*)(lds + (buf) * 65536 + c_ * 1024), 16, 0, 0); \
            const unsigned ov_ = (unsigned)(row_ * pitch + vcol + ((rv_ ^ ((row_ & 3) << 2)) << 3)); \
            __builtin_amdgcn_global_load_lds((const unsigned*)(gk_ + ov_), (LAS unsigned*)(lds + (buf) * 65536 + 32768 + c_ * 1024), 16, 0, 0); } } while (0)
    AT_ISSUE(0, 0);
    bf16x8 qf[NKS];
    { const bf16_t* qp = src + (rowbase + qrow) * pitch + h * 256 + cc * 128 + 8 * hh;
#pragma unroll
      for (int d0 = 0; d0 < NKS; ++d0) qf[d0] = *(const bf16x8*)(qp + 16 * d0); }
    f32x16 O[NDB];
#pragma unroll
    for (int db = 0; db < NDB; ++db)
#pragma unroll
        for (int i = 0; i < 16; ++i) O[db][i] = 0.f;
    float mrun = 0.f, lrun = 0.f;
    const float lgam = __builtin_log2f(1.0f - __builtin_amdgcn_exp2f(-5.0f - (float)h));
    const int r15 = r & 15;
    const int kunit0 = cc * 16;
    const int q4 = (lane & 15) >> 2, p4 = lane & 3, blk16 = (lane >> 4) & 1;
    const int vlane = (4 * hh + q4) * 512 + ((2 * blk16 + (p4 >> 1)) << 4) + 8 * (p4 & 1);
    for (int t = 0; t < NT; ++t) {
        if (t + 1 < NT) { AT_ISSUE(t + 1, (t + 1) & 1); AT_WAITV(8); } else { AT_WAITV(0); }
        AT_BAR();
        const bool active = MODE ? true : !(t == NT - 1 && rg < 2);
        if (active) {
            const LAS unsigned char* Kb = lds + (t & 1) * 65536; const LAS unsigned char* Vb = Kb + 32768;
            int r15v = r15 ^ hh ^ kunit0, q4v = q4 << 2; asm volatile("" : "+v"(r15v), "+v"(q4v));
            bf16x8 pf[4];
            if constexpr (MODE) {
                f32x16 p0, p1;
#pragma unroll
                for (int i = 0; i < 16; ++i) { p0[i] = -mrun; p1[i] = -mrun; }
                { const LAS unsigned char* kr0 = Kb + r * 512; const LAS unsigned char* kr1 = Kb + (32 + r) * 512;
#pragma unroll
                  for (int d0 = 0; d0 < NKS; ++d0) { const int uo = ((2 * d0) ^ r15v) << 4;
                      const bf16x8 k0 = *(const LAS bf16x8*)(kr0 + uo); const bf16x8 k1 = *(const LAS bf16x8*)(kr1 + uo);
                      p0 = MF32(k0, qf[d0], p0); p1 = MF32(k1, qf[d0], p1);
                      if ((d0 & 3) == 3) __builtin_amdgcn_sched_barrier(0); } }
                float rm = p0[0];
#pragma unroll
                for (int i = 0; i < 16; ++i) { rm = fmaxf(rm, p0[i]); rm = fmaxf(rm, p1[i]); }
                rm = fmaxf(rm, __shfl_xor(rm, 32));
                if (t == 0 || __any(rm > 8.0f)) {
                    const float dl = (t == 0) ? rm : fmaxf(rm, 0.f); const float al = (t == 0) ? 1.0f : __builtin_amdgcn_exp2f(-dl); lrun *= al; mrun += dl;
#pragma unroll
                    for (int i = 0; i < 16; ++i) { p0[i] -= dl; p1[i] -= dl; }
#pragma unroll
                    for (int db = 0; db < NDB; ++db) O[db] = O[db] * al;
                }
                float sum = 0.f;
#pragma unroll
                for (int i = 0; i < 16; ++i) { p0[i] = __builtin_amdgcn_exp2f(p0[i]); p1[i] = __builtin_amdgcn_exp2f(p1[i]); sum += p0[i] + p1[i]; }
                lrun += sum;
                u32x4 w;
                w.x = cvt_pk_bf16(p0[0], p0[1]); w.y = cvt_pk_bf16(p0[2], p0[3]); w.z = cvt_pk_bf16(p0[4], p0[5]); w.w = cvt_pk_bf16(p0[6], p0[7]); pf[0] = __builtin_bit_cast(bf16x8, w);
                w.x = cvt_pk_bf16(p0[8], p0[9]); w.y = cvt_pk_bf16(p0[10], p0[11]); w.z = cvt_pk_bf16(p0[12], p0[13]); w.w = cvt_pk_bf16(p0[14], p0[15]); pf[1] = __builtin_bit_cast(bf16x8, w);
                w.x = cvt_pk_bf16(p1[0], p1[1]); w.y = cvt_pk_bf16(p1[2], p1[3]); w.z = cvt_pk_bf16(p1[4], p1[5]); w.w = cvt_pk_bf16(p1[6], p1[7]); pf[2] = __builtin_bit_cast(bf16x8, w);
                w.x = cvt_pk_bf16(p1[8], p1[9]); w.y = cvt_pk_bf16(p1[10], p1[11]); w.z = cvt_pk_bf16(p1[12], p1[13]); w.w = cvt_pk_bf16(p1[14], p1[15]); pf[3] = __builtin_bit_cast(bf16x8, w);
            } else {
#pragma unroll
                for (int blk = 0; blk < 2; ++blk) {
                    f32x16 p;
#pragma unroll
                    for (int i = 0; i < 16; ++i) p[i] = 0.f;
                    const LAS unsigned char* kr = Kb + (32 * blk + r) * 512;
#pragma unroll
                    for (int d0 = 0; d0 < NKS; ++d0) { const int uo = ((2 * d0) ^ r15v) << 4;
                        const bf16x8 k0 = *(const LAS bf16x8*)(kr + uo); p = MF32(k0, qf[d0], p);
                        if ((d0 & 3) == 3) __builtin_amdgcn_sched_barrier(0); }
                    const int kb = t * 64 + 32 * blk + 4 * hh;
#pragma unroll
                    for (int i = 0; i < 16; ++i) { const int kv = kb + (i & 3) + 8 * (i >> 2);
                        p[i] *= __builtin_amdgcn_exp2f(lgam * fabsf((float)(qrow - kv)) - 4.0f); }
                    u32x4 w;
                    w.x = cvt_pk_bf16(p[0], p[1]); w.y = cvt_pk_bf16(p[2], p[3]); w.z = cvt_pk_bf16(p[4], p[5]); w.w = cvt_pk_bf16(p[6], p[7]); pf[2 * blk] = __builtin_bit_cast(bf16x8, w);
                    w.x = cvt_pk_bf16(p[8], p[9]); w.y = cvt_pk_bf16(p[10], p[11]); w.z = cvt_pk_bf16(p[12], p[13]); w.w = cvt_pk_bf16(p[14], p[15]); pf[2 * blk + 1] = __builtin_bit_cast(bf16x8, w);
                    __builtin_amdgcn_sched_barrier(0);
                }
            }
            const LAS unsigned char* vb = Vb + vlane;
            __builtin_amdgcn_sched_barrier(0);
#pragma unroll
            for (int db = 0; db < NDB; ++db) {
                const int dunit = vh * 16 + 4 * db;
                const LAS unsigned char* vp = vb + ((dunit ^ q4v) << 4);
#pragma unroll
                for (int ks = 0; ks < 4; ++ks) {
                    const int kvb = 32 * (ks >> 1) + 16 * (ks & 1);
                    const s16x4 lo = vtr(vp + kvb * 512), hi = vtr(vp + (kvb + 8) * 512);
                    const bf16x8 vf = __builtin_shufflevector(lo, hi, 0, 1, 2, 3, 4, 5, 6, 7);
                    O[db] = MF32(vf, pf[ks], O[db]);
                }
                __builtin_amdgcn_sched_barrier(0);
            }
        }
        AT_BAR();
    }
    const size_t orow = rowbase + qrow;
    LAS float* SS = (LAS float*)(lds + 131072);
    if constexpr (MODE) {
        const float l = lrun + __shfl_xor(lrun, 32); const float inv = 1.0f / l;
        LAS float* X = (LAS float*)(lds + (wid & 3) * 16384);
        if (cc == 1) {
#pragma unroll
            for (int db = 0; db < NDB; ++db)
#pragma unroll
                for (int i = 0; i < 16; ++i) X[(db * 16 + i) * 64 + lane] = O[db][i] * inv;
        }
        AT_BAR();
        float ss = 0.f;
        if (cc == 0) {
#pragma unroll
            for (int db = 0; db < NDB; ++db)
#pragma unroll
                for (int i = 0; i < 16; ++i) { const float o = O[db][i] * inv - lam * X[(db * 16 + i) * 64 + lane]; O[db][i] = o; ss += o * o; }
        }
        ss += __shfl_xor(ss, 32);
        if (hh == 0) SS[wid * 32 + r] = ss;
        AT_BAR();
        if (cc == 0) {
            ss += SS[(wid ^ 2) * 32 + r];
            const float rs = (1.0f - LAMBDA_INIT) / sqrtf(ss * (1.0f / 256.0f) + EPS);
            bf16_t* op = outp + orow * DM + h * 256 + vh * 128 + 4 * hh;
            const float* slp = subln + vh * 128 + 4 * hh;
#pragma unroll
            for (int db = 0; db < NDB; ++db)
#pragma unroll
                for (int i4 = 0; i4 < 4; ++i4) { const int d = 32 * db + 8 * i4;
                    const f32x4 sl = *(const f32x4*)(slp + d);
                    u32x2 w; w.x = cvt_pk_bf16(O[db][4 * i4] * rs * sl[0], O[db][4 * i4 + 1] * rs * sl[1]); w.y = cvt_pk_bf16(O[db][4 * i4 + 2] * rs * sl[2], O[db][4 * i4 + 3] * rs * sl[3]);
                    *(u32x2*)(op + d) = w; }
        }
        AT_BAR();
    } else {
        float ss = 0.f;
#pragma unroll
        for (int db = 0; db < NDB; ++db)
#pragma unroll
            for (int i = 0; i < 16; ++i) ss += O[db][i] * O[db][i];
        ss += __shfl_xor(ss, 32);
        if (hh == 0) SS[wid * 32 + r] = ss;
        AT_BAR();
        ss += SS[(wid ^ 4) * 32 + r];
        const float rs = 1.0f / sqrtf(ss * (1.0f / 256.0f) + EPS);
        const bf16_t* gp = gsrc + orow * PW + 3072 + h * 256 + vh * 128 + 4 * hh;
        bf16_t* op = outp + orow * DM + h * 256 + vh * 128 + 4 * hh;
#pragma unroll
        for (int db = 0; db < NDB; ++db)
#pragma unroll
            for (int i4 = 0; i4 < 4; ++i4) { const int d = 32 * db + 8 * i4;
                const u32x2 gg = *(const u32x2*)(gp + d);
                u32x2 w; w.x = cvt_pk_bf16(O[db][4 * i4] * rs * silu_f(bflo(gg.x)), O[db][4 * i4 + 1] * rs * silu_f(bfhi(gg.x)));
                w.y = cvt_pk_bf16(O[db][4 * i4 + 2] * rs * silu_f(bflo(gg.y)), O[db][4 * i4 + 3] * rs * silu_f(bfhi(gg.y)));
                *(u32x2*)(op + d) = w; }
        AT_BAR();
    }
#undef AT_ISSUE
}

template <int MODE>
__device__ __forceinline__ void attn_phase(LAS unsigned char* lds, const bf16_t* src, int pitch, int kcol0, int vcol0, int nheads, bf16_t* outp, const bf16_t* gsrc, const float* subln, float lam, int vcu, int G) {
    constexpr int NU = MODE ? 32 : 16;
    const int npairs = 16 * nheads * (NU / 2);
    for (int pr = vcu; pr < npairs; pr += G) {
        const int bh = pr / (NU / 2), p = pr % (NU / 2), b = bh / nheads, h = bh % nheads;
        attn_unit<MODE>(lds, src, pitch, kcol0 + h * 256, vcol0 + h * 256, b, h, NU - 1 - p, outp, gsrc, subln, lam);
        attn_unit<MODE>(lds, src, pitch, kcol0 + h * 256, vcol0 + h * 256, b, h, p, outp, gsrc, subln, lam);
    }
}

#define XB_TMO      128
#define XB_XCNT(j)  (256  + 64 * (j))
#define XB_XSUB(j)  (1280 + 64 * (j))
#define XB_XGEN(j)  (2304 + 64 * (j))
#define XB_TOP      3328
#define XB_TOPGEN   3392
#define XCD_BAR_WORDS 3456
#define XB_SPIN_CAP (1u << 18)
__device__ __forceinline__ unsigned xb_ld(unsigned* p)              { return __hip_atomic_load(p, __ATOMIC_RELAXED, __HIP_MEMORY_SCOPE_AGENT); }
__device__ __forceinline__ unsigned xb_add(unsigned* p, unsigned v) { return __hip_atomic_fetch_add(p, v, __ATOMIC_RELAXED, __HIP_MEMORY_SCOPE_AGENT); }
__device__ __forceinline__ unsigned xb_xcc_id() { return (unsigned)__builtin_amdgcn_s_getreg((3 << 11) | 20) & 0xFu; }
#define XB_SPIN(cond, bar) do { unsigned _sp = 0; while (cond) { __builtin_amdgcn_s_sleep(1); \
    if ((++_sp & 255u) == 0u) { if (xb_ld(&(bar)[XB_TMO])) break; if (_sp > XB_SPIN_CAP) { atomicAdd(&(bar)[XB_TMO], 1u); break; } } } } while (0)
struct XcdBarrier { unsigned* bar; unsigned x; volatile LAS unsigned* st; };
__device__ __forceinline__ XcdBarrier xcd_barrier_post(unsigned* bar, volatile LAS unsigned* st) {
    XcdBarrier b; b.bar = bar; b.x = xb_xcc_id(); b.st = st;
    if (threadIdx.x == 0) (void)xb_add(&bar[XB_XCNT(b.x)], 1u);
    return b;
}
__device__ __forceinline__ void xcd_barrier_complete(unsigned* bar, unsigned x, unsigned& nloc, unsigned& nx) {
    const unsigned G = gridDim.x * gridDim.y * gridDim.z;
    unsigned sum, cnt, mine, sp = 0u;
    for (;;) {
        sum = 0u; cnt = 0u; mine = 0u;
#pragma unroll
        for (unsigned j = 0; j < 16; ++j) { const unsigned c = xb_ld(&bar[XB_XCNT(j)]); sum += c; cnt += (c > 0u) ? 1u : 0u; mine = (j == x) ? c : mine; }
        if (sum == G) break;
        __builtin_amdgcn_s_sleep(1);
        if ((++sp & 255u) == 0u) { if (xb_ld(&bar[XB_TMO])) break; if (sp > XB_SPIN_CAP) { atomicAdd(&bar[XB_TMO], 1u); break; } }
    }
    nloc = mine > 0u ? mine : 1u; nx = cnt > 0u ? cnt : 1u;
}
__device__ __forceinline__ void xcd_barrier(const XcdBarrier& b) {
    asm volatile("s_waitcnt vmcnt(0)" ::: "memory");
    __syncthreads();
    if (threadIdx.x == 0) {
        unsigned* bar = b.bar;
        __builtin_amdgcn_s_waitcnt(0);
        unsigned nloc = b.st[0], nx = b.st[1];
        if (nloc == 0u) { xcd_barrier_complete(bar, b.x, nloc, nx); b.st[0] = nloc; b.st[1] = nx; }
        const unsigned old = xb_add(&bar[XB_XSUB(b.x)], 1u);
        const unsigned gen = old / nloc;
        if (old + 1u == (gen + 1u) * nloc) {
            __builtin_amdgcn_fence(__ATOMIC_RELEASE, "agent");
            asm volatile("s_waitcnt vmcnt(0)" ::: "memory");
            const unsigned og = xb_add(&bar[XB_TOP], 1u);
            const unsigned tg = og / nx;
            if (og + 1u == (tg + 1u) * nx) xb_add(&bar[XB_TOPGEN], 1u);
            else XB_SPIN(xb_ld(&bar[XB_TOPGEN]) == tg, bar);
            __builtin_amdgcn_fence(__ATOMIC_ACQUIRE, "agent");
            xb_add(&bar[XB_XGEN(b.x)], 1u);
            asm volatile("s_waitcnt vmcnt(0)" ::: "memory");
        } else {
            XB_SPIN(xb_ld(&bar[XB_XGEN(b.x)]) == gen, bar);
            __builtin_amdgcn_fence(__ATOMIC_ACQUIRE, "agent");
            asm volatile("s_waitcnt vmcnt(0)" ::: "memory");
        }
    }
    __syncthreads();
}

struct Params { const float* in[26]; float* out; unsigned char* ws; int lo, hi; };
constexpr int NPHASE = 17;

__global__ void __launch_bounds__(512) fwd_megakernel(Params P) {
    extern __shared__ __attribute__((aligned(16))) unsigned char lds_raw[];
    LAS unsigned char* lds = (LAS unsigned char*)lds_raw;
    const int tid = threadIdx.x, lane = tid & 63, wave = __builtin_amdgcn_readfirstlane(tid >> 6);
    const int G = gridDim.x, bx = blockIdx.x;
    const int vcu = (G % 8 == 0) ? (bx % 8) * (G / 8) + bx / 8 : bx;
    const int gw = vcu * 8 + wave, NGW = G * 8;
    unsigned char* ws = P.ws;
    float* out = P.out;
    bf16_t* Wgu = (bf16_t*)(ws + WS_WGU); bf16_t* Wd = (bf16_t*)(ws + WS_WD); bf16_t* Win = (bf16_t*)(ws + WS_WIN); bf16_t* Wout = (bf16_t*)(ws + WS_WOUT);
    bf16_t* Wglu = (bf16_t*)(ws + WS_WGLU); bf16_t* Wqkv = (bf16_t*)(ws + WS_WQKV); bf16_t* Wco = (bf16_t*)(ws + WS_WCO);
    bf16_t* XN = (bf16_t*)(ws + WS_XN); bf16_t* BIG = (bf16_t*)(ws + WS_BIG); bf16_t* ZB = (bf16_t*)(ws + WS_Z);
    const float* x = P.in[0]; const float* ffn_norm = P.in[1]; const float* mix_norm = P.in[5];
#if MK_PER_PHASE
#define SYNC(k) do { } while (0)
#else
    cg::grid_group grid = cg::this_grid();
    { volatile LAS unsigned* st0 = (volatile LAS unsigned*)(lds + 139264); if (tid < 2) st0[tid] = 0u; }
    __syncthreads();
    const XcdBarrier xbar = xcd_barrier_post((unsigned*)(ws + WS_BAR), (volatile LAS unsigned*)(lds + 139264));
#define SYNC(k) do { if (P.lo <= (k) && (k) + 1 < P.hi) { if ((k) == 0) grid.sync(); else xcd_barrier(xbar); } } while (0)
#endif
#ifndef DUPMASK
#define DUPMASK 0u
#endif
#define IN(k) (P.lo <= (k) && (k) < P.hi)
#define REP(k) for (int rep_ = 0; rep_ < (((DUPMASK >> (k)) & 1u) ? 2 : 1); ++rep_)

    u64_t* SSQ = (u64_t*)(ws + WS_SSQ);
    bf16_t* YC = (bf16_t*)(ws + WS_YC);
    const float* rcos = (const float*)(ws + WS_RCOS); const float* rsin = (const float*)(ws + WS_RSIN);
    const float* acos_ = (const float*)(ws + WS_ACOS); const float* asin_ = (const float*)(ws + WS_ASIN);
    if (IN(0)) REP(0) {
        LAS float* scr = (LAS float*)(lds + wave * 16640);
        const size_t gsz = (size_t)DM * DFF;
#pragma unroll 1
        for (int i = 0; i < 4; ++i) {
            conv_matrix(P.in[2] + i * gsz, Wgu + (size_t)i * NGU * DM, DM, DFF, 1, ffn_norm + i * DM, scr, gw, NGW, lane);
            conv_matrix(P.in[3] + i * gsz, Wgu + (size_t)i * NGU * DM, DM, DFF, 2, ffn_norm + i * DM, scr, gw, NGW, lane);
            conv_matrix(P.in[4] + i * gsz, Wd + (size_t)i * DM * DFF, DFF, DM, 0, nullptr, scr, gw, NGW, lane);
        }
        conv_matrix(P.in[6], Win, DM, PW, 0, mix_norm, scr, gw, NGW, lane);
        conv_matrix(P.in[7], Wout, DM, DM, 0, nullptr, scr, gw, NGW, lane);
        conv_matrix(P.in[16], Wglu, 1024, 1024, 0, nullptr, scr, gw, NGW, lane);
        conv_matrix(P.in[18], Wqkv, DM, QW, 0, mix_norm + DM, scr, gw, NGW, lane);
        conv_matrix(P.in[19], Wco, DM, DM, 0, nullptr, scr, gw, NGW, lane);
        tables_phase(ws, nullptr, P.in[8], P.in[9], P.in[10], P.in[11], P.in[12], P.in[20], P.in[21], P.in[22], P.in[23], vcu * 512 + tid, G * 512);
        for (int i = vcu * 512 + tid; i < 6 * TT; i += G * 512) SSQ[TT + i] = 0ull;
        cast_phase(x, XN, SSQ, gw, NGW, lane);
    }
    SYNC(0);
#if !MK_PER_PHASE
    if ((DUPMASK >> 20) & 1u) { for (int q_ = 0; q_ < 32; ++q_) grid.sync(); }
#endif
    if (IN(1)) { run_gemm(lds, XN, Wgu, TT, NGU, DM, EpiSwiglu{BIG, DFF, SSQ}); if ((DUPMASK >> 1) & 1u) { run_gemm(lds, XN, Wgu, TT, NGU, DM, EpiSwiglu{BIG, DFF, SSQ}); } }
    SYNC(1);
    if (IN(2)) run_gemm(lds, BIG, Wd, TT, DM, DFF, EpiResid<true, false, 1>{x, nullptr, XN, SSQ + 1 * TT});
    if (IN(2) && ((DUPMASK >> 2) & 1u)) run_gemm(lds, BIG, Wd, TT, DM, DFF, EpiResid<false, false, 2>{nullptr, nullptr, XN, nullptr});
    SYNC(2);
    if (IN(3)) { run_gemm(lds, XN, Win, TT, PW, DM, EpiWin{BIG, rcos, rsin, SSQ + 1 * TT}); if ((DUPMASK >> 3) & 1u) { run_gemm(lds, XN, Win, TT, PW, DM, EpiWin{BIG, rcos, rsin, SSQ + 1 * TT}); } }
    SYNC(3);
    if (IN(4)) REP(4) {
        const int GH = G / 2;
        if (G >= 2 && vcu < GH) attn_phase<0>(lds, BIG, PW, 1024, 2048, 4, YC, BIG, nullptr, 0.f, vcu, GH);
        else if (G >= 2) s5_phase(lds, ws, BIG, P.in[13], P.in[14], P.in[15], ZB, vcu - GH, G - GH, wave, lane);
        else { attn_phase<0>(lds, BIG, PW, 1024, 2048, 4, YC, BIG, nullptr, 0.f, vcu, G); s5_phase(lds, ws, BIG, P.in[13], P.in[14], P.in[15], ZB, vcu, G, wave, lane); }
    }
    SYNC(4);
    if (IN(5)) run_gemm(lds, ZB, Wglu, TT, 1024, 1024, EpiGlu{ZB, P.in[17], YC});
    SYNC(5);
    if (IN(6)) run_gemm(lds, YC, Wout, TT, DM, DM, EpiResid<false, false, 0>{nullptr, nullptr, XN, SSQ + 2 * TT});
    if (IN(6) && ((DUPMASK >> 6) & 1u)) run_gemm(lds, YC, Wout, TT, DM, DM, EpiResid<false, false, 2>{nullptr, nullptr, XN, nullptr});
    SYNC(6);
    if (IN(7)) { run_gemm(lds, XN, Wgu + (size_t)1 * NGU * DM, TT, NGU, DM, EpiSwiglu{BIG, DFF, SSQ + 2 * TT}); if ((DUPMASK >> 7) & 1u) { run_gemm(lds, XN, Wgu + (size_t)1 * NGU * DM, TT, NGU, DM, EpiSwiglu{BIG, DFF, SSQ + 2 * TT}); } }
    SYNC(7);
    if (IN(8)) run_gemm(lds, BIG, Wd + (size_t)1 * DM * DFF, TT, DM, DFF, EpiResid<false, false, 1>{nullptr, nullptr, XN, SSQ + 3 * TT});
    if (IN(8) && ((DUPMASK >> 8) & 1u)) run_gemm(lds, BIG, Wd + (size_t)1 * DM * DFF, TT, DM, DFF, EpiResid<false, false, 2>{nullptr, nullptr, XN, nullptr});
    SYNC(8);
    if (IN(9)) { run_gemm(lds, XN, Wgu + (size_t)2 * NGU * DM, TT, NGU, DM, EpiSwiglu{BIG, DFF, SSQ + 3 * TT}); if ((DUPMASK >> 9) & 1u) { run_gemm(lds, XN, Wgu + (size_t)2 * NGU * DM, TT, NGU, DM, EpiSwiglu{BIG, DFF, SSQ + 3 * TT}); } }
    SYNC(9);
    if (IN(10)) run_gemm(lds, BIG, Wd + (size_t)2 * DM * DFF, TT, DM, DFF, EpiResid<false, false, 1>{nullptr, nullptr, XN, SSQ + 4 * TT});
    if (IN(10) && ((DUPMASK >> 10) & 1u)) run_gemm(lds, BIG, Wd + (size_t)2 * DM * DFF, TT, DM, DFF, EpiResid<false, false, 2>{nullptr, nullptr, XN, nullptr});
    SYNC(10);
    if (IN(11)) { run_gemm(lds, XN, Wqkv, TT, QW, DM, EpiQkv{BIG, acos_, asin_, SSQ + 4 * TT}); if ((DUPMASK >> 11) & 1u) { run_gemm(lds, XN, Wqkv, TT, QW, DM, EpiQkv{BIG, acos_, asin_, SSQ + 4 * TT}); } }
    SYNC(11);
#ifndef NO_A1
    if (IN(12)) REP(12) { const float lam = ((const float*)(ws + WS_CTL))[0]; attn_phase<1>(lds, BIG, QW, 2048, 4096, 8, YC, nullptr, P.in[24], lam, vcu, G); }
#endif
    SYNC(12);
    if (IN(13)) run_gemm(lds, YC, Wco, TT, DM, DM, EpiResid<false, false, 0>{nullptr, nullptr, XN, SSQ + 5 * TT});
    if (IN(13) && ((DUPMASK >> 13) & 1u)) run_gemm(lds, YC, Wco, TT, DM, DM, EpiResid<false, false, 2>{nullptr, nullptr, XN, nullptr});
    SYNC(13);
    if (IN(14)) { run_gemm(lds, XN, Wgu + (size_t)3 * NGU * DM, TT, NGU, DM, EpiSwiglu{BIG, DFF, SSQ + 5 * TT}); if ((DUPMASK >> 14) & 1u) { run_gemm(lds, XN, Wgu + (size_t)3 * NGU * DM, TT, NGU, DM, EpiSwiglu{BIG, DFF, SSQ + 5 * TT}); } }
    SYNC(14);
    if (IN(15)) run_gemm(lds, BIG, Wd + (size_t)3 * DM * DFF, TT, DM, DFF, EpiResid<false, false, 1>{nullptr, nullptr, XN, SSQ + 6 * TT});
    if (IN(15) && ((DUPMASK >> 15) & 1u)) run_gemm(lds, BIG, Wd + (size_t)3 * DM * DFF, TT, DM, DFF, EpiResid<false, false, 2>{nullptr, nullptr, XN, nullptr});
    SYNC(15);
    if (IN(16)) final_phase(XN, SSQ + 6 * TT, P.in[25], out, gw, NGW, lane);
#undef IN
#undef SYNC
}

extern "C" void kernel_launch(void* const* d_in, const int* in_sizes, int n_in, void* d_out, int out_size, void* d_ws, size_t ws_size, hipStream_t stream) {
    static int grid = 0;
    if (grid == 0) {
        if (n_in != 26 || out_size != TT * DM || ws_size < WS_END) { fprintf(stderr, "kernel_launch: unexpected shapes (n_in %d, out %d, ws %zu < %zu)\n", n_in, out_size, ws_size, (size_t)WS_END); grid = -1; return; }
        int dev = 0, cus = 0, per_cu = 0;
        hipGetDevice(&dev); hipDeviceGetAttribute(&cus, hipDeviceAttributeMultiprocessorCount, dev);
        if (hipFuncSetAttribute((const void*)fwd_megakernel, hipFuncAttributeMaxDynamicSharedMemorySize, LDS_BYTES) != hipSuccess) { fprintf(stderr, "kernel_launch: hipFuncSetAttribute failed\n"); grid = -1; return; }
        if (hipOccupancyMaxActiveBlocksPerMultiprocessor(&per_cu, (const void*)fwd_megakernel, 512, LDS_BYTES) != hipSuccess || per_cu < 1) { fprintf(stderr, "kernel_launch: occupancy query says %d\n", per_cu); per_cu = 1; }
        (void)hipGetLastError();
        grid = cus * per_cu;
        fprintf(stderr, "kernel_launch: grid %d (cus %d x %d)\n", grid, cus, per_cu);
    }
    if (grid < 0) return;
    if (hipMemsetAsync((char*)d_ws + WS_BAR, 0, BAR_BYTES, stream) != hipSuccess) { fprintf(stderr, "kernel_launch: hipMemsetAsync failed\n"); return; }
    Params p{};
    for (int i = 0; i < 26; ++i) p.in[i] = (const float*)d_in[i];
    p.out = (float*)d_out; p.ws = (unsigned char*)d_ws;
#if MK_PER_PHASE
    for (int k = 0; k < NPHASE; ++k) { p.lo = k; p.hi = k + 1; hipLaunchKernelGGL(fwd_megakernel, dim3(grid), dim3(512), LDS_BYTES, stream, p); }
#else
    p.lo = 0; p.hi = NPHASE;
    void* args[] = {&p};
    hipError_t e = hipLaunchCooperativeKernel((const void*)fwd_megakernel, dim3(grid), dim3(512), args, LDS_BYTES, stream);
    if (e != hipSuccess) fprintf(stderr, "cooperative launch failed: %s (grid %d)\n", hipGetErrorString(e), grid);
#endif
}
```

```cpp
#include <hip/hip_runtime.h>
#include <hip/hip_cooperative_groups.h>
#include <cstdio>
#include <cstdint>
namespace cg = cooperative_groups;

#define LAS __attribute__((address_space(3)))
typedef unsigned short bf16_t;
typedef unsigned long long u64_t;
constexpr float SSQ_FIX = 16777216.0f, SSQ_INV = 1.0f / 16777216.0f;
typedef short bf16x8 __attribute__((ext_vector_type(8)));
typedef short s16x4 __attribute__((ext_vector_type(4)));
typedef float f32x4 __attribute__((ext_vector_type(4)));
typedef float f32x2 __attribute__((ext_vector_type(2)));
typedef float f32x16 __attribute__((ext_vector_type(16)));
typedef unsigned u32x4 __attribute__((ext_vector_type(4)));
typedef unsigned u32x2 __attribute__((ext_vector_type(2)));

#ifndef MK_PER_PHASE
#define MK_PER_PHASE 0
#endif

constexpr int TT = 32768, SEQ = 2048, DM = 2048, DFF = 5504, NGU = 2 * DFF;
constexpr int PW = 5120, QW = 6144;
constexpr float EPS = 1e-6f;
constexpr float LAMBDA_INIT = 0.35550906759f;
constexpr float QSCALE = 0.08838834764831845f * 1.4426950408889634f;

constexpr size_t MiB = 1u << 20;
constexpr size_t WS_CTL = 0, WS_BAR = 4096, BAR_BYTES = 16384;
constexpr size_t WS_RCOS = 1 * MiB, WS_RSIN = 2 * MiB, WS_ACOS = 3 * MiB, WS_ASIN = 3 * MiB + 128 * 1024, WS_S5A = 3 * MiB + 512 * 1024, WS_S5BB = 4 * MiB;
constexpr size_t WS_W = 8 * MiB;
constexpr size_t SZ_WGU = (size_t)NGU * DM * 2, SZ_WD = (size_t)DM * DFF * 2;
constexpr size_t WS_WGU = WS_W, WS_WD = WS_WGU + 4 * SZ_WGU, WS_WIN = WS_WD + 4 * SZ_WD, WS_WOUT = WS_WIN + (size_t)PW * DM * 2,
                 WS_WGLU = WS_WOUT + (size_t)DM * DM * 2, WS_WQKV = WS_WGLU + (size_t)1024 * 1024 * 2, WS_WCO = WS_WQKV + (size_t)QW * DM * 2,
                 WS_WEND = WS_WCO + (size_t)DM * DM * 2;
constexpr size_t WS_XN = 328 * MiB;
constexpr size_t WS_BIG = 456 * MiB;
constexpr size_t WS_Z = WS_BIG + (size_t)TT * PW * 2;
constexpr size_t WS_YC = WS_BIG + (size_t)TT * QW * 2;
constexpr size_t WS_END = WS_YC + (size_t)TT * DM * 2;
constexpr size_t WS_SSQ = 5 * MiB;
static_assert(WS_WEND <= WS_XN && WS_XN + (size_t)TT * DM * 2 <= WS_BIG && WS_Z + (size_t)TT * 1024 * 2 <= WS_END, "ws map");

constexpr int LDS_BYTES = 147456;

namespace pg8 {
constexpr int BM = 256, BK = 64, HALF = 128, HTB = HALF * BK * 2, STAGE_BYTES = 8 * HTB, NXCD = 8, WGM = 8;
__host__ __device__ __forceinline__ int lds_byte(int r, int c) { const int st = (r >> 4) * 2 + (c >> 5), rr = r & 15, cc = c & 31, ob = rr * 64 + cc * 2; return st * 1024 + (ob ^ (((ob >> 9) & 1) << 5)); }
__host__ __device__ __forceinline__ void stage_rc(int b, int& R, int& C) { const int st = b / 1024, sb = b % 1024, swz = sb ^ (((sb >> 9) & 1) << 5); R = (st >> 1) * 16 + swz / 64; C = (st & 1) * 32 + (swz % 64) / 2; }
__host__ __device__ __forceinline__ int perm32(int rho) { const int n = rho >> 4, i = rho & 15; return 8 * (i >> 2) + 4 * n + (i & 3); }
struct Unit { int pm, pn; };
struct Gemm { const bf16_t* A; const bf16_t* Bt; int M, N, K; };
struct StaticOrder {
    int nM, nN, nwg, G, c;
    __host__ __device__ void init(int M, int N, int G_, int c_) { nM = M / BM; nN = N / BM; nwg = nM * nN; G = G_; c = c_; }
    __host__ __device__ bool next(int i, Unit& u) const {
        const long L = (long)i * G + c; if (L >= nwg) return false;
        int wgid = (int)L; { const int q = nwg / NXCD, r = nwg % NXCD, xcd = wgid % NXCD, off = wgid / NXCD; wgid = (xcd < r ? xcd * (q + 1) : r * (q + 1) + (xcd - r) * q) + off; }
        const int nig = WGM * nN, gid = wgid / nig, fm = gid * WGM, gsz = (nM - fm) < WGM ? (nM - fm) : WGM;
        u.pm = fm + ((wgid % nig) % gsz); u.pn = (wgid % nig) / gsz; return true;
    }
    __device__ __forceinline__ void a_ready(const Unit&) const {}
    __device__ __forceinline__ void done(const Unit&) const {}
};
__device__ __forceinline__ unsigned cvt_pk_bf16(float lo, float hi) { unsigned r; asm volatile("v_cvt_pk_bf16_f32 %0, %1, %2" : "=v"(r) : "v"(lo), "v"(hi)); return r; }

template <class Epi, class Sched, bool ALIGN_EPI = false, bool SP2 = false>
__device__ __forceinline__ void gemm_phase(LAS unsigned char* lds, const Gemm g, const Sched S, const Epi E) {
    const int tid = threadIdx.x, wid = __builtin_amdgcn_readfirstlane(tid >> 6), lane = tid & 63, wr = wid >> 2, wc = wid & 3, fr = lane & 15, fq = lane >> 4;
    const int K = g.K, nt = K / BK;
    unsigned voffA[2], voffB[2];
#pragma unroll
    for (int i = 0; i < 2; ++i) { int R, C; stage_rc(tid * 16 + i * 8192, R, C); const int Rb = Epi::PERM ? ((R & ~31) + perm32(R & 31)) : R;
        voffA[i] = (unsigned)(R * K + C) * 2u; voffB[i] = (unsigned)(Rb * K + C) * 2u; }
    const size_t kstep = (size_t)(BK * 2);
    const size_t hstep = (size_t)HALF * K * 2;
    const size_t tstep = 2 * hstep;
    const unsigned ldsw = (unsigned)wid * 1024u;
    const int aoff = lds_byte(wr * 64 + fr, fq * 8), boff = lds_byte(wc * 32 + fr, fq * 8);
#define PG8_SA(b, h) (((b) * 2 + (h)) * HTB)
#define PG8_SB(b, h) ((4 + (b) * 2 + (h)) * HTB)
#define PG8_STAGE(bufoff, gbase, voff) do { _Pragma("unroll") for (int _i = 0; _i < 2; ++_i) \
        __builtin_amdgcn_global_load_lds((const unsigned*)((const char*)(gbase) + (voff)[_i]), (LAS unsigned*)(lds + (bufoff) + ldsw + _i * 8192), 16, 0, 0); } while (0)
#define PG8_LDA(dst, b, h) do { _Pragma("unroll") for (int m = 0; m < 4; ++m) _Pragma("unroll") for (int k = 0; k < 2; ++k) dst[m][k] = *(const LAS bf16x8*)(lds + PG8_SA(b, h) + aoff + m * 2048 + k * 1024); } while (0)
#define PG8_LDB(dst, b, h) do { _Pragma("unroll") for (int n = 0; n < 2; ++n) _Pragma("unroll") for (int k = 0; k < 2; ++k) dst[n][k] = *(const LAS bf16x8*)(lds + PG8_SB(b, h) + boff + n * 2048 + k * 1024); } while (0)
#define PG8_MMA(ai, bj, At, Bt) do { __builtin_amdgcn_s_setprio(1); _Pragma("unroll") for (int m = 0; m < 4; ++m) _Pragma("unroll") for (int n = 0; n < 2; ++n) _Pragma("unroll") for (int k = 0; k < 2; ++k) \
        acc[ai][bj][m][n] = __builtin_amdgcn_mfma_f32_16x16x32_bf16(Bt[n][k], At[m][k], acc[ai][bj][m][n], 0, 0, 0); __builtin_amdgcn_s_setprio(0); } while (0)
#define PG8_WAIT_V(n) asm volatile("s_waitcnt vmcnt(" #n ")" ::: "memory")
#define PG8_WAIT_L(n) asm volatile("s_waitcnt lgkmcnt(" #n ")" ::: "memory")
#define PG8_BAR __builtin_amdgcn_s_barrier()
#define PG8_SCHED __builtin_amdgcn_sched_barrier(0)
    Unit cur, nxt; int ui = 0;
    if (!S.next(0, cur)) return;
    f32x4 acc[2][2][4][2];
#pragma unroll
    for (int a = 0; a < 2; ++a)
#pragma unroll
        for (int b = 0; b < 2; ++b)
#pragma unroll
            for (int m = 0; m < 4; ++m)
#pragma unroll
                for (int n = 0; n < 2; ++n) acc[a][b][m][n] = (f32x4){0.f, 0.f, 0.f, 0.f};
    bf16x8 At[4][2], B0[2][2], B1[2][2];
    const char* cA = (const char*)g.A + (size_t)cur.pm * tstep; const char* cB = (const char*)g.Bt + (size_t)cur.pn * tstep;
    S.a_ready(cur);
    if constexpr (SP2) {
        PG8_STAGE(PG8_SB(0, 0), cB, voffB); PG8_STAGE(PG8_SB(0, 1), cB + hstep, voffB); PG8_STAGE(PG8_SA(0, 0), cA, voffA); PG8_STAGE(PG8_SA(0, 1), cA + hstep, voffA);
        if (wr == 1) PG8_BAR;
        PG8_WAIT_V(2); PG8_BAR;
        PG8_STAGE(PG8_SB(1, 0), cB + kstep, voffB); PG8_STAGE(PG8_SA(1, 0), cA + kstep, voffA); PG8_STAGE(PG8_SB(1, 1), cB + hstep + kstep, voffB);
        PG8_WAIT_V(6); PG8_BAR;
    } else {
        PG8_STAGE(PG8_SB(0, 0), cB, voffB); PG8_STAGE(PG8_SA(0, 0), cA, voffA); PG8_STAGE(PG8_SB(0, 1), cB + hstep, voffB); PG8_STAGE(PG8_SA(0, 1), cA + hstep, voffA);
        if (wr == 1) PG8_BAR;
        PG8_WAIT_V(4); PG8_BAR;
        PG8_STAGE(PG8_SB(1, 0), cB + kstep, voffB); PG8_STAGE(PG8_SA(1, 0), cA + kstep, voffA); PG8_STAGE(PG8_SB(1, 1), cB + hstep + kstep, voffB);
        PG8_WAIT_V(6); PG8_BAR;
    }
    for (;;) {
        const bool has_next = S.next(ui + 1, nxt);
        const char* nA = has_next ? (const char*)g.A + (size_t)nxt.pm * tstep : cA; const char* nB = has_next ? (const char*)g.Bt + (size_t)nxt.pn * tstep : cB;
        for (int t = 0; t < nt; t += 2) {
            const bool last = (t == nt - 2);
            const char* a1 = cA + (size_t)(t + 1) * kstep;
            const char* a2 = last ? nA : cA + (size_t)(t + 2) * kstep; const char* b2 = last ? nB : cB + (size_t)(t + 2) * kstep;
            const char* a3 = a2 + kstep; const char* b3 = b2 + kstep;
            if (last && has_next) S.a_ready(nxt);
            if constexpr (SP2) {
            PG8_LDB(B0, 0, 0); PG8_LDB(B1, 0, 1); PG8_SCHED; PG8_LDA(At, 0, 0); PG8_STAGE(PG8_SA(1, 1), a1 + hstep, voffA);
            PG8_WAIT_V(8); PG8_WAIT_L(0); PG8_BAR; PG8_MMA(0, 0, At, B0); PG8_MMA(0, 1, At, B1); PG8_BAR; PG8_SCHED;
            PG8_LDA(At, 0, 1); PG8_STAGE(PG8_SB(0, 0), b2, voffB); PG8_STAGE(PG8_SB(0, 1), b2 + hstep, voffB); PG8_STAGE(PG8_SA(0, 0), a2, voffA);
            PG8_WAIT_V(8); PG8_WAIT_L(0); PG8_BAR; PG8_MMA(1, 0, At, B0); PG8_MMA(1, 1, At, B1); PG8_BAR; PG8_SCHED;
            PG8_LDB(B0, 1, 0); PG8_LDB(B1, 1, 1); PG8_SCHED; PG8_LDA(At, 1, 0); PG8_STAGE(PG8_SA(0, 1), a2 + hstep, voffA);
            PG8_WAIT_V(8); PG8_WAIT_L(0); PG8_BAR; PG8_MMA(0, 0, At, B0); PG8_MMA(0, 1, At, B1); PG8_BAR; PG8_SCHED;
            PG8_LDA(At, 1, 1); PG8_STAGE(PG8_SB(1, 0), b3, voffB); PG8_STAGE(PG8_SB(1, 1), b3 + hstep, voffB); PG8_STAGE(PG8_SA(1, 0), a3, voffA);
            PG8_WAIT_V(8); PG8_WAIT_L(0); PG8_BAR; PG8_MMA(1, 0, At, B0); PG8_MMA(1, 1, At, B1); PG8_BAR; PG8_SCHED;
            } else {
            PG8_LDB(B0, 0, 0); PG8_SCHED; PG8_LDA(At, 0, 0); PG8_STAGE(PG8_SA(1, 1), a1 + hstep, voffA);
            PG8_WAIT_L(8); PG8_BAR; PG8_WAIT_L(0); PG8_MMA(0, 0, At, B0); PG8_BAR; PG8_SCHED;
            PG8_LDB(B1, 0, 1); PG8_STAGE(PG8_SB(0, 0), b2, voffB);
            PG8_BAR; PG8_WAIT_L(0); PG8_MMA(0, 1, At, B1); PG8_BAR;
            PG8_LDA(At, 0, 1); PG8_STAGE(PG8_SA(0, 0), a2, voffA);
            PG8_BAR; PG8_WAIT_L(0); PG8_MMA(1, 0, At, B0); PG8_BAR; PG8_SCHED;
            PG8_STAGE(PG8_SB(0, 1), b2 + hstep, voffB);
            PG8_WAIT_V(6); PG8_BAR; PG8_MMA(1, 1, At, B1); PG8_BAR;
            PG8_LDB(B0, 1, 0); PG8_SCHED; PG8_LDA(At, 1, 0); PG8_STAGE(PG8_SA(0, 1), a2 + hstep, voffA);
            PG8_WAIT_L(8); PG8_BAR; PG8_WAIT_L(0); PG8_MMA(0, 0, At, B0); PG8_BAR; PG8_SCHED;
            PG8_LDB(B1, 1, 1); PG8_STAGE(PG8_SB(1, 0), b3, voffB);
            PG8_BAR; PG8_WAIT_L(0); PG8_MMA(0, 1, At, B1); PG8_BAR;
            PG8_LDA(At, 1, 1); PG8_STAGE(PG8_SA(1, 0), a3, voffA);
            PG8_BAR; PG8_WAIT_L(0); PG8_MMA(1, 0, At, B0); PG8_BAR; PG8_SCHED;
            PG8_STAGE(PG8_SB(1, 1), b3 + hstep, voffB);
            PG8_WAIT_V(6); PG8_BAR; PG8_MMA(1, 1, At, B1); PG8_BAR;
            }
        }
        if constexpr (ALIGN_EPI) { if (wr == 0) PG8_BAR; }
        if constexpr (!Epi::AFTER_DRAIN) { E(acc, cur, wr, wc, fr, fq); S.done(cur); }
        if (!has_next) break;
#pragma unroll
        for (int a = 0; a < 2; ++a)
#pragma unroll
            for (int b = 0; b < 2; ++b)
#pragma unroll
                for (int m = 0; m < 4; ++m)
#pragma unroll
                    for (int n = 0; n < 2; ++n) acc[a][b][m][n] = (f32x4){0.f, 0.f, 0.f, 0.f};
        cur = nxt; cA = nA; cB = nB; ++ui;
        if constexpr (ALIGN_EPI) { if (wr == 1) PG8_BAR; }
    }
    PG8_WAIT_V(0);
    if constexpr (!ALIGN_EPI) { if (wr == 0) PG8_BAR; }
    PG8_BAR;
#undef PG8_SA
#undef PG8_SB
#undef PG8_STAGE
#undef PG8_LDA
#undef PG8_LDB
#undef PG8_MMA
#undef PG8_WAIT_V
#undef PG8_WAIT_L
#undef PG8_BAR
#undef PG8_SCHED
}
}

__device__ __forceinline__ unsigned f2bf(float f) { unsigned u = __builtin_bit_cast(unsigned, f); return (u + 0x7fffu + ((u >> 16) & 1u)) >> 16; }
__device__ __forceinline__ unsigned pk2(float lo, float hi) { return f2bf(lo) | (f2bf(hi) << 16); }
__device__ __forceinline__ float bf2f(unsigned short b) { return __builtin_bit_cast(float, (unsigned)b << 16); }
__device__ __forceinline__ float bflo(unsigned w) { return __builtin_bit_cast(float, w << 16); }
__device__ __forceinline__ float bfhi(unsigned w) { return __builtin_bit_cast(float, w & 0xffff0000u); }
__device__ __forceinline__ float fast_sigmoid(float x) { return __builtin_amdgcn_rcpf(1.0f + __builtin_amdgcn_exp2f(-1.4426950408889634f * x)); }
__device__ __forceinline__ float silu_f(float x) { return x * fast_sigmoid(x); }
__device__ __forceinline__ float gelu_tanh_f(float y) { return y * fast_sigmoid(1.5957691216057308f * (y + 0.044715f * y * y * y)); }
__device__ __forceinline__ float wave_sum(float v) {
#pragma unroll
    for (int o = 1; o < 64; o <<= 1) v += __shfl_xor(v, o);
    return v;
}
__device__ __forceinline__ void sincos_d(double a, double& s, double& c) {
    const double k = rint(a * 0.15915494309189535);
    const double r = fma(-k, 6.283185307179586, a), r2 = r * r;
    double ts = r, tc = 1.0; s = r; c = 1.0;
    for (int n = 1; n <= 13; ++n) { tc *= -r2 / (double)((2 * n - 1) * (2 * n)); c += tc; ts *= -r2 / (double)((2 * n) * (2 * n + 1)); s += ts; }
}

using pg8::Unit; using pg8::cvt_pk_bf16;
struct EpiSwiglu {
    static constexpr bool PERM = true, AFTER_DRAIN = false;
    bf16_t* O; int ldo; const u64_t* ssq;
    __device__ __forceinline__ void operator()(const f32x4 (&acc)[2][2][4][2], const Unit& u, int wr, int wc, int fr, int fq) const {
        const int row0 = u.pm * 256 + wr * 64 + fr, col0 = u.pn * 128 + wc * 32 + 8 * fq;
        float rsv[2][4];
#pragma unroll
        for (int ai = 0; ai < 2; ++ai)
#pragma unroll
            for (int m = 0; m < 4; ++m) rsv[ai][m] = (float)ssq[row0 + ai * 128 + m * 16] * SSQ_INV;
#pragma unroll
        for (int ai = 0; ai < 2; ++ai)
#pragma unroll
            for (int m = 0; m < 4; ++m) {
                const int row = row0 + ai * 128 + m * 16;
                const float rs = __builtin_amdgcn_rsqf(rsv[ai][m] * (1.0f / DM) + EPS);
                bf16_t* rowp = O + (size_t)row * ldo + col0;
                const f32x4 g0 = acc[ai][0][m][0] * rs, g1 = acc[ai][0][m][1] * rs, u0 = acc[ai][1][m][0] * rs, u1 = acc[ai][1][m][1] * rs;
                u32x4 w;
                w.x = cvt_pk_bf16(silu_f(g0[0]) * u0[0], silu_f(g0[1]) * u0[1]); w.y = cvt_pk_bf16(silu_f(g0[2]) * u0[2], silu_f(g0[3]) * u0[3]);
                w.z = cvt_pk_bf16(silu_f(g1[0]) * u1[0], silu_f(g1[1]) * u1[1]); w.w = cvt_pk_bf16(silu_f(g1[2]) * u1[2], silu_f(g1[3]) * u1[3]);
                *(u32x4*)rowp = w;
            }
    }
};
template <bool BASE_F32, bool OUT_F32, int SCALE> struct EpiResid {
    static constexpr bool PERM = false, AFTER_DRAIN = false;
    const float* basef; float* outf; bf16_t* xb; u64_t* ssq;
    __device__ __forceinline__ void operator()(const f32x4 (&acc)[2][2][4][2], const Unit& u, int wr, int wc, int fr, int fq) const {
        const int col0 = u.pn * 256 + wc * 32 + 4 * fq;
        constexpr float sc = (SCALE == 2 ? 0.0f : SCALE == 1 ? 0.5f : 1.0f);
#pragma unroll
        for (int ai = 0; ai < 2; ++ai) {
            f32x4 pre[4][2][2];
#pragma unroll
            for (int m = 0; m < 4; ++m) { const size_t off = (size_t)(u.pm * 256 + ai * 128 + wr * 64 + m * 16 + fr) * DM + col0;
#pragma unroll
                for (int bj = 0; bj < 2; ++bj)
#pragma unroll
                    for (int n = 0; n < 2; ++n) {
                        if constexpr (BASE_F32) pre[m][bj][n] = *(const f32x4*)(basef + off + bj * 128 + n * 16);
                        else { const u32x2 w = *(const u32x2*)(xb + off + bj * 128 + n * 16); pre[m][bj][n] = (f32x4){bflo(w.x), bfhi(w.x), bflo(w.y), bfhi(w.y)}; } } }
#pragma unroll
            for (int m = 0; m < 4; ++m) {
                const int row = u.pm * 256 + ai * 128 + wr * 64 + m * 16 + fr;
                const size_t off = (size_t)row * DM + col0;
                float sq = 0.f;
#pragma unroll
                for (int bj = 0; bj < 2; ++bj)
#pragma unroll
                    for (int n = 0; n < 2; ++n) { const f32x4 v = pre[m][bj][n] + acc[ai][bj][m][n] * sc;
                        if constexpr (OUT_F32) *(f32x4*)(outf + off + bj * 128 + n * 16) = v;
                        else { u32x2 w; w.x = cvt_pk_bf16(v[0], v[1]); w.y = cvt_pk_bf16(v[2], v[3]); *(u32x2*)(xb + off + bj * 128 + n * 16) = w;
                               sq += (v[0] * v[0] + v[1] * v[1]) + (v[2] * v[2] + v[3] * v[3]); } }
                if constexpr (!OUT_F32 && SCALE != 2) { sq += __shfl_xor(sq, 16); sq += __shfl_xor(sq, 32); if (fq == 0) atomicAdd(ssq + row, (u64_t)(sq * SSQ_FIX)); }
            }
        }
    }
};
struct EpiWin {
    static constexpr bool PERM = true, AFTER_DRAIN = false;
    bf16_t* O; const float* cs; const float* sn; const u64_t* ssq;
    __device__ __forceinline__ void operator()(const f32x4 (&acc)[2][2][4][2], const Unit& u, int wr, int wc, int fr, int fq) const {
        const int row0 = u.pm * 256 + wr * 64 + fr, col0 = u.pn * 256 + wc * 32 + 8 * fq;
        const bool rot = u.pn < 8;
        float rsv[2][4];
#pragma unroll
        for (int ai = 0; ai < 2; ++ai)
#pragma unroll
            for (int m = 0; m < 4; ++m) rsv[ai][m] = (float)ssq[row0 + ai * 128 + m * 16] * SSQ_INV;
#pragma unroll
        for (int ai = 0; ai < 2; ++ai) {
            f32x4 cc[4][2], sv[4][2];
#pragma unroll
            for (int m = 0; m < 4; ++m) {
                if (rot) { const int pos = (row0 + ai * 128 + m * 16) & (SEQ - 1);
                    const float* cp = cs + pos * 128 + wc * 32 + 8 * fq; const float* sp = sn + pos * 128 + wc * 32 + 8 * fq;
                    cc[m][0] = *(const f32x4*)cp; cc[m][1] = *(const f32x4*)(cp + 4); sv[m][0] = *(const f32x4*)sp; sv[m][1] = *(const f32x4*)(sp + 4); }
                else { cc[m][0] = cc[m][1] = (f32x4){1.f, 1.f, 1.f, 1.f}; sv[m][0] = sv[m][1] = (f32x4){0.f, 0.f, 0.f, 0.f}; }
            }
#pragma unroll
            for (int m = 0; m < 4; ++m) {
                const int row = row0 + ai * 128 + m * 16;
                const float rs = __builtin_amdgcn_rsqf(rsv[ai][m] * (1.0f / DM) + EPS);
                const f32x4 a0 = acc[ai][0][m][0] * rs, a1 = acc[ai][0][m][1] * rs, b0 = acc[ai][1][m][0] * rs, b1 = acc[ai][1][m][1] * rs;
                const f32x4 na0 = a0 * cc[m][0] - b0 * sv[m][0], nb0 = b0 * cc[m][0] + a0 * sv[m][0], na1 = a1 * cc[m][1] - b1 * sv[m][1], nb1 = b1 * cc[m][1] + a1 * sv[m][1];
                bf16_t* rowp = O + (size_t)row * PW + col0;
                u32x4 w; w.x = cvt_pk_bf16(na0[0], na0[1]); w.y = cvt_pk_bf16(na0[2], na0[3]); w.z = cvt_pk_bf16(na1[0], na1[1]); w.w = cvt_pk_bf16(na1[2], na1[3]);
                *(u32x4*)rowp = w;
                u32x4 v; v.x = cvt_pk_bf16(nb0[0], nb0[1]); v.y = cvt_pk_bf16(nb0[2], nb0[3]); v.z = cvt_pk_bf16(nb1[0], nb1[1]); v.w = cvt_pk_bf16(nb1[2], nb1[3]);
                *(u32x4*)(rowp + 128) = v;
            }
        }
    }
};
struct EpiQkv {
    static constexpr bool PERM = false, AFTER_DRAIN = false;
    bf16_t* O; const float* cs; const float* sn; const u64_t* ssq;
    __device__ __forceinline__ void operator()(const f32x4 (&acc)[2][2][4][2], const Unit& u, int wr, int wc, int fr, int fq) const {
        const int col0 = u.pn * 256 + wc * 32 + 4 * fq;
        const bool rot = (u.pn < 16) && (wc == 0);
        const float sc0 = (u.pn < 8) ? QSCALE : 1.0f;
        float rsv[2][4]; f32x4 cv[2][4], sv[2][4];
#pragma unroll
        for (int ai = 0; ai < 2; ++ai)
#pragma unroll
            for (int m = 0; m < 4; ++m) { const int row = u.pm * 256 + ai * 128 + wr * 64 + m * 16 + fr; rsv[ai][m] = (float)ssq[row] * SSQ_INV;
                if (rot) { const int pos = row & (SEQ - 1); cv[ai][m] = *(const f32x4*)(cs + pos * 16 + 4 * fq); sv[ai][m] = *(const f32x4*)(sn + pos * 16 + 4 * fq); }
                else { cv[ai][m] = (f32x4){1.f, 1.f, 1.f, 1.f}; sv[ai][m] = (f32x4){0.f, 0.f, 0.f, 0.f}; } }
#pragma unroll
        for (int ai = 0; ai < 2; ++ai)
#pragma unroll
            for (int m = 0; m < 4; ++m) {
                const int row = u.pm * 256 + ai * 128 + wr * 64 + m * 16 + fr;
                const float sc = sc0 * __builtin_amdgcn_rsqf(rsv[ai][m] * (1.0f / DM) + EPS);
                const f32x4 c = cv[ai][m], s = sv[ai][m];
#pragma unroll
                for (int bj = 0; bj < 2; ++bj) {
                    const f32x4 x0 = acc[ai][bj][m][0], x1 = acc[ai][bj][m][1];
                    const f32x4 n0 = (x0 * c - x1 * s) * sc, n1 = (x1 * c + x0 * s) * sc;
                    bf16_t* p = O + (size_t)row * QW + col0 + bj * 128;
                    u32x2 w0; w0.x = cvt_pk_bf16(n0[0], n0[1]); w0.y = cvt_pk_bf16(n0[2], n0[3]); *(u32x2*)p = w0;
                    u32x2 w1; w1.x = cvt_pk_bf16(n1[0], n1[1]); w1.y = cvt_pk_bf16(n1[2], n1[3]); *(u32x2*)(p + 16) = w1;
                }
            }
    }
};
struct EpiGlu {
    static constexpr bool PERM = true, AFTER_DRAIN = false;
    const bf16_t* Z; const float* bias; bf16_t* Y;
    __device__ __forceinline__ void operator()(const f32x4 (&acc)[2][2][4][2], const Unit& u, int wr, int wc, int fr, int fq) const {
        const int row0 = u.pm * 256 + wr * 64 + fr, col0 = u.pn * 256 + wc * 32 + 8 * fq;
#pragma unroll
        for (int bj = 0; bj < 2; ++bj) {
            const f32x4 bv0 = *(const f32x4*)(bias + col0 + bj * 128), bv1 = *(const f32x4*)(bias + col0 + bj * 128 + 4);
            u32x4 zz[2][4];
#pragma unroll
            for (int ai = 0; ai < 2; ++ai)
#pragma unroll
                for (int m = 0; m < 4; ++m) zz[ai][m] = *(const u32x4*)(Z + (size_t)(row0 + ai * 128 + m * 16) * 1024 + col0 + bj * 128);
#pragma unroll
            for (int ai = 0; ai < 2; ++ai)
#pragma unroll
                for (int m = 0; m < 4; ++m) {
                    const int row = row0 + ai * 128 + m * 16;
                    const u32x4 z4 = zz[ai][m];
                    const f32x4 v0 = acc[ai][bj][m][0] + bv0, v1 = acc[ai][bj][m][1] + bv1;
                    u32x4 w;
                    w.x = cvt_pk_bf16(bflo(z4.x) * fast_sigmoid(v0[0]), bfhi(z4.x) * fast_sigmoid(v0[1]));
                    w.y = cvt_pk_bf16(bflo(z4.y) * fast_sigmoid(v0[2]), bfhi(z4.y) * fast_sigmoid(v0[3]));
                    w.z = cvt_pk_bf16(bflo(z4.z) * fast_sigmoid(v1[0]), bfhi(z4.z) * fast_sigmoid(v1[1]));
                    w.w = cvt_pk_bf16(bflo(z4.w) * fast_sigmoid(v1[2]), bfhi(z4.w) * fast_sigmoid(v1[3]));
                    *(u32x4*)(Y + (size_t)row * DM + 1024 + col0 + bj * 128) = w;
                }
        }
    }
};

template <class Epi>
__device__ __forceinline__ void run_gemm(LAS unsigned char* lds, const bf16_t* A, const bf16_t* Bt, int M, int N, int K, const Epi E) {
    pg8::Gemm g{A, Bt, M, N, K}; pg8::StaticOrder S; S.init(M, N, (int)gridDim.x, (int)blockIdx.x);
    pg8::gemm_phase<Epi, pg8::StaticOrder, true, true>(lds, g, S, E);
}

__device__ __forceinline__ void conv_matrix(const float* __restrict__ W, bf16_t* __restrict__ WT, int K, int N, int mode, const float* __restrict__ gain, LAS float* scr, int gw, int NGW, int lane) {
    const int nblk = N / 64, nitems = (K / 64) * nblk;
    for (int item = gw; item < nitems; item += NGW) {
        const int kb = item / nblk, nb = item % nblk, k0 = 64 * kb, n0 = 64 * nb;
        const float gv = gain ? gain[k0 + lane] : 1.0f;
        const float* wp = W + (size_t)k0 * N + n0 + lane;
#pragma unroll
        for (int i = 0; i < 64; ++i) { const float v = wp[(size_t)i * N];
            scr[i * 65 + lane] = v * __builtin_bit_cast(float, __builtin_amdgcn_readlane(__builtin_bit_cast(int, gv), i)); }
        asm volatile("s_waitcnt lgkmcnt(0)" ::: "memory");
        const int c = lane & 7, ns = lane >> 3;
        const int rbase = (mode == 0) ? n0 : ((n0 >> 7) * 256 + (n0 & 127) + (mode == 2 ? 128 : 0));
#pragma unroll
        for (int j = 0; j < 8; ++j) { const int n = ns + 8 * j; const LAS float* sp = scr + (8 * c) * 65 + n;
            u32x4 o; o.x = pk2(sp[0 * 65], sp[1 * 65]); o.y = pk2(sp[2 * 65], sp[3 * 65]); o.z = pk2(sp[4 * 65], sp[5 * 65]); o.w = pk2(sp[6 * 65], sp[7 * 65]);
            *(u32x4*)(WT + (size_t)(rbase + n) * K + k0 + 8 * c) = o; }
        asm volatile("s_waitcnt lgkmcnt(0)" ::: "memory");
    }
}

template <bool TO_BF16>
__device__ __forceinline__ void rmsnorm_phase(const float* in, const float* __restrict__ g, bf16_t* outb, float* outf, int gw, int NGW, int lane) {
    f32x4 gv[8];
#pragma unroll
    for (int j = 0; j < 8; ++j) gv[j] = ((const f32x4*)g)[lane + 64 * j];
    for (int row = gw; row < TT; row += NGW) {
        const f32x4* xr = (const f32x4*)(in + (size_t)row * DM) + lane;
        f32x4 v[8]; float ss = 0.f;
#pragma unroll
        for (int j = 0; j < 8; ++j) { v[j] = xr[64 * j]; ss += (v[j][0] * v[j][0] + v[j][1] * v[j][1]) + (v[j][2] * v[j][2] + v[j][3] * v[j][3]); }
        const float rs = 1.0f / sqrtf(wave_sum(ss) * (1.0f / DM) + EPS);
#pragma unroll
        for (int j = 0; j < 8; ++j) {
            const f32x4 y = v[j] * rs * gv[j];
            if constexpr (TO_BF16) { u32x2 w; w.x = pk2(y[0], y[1]); w.y = pk2(y[2], y[3]); *((u32x2*)(outb + (size_t)row * DM) + lane + 64 * j) = w; }
            else { *((f32x4*)(outf + (size_t)row * DM) + lane + 64 * j) = y; }
        }
    }
}

__device__ __forceinline__ void cast_phase(const float* in, bf16_t* outb, u64_t* ssq, int gw, int NGW, int lane) {
    for (int row = gw; row < TT; row += NGW) {
        const f32x4* xr = (const f32x4*)(in + (size_t)row * DM) + lane;
        f32x4 v[8]; float ss = 0.f;
#pragma unroll
        for (int j = 0; j < 8; ++j) { v[j] = xr[64 * j]; ss += (v[j][0] * v[j][0] + v[j][1] * v[j][1]) + (v[j][2] * v[j][2] + v[j][3] * v[j][3]); }
        ss = wave_sum(ss);
        if (lane == 0) ssq[row] = (u64_t)(ss * SSQ_FIX);
#pragma unroll
        for (int j = 0; j < 8; ++j) { u32x2 w; w.x = pk2(v[j][0], v[j][1]); w.y = pk2(v[j][2], v[j][3]); *((u32x2*)(outb + (size_t)row * DM) + lane + 64 * j) = w; }
    }
}

__device__ __forceinline__ void final_phase(const bf16_t* xb, const u64_t* ssq, const float* __restrict__ g, float* outf, int gw, int NGW, int lane) {
    f32x4 gv[4][2];
#pragma unroll
    for (int j = 0; j < 4; ++j) { gv[j][0] = *(const f32x4*)(g + 8 * (lane + 64 * j)); gv[j][1] = *(const f32x4*)(g + 8 * (lane + 64 * j) + 4); }
    for (int row = gw; row < TT; row += NGW) {
        const float rs = __builtin_amdgcn_rsqf((float)ssq[row] * SSQ_INV * (1.0f / DM) + EPS);
        const u32x4* xr = (const u32x4*)(xb + (size_t)row * DM) + lane;
        u32x4 v[4];
#pragma unroll
        for (int j = 0; j < 4; ++j) v[j] = xr[64 * j];
#pragma unroll
        for (int j = 0; j < 4; ++j) {
            float* op = outf + (size_t)row * DM + 8 * (lane + 64 * j);
            *(f32x4*)op = (f32x4){bflo(v[j].x), bfhi(v[j].x), bflo(v[j].y), bfhi(v[j].y)} * rs * gv[j][0];
            *(f32x4*)(op + 4) = (f32x4){bflo(v[j].z), bfhi(v[j].z), bflo(v[j].w), bfhi(v[j].w)} * rs * gv[j][1];
        }
    }
}

__device__ __forceinline__ void tables_phase(unsigned char* ws, const float* const* in_unused, const float* lam_re, const float* lam_im, const float* log_step, const float* b_re, const float* b_im,
                                             const float* lq1, const float* lk1, const float* lq2, const float* lk2, int gtid, int NT_) {
    float* rcos = (float*)(ws + WS_RCOS); float* rsin = (float*)(ws + WS_RSIN); float* acos_ = (float*)(ws + WS_ACOS); float* asin_ = (float*)(ws + WS_ASIN);
    float* s5a = (float*)(ws + WS_S5A); float* s5bb = (float*)(ws + WS_S5BB);
    for (int i = gtid; i < SEQ * 128; i += NT_) {
        const int pos = i >> 7, f = i & 127;
        const float inv = (float)exp2(-((double)(2 * f) / 256.0) * 13.287712379549449);
        const float ang = (float)pos * inv; double s, c; sincos_d((double)ang, s, c); rcos[i] = (float)c; rsin[i] = (float)s;
    }
    for (int i = gtid; i < SEQ * 16; i += NT_) {
        const int pos = i >> 4, f = i & 15;
        const float inv = (float)exp2(-((double)(2 * f) / 32.0) * 18.931568569324174);
        const float ang = (float)pos * inv; double s, c; sincos_d((double)ang, s, c); acos_[i] = (float)c; asin_[i] = (float)s;
    }
    for (int i = gtid; i < 64 * 64; i += NT_) {
        const int g = i >> 6;
        const double step = exp((double)log_step[g]), lr = (double)lam_re[i], li = (double)lam_im[i];
        const double mag = exp(lr * step); double s, c; sincos_d(li * step, s, c);
        const double are = mag * c, aim = mag * s, den = lr * lr + li * li, nr = are - 1.0;
        const double fre = (nr * lr + aim * li) / den, fim = (aim * lr - nr * li) / den;
        s5a[2 * i] = (float)are; s5a[2 * i + 1] = (float)aim;
        for (int p = 0; p < 16; ++p) { const double br = (double)b_re[i * 16 + p], bi = (double)b_im[i * 16 + p];
            s5bb[(size_t)i * 32 + p] = (float)(fre * br - fim * bi); s5bb[(size_t)i * 32 + 16 + p] = (float)(fre * bi + fim * br); }
    }
    if (gtid == 0) { float s1 = 0.f, s2 = 0.f; for (int i = 0; i < 128; ++i) { s1 += lq1[i] * lk1[i]; s2 += lq2[i] * lk2[i]; }
        ((float*)(ws + WS_CTL))[0] = expf(s1) - expf(s2) + LAMBDA_INIT; }
}

__device__ __forceinline__ void s5_phase(LAS unsigned char* lds, const unsigned char* ws, const bf16_t* proj, const float* c_re, const float* c_im, const float* dskip, bf16_t* z,
                                         int vcu, int G, int wave, int lane) {
    const float* s5a = (const float*)(ws + WS_S5A); const float* s5bb = (const float*)(ws + WS_S5BB);
    LAS bf16_t* Hc = (LAS bf16_t*)(lds + wave * 8704);
    const int fr = lane & 15, fq = lane >> 4;
    for (int seq = vcu * 8 + wave; seq < 1024; seq += G * 8) {
        const int b = seq >> 6, g = seq & 63, n = lane;
        float bbre[16], bbim[16];
#pragma unroll
        for (int p = 0; p < 16; ++p) { bbre[p] = s5bb[(size_t)(g * 64 + n) * 32 + p]; bbim[p] = s5bb[(size_t)(g * 64 + n) * 32 + 16 + p]; }
        const float are = s5a[2 * (g * 64 + n)], aim = s5a[2 * (g * 64 + n) + 1];
        bf16x8 cf[4];
#pragma unroll
        for (int ks = 0; ks < 4; ++ks) { u32x4 w; unsigned* wp = (unsigned*)&w;
#pragma unroll
            for (int j2 = 0; j2 < 4; ++j2) { float v[2];
#pragma unroll
                for (int e = 0; e < 2; ++e) { const int k = 32 * ks + 8 * fq + 2 * j2 + e; v[e] = (k < 64) ? c_re[(size_t)(g * 16 + fr) * 64 + k] : -c_im[(size_t)(g * 16 + fr) * 64 + (k - 64)]; }
                wp[j2] = pk2(v[0], v[1]); }
            cf[ks] = __builtin_bit_cast(bf16x8, w); }
        const float dsk = dskip[g * 16 + fr];
        float hre = 0.f, him = 0.f;
        for (int ch = 0; ch < SEQ / 32; ++ch) {
            const size_t row0 = (size_t)b * SEQ + ch * 32;
            const bf16_t* up = proj + (row0 + (lane & 31)) * PW + 4096 + g * 16;
            const u32x4 ua = *(const u32x4*)up, ub = *(const u32x4*)(up + 8);
            float uf[16];
            uf[0] = bflo(ua.x); uf[1] = bfhi(ua.x); uf[2] = bflo(ua.y); uf[3] = bfhi(ua.y); uf[4] = bflo(ua.z); uf[5] = bfhi(ua.z); uf[6] = bflo(ua.w); uf[7] = bfhi(ua.w);
            uf[8] = bflo(ub.x); uf[9] = bfhi(ub.x); uf[10] = bflo(ub.y); uf[11] = bfhi(ub.y); uf[12] = bflo(ub.z); uf[13] = bfhi(ub.z); uf[14] = bflo(ub.w); uf[15] = bfhi(ub.w);
#pragma unroll
            for (int k = 0; k < 32; ++k) {
                f32x2 xx = (f32x2){0.f, 0.f};
#pragma unroll
                for (int p = 0; p < 16; ++p) { const float su = __builtin_bit_cast(float, __builtin_amdgcn_readlane(__builtin_bit_cast(int, uf[p]), k));
                    xx = __builtin_elementwise_fma((f32x2){su, su}, (f32x2){bbre[p], bbim[p]}, xx); }
                const float nr = are * hre - aim * him + xx[0], ni = are * him + aim * hre + xx[1]; hre = nr; him = ni;
                Hc[k * 136 + n] = (bf16_t)f2bf(hre); Hc[k * 136 + 64 + n] = (bf16_t)f2bf(him);
            }
#pragma unroll
            for (int sb = 0; sb < 2; ++sb) {
                f32x4 y = (f32x4){0.f, 0.f, 0.f, 0.f};
#pragma unroll
                for (int ks = 0; ks < 4; ++ks) { const bf16x8 hf = *(const LAS bf16x8*)(Hc + (16 * sb + fr) * 136 + 32 * ks + 8 * fq); y = __builtin_amdgcn_mfma_f32_16x16x32_bf16(hf, cf[ks], y, 0, 0, 0); }
#pragma unroll
                for (int i = 0; i < 4; ++i) { const size_t row = row0 + 16 * sb + 4 * fq + i;
                    const float uu = bf2f(proj[row * PW + 4096 + g * 16 + fr]); const float yy = y[i] + dsk * uu;
                    z[row * 1024 + g * 16 + fr] = (bf16_t)f2bf(gelu_tanh_f(yy)); }
            }
        }
    }
}

#define MF32(a, b, c) __builtin_amdgcn_mfma_f32_32x32x16_bf16((a), (b), (c), 0, 0, 0)
#define AT_WAITV(n) asm volatile("s_waitcnt vmcnt(" #n ")" ::: "memory")
#define AT_BAR() asm volatile("s_waitcnt lgkmcnt(0)\n\ts_barrier" ::: "memory")
__device__ __forceinline__ s16x4 vtr(const LAS unsigned char* p) { typedef short v4i16_t __attribute__((ext_vector_type(4))); return __builtin_bit_cast(s16x4, __builtin_amdgcn_ds_read_tr16_b64_v4i16((LAS v4i16_t*)p)); }
__device__ __forceinline__ int crow(int i, int h) { return (i & 3) + 8 * (i >> 2) + 4 * h; }

template <int MODE>
__device__ __forceinline__ void attn_unit(LAS unsigned char* lds, const bf16_t* src, const int pitch, const int kcol, const int vcol, const int b, const int h, const int ub,
                                          bf16_t* outp, const bf16_t* gsrc, const float* subln, const float lam) {
    constexpr int NKS = MODE ? 8 : 16, NDB = 4, ROWS = MODE ? 64 : 128;
    const int tid = threadIdx.x, lane = tid & 63, r = lane & 31, hh = lane >> 5;
    const int wid = __builtin_amdgcn_readfirstlane(tid >> 6);
    const int rg = MODE ? (wid & 1) : (wid & 3), vh = MODE ? ((wid >> 1) & 1) : (wid >> 2), cc = MODE ? (wid >> 2) : 0;
    const size_t rowbase = (size_t)b * SEQ; const int q0 = ub * ROWS, NT = MODE ? (ub + 1) : (2 * ub + 2);
    const int qrow = q0 + rg * 32 + r;
    AT_WAITV(0);
#define AT_ISSUE(t, buf) do { const bf16_t* gk_ = src + (rowbase + (size_t)(t) * 64) * pitch; int rv_ = r; asm volatile("" : "+v"(rv_)); \
        _Pragma("unroll") for (int i_ = 0; i_ < 4; ++i_) { const int c_ = wid * 4 + i_; const int row_ = c_ * 2 + hh; \
            const unsigned ok_ = (unsigned)(row_ * pitch + kcol + ((rv_ ^ (row_ & 15)) << 3)); \
            __builtin_amdgcn_global_load_lds((const unsigned*)(gk_ + ok_), (LAS unsigned*)(lds + (buf) * 65536 + c_ * 1024), 16, 0, 0); \
            const unsigned ov_ = (unsigned)(row_ * pitch + vcol + ((rv_ ^ ((row_ & 3) << 2)) << 3)); \
            __builtin_amdgcn_global_load_lds((const unsigned*)(gk_ + ov_), (LAS unsigned*)(lds + (buf) * 65536 + 32768 + c_ * 1024), 16, 0, 0); } } while (0)
    AT_ISSUE(0, 0);
    bf16x8 qf[NKS];
    { const bf16_t* qp = src + (rowbase + qrow) * pitch + h * 256 + cc * 128 + 8 * hh;
#pragma unroll
      for (int d0 = 0; d0 < NKS; ++d0) qf[d0] = *(const bf16x8*)(qp + 16 * d0); }
    f32x16 O[NDB];
#pragma unroll
    for (int db = 0; db < NDB; ++db)
#pragma unroll
        for (int i = 0; i < 16; ++i) O[db][i] = 0.f;
    float mrun = 0.f, lrun = 0.f;
    const float lgam = __builtin_log2f(1.0f - __builtin_amdgcn_exp2f(-5.0f - (float)h));
    const int r15 = r & 15;
    const int kunit0 = cc * 16;
    const int q4 = (lane & 15) >> 2, p4 = lane & 3, blk16 = (lane >> 4) & 1;
    const int vlane = (4 * hh + q4) * 512 + ((2 * blk16 + (p4 >> 1)) << 4) + 8 * (p4 & 1);
    for (int t = 0; t < NT; ++t) {
        if (t + 1 < NT) { AT_ISSUE(t + 1, (t + 1) & 1); AT_WAITV(8); } else { AT_WAITV(0); }
        AT_BAR();
        const bool active = MODE ? true : !(t == NT - 1 && rg < 2);
        if (active) {
            const LAS unsigned char* Kb = lds + (t & 1) * 65536; const LAS unsigned char* Vb = Kb + 32768;
            int r15v = r15 ^ hh ^ kunit0, q4v = q4 << 2; asm volatile("" : "+v"(r15v), "+v"(q4v));
            bf16x8 pf[4];
            if constexpr (MODE) {
                f32x16 p0, p1;
#pragma unroll
                for (int i = 0; i < 16; ++i) { p0[i] = -mrun; p1[i] = -mrun; }
                { const LAS unsigned char* kr0 = Kb + r * 512; const LAS unsigned char* kr1 = Kb + (32 + r) * 512;
#pragma unroll
                  for (int d0 = 0; d0 < NKS; ++d0) { const int uo = ((2 * d0) ^ r15v) << 4;
                      const bf16x8 k0 = *(const LAS bf16x8*)(kr0 + uo); const bf16x8 k1 = *(const LAS bf16x8*)(kr1 + uo);
                      p0 = MF32(k0, qf[d0], p0); p1 = MF32(k1, qf[d0], p1);
                      if ((d0 & 3) == 3) __builtin_amdgcn_sched_barrier(0); } }
                float rm = p0[0];
#pragma unroll
                for (int i = 0; i < 16; ++i) { rm = fmaxf(rm, p0[i]); rm = fmaxf(rm, p1[i]); }
                rm = fmaxf(rm, __shfl_xor(rm, 32));
                if (t == 0 || __any(rm > 8.0f)) {
                    const float dl = (t == 0) ? rm : fmaxf(rm, 0.f); const float al = (t == 0) ? 1.0f : __builtin_amdgcn_exp2f(-dl); lrun *= al; mrun += dl;
#pragma unroll
                    for (int i = 0; i < 16; ++i) { p0[i] -= dl; p1[i] -= dl; }
#pragma unroll
                    for (int db = 0; db < NDB; ++db) O[db] = O[db] * al;
                }
                float sum = 0.f;
#pragma unroll
                for (int i = 0; i < 16; ++i) { p0[i] = __builtin_amdgcn_exp2f(p0[i]); p1[i] = __builtin_amdgcn_exp2f(p1[i]); sum += p0[i] + p1[i]; }
                lrun += sum;
                u32x4 w;
                w.x = cvt_pk_bf16(p0[0], p0[1]); w.y = cvt_pk_bf16(p0[2], p0[3]); w.z = cvt_pk_bf16(p0[4], p0[5]); w.w = cvt_pk_bf16(p0[6], p0[7]); pf[0] = __builtin_bit_cast(bf16x8, w);
                w.x = cvt_pk_bf16(p0[8], p0[9]); w.y = cvt_pk_bf16(p0[10], p0[11]); w.z = cvt_pk_bf16(p0[12], p0[13]); w.w = cvt_pk_bf16(p0[14], p0[15]); pf[1] = __builtin_bit_cast(bf16x8, w);
                w.x = cvt_pk_bf16(p1[0], p1[1]); w.y = cvt_pk_bf16(p1[2], p1[3]); w.z = cvt_pk_bf16(p1[4], p1[5]); w.w = cvt_pk_bf16(p1[6], p1[7]); pf[2] = __builtin_bit_cast(bf16x8, w);
                w.x = cvt_pk_bf16(p1[8], p1[9]); w.y = cvt_pk_bf16(p1[10], p1[11]); w.z = cvt_pk_bf16(p1[12], p1[13]); w.w = cvt_pk_bf16(p1[14], p1[15]); pf[3] = __builtin_bit_cast(bf16x8, w);
            } else {
#pragma unroll
                for (int blk = 0; blk < 2; ++blk) {
                    f32x16 p;
#pragma unroll
                    for (int i = 0; i < 16; ++i) p[i] = 0.f;
                    const LAS unsigned char* kr = Kb + (32 * blk + r) * 512;
#pragma unroll
                    for (int d0 = 0; d0 < NKS; ++d0) { const int uo = ((2 * d0) ^ r15v) << 4;
                        const bf16x8 k0 = *(const LAS bf16x8*)(kr + uo); p = MF32(k0, qf[d0], p);
                        if ((d0 & 3) == 3) __builtin_amdgcn_sched_barrier(0); }
                    const int kb = t * 64 + 32 * blk + 4 * hh;
#pragma unroll
                    for (int i = 0; i < 16; ++i) { const int kv = kb + (i & 3) + 8 * (i >> 2);
                        p[i] *= __builtin_amdgcn_exp2f(lgam * fabsf((float)(qrow - kv)) - 4.0f); }
                    u32x4 w;
                    w.x = cvt_pk_bf16(p[0], p[1]); w.y = cvt_pk_bf16(p[2], p[3]); w.z = cvt_pk_bf16(p[4], p[5]); w.w = cvt_pk_bf16(p[6], p[7]); pf[2 * blk] = __builtin_bit_cast(bf16x8, w);
                    w.x = cvt_pk_bf16(p[8], p[9]); w.y = cvt_pk_bf16(p[10], p[11]); w.z = cvt_pk_bf16(p[12], p[13]); w.w = cvt_pk_bf16(p[14], p[15]); pf[2 * blk + 1] = __builtin_bit_cast(bf16x8, w);
                    __builtin_amdgcn_sched_barrier(0);
                }
            }
            const LAS unsigned char* vb = Vb + vlane;
            __builtin_amdgcn_sched_barrier(0);
#pragma unroll
            for (int db = 0; db < NDB; ++db) {
                const int dunit = vh * 16 + 4 * db;
                const LAS unsigned char* vp = vb + ((dunit ^ q4v) << 4);
#pragma unroll
                for (int ks = 0; ks < 4; ++ks) {
                    const int kvb = 32 * (ks >> 1) + 16 * (ks & 1);
                    const s16x4 lo = vtr(vp + kvb * 512), hi = vtr(vp + (kvb + 8) * 512);
                    const bf16x8 vf = __builtin_shufflevector(lo, hi, 0, 1, 2, 3, 4, 5, 6, 7);
                    O[db] = MF32(vf, pf[ks], O[db]);
                }
                __builtin_amdgcn_sched_barrier(0);
            }
        }
        AT_BAR();
    }
    const size_t orow = rowbase + qrow;
    LAS float* SS = (LAS float*)(lds + 131072);
    if constexpr (MODE) {
        const float l = lrun + __shfl_xor(lrun, 32); const float inv = 1.0f / l;
        LAS float* X = (LAS float*)(lds + (wid & 3) * 16384);
        if (cc == 1) {
#pragma unroll
            for (int db = 0; db < NDB; ++db)
#pragma unroll
                for (int i = 0; i < 16; ++i) X[(db * 16 + i) * 64 + lane] = O[db][i] * inv;
        }
        AT_BAR();
        float ss = 0.f;
        if (cc == 0) {
#pragma unroll
            for (int db = 0; db < NDB; ++db)
#pragma unroll
                for (int i = 0; i < 16; ++i) { const float o = O[db][i] * inv - lam * X[(db * 16 + i) * 64 + lane]; O[db][i] = o; ss += o * o; }
        }
        ss += __shfl_xor(ss, 32);
        if (hh == 0) SS[wid * 32 + r] = ss;
        AT_BAR();
        if (cc == 0) {
            ss += SS[(wid ^ 2) * 32 + r];
            const float rs = (1.0f - LAMBDA_INIT) / sqrtf(ss * (1.0f / 256.0f) + EPS);
            bf16_t* op = outp + orow * DM + h * 256 + vh * 128 + 4 * hh;
            const float* slp = subln + vh * 128 + 4 * hh;
#pragma unroll
            for (int db = 0; db < NDB; ++db)
#pragma unroll
                for (int i4 = 0; i4 < 4; ++i4) { const int d = 32 * db + 8 * i4;
                    const f32x4 sl = *(const f32x4*)(slp + d);
                    u32x2 w; w.x = cvt_pk_bf16(O[db][4 * i4] * rs * sl[0], O[db][4 * i4 + 1] * rs * sl[1]); w.y = cvt_pk_bf16(O[db][4 * i4 + 2] * rs * sl[2], O[db][4 * i4 + 3] * rs * sl[3]);
                    *(u32x2*)(op + d) = w; }
        }
        AT_BAR();
    } else {
        float ss = 0.f;
#pragma unroll
        for (int db = 0; db < NDB; ++db)
#pragma unroll
            for (int i = 0; i < 16; ++i) ss += O[db][i] * O[db][i];
        ss += __shfl_xor(ss, 32);
        if (hh == 0) SS[wid * 32 + r] = ss;
        AT_BAR();
        ss += SS[(wid ^ 4) * 32 + r];
        const float rs = 1.0f / sqrtf(ss * (1.0f / 256.0f) + EPS);
        const bf16_t* gp = gsrc + orow * PW + 3072 + h * 256 + vh * 128 + 4 * hh;
        bf16_t* op = outp + orow * DM + h * 256 + vh * 128 + 4 * hh;
#pragma unroll
        for (int db = 0; db < NDB; ++db)
#pragma unroll
            for (int i4 = 0; i4 < 4; ++i4) { const int d = 32 * db + 8 * i4;
                const u32x2 gg = *(const u32x2*)(gp + d);
                u32x2 w; w.x = cvt_pk_bf16(O[db][4 * i4] * rs * silu_f(bflo(gg.x)), O[db][4 * i4 + 1] * rs * silu_f(bfhi(gg.x)));
                w.y = cvt_pk_bf16(O[db][4 * i4 + 2] * rs * silu_f(bflo(gg.y)), O[db][4 * i4 + 3] * rs * silu_f(bfhi(gg.y)));
                *(u32x2*)(op + d) = w; }
        AT_BAR();
    }
#undef AT_ISSUE
}

__device__ __forceinline__ void attn_unit_diff128(LAS unsigned char* lds, const bf16_t* src, const int pitch, const int kcol, const int vcol, const int b, const int h, const int ub,
                                                  bf16_t* outp, const float* subln, const float lam) {
    constexpr int NKS = 8, NDB = 8;
    const int tid = threadIdx.x, lane = tid & 63, r = lane & 31, hh = lane >> 5;
    const int wid = __builtin_amdgcn_readfirstlane(tid >> 6);
    const int rg = wid & 3, cc = wid >> 2;
    const size_t rowbase = (size_t)b * SEQ; const int q0 = ub * 128, NT = 2 * ub + 2;
    const int qrow = q0 + rg * 32 + r;
    AT_WAITV(0);
#define AT_ISSUE(t, buf) do { const bf16_t* gk_ = src + (rowbase + (size_t)(t) * 64) * pitch; int rv_ = r; asm volatile("" : "+v"(rv_)); \
        _Pragma("unroll") for (int i_ = 0; i_ < 4; ++i_) { const int c_ = wid * 4 + i_; const int row_ = c_ * 2 + hh; \
            const unsigned ok_ = (unsigned)(row_ * pitch + kcol + ((rv_ ^ (row_ & 15)) << 3)); \
            __builtin_amdgcn_global_load_lds((const unsigned*)(gk_ + ok_), (LAS unsigned*)(lds + (buf) * 65536 + c_ * 1024), 16, 0, 0); \
            const unsigned ov_ = (unsigned)(row_ * pitch + vcol + ((rv_ ^ ((row_ & 3) << 2)) << 3)); \
            __builtin_amdgcn_global_load_lds((const unsigned*)(gk_ + ov_), (LAS unsigned*)(lds + (buf) * 65536 + 32768 + c_ * 1024), 16, 0, 0); } } while (0)
    AT_ISSUE(0, 0);
    bf16x8 qf[NKS];
    { const bf16_t* qp = src + (rowbase + qrow) * pitch + h * 256 + cc * 128 + 8 * hh;
#pragma unroll
      for (int d0 = 0; d0 < NKS; ++d0) qf[d0] = *(const bf16x8*)(qp + 16 * d0); }
    f32x16 O[NDB];
#pragma unroll
    for (int db = 0; db < NDB; ++db)
#pragma unroll
        for (int i = 0; i < 16; ++i) O[db][i] = 0.f;
    float mrun = 0.f, lrun = 0.f;
    const int r15 = r & 15, kunit0 = cc * 16;
    const int q4 = (lane & 15) >> 2, p4 = lane & 3, blk16 = (lane >> 4) & 1;
    const int vlane = (4 * hh + q4) * 512 + ((2 * blk16 + (p4 >> 1)) << 4) + 8 * (p4 & 1);
    for (int t = 0; t < NT; ++t) {
        if (t + 1 < NT) { AT_ISSUE(t + 1, (t + 1) & 1); AT_WAITV(8); } else { AT_WAITV(0); }
        AT_BAR();
        const bool active = !(t == NT - 1 && rg < 2);
        if (active) {
            const LAS unsigned char* Kb = lds + (t & 1) * 65536; const LAS unsigned char* Vb = Kb + 32768;
            int r15v = r15 ^ hh ^ kunit0, q4v = q4 << 2; asm volatile("" : "+v"(r15v), "+v"(q4v));
            const LAS unsigned char* vb = Vb + vlane;
#pragma unroll
            for (int blk = 0; blk < 2; ++blk) {
                f32x16 p;
#pragma unroll
                for (int i = 0; i < 16; ++i) p[i] = -mrun;
                const LAS unsigned char* kr = Kb + (32 * blk + r) * 512;
#pragma unroll
                for (int d0 = 0; d0 < NKS; ++d0) { const int uo = ((2 * d0) ^ r15v) << 4;
                    const bf16x8 k0 = *(const LAS bf16x8*)(kr + uo); p = MF32(k0, qf[d0], p);
                    if ((d0 & 3) == 3) __builtin_amdgcn_sched_barrier(0); }
                float rm = p[0];
#pragma unroll
                for (int i = 1; i < 16; ++i) rm = fmaxf(rm, p[i]);
                rm = fmaxf(rm, __shfl_xor(rm, 32));
                const bool first = (t == 0) && (blk == 0);
                if (first || __any(rm > 8.0f)) {
                    const float dl = first ? rm : fmaxf(rm, 0.f); const float al = first ? 1.0f : __builtin_amdgcn_exp2f(-dl); lrun *= al; mrun += dl;
#pragma unroll
                    for (int i = 0; i < 16; ++i) p[i] -= dl;
#pragma unroll
                    for (int db = 0; db < NDB; ++db) O[db] = O[db] * al;
                }
                float sum = 0.f;
#pragma unroll
                for (int i = 0; i < 16; ++i) { p[i] = __builtin_amdgcn_exp2f(p[i]); sum += p[i]; }
                lrun += sum;
                bf16x8 pf[2];
                { u32x4 w;
                  w.x = cvt_pk_bf16(p[0], p[1]); w.y = cvt_pk_bf16(p[2], p[3]); w.z = cvt_pk_bf16(p[4], p[5]); w.w = cvt_pk_bf16(p[6], p[7]); pf[0] = __builtin_bit_cast(bf16x8, w);
                  w.x = cvt_pk_bf16(p[8], p[9]); w.y = cvt_pk_bf16(p[10], p[11]); w.z = cvt_pk_bf16(p[12], p[13]); w.w = cvt_pk_bf16(p[14], p[15]); pf[1] = __builtin_bit_cast(bf16x8, w); }
                __builtin_amdgcn_sched_barrier(0);
#pragma unroll
                for (int db = 0; db < NDB; ++db) {
                    const LAS unsigned char* vp = vb + (((4 * db) ^ q4v) << 4);
#pragma unroll
                    for (int ks = 0; ks < 2; ++ks) {
                        const int kvb = 32 * blk + 16 * ks;
                        const s16x4 lo = vtr(vp + kvb * 512), hi = vtr(vp + (kvb + 8) * 512);
                        const bf16x8 vf = __builtin_shufflevector(lo, hi, 0, 1, 2, 3, 4, 5, 6, 7);
                        O[db] = MF32(vf, pf[ks], O[db]);
                    }
                    if (db & 1) __builtin_amdgcn_sched_barrier(0);
                }
            }
        }
        AT_BAR();
    }
    const size_t orow = rowbase + qrow;
    const float l = lrun + __shfl_xor(lrun, 32); const float inv = 1.0f / l;
    LAS float* X = (LAS float*)(lds + rg * 32768);
    if (cc == 1) {
#pragma unroll
        for (int db = 0; db < NDB; ++db)
#pragma unroll
            for (int i = 0; i < 16; ++i) X[(db * 16 + i) * 64 + lane] = O[db][i] * inv;
    }
    AT_BAR();
    if (cc == 0) {
        float ss = 0.f;
#pragma unroll
        for (int db = 0; db < NDB; ++db)
#pragma unroll
            for (int i = 0; i < 16; ++i) { const float o = O[db][i] * inv - lam * X[(db * 16 + i) * 64 + lane]; O[db][i] = o; ss += o * o; }
        ss += __shfl_xor(ss, 32);
        const float rs = (1.0f - LAMBDA_INIT) / sqrtf(ss * (1.0f / 256.0f) + EPS);
        bf16_t* op = outp + orow * DM + h * 256 + 4 * hh;
        const float* slp = subln + 4 * hh;
#pragma unroll
        for (int db = 0; db < NDB; ++db)
#pragma unroll
            for (int i4 = 0; i4 < 4; ++i4) { const int d = 32 * db + 8 * i4;
                const f32x4 sl = *(const f32x4*)(slp + d);
                u32x2 w; w.x = cvt_pk_bf16(O[db][4 * i4] * rs * sl[0], O[db][4 * i4 + 1] * rs * sl[1]); w.y = cvt_pk_bf16(O[db][4 * i4 + 2] * rs * sl[2], O[db][4 * i4 + 3] * rs * sl[3]);
                *(u32x2*)(op + d) = w; }
    }
    AT_BAR();
#undef AT_ISSUE
}

template <int MODE>
__device__ __forceinline__ void attn_phase(LAS unsigned char* lds, const bf16_t* src, int pitch, int kcol0, int vcol0, int nheads, bf16_t* outp, const bf16_t* gsrc, const float* subln, float lam, int vcu, int G) {
    constexpr int NU = 16;
    const int npairs = 16 * nheads * (NU / 2);
    for (int pr = vcu; pr < npairs; pr += G) {
        const int bh = pr / (NU / 2), p = pr % (NU / 2), b = bh / nheads, h = bh % nheads;
        if constexpr (MODE) {
            attn_unit_diff128(lds, src, pitch, kcol0 + h * 256, vcol0 + h * 256, b, h, NU - 1 - p, outp, subln, lam);
            attn_unit_diff128(lds, src, pitch, kcol0 + h * 256, vcol0 + h * 256, b, h, p, outp, subln, lam);
        } else {
            attn_unit<0>(lds, src, pitch, kcol0 + h * 256, vcol0 + h * 256, b, h, NU - 1 - p, outp, gsrc, subln, lam);
            attn_unit<0>(lds, src, pitch, kcol0 + h * 256, vcol0 + h * 256, b, h, p, outp, gsrc, subln, lam);
        }
    }
}

#define XB_TMO      128
#define XB_XCNT(j)  (256  + 64 * (j))
#define XB_XSUB(j)  (1280 + 64 * (j))
#define XB_XGEN(j)  (2304 + 64 * (j))
#define XB_TOP      3328
#define XB_TOPGEN   3392
#define XCD_BAR_WORDS 3456
#define XB_SPIN_CAP (1u << 18)
__device__ __forceinline__ unsigned xb_ld(unsigned* p)              { return __hip_atomic_load(p, __ATOMIC_RELAXED, __HIP_MEMORY_SCOPE_AGENT); }
__device__ __forceinline__ unsigned xb_add(unsigned* p, unsigned v) { return __hip_atomic_fetch_add(p, v, __ATOMIC_RELAXED, __HIP_MEMORY_SCOPE_AGENT); }
__device__ __forceinline__ unsigned xb_xcc_id() { return (unsigned)__builtin_amdgcn_s_getreg((3 << 11) | 20) & 0xFu; }
#define XB_SPIN(cond, bar) do { unsigned _sp = 0; while (cond) { __builtin_amdgcn_s_sleep(1); \
    if ((++_sp & 255u) == 0u) { if (xb_ld(&(bar)[XB_TMO])) break; if (_sp > XB_SPIN_CAP) { atomicAdd(&(bar)[XB_TMO], 1u); break; } } } } while (0)
struct XcdBarrier { unsigned* bar; unsigned x; volatile LAS unsigned* st; };
__device__ __forceinline__ XcdBarrier xcd_barrier_post(unsigned* bar, volatile LAS unsigned* st) {
    XcdBarrier b; b.bar = bar; b.x = xb_xcc_id(); b.st = st;
    if (threadIdx.x == 0) (void)xb_add(&bar[XB_XCNT(b.x)], 1u);
    return b;
}
__device__ __forceinline__ void xcd_barrier_complete(unsigned* bar, unsigned x, unsigned& nloc, unsigned& nx) {
    const unsigned G = gridDim.x * gridDim.y * gridDim.z;
    unsigned sum, cnt, mine, sp = 0u;
    for (;;) {
        sum = 0u; cnt = 0u; mine = 0u;
#pragma unroll
        for (unsigned j = 0; j < 16; ++j) { const unsigned c = xb_ld(&bar[XB_XCNT(j)]); sum += c; cnt += (c > 0u) ? 1u : 0u; mine = (j == x) ? c : mine; }
        if (sum == G) break;
        __builtin_amdgcn_s_sleep(1);
        if ((++sp & 255u) == 0u) { if (xb_ld(&bar[XB_TMO])) break; if (sp > XB_SPIN_CAP) { atomicAdd(&bar[XB_TMO], 1u); break; } }
    }
    nloc = mine > 0u ? mine : 1u; nx = cnt > 0u ? cnt : 1u;
}
__device__ __forceinline__ void xcd_barrier(const XcdBarrier& b) {
    asm volatile("s_waitcnt vmcnt(0)" ::: "memory");
    __syncthreads();
    if (threadIdx.x == 0) {
        unsigned* bar = b.bar;
        __builtin_amdgcn_s_waitcnt(0);
        unsigned nloc = b.st[0], nx = b.st[1];
        if (nloc == 0u) { xcd_barrier_complete(bar, b.x, nloc, nx); b.st[0] = nloc; b.st[1] = nx; }
        const unsigned old = xb_add(&bar[XB_XSUB(b.x)], 1u);
        const unsigned gen = old / nloc;
        if (old + 1u == (gen + 1u) * nloc) {
            __builtin_amdgcn_fence(__ATOMIC_RELEASE, "agent");
            asm volatile("s_waitcnt vmcnt(0)" ::: "memory");
            const unsigned og = xb_add(&bar[XB_TOP], 1u);
            const unsigned tg = og / nx;
            if (og + 1u == (tg + 1u) * nx) xb_add(&bar[XB_TOPGEN], 1u);
            else XB_SPIN(xb_ld(&bar[XB_TOPGEN]) == tg, bar);
            __builtin_amdgcn_fence(__ATOMIC_ACQUIRE, "agent");
            xb_add(&bar[XB_XGEN(b.x)], 1u);
            asm volatile("s_waitcnt vmcnt(0)" ::: "memory");
        } else {
            XB_SPIN(xb_ld(&bar[XB_XGEN(b.x)]) == gen, bar);
            __builtin_amdgcn_fence(__ATOMIC_ACQUIRE, "agent");
            asm volatile("s_waitcnt vmcnt(0)" ::: "memory");
        }
    }
    __syncthreads();
}

struct Params { const float* in[26]; float* out; unsigned char* ws; int lo, hi; };
constexpr int NPHASE = 17;

__global__ void __launch_bounds__(512) fwd_megakernel(Params P) {
    extern __shared__ __attribute__((aligned(16))) unsigned char lds_raw[];
    LAS unsigned char* lds = (LAS unsigned char*)lds_raw;
    const int tid = threadIdx.x, lane = tid & 63, wave = __builtin_amdgcn_readfirstlane(tid >> 6);
    const int G = gridDim.x, bx = blockIdx.x;
    const int vcu = (G % 8 == 0) ? (bx % 8) * (G / 8) + bx / 8 : bx;
    const int gw = vcu * 8 + wave, NGW = G * 8;
    unsigned char* ws = P.ws;
    float* out = P.out;
    bf16_t* Wgu = (bf16_t*)(ws + WS_WGU); bf16_t* Wd = (bf16_t*)(ws + WS_WD); bf16_t* Win = (bf16_t*)(ws + WS_WIN); bf16_t* Wout = (bf16_t*)(ws + WS_WOUT);
    bf16_t* Wglu = (bf16_t*)(ws + WS_WGLU); bf16_t* Wqkv = (bf16_t*)(ws + WS_WQKV); bf16_t* Wco = (bf16_t*)(ws + WS_WCO);
    bf16_t* XN = (bf16_t*)(ws + WS_XN); bf16_t* BIG = (bf16_t*)(ws + WS_BIG); bf16_t* ZB = (bf16_t*)(ws + WS_Z);
    const float* x = P.in[0]; const float* ffn_norm = P.in[1]; const float* mix_norm = P.in[5];
#if MK_PER_PHASE
#define SYNC(k) do { } while (0)
#else
    cg::grid_group grid = cg::this_grid();
    { volatile LAS unsigned* st0 = (volatile LAS unsigned*)(lds + 139264); if (tid < 2) st0[tid] = 0u; }
    __syncthreads();
    const XcdBarrier xbar = xcd_barrier_post((unsigned*)(ws + WS_BAR), (volatile LAS unsigned*)(lds + 139264));
#define SYNC(k) do { if (P.lo <= (k) && (k) + 1 < P.hi) { if ((k) == 0) grid.sync(); else xcd_barrier(xbar); } } while (0)
#endif
#ifndef DUPMASK
#define DUPMASK 0u
#endif
#define IN(k) (P.lo <= (k) && (k) < P.hi)
#define REP(k) for (int rep_ = 0; rep_ < (((DUPMASK >> (k)) & 1u) ? 2 : 1); ++rep_)

    u64_t* SSQ = (u64_t*)(ws + WS_SSQ);
    bf16_t* YC = (bf16_t*)(ws + WS_YC);
    const float* rcos = (const float*)(ws + WS_RCOS); const float* rsin = (const float*)(ws + WS_RSIN);
    const float* acos_ = (const float*)(ws + WS_ACOS); const float* asin_ = (const float*)(ws + WS_ASIN);
    if (IN(0)) REP(0) {
        LAS float* scr = (LAS float*)(lds + wave * 16640);
        const size_t gsz = (size_t)DM * DFF;
#pragma unroll 1
        for (int i = 0; i < 4; ++i) {
            conv_matrix(P.in[2] + i * gsz, Wgu + (size_t)i * NGU * DM, DM, DFF, 1, ffn_norm + i * DM, scr, gw, NGW, lane);
            conv_matrix(P.in[3] + i * gsz, Wgu + (size_t)i * NGU * DM, DM, DFF, 2, ffn_norm + i * DM, scr, gw, NGW, lane);
            conv_matrix(P.in[4] + i * gsz, Wd + (size_t)i * DM * DFF, DFF, DM, 0, nullptr, scr, gw, NGW, lane);
        }
        conv_matrix(P.in[6], Win, DM, PW, 0, mix_norm, scr, gw, NGW, lane);
        conv_matrix(P.in[7], Wout, DM, DM, 0, nullptr, scr, gw, NGW, lane);
        conv_matrix(P.in[16], Wglu, 1024, 1024, 0, nullptr, scr, gw, NGW, lane);
        conv_matrix(P.in[18], Wqkv, DM, QW, 0, mix_norm + DM, scr, gw, NGW, lane);
        conv_matrix(P.in[19], Wco, DM, DM, 0, nullptr, scr, gw, NGW, lane);
        tables_phase(ws, nullptr, P.in[8], P.in[9], P.in[10], P.in[11], P.in[12], P.in[20], P.in[21], P.in[22], P.in[23], vcu * 512 + tid, G * 512);
        for (int i = vcu * 512 + tid; i < 6 * TT; i += G * 512) SSQ[TT + i] = 0ull;
        cast_phase(x, XN, SSQ, gw, NGW, lane);
    }
    SYNC(0);
#if !MK_PER_PHASE
    if ((DUPMASK >> 20) & 1u) { for (int q_ = 0; q_ < 32; ++q_) grid.sync(); }
#endif
    if (IN(1)) { run_gemm(lds, XN, Wgu, TT, NGU, DM, EpiSwiglu{BIG, DFF, SSQ}); if ((DUPMASK >> 1) & 1u) { run_gemm(lds, XN, Wgu, TT, NGU, DM, EpiSwiglu{BIG, DFF, SSQ}); } }
    SYNC(1);
    if (IN(2)) run_gemm(lds, BIG, Wd, TT, DM, DFF, EpiResid<true, false, 1>{x, nullptr, XN, SSQ + 1 * TT});
    if (IN(2) && ((DUPMASK >> 2) & 1u)) run_gemm(lds, BIG, Wd, TT, DM, DFF, EpiResid<false, false, 2>{nullptr, nullptr, XN, nullptr});
    SYNC(2);
    if (IN(3)) { run_gemm(lds, XN, Win, TT, PW, DM, EpiWin{BIG, rcos, rsin, SSQ + 1 * TT}); if ((DUPMASK >> 3) & 1u) { run_gemm(lds, XN, Win, TT, PW, DM, EpiWin{BIG, rcos, rsin, SSQ + 1 * TT}); } }
    SYNC(3);
    if (IN(4)) REP(4) {
        const int GH = G / 2;
        if (G >= 2 && vcu < GH) attn_phase<0>(lds, BIG, PW, 1024, 2048, 4, YC, BIG, nullptr, 0.f, vcu, GH);
        else if (G >= 2) s5_phase(lds, ws, BIG, P.in[13], P.in[14], P.in[15], ZB, vcu - GH, G - GH, wave, lane);
        else { attn_phase<0>(lds, BIG, PW, 1024, 2048, 4, YC, BIG, nullptr, 0.f, vcu, G); s5_phase(lds, ws, BIG, P.in[13], P.in[14], P.in[15], ZB, vcu, G, wave, lane); }
    }
    SYNC(4);
    if (IN(5)) run_gemm(lds, ZB, Wglu, TT, 1024, 1024, EpiGlu{ZB, P.in[17], YC});
    SYNC(5);
    if (IN(6)) run_gemm(lds, YC, Wout, TT, DM, DM, EpiResid<false, false, 0>{nullptr, nullptr, XN, SSQ + 2 * TT});
    if (IN(6) && ((DUPMASK >> 6) & 1u)) run_gemm(lds, YC, Wout, TT, DM, DM, EpiResid<false, false, 2>{nullptr, nullptr, XN, nullptr});
    SYNC(6);
    if (IN(7)) { run_gemm(lds, XN, Wgu + (size_t)1 * NGU * DM, TT, NGU, DM, EpiSwiglu{BIG, DFF, SSQ + 2 * TT}); if ((DUPMASK >> 7) & 1u) { run_gemm(lds, XN, Wgu + (size_t)1 * NGU * DM, TT, NGU, DM, EpiSwiglu{BIG, DFF, SSQ + 2 * TT}); } }
    SYNC(7);
    if (IN(8)) run_gemm(lds, BIG, Wd + (size_t)1 * DM * DFF, TT, DM, DFF, EpiResid<false, false, 1>{nullptr, nullptr, XN, SSQ + 3 * TT});
    if (IN(8) && ((DUPMASK >> 8) & 1u)) run_gemm(lds, BIG, Wd + (size_t)1 * DM * DFF, TT, DM, DFF, EpiResid<false, false, 2>{nullptr, nullptr, XN, nullptr});
    SYNC(8);
    if (IN(9)) { run_gemm(lds, XN, Wgu + (size_t)2 * NGU * DM, TT, NGU, DM, EpiSwiglu{BIG, DFF, SSQ + 3 * TT}); if ((DUPMASK >> 9) & 1u) { run_gemm(lds, XN, Wgu + (size_t)2 * NGU * DM, TT, NGU, DM, EpiSwiglu{BIG, DFF, SSQ + 3 * TT}); } }
    SYNC(9);
    if (IN(10)) run_gemm(lds, BIG, Wd + (size_t)2 * DM * DFF, TT, DM, DFF, EpiResid<false, false, 1>{nullptr, nullptr, XN, SSQ + 4 * TT});
    if (IN(10) && ((DUPMASK >> 10) & 1u)) run_gemm(lds, BIG, Wd + (size_t)2 * DM * DFF, TT, DM, DFF, EpiResid<false, false, 2>{nullptr, nullptr, XN, nullptr});
    SYNC(10);
    if (IN(11)) { run_gemm(lds, XN, Wqkv, TT, QW, DM, EpiQkv{BIG, acos_, asin_, SSQ + 4 * TT}); if ((DUPMASK >> 11) & 1u) { run_gemm(lds, XN, Wqkv, TT, QW, DM, EpiQkv{BIG, acos_, asin_, SSQ + 4 * TT}); } }
    SYNC(11);
#ifndef NO_A1
    if (IN(12)) REP(12) { const float lam = ((const float*)(ws + WS_CTL))[0]; attn_phase<1>(lds, BIG, QW, 2048, 4096, 8, YC, nullptr, P.in[24], lam, vcu, G); }
#endif
    SYNC(12);
    if (IN(13)) run_gemm(lds, YC, Wco, TT, DM, DM, EpiResid<false, false, 0>{nullptr, nullptr, XN, SSQ + 5 * TT});
    if (IN(13) && ((DUPMASK >> 13) & 1u)) run_gemm(lds, YC, Wco, TT, DM, DM, EpiResid<false, false, 2>{nullptr, nullptr, XN, nullptr});
    SYNC(13);
    if (IN(14)) { run_gemm(lds, XN, Wgu + (size_t)3 * NGU * DM, TT, NGU, DM, EpiSwiglu{BIG, DFF, SSQ + 5 * TT}); if ((DUPMASK >> 14) & 1u) { run_gemm(lds, XN, Wgu + (size_t)3 * NGU * DM, TT, NGU, DM, EpiSwiglu{BIG, DFF, SSQ + 5 * TT}); } }
    SYNC(14);
    if (IN(15)) run_gemm(lds, BIG, Wd + (size_t)3 * DM * DFF, TT, DM, DFF, EpiResid<false, false, 1>{nullptr, nullptr, XN, SSQ + 6 * TT});
    if (IN(15) && ((DUPMASK >> 15) & 1u)) run_gemm(lds, BIG, Wd + (size_t)3 * DM * DFF, TT, DM, DFF, EpiResid<false, false, 2>{nullptr, nullptr, XN, nullptr});
    SYNC(15);
    if (IN(16)) final_phase(XN, SSQ + 6 * TT, P.in[25], out, gw, NGW, lane);
#undef IN
#undef SYNC
}

extern "C" void kernel_launch(void* const* d_in, const int* in_sizes, int n_in, void* d_out, int out_size, void* d_ws, size_t ws_size, hipStream_t stream) {
    static int grid = 0;
    if (grid == 0) {
        if (n_in != 26 || out_size != TT * DM || ws_size < WS_END) { fprintf(stderr, "kernel_launch: unexpected shapes (n_in %d, out %d, ws %zu < %zu)\n", n_in, out_size, ws_size, (size_t)WS_END); grid = -1; return; }
        int dev = 0, cus = 0, per_cu = 0;
        hipGetDevice(&dev); hipDeviceGetAttribute(&cus, hipDeviceAttributeMultiprocessorCount, dev);
        if (hipFuncSetAttribute((const void*)fwd_megakernel, hipFuncAttributeMaxDynamicSharedMemorySize, LDS_BYTES) != hipSuccess) { fprintf(stderr, "kernel_launch: hipFuncSetAttribute failed\n"); grid = -1; return; }
        if (hipOccupancyMaxActiveBlocksPerMultiprocessor(&per_cu, (const void*)fwd_megakernel, 512, LDS_BYTES) != hipSuccess || per_cu < 1) { fprintf(stderr, "kernel_launch: occupancy query says %d\n", per_cu); per_cu = 1; }
        (void)hipGetLastError();
        grid = cus * per_cu;
        fprintf(stderr, "kernel_launch: grid %d (cus %d x %d)\n", grid, cus, per_cu);
    }
    if (grid < 0) return;
    if (hipMemsetAsync((char*)d_ws + WS_BAR, 0, BAR_BYTES, stream) != hipSuccess) { fprintf(stderr, "kernel_launch: hipMemsetAsync failed\n"); return; }
    Params p{};
    for (int i = 0; i < 26; ++i) p.in[i] = (const float*)d_in[i];
    p.out = (float*)d_out; p.ws = (unsigned char*)d_ws;
#if MK_PER_PHASE
    for (int k = 0; k < NPHASE; ++k) { p.lo = k; p.hi = k + 1; hipLaunchKernelGGL(fwd_megakernel, dim3(grid), dim3(512), LDS_BYTES, stream, p); }
#else
    p.lo = 0; p.hi = NPHASE;
    void* args[] = {&p};
    hipError_t e = hipLaunchCooperativeKernel((const void*)fwd_megakernel, dim3(grid), dim3(512), args, LDS_BYTES, stream);
    if (e != hipSuccess) fprintf(stderr, "cooperative launch failed: %s (grid %d)\n", hipGetErrorString(e), grid);
#endif
}
```

```cpp
#include <hip/hip_runtime.h>
#include <hip/hip_cooperative_groups.h>
#include <cstdio>
#include <cstdint>
namespace cg = cooperative_groups;

#define LAS __attribute__((address_space(3)))
typedef unsigned short bf16_t;
typedef unsigned long long u64_t;
constexpr float SSQ_FIX = 16777216.0f, SSQ_INV = 1.0f / 16777216.0f;
typedef short bf16x8 __attribute__((ext_vector_type(8)));
typedef short s16x4 __attribute__((ext_vector_type(4)));
typedef float f32x4 __attribute__((ext_vector_type(4)));
typedef float f32x2 __attribute__((ext_vector_type(2)));
typedef float f32x16 __attribute__((ext_vector_type(16)));
typedef unsigned u32x4 __attribute__((ext_vector_type(4)));
typedef unsigned u32x2 __attribute__((ext_vector_type(2)));

#ifndef MK_PER_PHASE
#define MK_PER_PHASE 0
#endif

constexpr int TT = 32768, SEQ = 2048, DM = 2048, DFF = 5504, NGU = 2 * DFF;
constexpr int PW = 5120, QW = 6144;
constexpr float EPS = 1e-6f;
constexpr float LAMBDA_INIT = 0.35550906759f;
constexpr float QSCALE = 0.08838834764831845f * 1.4426950408889634f;

constexpr size_t MiB = 1u << 20;
constexpr size_t WS_CTL = 0, WS_BAR = 4096, BAR_BYTES = 16384;
constexpr size_t WS_RCOS = 1 * MiB, WS_RSIN = 2 * MiB, WS_ACOS = 3 * MiB, WS_ASIN = 3 * MiB + 128 * 1024, WS_S5A = 3 * MiB + 512 * 1024, WS_S5BB = 4 * MiB;
constexpr size_t WS_W = 8 * MiB;
constexpr size_t SZ_WGU = (size_t)NGU * DM * 2, SZ_WD = (size_t)DM * DFF * 2;
constexpr size_t WS_WGU = WS_W, WS_WD = WS_WGU + 4 * SZ_WGU, WS_WIN = WS_WD + 4 * SZ_WD, WS_WOUT = WS_WIN + (size_t)PW * DM * 2,
                 WS_WGLU = WS_WOUT + (size_t)DM * DM * 2, WS_WQKV = WS_WGLU + (size_t)1024 * 1024 * 2, WS_WCO = WS_WQKV + (size_t)QW * DM * 2,
                 WS_WEND = WS_WCO + (size_t)DM * DM * 2;
constexpr size_t WS_XN = 328 * MiB;
constexpr size_t WS_BIG = 456 * MiB;
constexpr size_t WS_Z = WS_BIG + (size_t)TT * PW * 2;
constexpr size_t WS_YC = WS_BIG + (size_t)TT * QW * 2;
constexpr size_t WS_END = WS_YC + (size_t)TT * DM * 2;
constexpr size_t WS_SSQ = 5 * MiB;
static_assert(WS_WEND <= WS_XN && WS_XN + (size_t)TT * DM * 2 <= WS_BIG && WS_Z + (size_t)TT * 1024 * 2 <= WS_END, "ws map");

constexpr int LDS_BYTES = 147456;

namespace pg8 {
constexpr int BM = 256, BK = 64, HALF = 128, HTB = HALF * BK * 2, STAGE_BYTES = 8 * HTB, NXCD = 8;
__host__ __device__ __forceinline__ int lds_byte(int r, int c) { const int st = (r >> 4) * 2 + (c >> 5), rr = r & 15, cc = c & 31, ob = rr * 64 + cc * 2; return st * 1024 + (ob ^ (((ob >> 9) & 1) << 5)); }
__host__ __device__ __forceinline__ void stage_rc(int b, int& R, int& C) { const int st = b / 1024, sb = b % 1024, swz = sb ^ (((sb >> 9) & 1) << 5); R = (st >> 1) * 16 + swz / 64; C = (st & 1) * 32 + (swz % 64) / 2; }
__host__ __device__ __forceinline__ int perm32(int rho) { const int n = rho >> 4, i = rho & 15; return 8 * (i >> 2) + 4 * n + (i & 3); }
struct Unit { int pm, pn; };
struct Gemm { const bf16_t* A; const bf16_t* Bt; int M, N, K; };
struct StaticOrder {
    int nM, nN, nwg, G, c, WGM;
    __host__ __device__ void init(int M, int N, int G_, int c_, int wgm_ = 8) { nM = M / BM; nN = N / BM; nwg = nM * nN; G = G_; c = c_; WGM = wgm_; }
    __host__ __device__ bool next(int i, Unit& u) const {
        const long L = (long)i * G + c; if (L >= nwg) return false;
        int wgid = (int)L; { const int q = nwg / NXCD, r = nwg % NXCD, xcd = wgid % NXCD, off = wgid / NXCD; wgid = (xcd < r ? xcd * (q + 1) : r * (q + 1) + (xcd - r) * q) + off; }
        const int nig = WGM * nN, gid = wgid / nig, fm = gid * WGM, gsz = (nM - fm) < WGM ? (nM - fm) : WGM;
        u.pm = fm + ((wgid % nig) % gsz); u.pn = (wgid % nig) / gsz; return true;
    }
    __device__ __forceinline__ void a_ready(const Unit&) const {}
    __device__ __forceinline__ void done(const Unit&) const {}
};
__device__ __forceinline__ unsigned cvt_pk_bf16(float lo, float hi) { unsigned r; asm volatile("v_cvt_pk_bf16_f32 %0, %1, %2" : "=v"(r) : "v"(lo), "v"(hi)); return r; }

template <class Epi, class Sched, bool ALIGN_EPI = false, bool SP2 = false>
__device__ __forceinline__ void gemm_phase(LAS unsigned char* lds, const Gemm g, const Sched S, const Epi E) {
    const int tid = threadIdx.x, wid = __builtin_amdgcn_readfirstlane(tid >> 6), lane = tid & 63, wr = wid >> 2, wc = wid & 3, fr = lane & 15, fq = lane >> 4;
    const int K = g.K, nt = K / BK;
    unsigned voffA[2], voffB[2];
#pragma unroll
    for (int i = 0; i < 2; ++i) { int R, C; stage_rc(tid * 16 + i * 8192, R, C); const int Rb = Epi::PERM ? ((R & ~31) + perm32(R & 31)) : R;
        voffA[i] = (unsigned)(R * K + C) * 2u; voffB[i] = (unsigned)(Rb * K + C) * 2u; }
    const size_t kstep = (size_t)(BK * 2);
    const size_t hstep = (size_t)HALF * K * 2;
    const size_t tstep = 2 * hstep;
    const unsigned ldsw = (unsigned)wid * 1024u;
    const int aoff = lds_byte(wr * 64 + fr, fq * 8), boff = lds_byte(wc * 32 + fr, fq * 8);
#define PG8_SA(b, h) (((b) * 2 + (h)) * HTB)
#define PG8_SB(b, h) ((4 + (b) * 2 + (h)) * HTB)
#define PG8_STAGE(bufoff, gbase, voff) do { _Pragma("unroll") for (int _i = 0; _i < 2; ++_i) \
        __builtin_amdgcn_global_load_lds((const unsigned*)((const char*)(gbase) + (voff)[_i]), (LAS unsigned*)(lds + (bufoff) + ldsw + _i * 8192), 16, 0, 0); } while (0)
#define PG8_LDA(dst, b, h) do { _Pragma("unroll") for (int m = 0; m < 4; ++m) _Pragma("unroll") for (int k = 0; k < 2; ++k) dst[m][k] = *(const LAS bf16x8*)(lds + PG8_SA(b, h) + aoff + m * 2048 + k * 1024); } while (0)
#define PG8_LDB(dst, b, h) do { _Pragma("unroll") for (int n = 0; n < 2; ++n) _Pragma("unroll") for (int k = 0; k < 2; ++k) dst[n][k] = *(const LAS bf16x8*)(lds + PG8_SB(b, h) + boff + n * 2048 + k * 1024); } while (0)
#define PG8_MMA(ai, bj, At, Bt) do { __builtin_amdgcn_s_setprio(1); _Pragma("unroll") for (int m = 0; m < 4; ++m) _Pragma("unroll") for (int n = 0; n < 2; ++n) _Pragma("unroll") for (int k = 0; k < 2; ++k) \
        acc[ai][bj][m][n] = __builtin_amdgcn_mfma_f32_16x16x32_bf16(Bt[n][k], At[m][k], acc[ai][bj][m][n], 0, 0, 0); __builtin_amdgcn_s_setprio(0); } while (0)
#define PG8_WAIT_V(n) asm volatile("s_waitcnt vmcnt(" #n ")" ::: "memory")
#define PG8_WAIT_L(n) asm volatile("s_waitcnt lgkmcnt(" #n ")" ::: "memory")
#define PG8_BAR __builtin_amdgcn_s_barrier()
#define PG8_SCHED __builtin_amdgcn_sched_barrier(0)
    Unit cur, nxt; int ui = 0;
    if (!S.next(0, cur)) return;
    f32x4 acc[2][2][4][2];
#pragma unroll
    for (int a = 0; a < 2; ++a)
#pragma unroll
        for (int b = 0; b < 2; ++b)
#pragma unroll
            for (int m = 0; m < 4; ++m)
#pragma unroll
                for (int n = 0; n < 2; ++n) acc[a][b][m][n] = (f32x4){0.f, 0.f, 0.f, 0.f};
    bf16x8 At[4][2], B0[2][2], B1[2][2];
    const char* cA = (const char*)g.A + (size_t)cur.pm * tstep; const char* cB = (const char*)g.Bt + (size_t)cur.pn * tstep;
    S.a_ready(cur);
    if constexpr (SP2) {
        PG8_STAGE(PG8_SB(0, 0), cB, voffB); PG8_STAGE(PG8_SB(0, 1), cB + hstep, voffB); PG8_STAGE(PG8_SA(0, 0), cA, voffA); PG8_STAGE(PG8_SA(0, 1), cA + hstep, voffA);
        if (wr == 1) PG8_BAR;
        PG8_WAIT_V(2); PG8_BAR;
        PG8_STAGE(PG8_SB(1, 0), cB + kstep, voffB); PG8_STAGE(PG8_SA(1, 0), cA + kstep, voffA); PG8_STAGE(PG8_SB(1, 1), cB + hstep + kstep, voffB);
        PG8_WAIT_V(6); PG8_BAR;
    } else {
        PG8_STAGE(PG8_SB(0, 0), cB, voffB); PG8_STAGE(PG8_SA(0, 0), cA, voffA); PG8_STAGE(PG8_SB(0, 1), cB + hstep, voffB); PG8_STAGE(PG8_SA(0, 1), cA + hstep, voffA);
        if (wr == 1) PG8_BAR;
        PG8_WAIT_V(4); PG8_BAR;
        PG8_STAGE(PG8_SB(1, 0), cB + kstep, voffB); PG8_STAGE(PG8_SA(1, 0), cA + kstep, voffA); PG8_STAGE(PG8_SB(1, 1), cB + hstep + kstep, voffB);
        PG8_WAIT_V(6); PG8_BAR;
    }
    for (;;) {
        const bool has_next = S.next(ui + 1, nxt);
        const char* nA = has_next ? (const char*)g.A + (size_t)nxt.pm * tstep : cA; const char* nB = has_next ? (const char*)g.Bt + (size_t)nxt.pn * tstep : cB;
        for (int t = 0; t < nt; t += 2) {
            const bool last = (t == nt - 2);
            const char* a1 = cA + (size_t)(t + 1) * kstep;
            const char* a2 = last ? nA : cA + (size_t)(t + 2) * kstep; const char* b2 = last ? nB : cB + (size_t)(t + 2) * kstep;
            const char* a3 = a2 + kstep; const char* b3 = b2 + kstep;
            if (last && has_next) S.a_ready(nxt);
            if constexpr (SP2) {
            PG8_LDB(B0, 0, 0); PG8_LDB(B1, 0, 1); PG8_SCHED; PG8_LDA(At, 0, 0); PG8_STAGE(PG8_SA(1, 1), a1 + hstep, voffA);
            PG8_WAIT_V(8); PG8_WAIT_L(0); PG8_BAR; PG8_MMA(0, 0, At, B0); PG8_MMA(0, 1, At, B1); PG8_BAR; PG8_SCHED;
            PG8_LDA(At, 0, 1); PG8_STAGE(PG8_SB(0, 0), b2, voffB); PG8_STAGE(PG8_SB(0, 1), b2 + hstep, voffB); PG8_STAGE(PG8_SA(0, 0), a2, voffA);
            PG8_WAIT_V(8); PG8_WAIT_L(0); PG8_BAR; PG8_MMA(1, 0, At, B0); PG8_MMA(1, 1, At, B1); PG8_BAR; PG8_SCHED;
            PG8_LDB(B0, 1, 0); PG8_LDB(B1, 1, 1); PG8_SCHED; PG8_LDA(At, 1, 0); PG8_STAGE(PG8_SA(0, 1), a2 + hstep, voffA);
            PG8_WAIT_V(8); PG8_WAIT_L(0); PG8_BAR; PG8_MMA(0, 0, At, B0); PG8_MMA(0, 1, At, B1); PG8_BAR; PG8_SCHED;
            PG8_LDA(At, 1, 1); PG8_STAGE(PG8_SB(1, 0), b3, voffB); PG8_STAGE(PG8_SB(1, 1), b3 + hstep, voffB); PG8_STAGE(PG8_SA(1, 0), a3, voffA);
            PG8_WAIT_V(8); PG8_WAIT_L(0); PG8_BAR; PG8_MMA(1, 0, At, B0); PG8_MMA(1, 1, At, B1); PG8_BAR; PG8_SCHED;
            } else {
            PG8_LDB(B0, 0, 0); PG8_SCHED; PG8_LDA(At, 0, 0); PG8_STAGE(PG8_SA(1, 1), a1 + hstep, voffA);
            PG8_WAIT_L(8); PG8_BAR; PG8_WAIT_L(0); PG8_MMA(0, 0, At, B0); PG8_BAR; PG8_SCHED;
            PG8_LDB(B1, 0, 1); PG8_STAGE(PG8_SB(0, 0), b2, voffB);
            PG8_BAR; PG8_WAIT_L(0); PG8_MMA(0, 1, At, B1); PG8_BAR;
            PG8_LDA(At, 0, 1); PG8_STAGE(PG8_SA(0, 0), a2, voffA);
            PG8_BAR; PG8_WAIT_L(0); PG8_MMA(1, 0, At, B0); PG8_BAR; PG8_SCHED;
            PG8_STAGE(PG8_SB(0, 1), b2 + hstep, voffB);
            PG8_WAIT_V(6); PG8_BAR; PG8_MMA(1, 1, At, B1); PG8_BAR;
            PG8_LDB(B0, 1, 0); PG8_SCHED; PG8_LDA(At, 1, 0); PG8_STAGE(PG8_SA(0, 1), a2 + hstep, voffA);
            PG8_WAIT_L(8); PG8_BAR; PG8_WAIT_L(0); PG8_MMA(0, 0, At, B0); PG8_BAR; PG8_SCHED;
            PG8_LDB(B1, 1, 1); PG8_STAGE(PG8_SB(1, 0), b3, voffB);
            PG8_BAR; PG8_WAIT_L(0); PG8_MMA(0, 1, At, B1); PG8_BAR;
            PG8_LDA(At, 1, 1); PG8_STAGE(PG8_SA(1, 0), a3, voffA);
            PG8_BAR; PG8_WAIT_L(0); PG8_MMA(1, 0, At, B0); PG8_BAR; PG8_SCHED;
            PG8_STAGE(PG8_SB(1, 1), b3 + hstep, voffB);
            PG8_WAIT_V(6); PG8_BAR; PG8_MMA(1, 1, At, B1); PG8_BAR;
            }
        }
        if constexpr (ALIGN_EPI) { if (wr == 0) PG8_BAR; }
        if constexpr (!Epi::AFTER_DRAIN) { E(acc, cur, wr, wc, fr, fq); S.done(cur); }
        if (!has_next) break;
#pragma unroll
        for (int a = 0; a < 2; ++a)
#pragma unroll
            for (int b = 0; b < 2; ++b)
#pragma unroll
                for (int m = 0; m < 4; ++m)
#pragma unroll
                    for (int n = 0; n < 2; ++n) acc[a][b][m][n] = (f32x4){0.f, 0.f, 0.f, 0.f};
        cur = nxt; cA = nA; cB = nB; ++ui;
        if constexpr (ALIGN_EPI) { if (wr == 1) PG8_BAR; }
    }
    PG8_WAIT_V(0);
    if constexpr (!ALIGN_EPI) { if (wr == 0) PG8_BAR; }
    PG8_BAR;
#undef PG8_SA
#undef PG8_SB
#undef PG8_STAGE
#undef PG8_LDA
#undef PG8_LDB
#undef PG8_MMA
#undef PG8_WAIT_V
#undef PG8_WAIT_L
#undef PG8_BAR
#undef PG8_SCHED
}
}

__device__ __forceinline__ unsigned f2bf(float f) { unsigned u = __builtin_bit_cast(unsigned, f); return (u + 0x7fffu + ((u >> 16) & 1u)) >> 16; }
__device__ __forceinline__ unsigned pk2(float lo, float hi) { return f2bf(lo) | (f2bf(hi) << 16); }
__device__ __forceinline__ float bf2f(unsigned short b) { return __builtin_bit_cast(float, (unsigned)b << 16); }
__device__ __forceinline__ float bflo(unsigned w) { return __builtin_bit_cast(float, w << 16); }
__device__ __forceinline__ float bfhi(unsigned w) { return __builtin_bit_cast(float, w & 0xffff0000u); }
__device__ __forceinline__ float fast_sigmoid(float x) { return __builtin_amdgcn_rcpf(1.0f + __builtin_amdgcn_exp2f(-1.4426950408889634f * x)); }
__device__ __forceinline__ float silu_f(float x) { return x * fast_sigmoid(x); }
__device__ __forceinline__ float gelu_tanh_f(float y) { return y * fast_sigmoid(1.5957691216057308f * (y + 0.044715f * y * y * y)); }
__device__ __forceinline__ float wave_sum(float v) {
#pragma unroll
    for (int o = 1; o < 64; o <<= 1) v += __shfl_xor(v, o);
    return v;
}
__device__ __forceinline__ void sincos_d(double a, double& s, double& c) {
    const double k = rint(a * 0.15915494309189535);
    const double r = fma(-k, 6.283185307179586, a), r2 = r * r;
    double ts = r, tc = 1.0; s = r; c = 1.0;
    for (int n = 1; n <= 13; ++n) { tc *= -r2 / (double)((2 * n - 1) * (2 * n)); c += tc; ts *= -r2 / (double)((2 * n) * (2 * n + 1)); s += ts; }
}

using pg8::Unit; using pg8::cvt_pk_bf16;
struct EpiSwiglu {
    static constexpr bool PERM = true, AFTER_DRAIN = false;
    bf16_t* O; int ldo; const u64_t* ssq;
    __device__ __forceinline__ void operator()(const f32x4 (&acc)[2][2][4][2], const Unit& u, int wr, int wc, int fr, int fq) const {
        const int row0 = u.pm * 256 + wr * 64 + fr, col0 = u.pn * 128 + wc * 32 + 8 * fq;
        float rsv[2][4];
#pragma unroll
        for (int ai = 0; ai < 2; ++ai)
#pragma unroll
            for (int m = 0; m < 4; ++m) rsv[ai][m] = (float)ssq[row0 + ai * 128 + m * 16] * SSQ_INV;
#pragma unroll
        for (int ai = 0; ai < 2; ++ai)
#pragma unroll
            for (int m = 0; m < 4; ++m) {
                const int row = row0 + ai * 128 + m * 16;
                const float rs = __builtin_amdgcn_rsqf(rsv[ai][m] * (1.0f / DM) + EPS);
                bf16_t* rowp = O + (size_t)row * ldo + col0;
                const f32x4 g0 = acc[ai][0][m][0] * rs, g1 = acc[ai][0][m][1] * rs, u0 = acc[ai][1][m][0] * rs, u1 = acc[ai][1][m][1] * rs;
                u32x4 w;
                w.x = cvt_pk_bf16(silu_f(g0[0]) * u0[0], silu_f(g0[1]) * u0[1]); w.y = cvt_pk_bf16(silu_f(g0[2]) * u0[2], silu_f(g0[3]) * u0[3]);
                w.z = cvt_pk_bf16(silu_f(g1[0]) * u1[0], silu_f(g1[1]) * u1[1]); w.w = cvt_pk_bf16(silu_f(g1[2]) * u1[2], silu_f(g1[3]) * u1[3]);
                *(u32x4*)rowp = w;
            }
    }
};
template <bool BASE_F32, bool OUT_F32, int SCALE> struct EpiResid {
    static constexpr bool PERM = false, AFTER_DRAIN = false;
    const float* basef; float* outf; bf16_t* xb; u64_t* ssq;
    __device__ __forceinline__ void operator()(const f32x4 (&acc)[2][2][4][2], const Unit& u, int wr, int wc, int fr, int fq) const {
        const int col0 = u.pn * 256 + wc * 32 + 4 * fq;
        constexpr float sc = (SCALE == 2 ? 0.0f : SCALE == 1 ? 0.5f : 1.0f);
#pragma unroll
        for (int ai = 0; ai < 2; ++ai) {
            f32x4 pre[4][2][2];
#pragma unroll
            for (int m = 0; m < 4; ++m) { const size_t off = (size_t)(u.pm * 256 + ai * 128 + wr * 64 + m * 16 + fr) * DM + col0;
#pragma unroll
                for (int bj = 0; bj < 2; ++bj)
#pragma unroll
                    for (int n = 0; n < 2; ++n) {
                        if constexpr (BASE_F32) pre[m][bj][n] = *(const f32x4*)(basef + off + bj * 128 + n * 16);
                        else { const u32x2 w = *(const u32x2*)(xb + off + bj * 128 + n * 16); pre[m][bj][n] = (f32x4){bflo(w.x), bfhi(w.x), bflo(w.y), bfhi(w.y)}; } } }
#pragma unroll
            for (int m = 0; m < 4; ++m) {
                const int row = u.pm * 256 + ai * 128 + wr * 64 + m * 16 + fr;
                const size_t off = (size_t)row * DM + col0;
                float sq = 0.f;
#pragma unroll
                for (int bj = 0; bj < 2; ++bj)
#pragma unroll
                    for (int n = 0; n < 2; ++n) { const f32x4 v = pre[m][bj][n] + acc[ai][bj][m][n] * sc;
                        if constexpr (OUT_F32) *(f32x4*)(outf + off + bj * 128 + n * 16) = v;
                        else { u32x2 w; w.x = cvt_pk_bf16(v[0], v[1]); w.y = cvt_pk_bf16(v[2], v[3]); *(u32x2*)(xb + off + bj * 128 + n * 16) = w;
                               sq += (v[0] * v[0] + v[1] * v[1]) + (v[2] * v[2] + v[3] * v[3]); } }
                if constexpr (!OUT_F32 && SCALE != 2) { sq += __shfl_xor(sq, 16); sq += __shfl_xor(sq, 32); if (fq == 0) atomicAdd(ssq + row, (u64_t)(sq * SSQ_FIX)); }
            }
        }
    }
};
struct EpiWin {
    static constexpr bool PERM = true, AFTER_DRAIN = false;
    bf16_t* O; const float* cs; const float* sn; const u64_t* ssq;
    __device__ __forceinline__ void operator()(const f32x4 (&acc)[2][2][4][2], const Unit& u, int wr, int wc, int fr, int fq) const {
        const int row0 = u.pm * 256 + wr * 64 + fr, col0 = u.pn * 256 + wc * 32 + 8 * fq;
        const bool rot = u.pn < 8;
        float rsv[2][4];
#pragma unroll
        for (int ai = 0; ai < 2; ++ai)
#pragma unroll
            for (int m = 0; m < 4; ++m) rsv[ai][m] = (float)ssq[row0 + ai * 128 + m * 16] * SSQ_INV;
#pragma unroll
        for (int ai = 0; ai < 2; ++ai) {
            f32x4 cc[4][2], sv[4][2];
#pragma unroll
            for (int m = 0; m < 4; ++m) {
                if (rot) { const int pos = (row0 + ai * 128 + m * 16) & (SEQ - 1);
                    const float* cp = cs + pos * 128 + wc * 32 + 8 * fq; const float* sp = sn + pos * 128 + wc * 32 + 8 * fq;
                    cc[m][0] = *(const f32x4*)cp; cc[m][1] = *(const f32x4*)(cp + 4); sv[m][0] = *(const f32x4*)sp; sv[m][1] = *(const f32x4*)(sp + 4); }
                else { cc[m][0] = cc[m][1] = (f32x4){1.f, 1.f, 1.f, 1.f}; sv[m][0] = sv[m][1] = (f32x4){0.f, 0.f, 0.f, 0.f}; }
            }
#pragma unroll
            for (int m = 0; m < 4; ++m) {
                const int row = row0 + ai * 128 + m * 16;
                const float rs = __builtin_amdgcn_rsqf(rsv[ai][m] * (1.0f / DM) + EPS);
                const f32x4 a0 = acc[ai][0][m][0] * rs, a1 = acc[ai][0][m][1] * rs, b0 = acc[ai][1][m][0] * rs, b1 = acc[ai][1][m][1] * rs;
                const f32x4 na0 = a0 * cc[m][0] - b0 * sv[m][0], nb0 = b0 * cc[m][0] + a0 * sv[m][0], na1 = a1 * cc[m][1] - b1 * sv[m][1], nb1 = b1 * cc[m][1] + a1 * sv[m][1];
                bf16_t* rowp = O + (size_t)row * PW + col0;
                u32x4 w; w.x = cvt_pk_bf16(na0[0], na0[1]); w.y = cvt_pk_bf16(na0[2], na0[3]); w.z = cvt_pk_bf16(na1[0], na1[1]); w.w = cvt_pk_bf16(na1[2], na1[3]);
                *(u32x4*)rowp = w;
                u32x4 v; v.x = cvt_pk_bf16(nb0[0], nb0[1]); v.y = cvt_pk_bf16(nb0[2], nb0[3]); v.z = cvt_pk_bf16(nb1[0], nb1[1]); v.w = cvt_pk_bf16(nb1[2], nb1[3]);
                *(u32x4*)(rowp + 128) = v;
            }
        }
    }
};
struct EpiQkv {
    static constexpr bool PERM = false, AFTER_DRAIN = false;
    bf16_t* O; const float* cs; const float* sn; const u64_t* ssq;
    __device__ __forceinline__ void operator()(const f32x4 (&acc)[2][2][4][2], const Unit& u, int wr, int wc, int fr, int fq) const {
        const int col0 = u.pn * 256 + wc * 32 + 4 * fq;
        const bool rot = (u.pn < 16) && (wc == 0);
        const float sc0 = (u.pn < 8) ? QSCALE : 1.0f;
        float rsv[2][4]; f32x4 cv[2][4], sv[2][4];
#pragma unroll
        for (int ai = 0; ai < 2; ++ai)
#pragma unroll
            for (int m = 0; m < 4; ++m) { const int row = u.pm * 256 + ai * 128 + wr * 64 + m * 16 + fr; rsv[ai][m] = (float)ssq[row] * SSQ_INV;
                if (rot) { const int pos = row & (SEQ - 1); cv[ai][m] = *(const f32x4*)(cs + pos * 16 + 4 * fq); sv[ai][m] = *(const f32x4*)(sn + pos * 16 + 4 * fq); }
                else { cv[ai][m] = (f32x4){1.f, 1.f, 1.f, 1.f}; sv[ai][m] = (f32x4){0.f, 0.f, 0.f, 0.f}; } }
#pragma unroll
        for (int ai = 0; ai < 2; ++ai)
#pragma unroll
            for (int m = 0; m < 4; ++m) {
                const int row = u.pm * 256 + ai * 128 + wr * 64 + m * 16 + fr;
                const float sc = sc0 * __builtin_amdgcn_rsqf(rsv[ai][m] * (1.0f / DM) + EPS);
                const f32x4 c = cv[ai][m], s = sv[ai][m];
#pragma unroll
                for (int bj = 0; bj < 2; ++bj) {
                    const f32x4 x0 = acc[ai][bj][m][0], x1 = acc[ai][bj][m][1];
                    const f32x4 n0 = (x0 * c - x1 * s) * sc, n1 = (x1 * c + x0 * s) * sc;
                    bf16_t* p = O + (size_t)row * QW + col0 + bj * 128;
                    u32x2 w0; w0.x = cvt_pk_bf16(n0[0], n0[1]); w0.y = cvt_pk_bf16(n0[2], n0[3]); *(u32x2*)p = w0;
                    u32x2 w1; w1.x = cvt_pk_bf16(n1[0], n1[1]); w1.y = cvt_pk_bf16(n1[2], n1[3]); *(u32x2*)(p + 16) = w1;
                }
            }
    }
};
struct EpiGlu {
    static constexpr bool PERM = true, AFTER_DRAIN = false;
    const bf16_t* Z; const float* bias; bf16_t* Y;
    __device__ __forceinline__ void operator()(const f32x4 (&acc)[2][2][4][2], const Unit& u, int wr, int wc, int fr, int fq) const {
        const int row0 = u.pm * 256 + wr * 64 + fr, col0 = u.pn * 256 + wc * 32 + 8 * fq;
#pragma unroll
        for (int bj = 0; bj < 2; ++bj) {
            const f32x4 bv0 = *(const f32x4*)(bias + col0 + bj * 128), bv1 = *(const f32x4*)(bias + col0 + bj * 128 + 4);
            u32x4 zz[2][4];
#pragma unroll
            for (int ai = 0; ai < 2; ++ai)
#pragma unroll
                for (int m = 0; m < 4; ++m) zz[ai][m] = *(const u32x4*)(Z + (size_t)(row0 + ai * 128 + m * 16) * 1024 + col0 + bj * 128);
#pragma unroll
            for (int ai = 0; ai < 2; ++ai)
#pragma unroll
                for (int m = 0; m < 4; ++m) {
                    const int row = row0 + ai * 128 + m * 16;
                    const u32x4 z4 = zz[ai][m];
                    const f32x4 v0 = acc[ai][bj][m][0] + bv0, v1 = acc[ai][bj][m][1] + bv1;
                    u32x4 w;
                    w.x = cvt_pk_bf16(bflo(z4.x) * fast_sigmoid(v0[0]), bfhi(z4.x) * fast_sigmoid(v0[1]));
                    w.y = cvt_pk_bf16(bflo(z4.y) * fast_sigmoid(v0[2]), bfhi(z4.y) * fast_sigmoid(v0[3]));
                    w.z = cvt_pk_bf16(bflo(z4.z) * fast_sigmoid(v1[0]), bfhi(z4.z) * fast_sigmoid(v1[1]));
                    w.w = cvt_pk_bf16(bflo(z4.w) * fast_sigmoid(v1[2]), bfhi(z4.w) * fast_sigmoid(v1[3]));
                    *(u32x4*)(Y + (size_t)row * DM + 1024 + col0 + bj * 128) = w;
                }
        }
    }
};

template <class Epi>
__device__ __forceinline__ void run_gemm(LAS unsigned char* lds, const bf16_t* A, const bf16_t* Bt, int M, int N, int K, const Epi E, int wgm = 8) {
    pg8::Gemm g{A, Bt, M, N, K}; pg8::StaticOrder S; S.init(M, N, (int)gridDim.x, (int)blockIdx.x, wgm);
    pg8::gemm_phase<Epi, pg8::StaticOrder, true, true>(lds, g, S, E);
}

__device__ __forceinline__ void conv_matrix(const float* __restrict__ W, bf16_t* __restrict__ WT, int K, int N, int mode, const float* __restrict__ gain, LAS float* scr, int gw, int NGW, int lane) {
    const int nblk = N / 64, nitems = (K / 64) * nblk;
    for (int item = gw; item < nitems; item += NGW) {
        const int kb = item / nblk, nb = item % nblk, k0 = 64 * kb, n0 = 64 * nb;
        const float gv = gain ? gain[k0 + lane] : 1.0f;
        const float* wp = W + (size_t)k0 * N + n0 + lane;
#pragma unroll
        for (int i = 0; i < 64; ++i) { const float v = wp[(size_t)i * N];
            scr[i * 65 + lane] = v * __builtin_bit_cast(float, __builtin_amdgcn_readlane(__builtin_bit_cast(int, gv), i)); }
        asm volatile("s_waitcnt lgkmcnt(0)" ::: "memory");
        const int c = lane & 7, ns = lane >> 3;
        const int rbase = (mode == 0) ? n0 : ((n0 >> 7) * 256 + (n0 & 127) + (mode == 2 ? 128 : 0));
#pragma unroll
        for (int j = 0; j < 8; ++j) { const int n = ns + 8 * j; const LAS float* sp = scr + (8 * c) * 65 + n;
            u32x4 o; o.x = pk2(sp[0 * 65], sp[1 * 65]); o.y = pk2(sp[2 * 65], sp[3 * 65]); o.z = pk2(sp[4 * 65], sp[5 * 65]); o.w = pk2(sp[6 * 65], sp[7 * 65]);
            *(u32x4*)(WT + (size_t)(rbase + n) * K + k0 + 8 * c) = o; }
        asm volatile("s_waitcnt lgkmcnt(0)" ::: "memory");
    }
}

template <bool TO_BF16>
__device__ __forceinline__ void rmsnorm_phase(const float* in, const float* __restrict__ g, bf16_t* outb, float* outf, int gw, int NGW, int lane) {
    f32x4 gv[8];
#pragma unroll
    for (int j = 0; j < 8; ++j) gv[j] = ((const f32x4*)g)[lane + 64 * j];
    for (int row = gw; row < TT; row += NGW) {
        const f32x4* xr = (const f32x4*)(in + (size_t)row * DM) + lane;
        f32x4 v[8]; float ss = 0.f;
#pragma unroll
        for (int j = 0; j < 8; ++j) { v[j] = xr[64 * j]; ss += (v[j][0] * v[j][0] + v[j][1] * v[j][1]) + (v[j][2] * v[j][2] + v[j][3] * v[j][3]); }
        const float rs = 1.0f / sqrtf(wave_sum(ss) * (1.0f / DM) + EPS);
#pragma unroll
        for (int j = 0; j < 8; ++j) {
            const f32x4 y = v[j] * rs * gv[j];
            if constexpr (TO_BF16) { u32x2 w; w.x = pk2(y[0], y[1]); w.y = pk2(y[2], y[3]); *((u32x2*)(outb + (size_t)row * DM) + lane + 64 * j) = w; }
            else { *((f32x4*)(outf + (size_t)row * DM) + lane + 64 * j) = y; }
        }
    }
}

__device__ __forceinline__ void cast_phase(const float* in, bf16_t* outb, u64_t* ssq, int gw, int NGW, int lane) {
    for (int row = gw; row < TT; row += NGW) {
        const f32x4* xr = (const f32x4*)(in + (size_t)row * DM) + lane;
        f32x4 v[8]; float ss = 0.f;
#pragma unroll
        for (int j = 0; j < 8; ++j) { v[j] = xr[64 * j]; ss += (v[j][0] * v[j][0] + v[j][1] * v[j][1]) + (v[j][2] * v[j][2] + v[j][3] * v[j][3]); }
        ss = wave_sum(ss);
        if (lane == 0) ssq[row] = (u64_t)(ss * SSQ_FIX);
#pragma unroll
        for (int j = 0; j < 8; ++j) { u32x2 w; w.x = pk2(v[j][0], v[j][1]); w.y = pk2(v[j][2], v[j][3]); *((u32x2*)(outb + (size_t)row * DM) + lane + 64 * j) = w; }
    }
}

__device__ __forceinline__ void final_phase(const bf16_t* xb, const u64_t* ssq, const float* __restrict__ g, float* outf, int gw, int NGW, int lane) {
    f32x4 gv[4][2];
#pragma unroll
    for (int j = 0; j < 4; ++j) { gv[j][0] = *(const f32x4*)(g + 8 * (lane + 64 * j)); gv[j][1] = *(const f32x4*)(g + 8 * (lane + 64 * j) + 4); }
    for (int row = gw; row < TT; row += NGW) {
        const float rs = __builtin_amdgcn_rsqf((float)ssq[row] * SSQ_INV * (1.0f / DM) + EPS);
        const u32x4* xr = (const u32x4*)(xb + (size_t)row * DM) + lane;
        u32x4 v[4];
#pragma unroll
        for (int j = 0; j < 4; ++j) v[j] = xr[64 * j];
#pragma unroll
        for (int j = 0; j < 4; ++j) {
            float* op = outf + (size_t)row * DM + 8 * (lane + 64 * j);
            *(f32x4*)op = (f32x4){bflo(v[j].x), bfhi(v[j].x), bflo(v[j].y), bfhi(v[j].y)} * rs * gv[j][0];
            *(f32x4*)(op + 4) = (f32x4){bflo(v[j].z), bfhi(v[j].z), bflo(v[j].w), bfhi(v[j].w)} * rs * gv[j][1];
        }
    }
}

__device__ __forceinline__ void tables_phase(unsigned char* ws, const float* const* in_unused, const float* lam_re, const float* lam_im, const float* log_step, const float* b_re, const float* b_im,
                                             const float* lq1, const float* lk1, const float* lq2, const float* lk2, int gtid, int NT_) {
    float* rcos = (float*)(ws + WS_RCOS); float* rsin = (float*)(ws + WS_RSIN); float* acos_ = (float*)(ws + WS_ACOS); float* asin_ = (float*)(ws + WS_ASIN);
    float* s5a = (float*)(ws + WS_S5A); float* s5bb = (float*)(ws + WS_S5BB);
    for (int i = gtid; i < SEQ * 128; i += NT_) {
        const int pos = i >> 7, f = i & 127;
        const float inv = (float)exp2(-((double)(2 * f) / 256.0) * 13.287712379549449);
        const float ang = (float)pos * inv; double s, c; sincos_d((double)ang, s, c); rcos[i] = (float)c; rsin[i] = (float)s;
    }
    for (int i = gtid; i < SEQ * 16; i += NT_) {
        const int pos = i >> 4, f = i & 15;
        const float inv = (float)exp2(-((double)(2 * f) / 32.0) * 18.931568569324174);
        const float ang = (float)pos * inv; double s, c; sincos_d((double)ang, s, c); acos_[i] = (float)c; asin_[i] = (float)s;
    }
    for (int i = gtid; i < 64 * 64; i += NT_) {
        const int g = i >> 6;
        const double step = exp((double)log_step[g]), lr = (double)lam_re[i], li = (double)lam_im[i];
        const double mag = exp(lr * step); double s, c; sincos_d(li * step, s, c);
        const double are = mag * c, aim = mag * s, den = lr * lr + li * li, nr = are - 1.0;
        const double fre = (nr * lr + aim * li) / den, fim = (aim * lr - nr * li) / den;
        s5a[2 * i] = (float)are; s5a[2 * i + 1] = (float)aim;
        for (int p = 0; p < 16; ++p) { const double br = (double)b_re[i * 16 + p], bi = (double)b_im[i * 16 + p];
            s5bb[(size_t)i * 32 + p] = (float)(fre * br - fim * bi); s5bb[(size_t)i * 32 + 16 + p] = (float)(fre * bi + fim * br); }
    }
    if (gtid == 0) { float s1 = 0.f, s2 = 0.f; for (int i = 0; i < 128; ++i) { s1 += lq1[i] * lk1[i]; s2 += lq2[i] * lk2[i]; }
        ((float*)(ws + WS_CTL))[0] = expf(s1) - expf(s2) + LAMBDA_INIT; }
}

__device__ __forceinline__ void s5_phase(LAS unsigned char* lds, const unsigned char* ws, const bf16_t* proj, const float* c_re, const float* c_im, const float* dskip, bf16_t* z,
                                         int vcu, int G, int wave, int lane) {
    const float* s5a = (const float*)(ws + WS_S5A); const float* s5bb = (const float*)(ws + WS_S5BB);
    LAS bf16_t* Hc = (LAS bf16_t*)(lds + wave * 8704);
    const int fr = lane & 15, fq = lane >> 4;
    for (int seq = vcu * 8 + wave; seq < 1024; seq += G * 8) {
        const int b = seq >> 6, g = seq & 63, n = lane;
        float bbre[16], bbim[16];
#pragma unroll
        for (int p = 0; p < 16; ++p) { bbre[p] = s5bb[(size_t)(g * 64 + n) * 32 + p]; bbim[p] = s5bb[(size_t)(g * 64 + n) * 32 + 16 + p]; }
        const float are = s5a[2 * (g * 64 + n)], aim = s5a[2 * (g * 64 + n) + 1];
        bf16x8 cf[4];
#pragma unroll
        for (int ks = 0; ks < 4; ++ks) { u32x4 w; unsigned* wp = (unsigned*)&w;
#pragma unroll
            for (int j2 = 0; j2 < 4; ++j2) { float v[2];
#pragma unroll
                for (int e = 0; e < 2; ++e) { const int k = 32 * ks + 8 * fq + 2 * j2 + e; v[e] = (k < 64) ? c_re[(size_t)(g * 16 + fr) * 64 + k] : -c_im[(size_t)(g * 16 + fr) * 64 + (k - 64)]; }
                wp[j2] = pk2(v[0], v[1]); }
            cf[ks] = __builtin_bit_cast(bf16x8, w); }
        const float dsk = dskip[g * 16 + fr];
        float hre = 0.f, him = 0.f;
        for (int ch = 0; ch < SEQ / 32; ++ch) {
            const size_t row0 = (size_t)b * SEQ + ch * 32;
            const bf16_t* up = proj + (row0 + (lane & 31)) * PW + 4096 + g * 16;
            const u32x4 ua = *(const u32x4*)up, ub = *(const u32x4*)(up + 8);
            float uf[16];
            uf[0] = bflo(ua.x); uf[1] = bfhi(ua.x); uf[2] = bflo(ua.y); uf[3] = bfhi(ua.y); uf[4] = bflo(ua.z); uf[5] = bfhi(ua.z); uf[6] = bflo(ua.w); uf[7] = bfhi(ua.w);
            uf[8] = bflo(ub.x); uf[9] = bfhi(ub.x); uf[10] = bflo(ub.y); uf[11] = bfhi(ub.y); uf[12] = bflo(ub.z); uf[13] = bfhi(ub.z); uf[14] = bflo(ub.w); uf[15] = bfhi(ub.w);
#pragma unroll
            for (int k = 0; k < 32; ++k) {
                f32x2 xx = (f32x2){0.f, 0.f};
#pragma unroll
                for (int p = 0; p < 16; ++p) { const float su = __builtin_bit_cast(float, __builtin_amdgcn_readlane(__builtin_bit_cast(int, uf[p]), k));
                    xx = __builtin_elementwise_fma((f32x2){su, su}, (f32x2){bbre[p], bbim[p]}, xx); }
                const float nr = are * hre - aim * him + xx[0], ni = are * him + aim * hre + xx[1]; hre = nr; him = ni;
                Hc[k * 136 + n] = (bf16_t)f2bf(hre); Hc[k * 136 + 64 + n] = (bf16_t)f2bf(him);
            }
#pragma unroll
            for (int sb = 0; sb < 2; ++sb) {
                f32x4 y = (f32x4){0.f, 0.f, 0.f, 0.f};
#pragma unroll
                for (int ks = 0; ks < 4; ++ks) { const bf16x8 hf = *(const LAS bf16x8*)(Hc + (16 * sb + fr) * 136 + 32 * ks + 8 * fq); y = __builtin_amdgcn_mfma_f32_16x16x32_bf16(hf, cf[ks], y, 0, 0, 0); }
#pragma unroll
                for (int i = 0; i < 4; ++i) { const size_t row = row0 + 16 * sb + 4 * fq + i;
                    const float uu = bf2f(proj[row * PW + 4096 + g * 16 + fr]); const float yy = y[i] + dsk * uu;
                    z[row * 1024 + g * 16 + fr] = (bf16_t)f2bf(gelu_tanh_f(yy)); }
            }
        }
    }
}

#define MF32(a, b, c) __builtin_amdgcn_mfma_f32_32x32x16_bf16((a), (b), (c), 0, 0, 0)
#define AT_WAITV(n) asm volatile("s_waitcnt vmcnt(" #n ")" ::: "memory")
#define AT_BAR() asm volatile("s_waitcnt lgkmcnt(0)\n\ts_barrier" ::: "memory")
__device__ __forceinline__ s16x4 vtr(const LAS unsigned char* p) { typedef short v4i16_t __attribute__((ext_vector_type(4))); return __builtin_bit_cast(s16x4, __builtin_amdgcn_ds_read_tr16_b64_v4i16((LAS v4i16_t*)p)); }
__device__ __forceinline__ int crow(int i, int h) { return (i & 3) + 8 * (i >> 2) + 4 * h; }

template <int MODE>
__device__ __forceinline__ void attn_unit(LAS unsigned char* lds, const bf16_t* src, const int pitch, const int kcol, const int vcol, const int b, const int h, const int ub,
                                          bf16_t* outp, const bf16_t* gsrc, const float* subln, const float lam) {
    constexpr int NKS = MODE ? 8 : 16, NDB = 4, ROWS = MODE ? 64 : 128;
    const int tid = threadIdx.x, lane = tid & 63, r = lane & 31, hh = lane >> 5;
    const int wid = __builtin_amdgcn_readfirstlane(tid >> 6);
    const int rg = MODE ? (wid & 1) : (wid & 3), vh = MODE ? ((wid >> 1) & 1) : (wid >> 2), cc = MODE ? (wid >> 2) : 0;
    const size_t rowbase = (size_t)b * SEQ; const int q0 = ub * ROWS, NT = MODE ? (ub + 1) : (2 * ub + 2);
    const int qrow = q0 + rg * 32 + r;
    AT_WAITV(0);
#define AT_ISSUE(t, buf) do { const bf16_t* gk_ = src + (rowbase + (size_t)(t) * 64) * pitch; int rv_ = r; asm volatile("" : "+v"(rv_)); \
        _Pragma("unroll") for (int i_ = 0; i_ < 4; ++i_) { const int c_ = wid * 4 + i_; const int row_ = c_ * 2 + hh; \
            const unsigned ok_ = (unsigned)(row_ * pitch + kcol + ((rv_ ^ (row_ & 15)) << 3)); \
            __builtin_amdgcn_global_load_lds((const unsigned*)(gk_ + ok_), (LAS unsigned*)(lds + (buf) * 65536 + c_ * 1024), 16, 0, 0); \
            const unsigned ov_ = (unsigned)(row_ * pitch + vcol + ((rv_ ^ ((row_ & 3) << 2)) << 3)); \
            __builtin_amdgcn_global_load_lds((const unsigned*)(gk_ + ov_), (LAS unsigned*)(lds + (buf) * 65536 + 32768 + c_ * 1024), 16, 0, 0); } } while (0)
    AT_ISSUE(0, 0);
    bf16x8 qf[NKS];
    { const bf16_t* qp = src + (rowbase + qrow) * pitch + h * 256 + cc * 128 + 8 * hh;
#pragma unroll
      for (int d0 = 0; d0 < NKS; ++d0) qf[d0] = *(const bf16x8*)(qp + 16 * d0); }
    f32x16 O[NDB];
#pragma unroll
    for (int db = 0; db < NDB; ++db)
#pragma unroll
        for (int i = 0; i < 16; ++i) O[db][i] = 0.f;
    float mrun = 0.f, lrun = 0.f;
    const float lgam = __builtin_log2f(1.0f - __builtin_amdgcn_exp2f(-5.0f - (float)h));
    const int r15 = r & 15;
    const int kunit0 = cc * 16;
    const int q4 = (lane & 15) >> 2, p4 = lane & 3, blk16 = (lane >> 4) & 1;
    const int vlane = (4 * hh + q4) * 512 + ((2 * blk16 + (p4 >> 1)) << 4) + 8 * (p4 & 1);
    for (int t = 0; t < NT; ++t) {
        if (t + 1 < NT) { AT_ISSUE(t + 1, (t + 1) & 1); AT_WAITV(8); } else { AT_WAITV(0); }
        AT_BAR();
        const bool active = MODE ? true : !(t == NT - 1 && rg < 2);
        if (active) {
            const LAS unsigned char* Kb = lds + (t & 1) * 65536; const LAS unsigned char* Vb = Kb + 32768;
            int r15v = r15 ^ hh ^ kunit0, q4v = q4 << 2; asm volatile("" : "+v"(r15v), "+v"(q4v));
            bf16x8 pf[4];
            if constexpr (MODE) {
                f32x16 p0, p1;
#pragma unroll
                for (int i = 0; i < 16; ++i) { p0[i] = -mrun; p1[i] = -mrun; }
                { const LAS unsigned char* kr0 = Kb + r * 512; const LAS unsigned char* kr1 = Kb + (32 + r) * 512;
#pragma unroll
                  for (int d0 = 0; d0 < NKS; ++d0) { const int uo = ((2 * d0) ^ r15v) << 4;
                      const bf16x8 k0 = *(const LAS bf16x8*)(kr0 + uo); const bf16x8 k1 = *(const LAS bf16x8*)(kr1 + uo);
                      p0 = MF32(k0, qf[d0], p0); p1 = MF32(k1, qf[d0], p1);
                      if ((d0 & 3) == 3) __builtin_amdgcn_sched_barrier(0); } }
                float rm = p0[0];
#pragma unroll
                for (int i = 0; i < 16; ++i) { rm = fmaxf(rm, p0[i]); rm = fmaxf(rm, p1[i]); }
                rm = fmaxf(rm, __shfl_xor(rm, 32));
                if (t == 0 || __any(rm > 8.0f)) {
                    const float dl = (t == 0) ? rm : fmaxf(rm, 0.f); const float al = (t == 0) ? 1.0f : __builtin_amdgcn_exp2f(-dl); lrun *= al; mrun += dl;
#pragma unroll
                    for (int i = 0; i < 16; ++i) { p0[i] -= dl; p1[i] -= dl; }
#pragma unroll
                    for (int db = 0; db < NDB; ++db) O[db] = O[db] * al;
                }
                float sum = 0.f;
#pragma unroll
                for (int i = 0; i < 16; ++i) { p0[i] = __builtin_amdgcn_exp2f(p0[i]); p1[i] = __builtin_amdgcn_exp2f(p1[i]); sum += p0[i] + p1[i]; }
                lrun += sum;
                u32x4 w;
                w.x = cvt_pk_bf16(p0[0], p0[1]); w.y = cvt_pk_bf16(p0[2], p0[3]); w.z = cvt_pk_bf16(p0[4], p0[5]); w.w = cvt_pk_bf16(p0[6], p0[7]); pf[0] = __builtin_bit_cast(bf16x8, w);
                w.x = cvt_pk_bf16(p0[8], p0[9]); w.y = cvt_pk_bf16(p0[10], p0[11]); w.z = cvt_pk_bf16(p0[12], p0[13]); w.w = cvt_pk_bf16(p0[14], p0[15]); pf[1] = __builtin_bit_cast(bf16x8, w);
                w.x = cvt_pk_bf16(p1[0], p1[1]); w.y = cvt_pk_bf16(p1[2], p1[3]); w.z = cvt_pk_bf16(p1[4], p1[5]); w.w = cvt_pk_bf16(p1[6], p1[7]); pf[2] = __builtin_bit_cast(bf16x8, w);
                w.x = cvt_pk_bf16(p1[8], p1[9]); w.y = cvt_pk_bf16(p1[10], p1[11]); w.z = cvt_pk_bf16(p1[12], p1[13]); w.w = cvt_pk_bf16(p1[14], p1[15]); pf[3] = __builtin_bit_cast(bf16x8, w);
            } else {
#pragma unroll
                for (int blk = 0; blk < 2; ++blk) {
                    f32x16 p;
#pragma unroll
                    for (int i = 0; i < 16; ++i) p[i] = 0.f;
                    const LAS unsigned char* kr = Kb + (32 * blk + r) * 512;
#pragma unroll
                    for (int d0 = 0; d0 < NKS; ++d0) { const int uo = ((2 * d0) ^ r15v) << 4;
                        const bf16x8 k0 = *(const LAS bf16x8*)(kr + uo); p = MF32(k0, qf[d0], p);
                        if ((d0 & 3) == 3) __builtin_amdgcn_sched_barrier(0); }
                    const int kb = t * 64 + 32 * blk + 4 * hh;
#pragma unroll
                    for (int i = 0; i < 16; ++i) { const int kv = kb + (i & 3) + 8 * (i >> 2);
                        p[i] *= __builtin_amdgcn_exp2f(lgam * fabsf((float)(qrow - kv)) - 4.0f); }
                    u32x4 w;
                    w.x = cvt_pk_bf16(p[0], p[1]); w.y = cvt_pk_bf16(p[2], p[3]); w.z = cvt_pk_bf16(p[4], p[5]); w.w = cvt_pk_bf16(p[6], p[7]); pf[2 * blk] = __builtin_bit_cast(bf16x8, w);
                    w.x = cvt_pk_bf16(p[8], p[9]); w.y = cvt_pk_bf16(p[10], p[11]); w.z = cvt_pk_bf16(p[12], p[13]); w.w = cvt_pk_bf16(p[14], p[15]); pf[2 * blk + 1] = __builtin_bit_cast(bf16x8, w);
                    __builtin_amdgcn_sched_barrier(0);
                }
            }
            const LAS unsigned char* vb = Vb + vlane;
            __builtin_amdgcn_sched_barrier(0);
#pragma unroll
            for (int db = 0; db < NDB; ++db) {
                const int dunit = vh * 16 + 4 * db;
                const LAS unsigned char* vp = vb + ((dunit ^ q4v) << 4);
#pragma unroll
                for (int ks = 0; ks < 4; ++ks) {
                    const int kvb = 32 * (ks >> 1) + 16 * (ks & 1);
                    const s16x4 lo = vtr(vp + kvb * 512), hi = vtr(vp + (kvb + 8) * 512);
                    const bf16x8 vf = __builtin_shufflevector(lo, hi, 0, 1, 2, 3, 4, 5, 6, 7);
                    O[db] = MF32(vf, pf[ks], O[db]);
                }
                __builtin_amdgcn_sched_barrier(0);
            }
        }
        AT_BAR();
    }
    const size_t orow = rowbase + qrow;
    LAS float* SS = (LAS float*)(lds + 131072);
    if constexpr (MODE) {
        const float l = lrun + __shfl_xor(lrun, 32); const float inv = 1.0f / l;
        LAS float* X = (LAS float*)(lds + (wid & 3) * 16384);
        if (cc == 1) {
#pragma unroll
            for (int db = 0; db < NDB; ++db)
#pragma unroll
                for (int i = 0; i < 16; ++i) X[(db * 16 + i) * 64 + lane] = O[db][i] * inv;
        }
        AT_BAR();
        float ss = 0.f;
        if (cc == 0) {
#pragma unroll
            for (int db = 0; db < NDB; ++db)
#pragma unroll
                for (int i = 0; i < 16; ++i) { const float o = O[db][i] * inv - lam * X[(db * 16 + i) * 64 + lane]; O[db][i] = o; ss += o * o; }
        }
        ss += __shfl_xor(ss, 32);
        if (hh == 0) SS[wid * 32 + r] = ss;
        AT_BAR();
        if (cc == 0) {
            ss += SS[(wid ^ 2) * 32 + r];
            const float rs = (1.0f - LAMBDA_INIT) / sqrtf(ss * (1.0f / 256.0f) + EPS);
            bf16_t* op = outp + orow * DM + h * 256 + vh * 128 + 4 * hh;
            const float* slp = subln + vh * 128 + 4 * hh;
#pragma unroll
            for (int db = 0; db < NDB; ++db)
#pragma unroll
                for (int i4 = 0; i4 < 4; ++i4) { const int d = 32 * db + 8 * i4;
                    const f32x4 sl = *(const f32x4*)(slp + d);
                    u32x2 w; w.x = cvt_pk_bf16(O[db][4 * i4] * rs * sl[0], O[db][4 * i4 + 1] * rs * sl[1]); w.y = cvt_pk_bf16(O[db][4 * i4 + 2] * rs * sl[2], O[db][4 * i4 + 3] * rs * sl[3]);
                    *(u32x2*)(op + d) = w; }
        }
        AT_BAR();
    } else {
        float ss = 0.f;
#pragma unroll
        for (int db = 0; db < NDB; ++db)
#pragma unroll
            for (int i = 0; i < 16; ++i) ss += O[db][i] * O[db][i];
        ss += __shfl_xor(ss, 32);
        if (hh == 0) SS[wid * 32 + r] = ss;
        AT_BAR();
        ss += SS[(wid ^ 4) * 32 + r];
        const float rs = 1.0f / sqrtf(ss * (1.0f / 256.0f) + EPS);
        const bf16_t* gp = gsrc + orow * PW + 3072 + h * 256 + vh * 128 + 4 * hh;
        bf16_t* op = outp + orow * DM + h * 256 + vh * 128 + 4 * hh;
#pragma unroll
        for (int db = 0; db < NDB; ++db)
#pragma unroll
            for (int i4 = 0; i4 < 4; ++i4) { const int d = 32 * db + 8 * i4;
                const u32x2 gg = *(const u32x2*)(gp + d);
                u32x2 w; w.x = cvt_pk_bf16(O[db][4 * i4] * rs * silu_f(bflo(gg.x)), O[db][4 * i4 + 1] * rs * silu_f(bfhi(gg.x)));
                w.y = cvt_pk_bf16(O[db][4 * i4 + 2] * rs * silu_f(bflo(gg.y)), O[db][4 * i4 + 3] * rs * silu_f(bfhi(gg.y)));
                *(u32x2*)(op + d) = w; }
        AT_BAR();
    }
#undef AT_ISSUE
}

__device__ __forceinline__ void attn_unit_diff128(LAS unsigned char* lds, const bf16_t* src, const int pitch, const int kcol, const int vcol, const int b, const int h, const int ub,
                                                  bf16_t* outp, const float* subln, const float lam) {
    constexpr int NKS = 8, NDB = 8;
    const int tid = threadIdx.x, lane = tid & 63, r = lane & 31, hh = lane >> 5;
    const int wid = __builtin_amdgcn_readfirstlane(tid >> 6);
    const int rg = wid & 3, cc = wid >> 2;
    const size_t rowbase = (size_t)b * SEQ; const int q0 = ub * 128, NT = 2 * ub + 2;
    const int qrow = q0 + rg * 32 + r;
    AT_WAITV(0);
#define AT_ISSUE(t, buf) do { const bf16_t* gk_ = src + (rowbase + (size_t)(t) * 64) * pitch; int rv_ = r; asm volatile("" : "+v"(rv_)); \
        _Pragma("unroll") for (int i_ = 0; i_ < 4; ++i_) { const int c_ = wid * 4 + i_; const int row_ = c_ * 2 + hh; \
            const unsigned ok_ = (unsigned)(row_ * pitch + kcol + ((rv_ ^ (row_ & 15)) << 3)); \
            __builtin_amdgcn_global_load_lds((const unsigned*)(gk_ + ok_), (LAS unsigned*)(lds + (buf) * 65536 + c_ * 1024), 16, 0, 0); \
            const unsigned ov_ = (unsigned)(row_ * pitch + vcol + ((rv_ ^ ((row_ & 3) << 2)) << 3)); \
            __builtin_amdgcn_global_load_lds((const unsigned*)(gk_ + ov_), (LAS unsigned*)(lds + (buf) * 65536 + 32768 + c_ * 1024), 16, 0, 0); } } while (0)
    AT_ISSUE(0, 0);
    bf16x8 qf[NKS];
    { const bf16_t* qp = src + (rowbase + qrow) * pitch + h * 256 + cc * 128 + 8 * hh;
#pragma unroll
      for (int d0 = 0; d0 < NKS; ++d0) qf[d0] = *(const bf16x8*)(qp + 16 * d0); }
    f32x16 O[NDB];
#pragma unroll
    for (int db = 0; db < NDB; ++db)
#pragma unroll
        for (int i = 0; i < 16; ++i) O[db][i] = 0.f;
    float mrun = 0.f, lrun = 0.f;
    const int r15 = r & 15, kunit0 = cc * 16;
    const int q4 = (lane & 15) >> 2, p4 = lane & 3, blk16 = (lane >> 4) & 1;
    const int vlane = (4 * hh + q4) * 512 + ((2 * blk16 + (p4 >> 1)) << 4) + 8 * (p4 & 1);
    for (int t = 0; t < NT; ++t) {
        if (t + 1 < NT) { AT_ISSUE(t + 1, (t + 1) & 1); AT_WAITV(8); } else { AT_WAITV(0); }
        AT_BAR();
        const bool active = !(t == NT - 1 && rg < 2);
        if (active) {
            const LAS unsigned char* Kb = lds + (t & 1) * 65536; const LAS unsigned char* Vb = Kb + 32768;
            int r15v = r15 ^ hh ^ kunit0, q4v = q4 << 2; asm volatile("" : "+v"(r15v), "+v"(q4v));
            const LAS unsigned char* vb = Vb + vlane;
#pragma unroll
            for (int blk = 0; blk < 2; ++blk) {
                f32x16 p;
#pragma unroll
                for (int i = 0; i < 16; ++i) p[i] = -mrun;
                const LAS unsigned char* kr = Kb + (32 * blk + r) * 512;
#pragma unroll
                for (int d0 = 0; d0 < NKS; ++d0) { const int uo = ((2 * d0) ^ r15v) << 4;
                    const bf16x8 k0 = *(const LAS bf16x8*)(kr + uo); p = MF32(k0, qf[d0], p);
                    if ((d0 & 3) == 3) __builtin_amdgcn_sched_barrier(0); }
                float rm = p[0];
#pragma unroll
                for (int i = 1; i < 16; ++i) rm = fmaxf(rm, p[i]);
                rm = fmaxf(rm, __shfl_xor(rm, 32));
                const bool first = (t == 0) && (blk == 0);
                if (first || __any(rm > 8.0f)) {
                    const float dl = first ? rm : fmaxf(rm, 0.f); const float al = first ? 1.0f : __builtin_amdgcn_exp2f(-dl); lrun *= al; mrun += dl;
#pragma unroll
                    for (int i = 0; i < 16; ++i) p[i] -= dl;
#pragma unroll
                    for (int db = 0; db < NDB; ++db) O[db] = O[db] * al;
                }
                float sum = 0.f;
#pragma unroll
                for (int i = 0; i < 16; ++i) { p[i] = __builtin_amdgcn_exp2f(p[i]); sum += p[i]; }
                lrun += sum;
                bf16x8 pf[2];
                { u32x4 w;
                  w.x = cvt_pk_bf16(p[0], p[1]); w.y = cvt_pk_bf16(p[2], p[3]); w.z = cvt_pk_bf16(p[4], p[5]); w.w = cvt_pk_bf16(p[6], p[7]); pf[0] = __builtin_bit_cast(bf16x8, w);
                  w.x = cvt_pk_bf16(p[8], p[9]); w.y = cvt_pk_bf16(p[10], p[11]); w.z = cvt_pk_bf16(p[12], p[13]); w.w = cvt_pk_bf16(p[14], p[15]); pf[1] = __builtin_bit_cast(bf16x8, w); }
                __builtin_amdgcn_sched_barrier(0);
#pragma unroll
                for (int db = 0; db < NDB; ++db) {
                    const LAS unsigned char* vp = vb + (((4 * db) ^ q4v) << 4);
#pragma unroll
                    for (int ks = 0; ks < 2; ++ks) {
                        const int kvb = 32 * blk + 16 * ks;
                        const s16x4 lo = vtr(vp + kvb * 512), hi = vtr(vp + (kvb + 8) * 512);
                        const bf16x8 vf = __builtin_shufflevector(lo, hi, 0, 1, 2, 3, 4, 5, 6, 7);
                        O[db] = MF32(vf, pf[ks], O[db]);
                    }
                    if (db & 1) __builtin_amdgcn_sched_barrier(0);
                }
            }
        }
        AT_BAR();
    }
    const size_t orow = rowbase + qrow;
    const float l = lrun + __shfl_xor(lrun, 32); const float inv = 1.0f / l;
    LAS float* X = (LAS float*)(lds + rg * 32768);
    if (cc == 1) {
#pragma unroll
        for (int db = 0; db < NDB; ++db)
#pragma unroll
            for (int i = 0; i < 16; ++i) X[(db * 16 + i) * 64 + lane] = O[db][i] * inv;
    }
    AT_BAR();
    if (cc == 0) {
        float ss = 0.f;
#pragma unroll
        for (int db = 0; db < NDB; ++db)
#pragma unroll
            for (int i = 0; i < 16; ++i) { const float o = O[db][i] * inv - lam * X[(db * 16 + i) * 64 + lane]; O[db][i] = o; ss += o * o; }
        ss += __shfl_xor(ss, 32);
        const float rs = (1.0f - LAMBDA_INIT) / sqrtf(ss * (1.0f / 256.0f) + EPS);
        bf16_t* op = outp + orow * DM + h * 256 + 4 * hh;
        const float* slp = subln + 4 * hh;
#pragma unroll
        for (int db = 0; db < NDB; ++db)
#pragma unroll
            for (int i4 = 0; i4 < 4; ++i4) { const int d = 32 * db + 8 * i4;
                const f32x4 sl = *(const f32x4*)(slp + d);
                u32x2 w; w.x = cvt_pk_bf16(O[db][4 * i4] * rs * sl[0], O[db][4 * i4 + 1] * rs * sl[1]); w.y = cvt_pk_bf16(O[db][4 * i4 + 2] * rs * sl[2], O[db][4 * i4 + 3] * rs * sl[3]);
                *(u32x2*)(op + d) = w; }
    }
    AT_BAR();
#undef AT_ISSUE
}

template <int MODE>
__device__ __forceinline__ void attn_phase(LAS unsigned char* lds, const bf16_t* src, int pitch, int kcol0, int vcol0, int nheads, bf16_t* outp, const bf16_t* gsrc, const float* subln, float lam, int vcu, int G) {
    constexpr int NU = 16;
    const int npairs = 16 * nheads * (NU / 2);
    for (int pr = vcu; pr < npairs; pr += G) {
        const int bh = pr / (NU / 2), p = pr % (NU / 2), b = bh / nheads, h = bh % nheads;
        if constexpr (MODE) {
            attn_unit_diff128(lds, src, pitch, kcol0 + h * 256, vcol0 + h * 256, b, h, NU - 1 - p, outp, subln, lam);
            attn_unit_diff128(lds, src, pitch, kcol0 + h * 256, vcol0 + h * 256, b, h, p, outp, subln, lam);
        } else {
            attn_unit<0>(lds, src, pitch, kcol0 + h * 256, vcol0 + h * 256, b, h, NU - 1 - p, outp, gsrc, subln, lam);
            attn_unit<0>(lds, src, pitch, kcol0 + h * 256, vcol0 + h * 256, b, h, p, outp, gsrc, subln, lam);
        }
    }
}

#define XB_TMO      128
#define XB_XCNT(j)  (256  + 64 * (j))
#define XB_XSUB(j)  (1280 + 64 * (j))
#define XB_XGEN(j)  (2304 + 64 * (j))
#define XB_TOP      3328
#define XB_TOPGEN   3392
#define XCD_BAR_WORDS 3456
#define XB_SPIN_CAP (1u << 18)
__device__ __forceinline__ unsigned xb_ld(unsigned* p)              { return __hip_atomic_load(p, __ATOMIC_RELAXED, __HIP_MEMORY_SCOPE_AGENT); }
__device__ __forceinline__ unsigned xb_add(unsigned* p, unsigned v) { return __hip_atomic_fetch_add(p, v, __ATOMIC_RELAXED, __HIP_MEMORY_SCOPE_AGENT); }
__device__ __forceinline__ unsigned xb_xcc_id() { return (unsigned)__builtin_amdgcn_s_getreg((3 << 11) | 20) & 0xFu; }
#define XB_SPIN(cond, bar) do { unsigned _sp = 0; while (cond) { __builtin_amdgcn_s_sleep(1); \
    if ((++_sp & 255u) == 0u) { if (xb_ld(&(bar)[XB_TMO])) break; if (_sp > XB_SPIN_CAP) { atomicAdd(&(bar)[XB_TMO], 1u); break; } } } } while (0)
struct XcdBarrier { unsigned* bar; unsigned x; volatile LAS unsigned* st; };
__device__ __forceinline__ XcdBarrier xcd_barrier_post(unsigned* bar, volatile LAS unsigned* st) {
    XcdBarrier b; b.bar = bar; b.x = xb_xcc_id(); b.st = st;
    if (threadIdx.x == 0) (void)xb_add(&bar[XB_XCNT(b.x)], 1u);
    return b;
}
__device__ __forceinline__ void xcd_barrier_complete(unsigned* bar, unsigned x, unsigned& nloc, unsigned& nx) {
    const unsigned G = gridDim.x * gridDim.y * gridDim.z;
    unsigned sum, cnt, mine, sp = 0u;
    for (;;) {
        sum = 0u; cnt = 0u; mine = 0u;
#pragma unroll
        for (unsigned j = 0; j < 16; ++j) { const unsigned c = xb_ld(&bar[XB_XCNT(j)]); sum += c; cnt += (c > 0u) ? 1u : 0u; mine = (j == x) ? c : mine; }
        if (sum == G) break;
        __builtin_amdgcn_s_sleep(1);
        if ((++sp & 255u) == 0u) { if (xb_ld(&bar[XB_TMO])) break; if (sp > XB_SPIN_CAP) { atomicAdd(&bar[XB_TMO], 1u); break; } }
    }
    nloc = mine > 0u ? mine : 1u; nx = cnt > 0u ? cnt : 1u;
}
__device__ __forceinline__ void xcd_barrier(const XcdBarrier& b) {
    asm volatile("s_waitcnt vmcnt(0)" ::: "memory");
    __syncthreads();
    if (threadIdx.x == 0) {
        unsigned* bar = b.bar;
        __builtin_amdgcn_s_waitcnt(0);
        unsigned nloc = b.st[0], nx = b.st[1];
        if (nloc == 0u) { xcd_barrier_complete(bar, b.x, nloc, nx); b.st[0] = nloc; b.st[1] = nx; }
        const unsigned old = xb_add(&bar[XB_XSUB(b.x)], 1u);
        const unsigned gen = old / nloc;
        if (old + 1u == (gen + 1u) * nloc) {
            __builtin_amdgcn_fence(__ATOMIC_RELEASE, "agent");
            asm volatile("s_waitcnt vmcnt(0)" ::: "memory");
            const unsigned og = xb_add(&bar[XB_TOP], 1u);
            const unsigned tg = og / nx;
            if (og + 1u == (tg + 1u) * nx) xb_add(&bar[XB_TOPGEN], 1u);
            else XB_SPIN(xb_ld(&bar[XB_TOPGEN]) == tg, bar);
            __builtin_amdgcn_fence(__ATOMIC_ACQUIRE, "agent");
            xb_add(&bar[XB_XGEN(b.x)], 1u);
            asm volatile("s_waitcnt vmcnt(0)" ::: "memory");
        } else {
            XB_SPIN(xb_ld(&bar[XB_XGEN(b.x)]) == gen, bar);
            __builtin_amdgcn_fence(__ATOMIC_ACQUIRE, "agent");
            asm volatile("s_waitcnt vmcnt(0)" ::: "memory");
        }
    }
    __syncthreads();
}

struct Params { const float* in[26]; float* out; unsigned char* ws; int lo, hi; };
constexpr int NPHASE = 17;

__global__ void __launch_bounds__(512) fwd_megakernel(Params P) {
    extern __shared__ __attribute__((aligned(16))) unsigned char lds_raw[];
    LAS unsigned char* lds = (LAS unsigned char*)lds_raw;
    const int tid = threadIdx.x, lane = tid & 63, wave = __builtin_amdgcn_readfirstlane(tid >> 6);
    const int G = gridDim.x, bx = blockIdx.x;
    const int vcu = (G % 8 == 0) ? (bx % 8) * (G / 8) + bx / 8 : bx;
    const int gw = vcu * 8 + wave, NGW = G * 8;
    unsigned char* ws = P.ws;
    float* out = P.out;
    bf16_t* Wgu = (bf16_t*)(ws + WS_WGU); bf16_t* Wd = (bf16_t*)(ws + WS_WD); bf16_t* Win = (bf16_t*)(ws + WS_WIN); bf16_t* Wout = (bf16_t*)(ws + WS_WOUT);
    bf16_t* Wglu = (bf16_t*)(ws + WS_WGLU); bf16_t* Wqkv = (bf16_t*)(ws + WS_WQKV); bf16_t* Wco = (bf16_t*)(ws + WS_WCO);
    bf16_t* XN = (bf16_t*)(ws + WS_XN); bf16_t* BIG = (bf16_t*)(ws + WS_BIG); bf16_t* ZB = (bf16_t*)(ws + WS_Z);
    const float* x = P.in[0]; const float* ffn_norm = P.in[1]; const float* mix_norm = P.in[5];
#if MK_PER_PHASE
#define SYNC(k) do { } while (0)
#else
    cg::grid_group grid = cg::this_grid();
    { volatile LAS unsigned* st0 = (volatile LAS unsigned*)(lds + 139264); if (tid < 2) st0[tid] = 0u; }
    __syncthreads();
    const XcdBarrier xbar = xcd_barrier_post((unsigned*)(ws + WS_BAR), (volatile LAS unsigned*)(lds + 139264));
#define SYNC(k) do { if (P.lo <= (k) && (k) + 1 < P.hi) { if ((k) == 0) grid.sync(); else xcd_barrier(xbar); } } while (0)
#endif
#ifndef WGM_DOWN
#define WGM_DOWN 4
#endif
#ifndef DUPMASK
#define DUPMASK 0u
#endif
#define IN(k) (P.lo <= (k) && (k) < P.hi)
#define REP(k) for (int rep_ = 0; rep_ < (((DUPMASK >> (k)) & 1u) ? 2 : 1); ++rep_)

    u64_t* SSQ = (u64_t*)(ws + WS_SSQ);
    bf16_t* YC = (bf16_t*)(ws + WS_YC);
    const float* rcos = (const float*)(ws + WS_RCOS); const float* rsin = (const float*)(ws + WS_RSIN);
    const float* acos_ = (const float*)(ws + WS_ACOS); const float* asin_ = (const float*)(ws + WS_ASIN);
    if (IN(0)) REP(0) {
        LAS float* scr = (LAS float*)(lds + wave * 16640);
        const size_t gsz = (size_t)DM * DFF;
#pragma unroll 1
        for (int i = 0; i < 4; ++i) {
            conv_matrix(P.in[2] + i * gsz, Wgu + (size_t)i * NGU * DM, DM, DFF, 1, ffn_norm + i * DM, scr, gw, NGW, lane);
            conv_matrix(P.in[3] + i * gsz, Wgu + (size_t)i * NGU * DM, DM, DFF, 2, ffn_norm + i * DM, scr, gw, NGW, lane);
            conv_matrix(P.in[4] + i * gsz, Wd + (size_t)i * DM * DFF, DFF, DM, 0, nullptr, scr, gw, NGW, lane);
        }
        conv_matrix(P.in[6], Win, DM, PW, 0, mix_norm, scr, gw, NGW, lane);
        conv_matrix(P.in[7], Wout, DM, DM, 0, nullptr, scr, gw, NGW, lane);
        conv_matrix(P.in[16], Wglu, 1024, 1024, 0, nullptr, scr, gw, NGW, lane);
        conv_matrix(P.in[18], Wqkv, DM, QW, 0, mix_norm + DM, scr, gw, NGW, lane);
        conv_matrix(P.in[19], Wco, DM, DM, 0, nullptr, scr, gw, NGW, lane);
        tables_phase(ws, nullptr, P.in[8], P.in[9], P.in[10], P.in[11], P.in[12], P.in[20], P.in[21], P.in[22], P.in[23], vcu * 512 + tid, G * 512);
        for (int i = vcu * 512 + tid; i < 6 * TT; i += G * 512) SSQ[TT + i] = 0ull;
        cast_phase(x, XN, SSQ, gw, NGW, lane);
    }
    SYNC(0);
#if !MK_PER_PHASE
    if ((DUPMASK >> 20) & 1u) { for (int q_ = 0; q_ < 32; ++q_) grid.sync(); }
#endif
    if (IN(1)) { run_gemm(lds, XN, Wgu, TT, NGU, DM, EpiSwiglu{BIG, DFF, SSQ}); if ((DUPMASK >> 1) & 1u) { run_gemm(lds, XN, Wgu, TT, NGU, DM, EpiSwiglu{BIG, DFF, SSQ}); } }
    SYNC(1);
    if (IN(2)) run_gemm(lds, BIG, Wd, TT, DM, DFF, EpiResid<true, false, 1>{x, nullptr, XN, SSQ + 1 * TT}, WGM_DOWN);
    if (IN(2) && ((DUPMASK >> 2) & 1u)) run_gemm(lds, BIG, Wd, TT, DM, DFF, EpiResid<false, false, 2>{nullptr, nullptr, XN, nullptr});
    SYNC(2);
    if (IN(3)) { run_gemm(lds, XN, Win, TT, PW, DM, EpiWin{BIG, rcos, rsin, SSQ + 1 * TT}); if ((DUPMASK >> 3) & 1u) { run_gemm(lds, XN, Win, TT, PW, DM, EpiWin{BIG, rcos, rsin, SSQ + 1 * TT}); } }
    SYNC(3);
    if (IN(4)) REP(4) {
        const int GH = G / 2;
        const bool do_ret = !(rep_ == 1 && ((DUPMASK >> 22) & 1u)), do_s5 = !(rep_ == 1 && ((DUPMASK >> 21) & 1u));
        if (G >= 2 && vcu < GH) { if (do_ret) attn_phase<0>(lds, BIG, PW, 1024, 2048, 4, YC, BIG, nullptr, 0.f, vcu, GH); }
        else if (G >= 2) { if (do_s5) s5_phase(lds, ws, BIG, P.in[13], P.in[14], P.in[15], ZB, vcu - GH, G - GH, wave, lane); }
        else { attn_phase<0>(lds, BIG, PW, 1024, 2048, 4, YC, BIG, nullptr, 0.f, vcu, G); s5_phase(lds, ws, BIG, P.in[13], P.in[14], P.in[15], ZB, vcu, G, wave, lane); }
    }
    SYNC(4);
    if (IN(5)) run_gemm(lds, ZB, Wglu, TT, 1024, 1024, EpiGlu{ZB, P.in[17], YC});
    SYNC(5);
    if (IN(6)) run_gemm(lds, YC, Wout, TT, DM, DM, EpiResid<false, false, 0>{nullptr, nullptr, XN, SSQ + 2 * TT});
    if (IN(6) && ((DUPMASK >> 6) & 1u)) run_gemm(lds, YC, Wout, TT, DM, DM, EpiResid<false, false, 2>{nullptr, nullptr, XN, nullptr});
    SYNC(6);
    if (IN(7)) { run_gemm(lds, XN, Wgu + (size_t)1 * NGU * DM, TT, NGU, DM, EpiSwiglu{BIG, DFF, SSQ + 2 * TT}); if ((DUPMASK >> 7) & 1u) { run_gemm(lds, XN, Wgu + (size_t)1 * NGU * DM, TT, NGU, DM, EpiSwiglu{BIG, DFF, SSQ + 2 * TT}); } }
    SYNC(7);
    if (IN(8)) run_gemm(lds, BIG, Wd + (size_t)1 * DM * DFF, TT, DM, DFF, EpiResid<false, false, 1>{nullptr, nullptr, XN, SSQ + 3 * TT}, WGM_DOWN);
    if (IN(8) && ((DUPMASK >> 8) & 1u)) run_gemm(lds, BIG, Wd + (size_t)1 * DM * DFF, TT, DM, DFF, EpiResid<false, false, 2>{nullptr, nullptr, XN, nullptr});
    SYNC(8);
    if (IN(9)) { run_gemm(lds, XN, Wgu + (size_t)2 * NGU * DM, TT, NGU, DM, EpiSwiglu{BIG, DFF, SSQ + 3 * TT}); if ((DUPMASK >> 9) & 1u) { run_gemm(lds, XN, Wgu + (size_t)2 * NGU * DM, TT, NGU, DM, EpiSwiglu{BIG, DFF, SSQ + 3 * TT}); } }
    SYNC(9);
    if (IN(10)) run_gemm(lds, BIG, Wd + (size_t)2 * DM * DFF, TT, DM, DFF, EpiResid<false, false, 1>{nullptr, nullptr, XN, SSQ + 4 * TT}, WGM_DOWN);
    if (IN(10) && ((DUPMASK >> 10) & 1u)) run_gemm(lds, BIG, Wd + (size_t)2 * DM * DFF, TT, DM, DFF, EpiResid<false, false, 2>{nullptr, nullptr, XN, nullptr});
    SYNC(10);
    if (IN(11)) { run_gemm(lds, XN, Wqkv, TT, QW, DM, EpiQkv{BIG, acos_, asin_, SSQ + 4 * TT}); if ((DUPMASK >> 11) & 1u) { run_gemm(lds, XN, Wqkv, TT, QW, DM, EpiQkv{BIG, acos_, asin_, SSQ + 4 * TT}); } }
    SYNC(11);
#ifndef NO_A1
    if (IN(12)) REP(12) { const float lam = ((const float*)(ws + WS_CTL))[0]; attn_phase<1>(lds, BIG, QW, 2048, 4096, 8, YC, nullptr, P.in[24], lam, vcu, G); }
#endif
    SYNC(12);
    if (IN(13)) run_gemm(lds, YC, Wco, TT, DM, DM, EpiResid<false, false, 0>{nullptr, nullptr, XN, SSQ + 5 * TT});
    if (IN(13) && ((DUPMASK >> 13) & 1u)) run_gemm(lds, YC, Wco, TT, DM, DM, EpiResid<false, false, 2>{nullptr, nullptr, XN, nullptr});
    SYNC(13);
    if (IN(14)) { run_gemm(lds, XN, Wgu + (size_t)3 * NGU * DM, TT, NGU, DM, EpiSwiglu{BIG, DFF, SSQ + 5 * TT}); if ((DUPMASK >> 14) & 1u) { run_gemm(lds, XN, Wgu + (size_t)3 * NGU * DM, TT, NGU, DM, EpiSwiglu{BIG, DFF, SSQ + 5 * TT}); } }
    SYNC(14);
    if (IN(15)) run_gemm(lds, BIG, Wd + (size_t)3 * DM * DFF, TT, DM, DFF, EpiResid<false, false, 1>{nullptr, nullptr, XN, SSQ + 6 * TT}, WGM_DOWN);
    if (IN(15) && ((DUPMASK >> 15) & 1u)) run_gemm(lds, BIG, Wd + (size_t)3 * DM * DFF, TT, DM, DFF, EpiResid<false, false, 2>{nullptr, nullptr, XN, nullptr});
    SYNC(15);
    if (IN(16)) final_phase(XN, SSQ + 6 * TT, P.in[25], out, gw, NGW, lane);
#undef IN
#undef SYNC
}

extern "C" void kernel_launch(void* const* d_in, const int* in_sizes, int n_in, void* d_out, int out_size, void* d_ws, size_t ws_size, hipStream_t stream) {
    static int grid = 0;
    if (grid == 0) {
        if (n_in != 26 || out_size != TT * DM || ws_size < WS_END) { fprintf(stderr, "kernel_launch: unexpected shapes (n_in %d, out %d, ws %zu < %zu)\n", n_in, out_size, ws_size, (size_t)WS_END); grid = -1; return; }
        int dev = 0, cus = 0, per_cu = 0;
        hipGetDevice(&dev); hipDeviceGetAttribute(&cus, hipDeviceAttributeMultiprocessorCount, dev);
        if (hipFuncSetAttribute((const void*)fwd_megakernel, hipFuncAttributeMaxDynamicSharedMemorySize, LDS_BYTES) != hipSuccess) { fprintf(stderr, "kernel_launch: hipFuncSetAttribute failed\n"); grid = -1; return; }
        if (hipOccupancyMaxActiveBlocksPerMultiprocessor(&per_cu, (const void*)fwd_megakernel, 512, LDS_BYTES) != hipSuccess || per_cu < 1) { fprintf(stderr, "kernel_launch: occupancy query says %d\n", per_cu); per_cu = 1; }
        (void)hipGetLastError();
        grid = cus * per_cu;
        fprintf(stderr, "kernel_launch: grid %d (cus %d x %d)\n", grid, cus, per_cu);
    }
    if (grid < 0) return;
    if (hipMemsetAsync((char*)d_ws + WS_BAR, 0, BAR_BYTES, stream) != hipSuccess) { fprintf(stderr, "kernel_launch: hipMemsetAsync failed\n"); return; }
    Params p{};
    for (int i = 0; i < 26; ++i) p.in[i] = (const float*)d_in[i];
    p.out = (float*)d_out; p.ws = (unsigned char*)d_ws;
#if MK_PER_PHASE
    for (int k = 0; k < NPHASE; ++k) { p.lo = k; p.hi = k + 1; hipLaunchKernelGGL(fwd_megakernel, dim3(grid), dim3(512), LDS_BYTES, stream, p); }
#else
    p.lo = 0; p.hi = NPHASE;
    void* args[] = {&p};
    hipError_t e = hipLaunchCooperativeKernel((const void*)fwd_megakernel, dim3(grid), dim3(512), args, LDS_BYTES, stream);
    if (e != hipSuccess) fprintf(stderr, "cooperative launch failed: %s (grid %d)\n", hipGetErrorString(e), grid);
#endif
}
```

```cpp
#include <hip/hip_runtime.h>
#include <hip/hip_cooperative_groups.h>
#include <cstdio>
#include <cstdint>
namespace cg = cooperative_groups;

#define LAS __attribute__((address_space(3)))
typedef unsigned short bf16_t;
typedef unsigned long long u64_t;
constexpr float SSQ_FIX = 16777216.0f, SSQ_INV = 1.0f / 16777216.0f;
typedef short bf16x8 __attribute__((ext_vector_type(8)));
typedef short s16x4 __attribute__((ext_vector_type(4)));
typedef float f32x4 __attribute__((ext_vector_type(4)));
typedef float f32x2 __attribute__((ext_vector_type(2)));
typedef float f32x16 __attribute__((ext_vector_type(16)));
typedef unsigned u32x4 __attribute__((ext_vector_type(4)));
typedef unsigned u32x2 __attribute__((ext_vector_type(2)));

#ifndef MK_PER_PHASE
#define MK_PER_PHASE 0
#endif

constexpr int TT = 32768, SEQ = 2048, DM = 2048, DFF = 5504, NGU = 2 * DFF;
constexpr int PW = 5120, QW = 6144;
constexpr float EPS = 1e-6f;
constexpr float LAMBDA_INIT = 0.35550906759f;
constexpr float QSCALE = 0.08838834764831845f * 1.4426950408889634f;

constexpr size_t MiB = 1u << 20;
constexpr size_t WS_CTL = 0, WS_BAR = 4096, BAR_BYTES = 16384;
constexpr size_t WS_RCOS = 1 * MiB, WS_RSIN = 2 * MiB, WS_ACOS = 3 * MiB, WS_ASIN = 3 * MiB + 128 * 1024, WS_S5A = 3 * MiB + 512 * 1024, WS_S5BB = 4 * MiB;
constexpr size_t WS_W = 8 * MiB;
constexpr size_t SZ_WGU = (size_t)NGU * DM * 2, SZ_WD = (size_t)DM * DFF * 2;
constexpr size_t WS_WGU = WS_W, WS_WD = WS_WGU + 4 * SZ_WGU, WS_WIN = WS_WD + 4 * SZ_WD, WS_WOUT = WS_WIN + (size_t)PW * DM * 2,
                 WS_WGLU = WS_WOUT + (size_t)DM * DM * 2, WS_WQKV = WS_WGLU + (size_t)1024 * 1024 * 2, WS_WCO = WS_WQKV + (size_t)QW * DM * 2,
                 WS_WEND = WS_WCO + (size_t)DM * DM * 2;
constexpr size_t WS_XN = 328 * MiB;
constexpr size_t WS_BIG = 456 * MiB;
constexpr size_t WS_Z = WS_BIG + (size_t)TT * PW * 2;
constexpr size_t WS_YC = WS_BIG + (size_t)TT * QW * 2;
constexpr size_t WS_END = WS_YC + (size_t)TT * DM * 2;
constexpr size_t WS_SSQ = 5 * MiB;
static_assert(WS_WEND <= WS_XN && WS_XN + (size_t)TT * DM * 2 <= WS_BIG && WS_Z + (size_t)TT * 1024 * 2 <= WS_END, "ws map");

constexpr int LDS_BYTES = 147456;

namespace pg8 {
constexpr int BM = 256, BK = 64, HALF = 128, HTB = HALF * BK * 2, STAGE_BYTES = 8 * HTB, NXCD = 8;
__host__ __device__ __forceinline__ int lds_byte(int r, int c) { const int st = (r >> 4) * 2 + (c >> 5), rr = r & 15, cc = c & 31, ob = rr * 64 + cc * 2; return st * 1024 + (ob ^ (((ob >> 9) & 1) << 5)); }
__host__ __device__ __forceinline__ void stage_rc(int b, int& R, int& C) { const int st = b / 1024, sb = b % 1024, swz = sb ^ (((sb >> 9) & 1) << 5); R = (st >> 1) * 16 + swz / 64; C = (st & 1) * 32 + (swz % 64) / 2; }
__host__ __device__ __forceinline__ int perm32(int rho) { const int n = rho >> 4, i = rho & 15; return 8 * (i >> 2) + 4 * n + (i & 3); }
struct Unit { int pm, pn; };
struct Gemm { const bf16_t* A; const bf16_t* Bt; int M, N, K; };
struct StaticOrder {
    int nM, nN, nwg, G, c, WGM;
    __host__ __device__ void init(int M, int N, int G_, int c_, int wgm_ = 8) { nM = M / BM; nN = N / BM; nwg = nM * nN; G = G_; c = c_; WGM = wgm_; }
    __host__ __device__ bool next(int i, Unit& u) const {
        const long L = (long)i * G + c; if (L >= nwg) return false;
        int wgid = (int)L; { const int q = nwg / NXCD, r = nwg % NXCD, xcd = wgid % NXCD, off = wgid / NXCD; wgid = (xcd < r ? xcd * (q + 1) : r * (q + 1) + (xcd - r) * q) + off; }
        const int nig = WGM * nN, gid = wgid / nig, fm = gid * WGM, gsz = (nM - fm) < WGM ? (nM - fm) : WGM;
        u.pm = fm + ((wgid % nig) % gsz); u.pn = (wgid % nig) / gsz; return true;
    }
    __device__ __forceinline__ void a_ready(const Unit&) const {}
    __device__ __forceinline__ void done(const Unit&) const {}
};
__device__ __forceinline__ unsigned cvt_pk_bf16(float lo, float hi) { unsigned r; asm volatile("v_cvt_pk_bf16_f32 %0, %1, %2" : "=v"(r) : "v"(lo), "v"(hi)); return r; }

template <class Epi, class Sched, bool ALIGN_EPI = false, bool SP2 = false>
__device__ __forceinline__ void gemm_phase(LAS unsigned char* lds, const Gemm g, const Sched S, const Epi E) {
    const int tid = threadIdx.x, wid = __builtin_amdgcn_readfirstlane(tid >> 6), lane = tid & 63, wr = wid >> 2, wc = wid & 3, fr = lane & 15, fq = lane >> 4;
    const int K = g.K, nt = K / BK;
    unsigned voffA[2], voffB[2];
#pragma unroll
    for (int i = 0; i < 2; ++i) { int R, C; stage_rc(tid * 16 + i * 8192, R, C); const int Rb = Epi::PERM ? ((R & ~31) + perm32(R & 31)) : R;
        voffA[i] = (unsigned)(R * K + C) * 2u; voffB[i] = (unsigned)(Rb * K + C) * 2u; }
    const size_t kstep = (size_t)(BK * 2);
    const size_t hstep = (size_t)HALF * K * 2;
    const size_t tstep = 2 * hstep;
    const unsigned ldsw = (unsigned)wid * 1024u;
    const int aoff = lds_byte(wr * 64 + fr, fq * 8), boff = lds_byte(wc * 32 + fr, fq * 8);
#define PG8_SA(b, h) (((b) * 2 + (h)) * HTB)
#define PG8_SB(b, h) ((4 + (b) * 2 + (h)) * HTB)
#define PG8_STAGE(bufoff, gbase, voff) do { _Pragma("unroll") for (int _i = 0; _i < 2; ++_i) \
        __builtin_amdgcn_global_load_lds((const unsigned*)((const char*)(gbase) + (voff)[_i]), (LAS unsigned*)(lds + (bufoff) + ldsw + _i * 8192), 16, 0, 0); } while (0)
#define PG8_LDA(dst, b, h) do { _Pragma("unroll") for (int m = 0; m < 4; ++m) _Pragma("unroll") for (int k = 0; k < 2; ++k) dst[m][k] = *(const LAS bf16x8*)(lds + PG8_SA(b, h) + aoff + m * 2048 + k * 1024); } while (0)
#define PG8_LDB(dst, b, h) do { _Pragma("unroll") for (int n = 0; n < 2; ++n) _Pragma("unroll") for (int k = 0; k < 2; ++k) dst[n][k] = *(const LAS bf16x8*)(lds + PG8_SB(b, h) + boff + n * 2048 + k * 1024); } while (0)
#define PG8_MMA(ai, bj, At, Bt) do { __builtin_amdgcn_s_setprio(1); _Pragma("unroll") for (int m = 0; m < 4; ++m) _Pragma("unroll") for (int n = 0; n < 2; ++n) _Pragma("unroll") for (int k = 0; k < 2; ++k) \
        acc[ai][bj][m][n] = __builtin_amdgcn_mfma_f32_16x16x32_bf16(Bt[n][k], At[m][k], acc[ai][bj][m][n], 0, 0, 0); __builtin_amdgcn_s_setprio(0); } while (0)
#define PG8_WAIT_V(n) asm volatile("s_waitcnt vmcnt(" #n ")" ::: "memory")
#define PG8_WAIT_L(n) asm volatile("s_waitcnt lgkmcnt(" #n ")" ::: "memory")
#define PG8_BAR __builtin_amdgcn_s_barrier()
#define PG8_SCHED __builtin_amdgcn_sched_barrier(0)
    Unit cur, nxt; int ui = 0;
    if (!S.next(0, cur)) return;
    f32x4 acc[2][2][4][2];
#pragma unroll
    for (int a = 0; a < 2; ++a)
#pragma unroll
        for (int b = 0; b < 2; ++b)
#pragma unroll
            for (int m = 0; m < 4; ++m)
#pragma unroll
                for (int n = 0; n < 2; ++n) acc[a][b][m][n] = (f32x4){0.f, 0.f, 0.f, 0.f};
    bf16x8 At[4][2], B0[2][2], B1[2][2];
    const char* cA = (const char*)g.A + (size_t)cur.pm * tstep; const char* cB = (const char*)g.Bt + (size_t)cur.pn * tstep;
    S.a_ready(cur);
    if constexpr (SP2) {
        PG8_STAGE(PG8_SB(0, 0), cB, voffB); PG8_STAGE(PG8_SB(0, 1), cB + hstep, voffB); PG8_STAGE(PG8_SA(0, 0), cA, voffA); PG8_STAGE(PG8_SA(0, 1), cA + hstep, voffA);
        if (wr == 1) PG8_BAR;
        PG8_WAIT_V(2); PG8_BAR;
        PG8_STAGE(PG8_SB(1, 0), cB + kstep, voffB); PG8_STAGE(PG8_SA(1, 0), cA + kstep, voffA); PG8_STAGE(PG8_SB(1, 1), cB + hstep + kstep, voffB);
        PG8_WAIT_V(6); PG8_BAR;
    } else {
        PG8_STAGE(PG8_SB(0, 0), cB, voffB); PG8_STAGE(PG8_SA(0, 0), cA, voffA); PG8_STAGE(PG8_SB(0, 1), cB + hstep, voffB); PG8_STAGE(PG8_SA(0, 1), cA + hstep, voffA);
        if (wr == 1) PG8_BAR;
        PG8_WAIT_V(4); PG8_BAR;
        PG8_STAGE(PG8_SB(1, 0), cB + kstep, voffB); PG8_STAGE(PG8_SA(1, 0), cA + kstep, voffA); PG8_STAGE(PG8_SB(1, 1), cB + hstep + kstep, voffB);
        PG8_WAIT_V(6); PG8_BAR;
    }
    for (;;) {
        const bool has_next = S.next(ui + 1, nxt);
        const char* nA = has_next ? (const char*)g.A + (size_t)nxt.pm * tstep : cA; const char* nB = has_next ? (const char*)g.Bt + (size_t)nxt.pn * tstep : cB;
        for (int t = 0; t < nt; t += 2) {
            const bool last = (t == nt - 2);
            const char* a1 = cA + (size_t)(t + 1) * kstep;
            const char* a2 = last ? nA : cA + (size_t)(t + 2) * kstep; const char* b2 = last ? nB : cB + (size_t)(t + 2) * kstep;
            const char* a3 = a2 + kstep; const char* b3 = b2 + kstep;
            if (last && has_next) S.a_ready(nxt);
            if constexpr (SP2) {
            PG8_LDB(B0, 0, 0); PG8_LDB(B1, 0, 1); PG8_SCHED; PG8_LDA(At, 0, 0); PG8_STAGE(PG8_SA(1, 1), a1 + hstep, voffA);
            PG8_WAIT_V(8); PG8_WAIT_L(0); PG8_BAR; PG8_MMA(0, 0, At, B0); PG8_MMA(0, 1, At, B1); PG8_BAR; PG8_SCHED;
            PG8_LDA(At, 0, 1); PG8_STAGE(PG8_SB(0, 0), b2, voffB); PG8_STAGE(PG8_SB(0, 1), b2 + hstep, voffB); PG8_STAGE(PG8_SA(0, 0), a2, voffA);
            PG8_WAIT_V(8); PG8_WAIT_L(0); PG8_BAR; PG8_MMA(1, 0, At, B0); PG8_MMA(1, 1, At, B1); PG8_BAR; PG8_SCHED;
            PG8_LDB(B0, 1, 0); PG8_LDB(B1, 1, 1); PG8_SCHED; PG8_LDA(At, 1, 0); PG8_STAGE(PG8_SA(0, 1), a2 + hstep, voffA);
            PG8_WAIT_V(8); PG8_WAIT_L(0); PG8_BAR; PG8_MMA(0, 0, At, B0); PG8_MMA(0, 1, At, B1); PG8_BAR; PG8_SCHED;
            PG8_LDA(At, 1, 1); PG8_STAGE(PG8_SB(1, 0), b3, voffB); PG8_STAGE(PG8_SB(1, 1), b3 + hstep, voffB); PG8_STAGE(PG8_SA(1, 0), a3, voffA);
            PG8_WAIT_V(8); PG8_WAIT_L(0); PG8_BAR; PG8_MMA(1, 0, At, B0); PG8_MMA(1, 1, At, B1); PG8_BAR; PG8_SCHED;
            } else {
            PG8_LDB(B0, 0, 0); PG8_SCHED; PG8_LDA(At, 0, 0); PG8_STAGE(PG8_SA(1, 1), a1 + hstep, voffA);
            PG8_WAIT_L(8); PG8_BAR; PG8_WAIT_L(0); PG8_MMA(0, 0, At, B0); PG8_BAR; PG8_SCHED;
            PG8_LDB(B1, 0, 1); PG8_STAGE(PG8_SB(0, 0), b2, voffB);
            PG8_BAR; PG8_WAIT_L(0); PG8_MMA(0, 1, At, B1); PG8_BAR;
            PG8_LDA(At, 0, 1); PG8_STAGE(PG8_SA(0, 0), a2, voffA);
            PG8_BAR; PG8_WAIT_L(0); PG8_MMA(1, 0, At, B0); PG8_BAR; PG8_SCHED;
            PG8_STAGE(PG8_SB(0, 1), b2 + hstep, voffB);
            PG8_WAIT_V(6); PG8_BAR; PG8_MMA(1, 1, At, B1); PG8_BAR;
            PG8_LDB(B0, 1, 0); PG8_SCHED; PG8_LDA(At, 1, 0); PG8_STAGE(PG8_SA(0, 1), a2 + hstep, voffA);
            PG8_WAIT_L(8); PG8_BAR; PG8_WAIT_L(0); PG8_MMA(0, 0, At, B0); PG8_BAR; PG8_SCHED;
            PG8_LDB(B1, 1, 1); PG8_STAGE(PG8_SB(1, 0), b3, voffB);
            PG8_BAR; PG8_WAIT_L(0); PG8_MMA(0, 1, At, B1); PG8_BAR;
            PG8_LDA(At, 1, 1); PG8_STAGE(PG8_SA(1, 0), a3, voffA);
            PG8_BAR; PG8_WAIT_L(0); PG8_MMA(1, 0, At, B0); PG8_BAR; PG8_SCHED;
            PG8_STAGE(PG8_SB(1, 1), b3 + hstep, voffB);
            PG8_WAIT_V(6); PG8_BAR; PG8_MMA(1, 1, At, B1); PG8_BAR;
            }
        }
        if constexpr (ALIGN_EPI) { if (wr == 0) PG8_BAR; }
        if constexpr (!Epi::AFTER_DRAIN) { E(acc, cur, wr, wc, fr, fq); S.done(cur); }
        if (!has_next) break;
#pragma unroll
        for (int a = 0; a < 2; ++a)
#pragma unroll
            for (int b = 0; b < 2; ++b)
#pragma unroll
                for (int m = 0; m < 4; ++m)
#pragma unroll
                    for (int n = 0; n < 2; ++n) acc[a][b][m][n] = (f32x4){0.f, 0.f, 0.f, 0.f};
        cur = nxt; cA = nA; cB = nB; ++ui;
        if constexpr (ALIGN_EPI) { if (wr == 1) PG8_BAR; }
    }
    PG8_WAIT_V(0);
    if constexpr (!ALIGN_EPI) { if (wr == 0) PG8_BAR; }
    PG8_BAR;
#undef PG8_SA
#undef PG8_SB
#undef PG8_STAGE
#undef PG8_LDA
#undef PG8_LDB
#undef PG8_MMA
#undef PG8_WAIT_V
#undef PG8_WAIT_L
#undef PG8_BAR
#undef PG8_SCHED
}
}

__device__ __forceinline__ unsigned f2bf(float f) { unsigned u = __builtin_bit_cast(unsigned, f); return (u + 0x7fffu + ((u >> 16) & 1u)) >> 16; }
__device__ __forceinline__ unsigned pk2(float lo, float hi) { return f2bf(lo) | (f2bf(hi) << 16); }
__device__ __forceinline__ float bf2f(unsigned short b) { return __builtin_bit_cast(float, (unsigned)b << 16); }
__device__ __forceinline__ float bflo(unsigned w) { return __builtin_bit_cast(float, w << 16); }
__device__ __forceinline__ float bfhi(unsigned w) { return __builtin_bit_cast(float, w & 0xffff0000u); }
__device__ __forceinline__ float fast_sigmoid(float x) { return __builtin_amdgcn_rcpf(1.0f + __builtin_amdgcn_exp2f(-1.4426950408889634f * x)); }
__device__ __forceinline__ float silu_f(float x) { return x * fast_sigmoid(x); }
__device__ __forceinline__ float gelu_tanh_f(float y) { return y * fast_sigmoid(1.5957691216057308f * (y + 0.044715f * y * y * y)); }
__device__ __forceinline__ float wave_sum(float v) {
#pragma unroll
    for (int o = 1; o < 64; o <<= 1) v += __shfl_xor(v, o);
    return v;
}
__device__ __forceinline__ void sincos_d(double a, double& s, double& c) {
    const double k = rint(a * 0.15915494309189535);
    const double r = fma(-k, 6.283185307179586, a), r2 = r * r;
    double ts = r, tc = 1.0; s = r; c = 1.0;
    for (int n = 1; n <= 13; ++n) { tc *= -r2 / (double)((2 * n - 1) * (2 * n)); c += tc; ts *= -r2 / (double)((2 * n) * (2 * n + 1)); s += ts; }
}

using pg8::Unit; using pg8::cvt_pk_bf16;
struct EpiSwiglu {
    static constexpr bool PERM = true, AFTER_DRAIN = false;
    bf16_t* O; int ldo; const u64_t* ssq;
    __device__ __forceinline__ void operator()(const f32x4 (&acc)[2][2][4][2], const Unit& u, int wr, int wc, int fr, int fq) const {
        const int row0 = u.pm * 256 + wr * 64 + fr, col0 = u.pn * 128 + wc * 32 + 8 * fq;
        float rsv[2][4];
#pragma unroll
        for (int ai = 0; ai < 2; ++ai)
#pragma unroll
            for (int m = 0; m < 4; ++m) rsv[ai][m] = (float)ssq[row0 + ai * 128 + m * 16] * SSQ_INV;
#pragma unroll
        for (int ai = 0; ai < 2; ++ai)
#pragma unroll
            for (int m = 0; m < 4; ++m) {
                const int row = row0 + ai * 128 + m * 16;
                const float rs = __builtin_amdgcn_rsqf(rsv[ai][m] * (1.0f / DM) + EPS);
                bf16_t* rowp = O + (size_t)row * ldo + col0;
                const f32x4 g0 = acc[ai][0][m][0] * rs, g1 = acc[ai][0][m][1] * rs, u0 = acc[ai][1][m][0] * rs, u1 = acc[ai][1][m][1] * rs;
                u32x4 w;
                w.x = cvt_pk_bf16(silu_f(g0[0]) * u0[0], silu_f(g0[1]) * u0[1]); w.y = cvt_pk_bf16(silu_f(g0[2]) * u0[2], silu_f(g0[3]) * u0[3]);
                w.z = cvt_pk_bf16(silu_f(g1[0]) * u1[0], silu_f(g1[1]) * u1[1]); w.w = cvt_pk_bf16(silu_f(g1[2]) * u1[2], silu_f(g1[3]) * u1[3]);
                *(u32x4*)rowp = w;
            }
    }
};
template <bool BASE_F32, bool OUT_F32, int SCALE> struct EpiResid {
    static constexpr bool PERM = false, AFTER_DRAIN = false;
    const float* basef; float* outf; bf16_t* xb; u64_t* ssq;
    __device__ __forceinline__ void operator()(const f32x4 (&acc)[2][2][4][2], const Unit& u, int wr, int wc, int fr, int fq) const {
        const int col0 = u.pn * 256 + wc * 32 + 4 * fq;
        constexpr float sc = (SCALE == 2 ? 0.0f : SCALE == 1 ? 0.5f : 1.0f);
#pragma unroll
        for (int ai = 0; ai < 2; ++ai) {
            f32x4 pre[4][2][2];
#pragma unroll
            for (int m = 0; m < 4; ++m) { const size_t off = (size_t)(u.pm * 256 + ai * 128 + wr * 64 + m * 16 + fr) * DM + col0;
#pragma unroll
                for (int bj = 0; bj < 2; ++bj)
#pragma unroll
                    for (int n = 0; n < 2; ++n) {
                        if constexpr (BASE_F32) pre[m][bj][n] = *(const f32x4*)(basef + off + bj * 128 + n * 16);
                        else { const u32x2 w = *(const u32x2*)(xb + off + bj * 128 + n * 16); pre[m][bj][n] = (f32x4){bflo(w.x), bfhi(w.x), bflo(w.y), bfhi(w.y)}; } } }
#pragma unroll
            for (int m = 0; m < 4; ++m) {
                const int row = u.pm * 256 + ai * 128 + wr * 64 + m * 16 + fr;
                const size_t off = (size_t)row * DM + col0;
                float sq = 0.f;
#pragma unroll
                for (int bj = 0; bj < 2; ++bj)
#pragma unroll
                    for (int n = 0; n < 2; ++n) { const f32x4 v = pre[m][bj][n] + acc[ai][bj][m][n] * sc;
                        if constexpr (OUT_F32) *(f32x4*)(outf + off + bj * 128 + n * 16) = v;
                        else { u32x2 w; w.x = cvt_pk_bf16(v[0], v[1]); w.y = cvt_pk_bf16(v[2], v[3]); *(u32x2*)(xb + off + bj * 128 + n * 16) = w;
                               sq += (v[0] * v[0] + v[1] * v[1]) + (v[2] * v[2] + v[3] * v[3]); } }
                if constexpr (!OUT_F32 && SCALE != 2) { sq += __shfl_xor(sq, 16); sq += __shfl_xor(sq, 32); if (fq == 0) atomicAdd(ssq + row, (u64_t)(sq * SSQ_FIX)); }
            }
        }
    }
};
struct EpiWin {
    static constexpr bool PERM = true, AFTER_DRAIN = false;
    bf16_t* O; const float* cs; const float* sn; const u64_t* ssq;
    __device__ __forceinline__ void operator()(const f32x4 (&acc)[2][2][4][2], const Unit& u, int wr, int wc, int fr, int fq) const {
        const int row0 = u.pm * 256 + wr * 64 + fr, col0 = u.pn * 256 + wc * 32 + 8 * fq;
        const bool rot = u.pn < 8;
        float rsv[2][4];
#pragma unroll
        for (int ai = 0; ai < 2; ++ai)
#pragma unroll
            for (int m = 0; m < 4; ++m) rsv[ai][m] = (float)ssq[row0 + ai * 128 + m * 16] * SSQ_INV;
#pragma unroll
        for (int ai = 0; ai < 2; ++ai) {
            f32x4 cc[4][2], sv[4][2];
#pragma unroll
            for (int m = 0; m < 4; ++m) {
                if (rot) { const int pos = (row0 + ai * 128 + m * 16) & (SEQ - 1);
                    const float* cp = cs + pos * 128 + wc * 32 + 8 * fq; const float* sp = sn + pos * 128 + wc * 32 + 8 * fq;
                    cc[m][0] = *(const f32x4*)cp; cc[m][1] = *(const f32x4*)(cp + 4); sv[m][0] = *(const f32x4*)sp; sv[m][1] = *(const f32x4*)(sp + 4); }
                else { cc[m][0] = cc[m][1] = (f32x4){1.f, 1.f, 1.f, 1.f}; sv[m][0] = sv[m][1] = (f32x4){0.f, 0.f, 0.f, 0.f}; }
            }
#pragma unroll
            for (int m = 0; m < 4; ++m) {
                const int row = row0 + ai * 128 + m * 16;
                const float rs = __builtin_amdgcn_rsqf(rsv[ai][m] * (1.0f / DM) + EPS);
                const f32x4 a0 = acc[ai][0][m][0] * rs, a1 = acc[ai][0][m][1] * rs, b0 = acc[ai][1][m][0] * rs, b1 = acc[ai][1][m][1] * rs;
                const f32x4 na0 = a0 * cc[m][0] - b0 * sv[m][0], nb0 = b0 * cc[m][0] + a0 * sv[m][0], na1 = a1 * cc[m][1] - b1 * sv[m][1], nb1 = b1 * cc[m][1] + a1 * sv[m][1];
                bf16_t* rowp = O + (size_t)row * PW + col0;
                u32x4 w; w.x = cvt_pk_bf16(na0[0], na0[1]); w.y = cvt_pk_bf16(na0[2], na0[3]); w.z = cvt_pk_bf16(na1[0], na1[1]); w.w = cvt_pk_bf16(na1[2], na1[3]);
                *(u32x4*)rowp = w;
                u32x4 v; v.x = cvt_pk_bf16(nb0[0], nb0[1]); v.y = cvt_pk_bf16(nb0[2], nb0[3]); v.z = cvt_pk_bf16(nb1[0], nb1[1]); v.w = cvt_pk_bf16(nb1[2], nb1[3]);
                *(u32x4*)(rowp + 128) = v;
            }
        }
    }
};
struct EpiQkv {
    static constexpr bool PERM = false, AFTER_DRAIN = false;
    bf16_t* O; const float* cs; const float* sn; const u64_t* ssq;
    __device__ __forceinline__ void operator()(const f32x4 (&acc)[2][2][4][2], const Unit& u, int wr, int wc, int fr, int fq) const {
        const int col0 = u.pn * 256 + wc * 32 + 4 * fq;
        const bool rot = (u.pn < 16) && (wc == 0);
        const float sc0 = (u.pn < 8) ? QSCALE : 1.0f;
        float rsv[2][4]; f32x4 cv[2][4], sv[2][4];
#pragma unroll
        for (int ai = 0; ai < 2; ++ai)
#pragma unroll
            for (int m = 0; m < 4; ++m) { const int row = u.pm * 256 + ai * 128 + wr * 64 + m * 16 + fr; rsv[ai][m] = (float)ssq[row] * SSQ_INV;
                if (rot) { const int pos = row & (SEQ - 1); cv[ai][m] = *(const f32x4*)(cs + pos * 16 + 4 * fq); sv[ai][m] = *(const f32x4*)(sn + pos * 16 + 4 * fq); }
                else { cv[ai][m] = (f32x4){1.f, 1.f, 1.f, 1.f}; sv[ai][m] = (f32x4){0.f, 0.f, 0.f, 0.f}; } }
#pragma unroll
        for (int ai = 0; ai < 2; ++ai)
#pragma unroll
            for (int m = 0; m < 4; ++m) {
                const int row = u.pm * 256 + ai * 128 + wr * 64 + m * 16 + fr;
                const float sc = sc0 * __builtin_amdgcn_rsqf(rsv[ai][m] * (1.0f / DM) + EPS);
                const f32x4 c = cv[ai][m], s = sv[ai][m];
#pragma unroll
                for (int bj = 0; bj < 2; ++bj) {
                    const f32x4 x0 = acc[ai][bj][m][0], x1 = acc[ai][bj][m][1];
                    const f32x4 n0 = (x0 * c - x1 * s) * sc, n1 = (x1 * c + x0 * s) * sc;
                    bf16_t* p = O + (size_t)row * QW + col0 + bj * 128;
                    u32x2 w0; w0.x = cvt_pk_bf16(n0[0], n0[1]); w0.y = cvt_pk_bf16(n0[2], n0[3]); *(u32x2*)p = w0;
                    u32x2 w1; w1.x = cvt_pk_bf16(n1[0], n1[1]); w1.y = cvt_pk_bf16(n1[2], n1[3]); *(u32x2*)(p + 16) = w1;
                }
            }
    }
};
struct EpiGlu {
    static constexpr bool PERM = true, AFTER_DRAIN = false;
    const bf16_t* Z; const float* bias; bf16_t* Y;
    __device__ __forceinline__ void operator()(const f32x4 (&acc)[2][2][4][2], const Unit& u, int wr, int wc, int fr, int fq) const {
        const int row0 = u.pm * 256 + wr * 64 + fr, col0 = u.pn * 256 + wc * 32 + 8 * fq;
#pragma unroll
        for (int bj = 0; bj < 2; ++bj) {
            const f32x4 bv0 = *(const f32x4*)(bias + col0 + bj * 128), bv1 = *(const f32x4*)(bias + col0 + bj * 128 + 4);
            u32x4 zz[2][4];
#pragma unroll
            for (int ai = 0; ai < 2; ++ai)
#pragma unroll
                for (int m = 0; m < 4; ++m) zz[ai][m] = *(const u32x4*)(Z + (size_t)(row0 + ai * 128 + m * 16) * 1024 + col0 + bj * 128);
#pragma unroll
            for (int ai = 0; ai < 2; ++ai)
#pragma unroll
                for (int m = 0; m < 4; ++m) {
                    const int row = row0 + ai * 128 + m * 16;
                    const u32x4 z4 = zz[ai][m];
                    const f32x4 v0 = acc[ai][bj][m][0] + bv0, v1 = acc[ai][bj][m][1] + bv1;
                    u32x4 w;
                    w.x = cvt_pk_bf16(bflo(z4.x) * fast_sigmoid(v0[0]), bfhi(z4.x) * fast_sigmoid(v0[1]));
                    w.y = cvt_pk_bf16(bflo(z4.y) * fast_sigmoid(v0[2]), bfhi(z4.y) * fast_sigmoid(v0[3]));
                    w.z = cvt_pk_bf16(bflo(z4.z) * fast_sigmoid(v1[0]), bfhi(z4.z) * fast_sigmoid(v1[1]));
                    w.w = cvt_pk_bf16(bflo(z4.w) * fast_sigmoid(v1[2]), bfhi(z4.w) * fast_sigmoid(v1[3]));
                    *(u32x4*)(Y + (size_t)row * DM + 1024 + col0 + bj * 128) = w;
                }
        }
    }
};

template <class Epi>
__device__ __forceinline__ void run_gemm(LAS unsigned char* lds, const bf16_t* A, const bf16_t* Bt, int M, int N, int K, const Epi E, int wgm = 8) {
    pg8::Gemm g{A, Bt, M, N, K}; pg8::StaticOrder S; S.init(M, N, (int)gridDim.x, (int)blockIdx.x, wgm);
    pg8::gemm_phase<Epi, pg8::StaticOrder, true, true>(lds, g, S, E);
}

__device__ __forceinline__ void conv_matrix(const float* __restrict__ W, bf16_t* __restrict__ WT, int K, int N, int mode, const float* __restrict__ gain, LAS float* scr, int gw, int NGW, int lane) {
    const int nblk = N / 64, nitems = (K / 64) * nblk;
    for (int item = gw; item < nitems; item += NGW) {
        const int kb = item / nblk, nb = item % nblk, k0 = 64 * kb, n0 = 64 * nb;
        const float gv = gain ? gain[k0 + lane] : 1.0f;
        const float* wp = W + (size_t)k0 * N + n0 + lane;
#pragma unroll
        for (int hb = 0; hb < 2; ++hb) {
            float v[32];
#pragma unroll
            for (int i = 0; i < 32; ++i) v[i] = wp[(size_t)(32 * hb + i) * N];
            asm volatile("" ::: "memory");
#pragma unroll
            for (int i = 0; i < 32; ++i) scr[(32 * hb + i) * 65 + lane] = v[i] * __builtin_bit_cast(float, __builtin_amdgcn_readlane(__builtin_bit_cast(int, gv), 32 * hb + i));
        }
        asm volatile("s_waitcnt lgkmcnt(0)" ::: "memory");
        const int c = lane & 7, ns = lane >> 3;
        const int rbase = (mode == 0) ? n0 : ((n0 >> 7) * 256 + (n0 & 127) + (mode == 2 ? 128 : 0));
#pragma unroll
        for (int j = 0; j < 8; ++j) { const int n = ns + 8 * j; const LAS float* sp = scr + (8 * c) * 65 + n;
            u32x4 o; o.x = pk2(sp[0 * 65], sp[1 * 65]); o.y = pk2(sp[2 * 65], sp[3 * 65]); o.z = pk2(sp[4 * 65], sp[5 * 65]); o.w = pk2(sp[6 * 65], sp[7 * 65]);
            *(u32x4*)(WT + (size_t)(rbase + n) * K + k0 + 8 * c) = o; }
        asm volatile("s_waitcnt lgkmcnt(0)" ::: "memory");
    }
}

template <bool TO_BF16>
__device__ __forceinline__ void rmsnorm_phase(const float* in, const float* __restrict__ g, bf16_t* outb, float* outf, int gw, int NGW, int lane) {
    f32x4 gv[8];
#pragma unroll
    for (int j = 0; j < 8; ++j) gv[j] = ((const f32x4*)g)[lane + 64 * j];
    for (int row = gw; row < TT; row += NGW) {
        const f32x4* xr = (const f32x4*)(in + (size_t)row * DM) + lane;
        f32x4 v[8]; float ss = 0.f;
#pragma unroll
        for (int j = 0; j < 8; ++j) { v[j] = xr[64 * j]; ss += (v[j][0] * v[j][0] + v[j][1] * v[j][1]) + (v[j][2] * v[j][2] + v[j][3] * v[j][3]); }
        const float rs = 1.0f / sqrtf(wave_sum(ss) * (1.0f / DM) + EPS);
#pragma unroll
        for (int j = 0; j < 8; ++j) {
            const f32x4 y = v[j] * rs * gv[j];
            if constexpr (TO_BF16) { u32x2 w; w.x = pk2(y[0], y[1]); w.y = pk2(y[2], y[3]); *((u32x2*)(outb + (size_t)row * DM) + lane + 64 * j) = w; }
            else { *((f32x4*)(outf + (size_t)row * DM) + lane + 64 * j) = y; }
        }
    }
}

__device__ __forceinline__ void cast_phase(const float* in, bf16_t* outb, u64_t* ssq, int gw, int NGW, int lane) {
    for (int row = gw; row < TT; row += NGW) {
        const f32x4* xr = (const f32x4*)(in + (size_t)row * DM) + lane;
        f32x4 v[8]; float ss = 0.f;
#pragma unroll
        for (int j = 0; j < 8; ++j) { v[j] = xr[64 * j]; ss += (v[j][0] * v[j][0] + v[j][1] * v[j][1]) + (v[j][2] * v[j][2] + v[j][3] * v[j][3]); }
        ss = wave_sum(ss);
        if (lane == 0) ssq[row] = (u64_t)(ss * SSQ_FIX);
#pragma unroll
        for (int j = 0; j < 8; ++j) { u32x2 w; w.x = pk2(v[j][0], v[j][1]); w.y = pk2(v[j][2], v[j][3]); *((u32x2*)(outb + (size_t)row * DM) + lane + 64 * j) = w; }
    }
}

__device__ __forceinline__ void final_phase(const bf16_t* xb, const u64_t* ssq, const float* __restrict__ g, float* outf, int gw, int NGW, int lane) {
    f32x4 gv[4][2];
#pragma unroll
    for (int j = 0; j < 4; ++j) { gv[j][0] = *(const f32x4*)(g + 8 * (lane + 64 * j)); gv[j][1] = *(const f32x4*)(g + 8 * (lane + 64 * j) + 4); }
    for (int row = gw; row < TT; row += NGW) {
        const float rs = __builtin_amdgcn_rsqf((float)ssq[row] * SSQ_INV * (1.0f / DM) + EPS);
        const u32x4* xr = (const u32x4*)(xb + (size_t)row * DM) + lane;
        u32x4 v[4];
#pragma unroll
        for (int j = 0; j < 4; ++j) v[j] = xr[64 * j];
#pragma unroll
        for (int j = 0; j < 4; ++j) {
            float* op = outf + (size_t)row * DM + 8 * (lane + 64 * j);
            *(f32x4*)op = (f32x4){bflo(v[j].x), bfhi(v[j].x), bflo(v[j].y), bfhi(v[j].y)} * rs * gv[j][0];
            *(f32x4*)(op + 4) = (f32x4){bflo(v[j].z), bfhi(v[j].z), bflo(v[j].w), bfhi(v[j].w)} * rs * gv[j][1];
        }
    }
}

__device__ __forceinline__ void tables_phase(unsigned char* ws, const float* const* in_unused, const float* lam_re, const float* lam_im, const float* log_step, const float* b_re, const float* b_im,
                                             const float* lq1, const float* lk1, const float* lq2, const float* lk2, int gtid, int NT_) {
    float* rcos = (float*)(ws + WS_RCOS); float* rsin = (float*)(ws + WS_RSIN); float* acos_ = (float*)(ws + WS_ACOS); float* asin_ = (float*)(ws + WS_ASIN);
    float* s5a = (float*)(ws + WS_S5A); float* s5bb = (float*)(ws + WS_S5BB);
    for (int i = gtid; i < SEQ * 128; i += NT_) {
        const int pos = i >> 7, f = i & 127;
        const float inv = (float)exp2(-((double)(2 * f) / 256.0) * 13.287712379549449);
        const float ang = (float)pos * inv; double s, c; sincos_d((double)ang, s, c); rcos[i] = (float)c; rsin[i] = (float)s;
    }
    for (int i = gtid; i < SEQ * 16; i += NT_) {
        const int pos = i >> 4, f = i & 15;
        const float inv = (float)exp2(-((double)(2 * f) / 32.0) * 18.931568569324174);
        const float ang = (float)pos * inv; double s, c; sincos_d((double)ang, s, c); acos_[i] = (float)c; asin_[i] = (float)s;
    }
    for (int i = gtid; i < 64 * 64; i += NT_) {
        const int g = i >> 6;
        const double step = exp((double)log_step[g]), lr = (double)lam_re[i], li = (double)lam_im[i];
        const double mag = exp(lr * step); double s, c; sincos_d(li * step, s, c);
        const double are = mag * c, aim = mag * s, den = lr * lr + li * li, nr = are - 1.0;
        const double fre = (nr * lr + aim * li) / den, fim = (aim * lr - nr * li) / den;
        s5a[2 * i] = (float)are; s5a[2 * i + 1] = (float)aim;
        for (int p = 0; p < 16; ++p) { const double br = (double)b_re[i * 16 + p], bi = (double)b_im[i * 16 + p];
            s5bb[(size_t)i * 32 + p] = (float)(fre * br - fim * bi); s5bb[(size_t)i * 32 + 16 + p] = (float)(fre * bi + fim * br); }
    }
    if (gtid == 0) { float s1 = 0.f, s2 = 0.f; for (int i = 0; i < 128; ++i) { s1 += lq1[i] * lk1[i]; s2 += lq2[i] * lk2[i]; }
        ((float*)(ws + WS_CTL))[0] = expf(s1) - expf(s2) + LAMBDA_INIT; }
}

__device__ __forceinline__ void s5_phase(LAS unsigned char* lds, const unsigned char* ws, const bf16_t* proj, const float* c_re, const float* c_im, const float* dskip, bf16_t* z,
                                         int vcu, int G, int wave, int lane) {
    const float* s5a = (const float*)(ws + WS_S5A); const float* s5bb = (const float*)(ws + WS_S5BB);
    LAS bf16_t* Hc = (LAS bf16_t*)(lds + wave * 8704);
    LAS float* Uc = (LAS float*)(lds + 8 * 8704 + wave * 2048);
    const int fr = lane & 15, fq = lane >> 4;
    for (int seq = vcu * 8 + wave; seq < 1024; seq += G * 8) {
        const int b = seq >> 6, g = seq & 63, n = lane;
        float bbre[16], bbim[16];
#pragma unroll
        for (int p = 0; p < 16; ++p) { bbre[p] = s5bb[(size_t)(g * 64 + n) * 32 + p]; bbim[p] = s5bb[(size_t)(g * 64 + n) * 32 + 16 + p]; }
        const float are = s5a[2 * (g * 64 + n)], aim = s5a[2 * (g * 64 + n) + 1];
        bf16x8 cf[4];
#pragma unroll
        for (int ks = 0; ks < 4; ++ks) { u32x4 w; unsigned* wp = (unsigned*)&w;
#pragma unroll
            for (int j2 = 0; j2 < 4; ++j2) { float v[2];
#pragma unroll
                for (int e = 0; e < 2; ++e) { const int k = 32 * ks + 8 * fq + 2 * j2 + e; v[e] = (k < 64) ? c_re[(size_t)(g * 16 + fr) * 64 + k] : -c_im[(size_t)(g * 16 + fr) * 64 + (k - 64)]; }
                wp[j2] = pk2(v[0], v[1]); }
            cf[ks] = __builtin_bit_cast(bf16x8, w); }
        const float dsk = dskip[g * 16 + fr];
        float hre = 0.f, him = 0.f;
        const bf16_t* ubase = proj + (size_t)b * SEQ * PW + 4096 + g * 16;
        u32x4 ua = *(const u32x4*)(ubase + (size_t)(lane & 31) * PW), ub = *(const u32x4*)(ubase + (size_t)(lane & 31) * PW + 8);
        unsigned short uu[2][4];
#pragma unroll
        for (int sb = 0; sb < 2; ++sb)
#pragma unroll
            for (int i = 0; i < 4; ++i) uu[sb][i] = ubase[(size_t)(16 * sb + 4 * fq + i) * PW + fr];
        for (int ch = 0; ch < SEQ / 32; ++ch) {
            const size_t row0 = (size_t)b * SEQ + ch * 32;
            const int chn = (ch + 1 < SEQ / 32) ? ch + 1 : ch;
            const bf16_t* unext = ubase + (size_t)chn * 32 * PW;
            const u32x4 ua_n = *(const u32x4*)(unext + (size_t)(lane & 31) * PW), ub_n = *(const u32x4*)(unext + (size_t)(lane & 31) * PW + 8);
            unsigned short uu_n[2][4];
#pragma unroll
            for (int sb = 0; sb < 2; ++sb)
#pragma unroll
                for (int i = 0; i < 4; ++i) uu_n[sb][i] = unext[(size_t)(16 * sb + 4 * fq + i) * PW + fr];
            if (lane < 32) {
                LAS f32x4* up4 = (LAS f32x4*)(Uc + lane * 16);
                up4[0] = (f32x4){bflo(ua.x), bfhi(ua.x), bflo(ua.y), bfhi(ua.y)}; up4[1] = (f32x4){bflo(ua.z), bfhi(ua.z), bflo(ua.w), bfhi(ua.w)};
                up4[2] = (f32x4){bflo(ub.x), bfhi(ub.x), bflo(ub.y), bfhi(ub.y)}; up4[3] = (f32x4){bflo(ub.z), bfhi(ub.z), bflo(ub.w), bfhi(ub.w)};
            }
#pragma unroll
            for (int k = 0; k < 32; ++k) {
                f32x2 xa = (f32x2){0.f, 0.f}, xb = (f32x2){0.f, 0.f};
#pragma unroll
                for (int q = 0; q < 4; ++q) { const f32x4 u4 = *(const LAS f32x4*)(Uc + k * 16 + 4 * q);
                    xa = __builtin_elementwise_fma((f32x2){u4[0], u4[0]}, (f32x2){bbre[4 * q], bbim[4 * q]}, xa);
                    xb = __builtin_elementwise_fma((f32x2){u4[1], u4[1]}, (f32x2){bbre[4 * q + 1], bbim[4 * q + 1]}, xb);
                    xa = __builtin_elementwise_fma((f32x2){u4[2], u4[2]}, (f32x2){bbre[4 * q + 2], bbim[4 * q + 2]}, xa);
                    xb = __builtin_elementwise_fma((f32x2){u4[3], u4[3]}, (f32x2){bbre[4 * q + 3], bbim[4 * q + 3]}, xb); }
                const f32x2 xx = xa + xb;
                const float nr = are * hre - aim * him + xx[0], ni = are * him + aim * hre + xx[1]; hre = nr; him = ni;
                Hc[k * 136 + n] = (bf16_t)f2bf(hre); Hc[k * 136 + 64 + n] = (bf16_t)f2bf(him);
            }
#pragma unroll
            for (int sb = 0; sb < 2; ++sb) {
                f32x4 y = (f32x4){0.f, 0.f, 0.f, 0.f};
#pragma unroll
                for (int ks = 0; ks < 4; ++ks) { const bf16x8 hf = *(const LAS bf16x8*)(Hc + (16 * sb + fr) * 136 + 32 * ks + 8 * fq); y = __builtin_amdgcn_mfma_f32_16x16x32_bf16(hf, cf[ks], y, 0, 0, 0); }
#pragma unroll
                for (int i = 0; i < 4; ++i) { const size_t row = row0 + 16 * sb + 4 * fq + i;
                    const float yy = y[i] + dsk * bf2f(uu[sb][i]);
                    z[row * 1024 + g * 16 + fr] = (bf16_t)f2bf(gelu_tanh_f(yy)); }
            }
            ua = ua_n; ub = ub_n;
#pragma unroll
            for (int sb = 0; sb < 2; ++sb)
#pragma unroll
                for (int i = 0; i < 4; ++i) uu[sb][i] = uu_n[sb][i];
        }
    }
}

#define MF32(a, b, c) __builtin_amdgcn_mfma_f32_32x32x16_bf16((a), (b), (c), 0, 0, 0)
#define AT_WAITV(n) asm volatile("s_waitcnt vmcnt(" #n ")" ::: "memory")
#define AT_BAR() asm volatile("s_waitcnt lgkmcnt(0)\n\ts_barrier" ::: "memory")
__device__ __forceinline__ s16x4 vtr(const LAS unsigned char* p) { typedef short v4i16_t __attribute__((ext_vector_type(4))); return __builtin_bit_cast(s16x4, __builtin_amdgcn_ds_read_tr16_b64_v4i16((LAS v4i16_t*)p)); }
__device__ __forceinline__ int crow(int i, int h) { return (i & 3) + 8 * (i >> 2) + 4 * h; }

template <int MODE>
__device__ __forceinline__ void attn_unit(LAS unsigned char* lds, const bf16_t* src, const int pitch, const int kcol, const int vcol, const int b, const int h, const int ub,
                                          bf16_t* outp, const bf16_t* gsrc, const float* subln, const float lam) {
    constexpr int NKS = MODE ? 8 : 16, NDB = 4, ROWS = MODE ? 64 : 128;
    const int tid = threadIdx.x, lane = tid & 63, r = lane & 31, hh = lane >> 5;
    const int wid = __builtin_amdgcn_readfirstlane(tid >> 6);
    const int rg = MODE ? (wid & 1) : (wid & 3), vh = MODE ? ((wid >> 1) & 1) : (wid >> 2), cc = MODE ? (wid >> 2) : 0;
    const size_t rowbase = (size_t)b * SEQ; const int q0 = ub * ROWS, NT = MODE ? (ub + 1) : (2 * ub + 2);
    const int qrow = q0 + rg * 32 + r;
    AT_WAITV(0);
#define AT_ISSUE(t, buf) do { const bf16_t* gk_ = src + (rowbase + (size_t)(t) * 64) * pitch; int rv_ = r; asm volatile("" : "+v"(rv_)); \
        _Pragma("unroll") for (int i_ = 0; i_ < 4; ++i_) { const int c_ = wid * 4 + i_; const int row_ = c_ * 2 + hh; \
            const unsigned ok_ = (unsigned)(row_ * pitch + kcol + ((rv_ ^ (row_ & 15)) << 3)); \
            __builtin_amdgcn_global_load_lds((const unsigned*)(gk_ + ok_), (LAS unsigned*)(lds + (buf) * 65536 + c_ * 1024), 16, 0, 0); \
            const unsigned ov_ = (unsigned)(row_ * pitch + vcol + ((rv_ ^ ((row_ & 3) << 2)) << 3)); \
            __builtin_amdgcn_global_load_lds((const unsigned*)(gk_ + ov_), (LAS unsigned*)(lds + (buf) * 65536 + 32768 + c_ * 1024), 16, 0, 0); } } while (0)
    AT_ISSUE(0, 0);
    bf16x8 qf[NKS];
    { const bf16_t* qp = src + (rowbase + qrow) * pitch + h * 256 + cc * 128 + 8 * hh;
#pragma unroll
      for (int d0 = 0; d0 < NKS; ++d0) qf[d0] = *(const bf16x8*)(qp + 16 * d0); }
    f32x16 O[NDB];
#pragma unroll
    for (int db = 0; db < NDB; ++db)
#pragma unroll
        for (int i = 0; i < 16; ++i) O[db][i] = 0.f;
    float mrun = 0.f, lrun = 0.f;
    const float lgam = __builtin_log2f(1.0f - __builtin_amdgcn_exp2f(-5.0f - (float)h));
    const int r15 = r & 15;
    const int kunit0 = cc * 16;
    const int q4 = (lane & 15) >> 2, p4 = lane & 3, blk16 = (lane >> 4) & 1;
    const int vlane = (4 * hh + q4) * 512 + ((2 * blk16 + (p4 >> 1)) << 4) + 8 * (p4 & 1);
    for (int t = 0; t < NT; ++t) {
        if (t + 1 < NT) { AT_ISSUE(t + 1, (t + 1) & 1); AT_WAITV(8); } else { AT_WAITV(0); }
        AT_BAR();
        const bool active = MODE ? true : !(t == NT - 1 && rg < 2);
        if (active) {
            const LAS unsigned char* Kb = lds + (t & 1) * 65536; const LAS unsigned char* Vb = Kb + 32768;
            int r15v = r15 ^ hh ^ kunit0, q4v = q4 << 2; asm volatile("" : "+v"(r15v), "+v"(q4v));
            bf16x8 pf[4];
            if constexpr (MODE) {
                f32x16 p0, p1;
#pragma unroll
                for (int i = 0; i < 16; ++i) { p0[i] = -mrun; p1[i] = -mrun; }
                { const LAS unsigned char* kr0 = Kb + r * 512; const LAS unsigned char* kr1 = Kb + (32 + r) * 512;
#pragma unroll
                  for (int d0 = 0; d0 < NKS; ++d0) { const int uo = ((2 * d0) ^ r15v) << 4;
                      const bf16x8 k0 = *(const LAS bf16x8*)(kr0 + uo); const bf16x8 k1 = *(const LAS bf16x8*)(kr1 + uo);
                      p0 = MF32(k0, qf[d0], p0); p1 = MF32(k1, qf[d0], p1);
                      if ((d0 & 3) == 3) __builtin_amdgcn_sched_barrier(0); } }
                float rm = p0[0];
#pragma unroll
                for (int i = 0; i < 16; ++i) { rm = fmaxf(rm, p0[i]); rm = fmaxf(rm, p1[i]); }
                rm = fmaxf(rm, __shfl_xor(rm, 32));
                if (t == 0 || __any(rm > 8.0f)) {
                    const float dl = (t == 0) ? rm : fmaxf(rm, 0.f); const float al = (t == 0) ? 1.0f : __builtin_amdgcn_exp2f(-dl); lrun *= al; mrun += dl;
#pragma unroll
                    for (int i = 0; i < 16; ++i) { p0[i] -= dl; p1[i] -= dl; }
#pragma unroll
                    for (int db = 0; db < NDB; ++db) O[db] = O[db] * al;
                }
                float sum = 0.f;
#pragma unroll
                for (int i = 0; i < 16; ++i) { p0[i] = __builtin_amdgcn_exp2f(p0[i]); p1[i] = __builtin_amdgcn_exp2f(p1[i]); sum += p0[i] + p1[i]; }
                lrun += sum;
                u32x4 w;
                w.x = cvt_pk_bf16(p0[0], p0[1]); w.y = cvt_pk_bf16(p0[2], p0[3]); w.z = cvt_pk_bf16(p0[4], p0[5]); w.w = cvt_pk_bf16(p0[6], p0[7]); pf[0] = __builtin_bit_cast(bf16x8, w);
                w.x = cvt_pk_bf16(p0[8], p0[9]); w.y = cvt_pk_bf16(p0[10], p0[11]); w.z = cvt_pk_bf16(p0[12], p0[13]); w.w = cvt_pk_bf16(p0[14], p0[15]); pf[1] = __builtin_bit_cast(bf16x8, w);
                w.x = cvt_pk_bf16(p1[0], p1[1]); w.y = cvt_pk_bf16(p1[2], p1[3]); w.z = cvt_pk_bf16(p1[4], p1[5]); w.w = cvt_pk_bf16(p1[6], p1[7]); pf[2] = __builtin_bit_cast(bf16x8, w);
                w.x = cvt_pk_bf16(p1[8], p1[9]); w.y = cvt_pk_bf16(p1[10], p1[11]); w.z = cvt_pk_bf16(p1[12], p1[13]); w.w = cvt_pk_bf16(p1[14], p1[15]); pf[3] = __builtin_bit_cast(bf16x8, w);
            } else {
#pragma unroll
                for (int blk = 0; blk < 2; ++blk) {
                    f32x16 p;
#pragma unroll
                    for (int i = 0; i < 16; ++i) p[i] = 0.f;
                    const LAS unsigned char* kr = Kb + (32 * blk + r) * 512;
#pragma unroll
                    for (int d0 = 0; d0 < NKS; ++d0) { const int uo = ((2 * d0) ^ r15v) << 4;
                        const bf16x8 k0 = *(const LAS bf16x8*)(kr + uo); p = MF32(k0, qf[d0], p);
                        if ((d0 & 3) == 3) __builtin_amdgcn_sched_barrier(0); }
                    const int kb = t * 64 + 32 * blk + 4 * hh;
#pragma unroll
                    for (int i = 0; i < 16; ++i) { const int kv = kb + (i & 3) + 8 * (i >> 2);
                        p[i] *= __builtin_amdgcn_exp2f(lgam * fabsf((float)(qrow - kv)) - 4.0f); }
                    u32x4 w;
                    w.x = cvt_pk_bf16(p[0], p[1]); w.y = cvt_pk_bf16(p[2], p[3]); w.z = cvt_pk_bf16(p[4], p[5]); w.w = cvt_pk_bf16(p[6], p[7]); pf[2 * blk] = __builtin_bit_cast(bf16x8, w);
                    w.x = cvt_pk_bf16(p[8], p[9]); w.y = cvt_pk_bf16(p[10], p[11]); w.z = cvt_pk_bf16(p[12], p[13]); w.w = cvt_pk_bf16(p[14], p[15]); pf[2 * blk + 1] = __builtin_bit_cast(bf16x8, w);
                    __builtin_amdgcn_sched_barrier(0);
                }
            }
            const LAS unsigned char* vb = Vb + vlane;
            __builtin_amdgcn_sched_barrier(0);
#pragma unroll
            for (int db = 0; db < NDB; ++db) {
                const int dunit = vh * 16 + 4 * db;
                const LAS unsigned char* vp = vb + ((dunit ^ q4v) << 4);
#pragma unroll
                for (int ks = 0; ks < 4; ++ks) {
                    const int kvb = 32 * (ks >> 1) + 16 * (ks & 1);
                    const s16x4 lo = vtr(vp + kvb * 512), hi = vtr(vp + (kvb + 8) * 512);
                    const bf16x8 vf = __builtin_shufflevector(lo, hi, 0, 1, 2, 3, 4, 5, 6, 7);
                    O[db] = MF32(vf, pf[ks], O[db]);
                }
                __builtin_amdgcn_sched_barrier(0);
            }
        }
        AT_BAR();
    }
    const size_t orow = rowbase + qrow;
    LAS float* SS = (LAS float*)(lds + 131072);
    if constexpr (MODE) {
        const float l = lrun + __shfl_xor(lrun, 32); const float inv = 1.0f / l;
        LAS float* X = (LAS float*)(lds + (wid & 3) * 16384);
        if (cc == 1) {
#pragma unroll
            for (int db = 0; db < NDB; ++db)
#pragma unroll
                for (int i = 0; i < 16; ++i) X[(db * 16 + i) * 64 + lane] = O[db][i] * inv;
        }
        AT_BAR();
        float ss = 0.f;
        if (cc == 0) {
#pragma unroll
            for (int db = 0; db < NDB; ++db)
#pragma unroll
                for (int i = 0; i < 16; ++i) { const float o = O[db][i] * inv - lam * X[(db * 16 + i) * 64 + lane]; O[db][i] = o; ss += o * o; }
        }
        ss += __shfl_xor(ss, 32);
        if (hh == 0) SS[wid * 32 + r] = ss;
        AT_BAR();
        if (cc == 0) {
            ss += SS[(wid ^ 2) * 32 + r];
            const float rs = (1.0f - LAMBDA_INIT) / sqrtf(ss * (1.0f / 256.0f) + EPS);
            bf16_t* op = outp + orow * DM + h * 256 + vh * 128 + 4 * hh;
            const float* slp = subln + vh * 128 + 4 * hh;
#pragma unroll
            for (int db = 0; db < NDB; ++db)
#pragma unroll
                for (int i4 = 0; i4 < 4; ++i4) { const int d = 32 * db + 8 * i4;
                    const f32x4 sl = *(const f32x4*)(slp + d);
                    u32x2 w; w.x = cvt_pk_bf16(O[db][4 * i4] * rs * sl[0], O[db][4 * i4 + 1] * rs * sl[1]); w.y = cvt_pk_bf16(O[db][4 * i4 + 2] * rs * sl[2], O[db][4 * i4 + 3] * rs * sl[3]);
                    *(u32x2*)(op + d) = w; }
        }
        AT_BAR();
    } else {
        float ss = 0.f;
#pragma unroll
        for (int db = 0; db < NDB; ++db)
#pragma unroll
            for (int i = 0; i < 16; ++i) ss += O[db][i] * O[db][i];
        ss += __shfl_xor(ss, 32);
        if (hh == 0) SS[wid * 32 + r] = ss;
        AT_BAR();
        ss += SS[(wid ^ 4) * 32 + r];
        const float rs = 1.0f / sqrtf(ss * (1.0f / 256.0f) + EPS);
        const bf16_t* gp = gsrc + orow * PW + 3072 + h * 256 + vh * 128 + 4 * hh;
        bf16_t* op = outp + orow * DM + h * 256 + vh * 128 + 4 * hh;
        u32x2 ggv[NDB][4];
#pragma unroll
        for (int db = 0; db < NDB; ++db)
#pragma unroll
            for (int i4 = 0; i4 < 4; ++i4) ggv[db][i4] = *(const u32x2*)(gp + 32 * db + 8 * i4);
#pragma unroll
        for (int db = 0; db < NDB; ++db)
#pragma unroll
            for (int i4 = 0; i4 < 4; ++i4) { const int d = 32 * db + 8 * i4;
                const u32x2 gg = ggv[db][i4];
                u32x2 w; w.x = cvt_pk_bf16(O[db][4 * i4] * rs * silu_f(bflo(gg.x)), O[db][4 * i4 + 1] * rs * silu_f(bfhi(gg.x)));
                w.y = cvt_pk_bf16(O[db][4 * i4 + 2] * rs * silu_f(bflo(gg.y)), O[db][4 * i4 + 3] * rs * silu_f(bfhi(gg.y)));
                *(u32x2*)(op + d) = w; }
        AT_BAR();
    }
#undef AT_ISSUE
}

__device__ __forceinline__ void attn_unit_diff128(LAS unsigned char* lds, const bf16_t* src, const int pitch, const int kcol, const int vcol, const int b, const int h, const int ub,
                                                  bf16_t* outp, const float* subln, const float lam) {
    constexpr int NKS = 8, NDB = 8;
    const int tid = threadIdx.x, lane = tid & 63, r = lane & 31, hh = lane >> 5;
    const int wid = __builtin_amdgcn_readfirstlane(tid >> 6);
    const int rg = wid & 3, cc = wid >> 2;
    const size_t rowbase = (size_t)b * SEQ; const int q0 = ub * 128, NT = 2 * ub + 2;
    const int qrow = q0 + rg * 32 + r;
    AT_WAITV(0);
#define AT_ISSUE(t, buf) do { const bf16_t* gk_ = src + (rowbase + (size_t)(t) * 64) * pitch; int rv_ = r; asm volatile("" : "+v"(rv_)); \
        _Pragma("unroll") for (int i_ = 0; i_ < 4; ++i_) { const int c_ = wid * 4 + i_; const int row_ = c_ * 2 + hh; \
            const unsigned ok_ = (unsigned)(row_ * pitch + kcol + ((rv_ ^ (row_ & 15)) << 3)); \
            __builtin_amdgcn_global_load_lds((const unsigned*)(gk_ + ok_), (LAS unsigned*)(lds + (buf) * 65536 + c_ * 1024), 16, 0, 0); \
            const unsigned ov_ = (unsigned)(row_ * pitch + vcol + ((rv_ ^ ((row_ & 3) << 2)) << 3)); \
            __builtin_amdgcn_global_load_lds((const unsigned*)(gk_ + ov_), (LAS unsigned*)(lds + (buf) * 65536 + 32768 + c_ * 1024), 16, 0, 0); } } while (0)
    AT_ISSUE(0, 0);
    bf16x8 qf[NKS];
    { const bf16_t* qp = src + (rowbase + qrow) * pitch + h * 256 + cc * 128 + 8 * hh;
#pragma unroll
      for (int d0 = 0; d0 < NKS; ++d0) qf[d0] = *(const bf16x8*)(qp + 16 * d0); }
    f32x16 O[NDB];
#pragma unroll
    for (int db = 0; db < NDB; ++db)
#pragma unroll
        for (int i = 0; i < 16; ++i) O[db][i] = 0.f;
    float mrun = 0.f, lrun = 0.f;
    const int r15 = r & 15, kunit0 = cc * 16;
    const int q4 = (lane & 15) >> 2, p4 = lane & 3, blk16 = (lane >> 4) & 1;
    const int vlane = (4 * hh + q4) * 512 + ((2 * blk16 + (p4 >> 1)) << 4) + 8 * (p4 & 1);
    for (int t = 0; t < NT; ++t) {
        if (t + 1 < NT) { AT_ISSUE(t + 1, (t + 1) & 1); AT_WAITV(8); } else { AT_WAITV(0); }
        AT_BAR();
        const bool active = !(t == NT - 1 && rg < 2);
        if (active) {
            const LAS unsigned char* Kb = lds + (t & 1) * 65536; const LAS unsigned char* Vb = Kb + 32768;
            int r15v = r15 ^ hh ^ kunit0, q4v = q4 << 2; asm volatile("" : "+v"(r15v), "+v"(q4v));
            const LAS unsigned char* vb = Vb + vlane;
#pragma unroll
            for (int blk = 0; blk < 2; ++blk) {
                f32x16 p;
#pragma unroll
                for (int i = 0; i < 16; ++i) p[i] = -mrun;
                const LAS unsigned char* kr = Kb + (32 * blk + r) * 512;
#pragma unroll
                for (int d0 = 0; d0 < NKS; ++d0) { const int uo = ((2 * d0) ^ r15v) << 4;
                    const bf16x8 k0 = *(const LAS bf16x8*)(kr + uo); p = MF32(k0, qf[d0], p);
                    if ((d0 & 3) == 3) __builtin_amdgcn_sched_barrier(0); }
                float rm = p[0];
#pragma unroll
                for (int i = 1; i < 16; ++i) rm = fmaxf(rm, p[i]);
                rm = fmaxf(rm, __shfl_xor(rm, 32));
                const bool first = (t == 0) && (blk == 0);
                if (first || __any(rm > 8.0f)) {
                    const float dl = first ? rm : fmaxf(rm, 0.f); const float al = first ? 1.0f : __builtin_amdgcn_exp2f(-dl); lrun *= al; mrun += dl;
#pragma unroll
                    for (int i = 0; i < 16; ++i) p[i] -= dl;
#pragma unroll
                    for (int db = 0; db < NDB; ++db) O[db] = O[db] * al;
                }
                float sum = 0.f;
#pragma unroll
                for (int i = 0; i < 16; ++i) { p[i] = __builtin_amdgcn_exp2f(p[i]); sum += p[i]; }
                lrun += sum;
                bf16x8 pf[2];
                { u32x4 w;
                  w.x = cvt_pk_bf16(p[0], p[1]); w.y = cvt_pk_bf16(p[2], p[3]); w.z = cvt_pk_bf16(p[4], p[5]); w.w = cvt_pk_bf16(p[6], p[7]); pf[0] = __builtin_bit_cast(bf16x8, w);
                  w.x = cvt_pk_bf16(p[8], p[9]); w.y = cvt_pk_bf16(p[10], p[11]); w.z = cvt_pk_bf16(p[12], p[13]); w.w = cvt_pk_bf16(p[14], p[15]); pf[1] = __builtin_bit_cast(bf16x8, w); }
                __builtin_amdgcn_sched_barrier(0);
#pragma unroll
                for (int db = 0; db < NDB; ++db) {
                    const LAS unsigned char* vp = vb + (((4 * db) ^ q4v) << 4);
#pragma unroll
                    for (int ks = 0; ks < 2; ++ks) {
                        const int kvb = 32 * blk + 16 * ks;
                        const s16x4 lo = vtr(vp + kvb * 512), hi = vtr(vp + (kvb + 8) * 512);
                        const bf16x8 vf = __builtin_shufflevector(lo, hi, 0, 1, 2, 3, 4, 5, 6, 7);
                        O[db] = MF32(vf, pf[ks], O[db]);
                    }
                    if (db & 1) __builtin_amdgcn_sched_barrier(0);
                }
            }
        }
        AT_BAR();
    }
    const size_t orow = rowbase + qrow;
    const float l = lrun + __shfl_xor(lrun, 32); const float inv = 1.0f / l;
    LAS float* X = (LAS float*)(lds + rg * 32768);
    if (cc == 1) {
#pragma unroll
        for (int db = 0; db < NDB; ++db)
#pragma unroll
            for (int i = 0; i < 16; ++i) X[(db * 16 + i) * 64 + lane] = O[db][i] * inv;
    }
    AT_BAR();
    if (cc == 0) {
        float ss = 0.f;
#pragma unroll
        for (int db = 0; db < NDB; ++db)
#pragma unroll
            for (int i = 0; i < 16; ++i) { const float o = O[db][i] * inv - lam * X[(db * 16 + i) * 64 + lane]; O[db][i] = o; ss += o * o; }
        ss += __shfl_xor(ss, 32);
        const float rs = (1.0f - LAMBDA_INIT) / sqrtf(ss * (1.0f / 256.0f) + EPS);
        bf16_t* op = outp + orow * DM + h * 256 + 4 * hh;
        const LAS float* slp = (const LAS float*)(lds + 132096) + 4 * hh;
#pragma unroll
        for (int db = 0; db < NDB; ++db)
#pragma unroll
            for (int i4 = 0; i4 < 4; ++i4) { const int d = 32 * db + 8 * i4;
                const f32x4 sl = *(const LAS f32x4*)(slp + d);
                u32x2 w; w.x = cvt_pk_bf16(O[db][4 * i4] * rs * sl[0], O[db][4 * i4 + 1] * rs * sl[1]); w.y = cvt_pk_bf16(O[db][4 * i4 + 2] * rs * sl[2], O[db][4 * i4 + 3] * rs * sl[3]);
                *(u32x2*)(op + d) = w; }
    }
    AT_BAR();
#undef AT_ISSUE
}

template <int MODE>
__device__ __forceinline__ void attn_phase(LAS unsigned char* lds, const bf16_t* src, int pitch, int kcol0, int vcol0, int nheads, bf16_t* outp, const bf16_t* gsrc, const float* subln, float lam, int vcu, int G) {
    constexpr int NU = 16;
    const int npairs = 16 * nheads * (NU / 2);
    if constexpr (MODE) { if (threadIdx.x < 256) ((LAS float*)(lds + 132096))[threadIdx.x] = subln[threadIdx.x]; __syncthreads(); }
    for (int pr = vcu; pr < npairs; pr += G) {
        const int bh = pr / (NU / 2), p = pr % (NU / 2), b = bh / nheads, h = bh % nheads;
        if constexpr (MODE) {
            attn_unit_diff128(lds, src, pitch, kcol0 + h * 256, vcol0 + h * 256, b, h, NU - 1 - p, outp, subln, lam);
            attn_unit_diff128(lds, src, pitch, kcol0 + h * 256, vcol0 + h * 256, b, h, p, outp, subln, lam);
        } else {
            attn_unit<0>(lds, src, pitch, kcol0 + h * 256, vcol0 + h * 256, b, h, NU - 1 - p, outp, gsrc, subln, lam);
            attn_unit<0>(lds, src, pitch, kcol0 + h * 256, vcol0 + h * 256, b, h, p, outp, gsrc, subln, lam);
        }
    }
}

#define XB_TMO      128
#define XB_XCNT(j)  (256  + 64 * (j))
#define XB_XSUB(j)  (1280 + 64 * (j))
#define XB_XGEN(j)  (2304 + 64 * (j))
#define XB_TOP      3328
#define XB_TOPGEN   3392
#define XCD_BAR_WORDS 3456
#define XB_SPIN_CAP (1u << 18)
__device__ __forceinline__ unsigned xb_ld(unsigned* p)              { return __hip_atomic_load(p, __ATOMIC_RELAXED, __HIP_MEMORY_SCOPE_AGENT); }
__device__ __forceinline__ unsigned xb_add(unsigned* p, unsigned v) { return __hip_atomic_fetch_add(p, v, __ATOMIC_RELAXED, __HIP_MEMORY_SCOPE_AGENT); }
__device__ __forceinline__ unsigned xb_xcc_id() { return (unsigned)__builtin_amdgcn_s_getreg((3 << 11) | 20) & 0xFu; }
#define XB_SPIN(cond, bar) do { unsigned _sp = 0; while (cond) { __builtin_amdgcn_s_sleep(1); \
    if ((++_sp & 255u) == 0u) { if (xb_ld(&(bar)[XB_TMO])) break; if (_sp > XB_SPIN_CAP) { atomicAdd(&(bar)[XB_TMO], 1u); break; } } } } while (0)
struct XcdBarrier { unsigned* bar; unsigned x; volatile LAS unsigned* st; };
__device__ __forceinline__ XcdBarrier xcd_barrier_post(unsigned* bar, volatile LAS unsigned* st) {
    XcdBarrier b; b.bar = bar; b.x = xb_xcc_id(); b.st = st;
    if (threadIdx.x == 0) (void)xb_add(&bar[XB_XCNT(b.x)], 1u);
    return b;
}
__device__ __forceinline__ void xcd_barrier_complete(unsigned* bar, unsigned x, unsigned& nloc, unsigned& nx) {
    const unsigned G = gridDim.x * gridDim.y * gridDim.z;
    unsigned sum, cnt, mine, sp = 0u;
    for (;;) {
        sum = 0u; cnt = 0u; mine = 0u;
#pragma unroll
        for (unsigned j = 0; j < 16; ++j) { const unsigned c = xb_ld(&bar[XB_XCNT(j)]); sum += c; cnt += (c > 0u) ? 1u : 0u; mine = (j == x) ? c : mine; }
        if (sum == G) break;
        __builtin_amdgcn_s_sleep(1);
        if ((++sp & 255u) == 0u) { if (xb_ld(&bar[XB_TMO])) break; if (sp > XB_SPIN_CAP) { atomicAdd(&bar[XB_TMO], 1u); break; } }
    }
    nloc = mine > 0u ? mine : 1u; nx = cnt > 0u ? cnt : 1u;
}
__device__ __forceinline__ void xcd_barrier(const XcdBarrier& b) {
    asm volatile("s_waitcnt vmcnt(0)" ::: "memory");
    __syncthreads();
    if (threadIdx.x == 0) {
        unsigned* bar = b.bar;
        __builtin_amdgcn_s_waitcnt(0);
        unsigned nloc = b.st[0], nx = b.st[1];
        if (nloc == 0u) { xcd_barrier_complete(bar, b.x, nloc, nx); b.st[0] = nloc; b.st[1] = nx; }
        const unsigned old = xb_add(&bar[XB_XSUB(b.x)], 1u);
        const unsigned gen = old / nloc;
        if (old + 1u == (gen + 1u) * nloc) {
            __builtin_amdgcn_fence(__ATOMIC_RELEASE, "agent");
            asm volatile("s_waitcnt vmcnt(0)" ::: "memory");
            const unsigned og = xb_add(&bar[XB_TOP], 1u);
            const unsigned tg = og / nx;
            if (og + 1u == (tg + 1u) * nx) xb_add(&bar[XB_TOPGEN], 1u);
            else XB_SPIN(xb_ld(&bar[XB_TOPGEN]) == tg, bar);
            __builtin_amdgcn_fence(__ATOMIC_ACQUIRE, "agent");
            xb_add(&bar[XB_XGEN(b.x)], 1u);
            asm volatile("s_waitcnt vmcnt(0)" ::: "memory");
        } else {
            XB_SPIN(xb_ld(&bar[XB_XGEN(b.x)]) == gen, bar);
            __builtin_amdgcn_fence(__ATOMIC_ACQUIRE, "agent");
            asm volatile("s_waitcnt vmcnt(0)" ::: "memory");
        }
    }
    __syncthreads();
}

struct Params { const float* in[26]; float* out; unsigned char* ws; int lo, hi; };
constexpr int NPHASE = 17;

__global__ void __launch_bounds__(512) fwd_megakernel(Params P) {
    extern __shared__ __attribute__((aligned(16))) unsigned char lds_raw[];
    LAS unsigned char* lds = (LAS unsigned char*)lds_raw;
    const int tid = threadIdx.x, lane = tid & 63, wave = __builtin_amdgcn_readfirstlane(tid >> 6);
    const int G = gridDim.x, bx = blockIdx.x;
    const int vcu = (G % 8 == 0) ? (bx % 8) * (G / 8) + bx / 8 : bx;
    const int gw = vcu * 8 + wave, NGW = G * 8;
    unsigned char* ws = P.ws;
    float* out = P.out;
    bf16_t* Wgu = (bf16_t*)(ws + WS_WGU); bf16_t* Wd = (bf16_t*)(ws + WS_WD); bf16_t* Win = (bf16_t*)(ws + WS_WIN); bf16_t* Wout = (bf16_t*)(ws + WS_WOUT);
    bf16_t* Wglu = (bf16_t*)(ws + WS_WGLU); bf16_t* Wqkv = (bf16_t*)(ws + WS_WQKV); bf16_t* Wco = (bf16_t*)(ws + WS_WCO);
    bf16_t* XN = (bf16_t*)(ws + WS_XN); bf16_t* BIG = (bf16_t*)(ws + WS_BIG); bf16_t* ZB = (bf16_t*)(ws + WS_Z);
    const float* x = P.in[0]; const float* ffn_norm = P.in[1]; const float* mix_norm = P.in[5];
#if MK_PER_PHASE
#define SYNC(k) do { } while (0)
#else
    cg::grid_group grid = cg::this_grid();
    { volatile LAS unsigned* st0 = (volatile LAS unsigned*)(lds + 139264); if (tid < 2) st0[tid] = 0u; }
    __syncthreads();
    const XcdBarrier xbar = xcd_barrier_post((unsigned*)(ws + WS_BAR), (volatile LAS unsigned*)(lds + 139264));
#define SYNC(k) do { if (P.lo <= (k) && (k) + 1 < P.hi) { if ((k) == 0) grid.sync(); else xcd_barrier(xbar); } } while (0)
#endif
#ifndef WGM_DOWN
#define WGM_DOWN 4
#endif
#ifndef DUPMASK
#define DUPMASK 0u
#endif
#define IN(k) (P.lo <= (k) && (k) < P.hi)
#define REP(k) for (int rep_ = 0; rep_ < (((DUPMASK >> (k)) & 1u) ? 2 : 1); ++rep_)

    u64_t* SSQ = (u64_t*)(ws + WS_SSQ);
    bf16_t* YC = (bf16_t*)(ws + WS_YC);
    const float* rcos = (const float*)(ws + WS_RCOS); const float* rsin = (const float*)(ws + WS_RSIN);
    const float* acos_ = (const float*)(ws + WS_ACOS); const float* asin_ = (const float*)(ws + WS_ASIN);
    if (IN(0)) REP(0) {
        LAS float* scr = (LAS float*)(lds + wave * 16640);
        const size_t gsz = (size_t)DM * DFF;
#pragma unroll 1
        for (int i = 0; i < 4; ++i) {
            conv_matrix(P.in[2] + i * gsz, Wgu + (size_t)i * NGU * DM, DM, DFF, 1, ffn_norm + i * DM, scr, gw, NGW, lane);
            conv_matrix(P.in[3] + i * gsz, Wgu + (size_t)i * NGU * DM, DM, DFF, 2, ffn_norm + i * DM, scr, gw, NGW, lane);
            conv_matrix(P.in[4] + i * gsz, Wd + (size_t)i * DM * DFF, DFF, DM, 0, nullptr, scr, gw, NGW, lane);
        }
        conv_matrix(P.in[6], Win, DM, PW, 0, mix_norm, scr, gw, NGW, lane);
        conv_matrix(P.in[7], Wout, DM, DM, 0, nullptr, scr, gw, NGW, lane);
        conv_matrix(P.in[16], Wglu, 1024, 1024, 0, nullptr, scr, gw, NGW, lane);
        conv_matrix(P.in[18], Wqkv, DM, QW, 0, mix_norm + DM, scr, gw, NGW, lane);
        conv_matrix(P.in[19], Wco, DM, DM, 0, nullptr, scr, gw, NGW, lane);
        tables_phase(ws, nullptr, P.in[8], P.in[9], P.in[10], P.in[11], P.in[12], P.in[20], P.in[21], P.in[22], P.in[23], vcu * 512 + tid, G * 512);
        for (int i = vcu * 512 + tid; i < 6 * TT; i += G * 512) SSQ[TT + i] = 0ull;
        cast_phase(x, XN, SSQ, gw, NGW, lane);
    }
    SYNC(0);
#if !MK_PER_PHASE
    if ((DUPMASK >> 20) & 1u) { for (int q_ = 0; q_ < 32; ++q_) grid.sync(); }
#endif
    if (IN(1)) { run_gemm(lds, XN, Wgu, TT, NGU, DM, EpiSwiglu{BIG, DFF, SSQ}); if ((DUPMASK >> 1) & 1u) { run_gemm(lds, XN, Wgu, TT, NGU, DM, EpiSwiglu{BIG, DFF, SSQ}); } }
    SYNC(1);
    if (IN(2)) run_gemm(lds, BIG, Wd, TT, DM, DFF, EpiResid<true, false, 1>{x, nullptr, XN, SSQ + 1 * TT}, WGM_DOWN);
    if (IN(2) && ((DUPMASK >> 2) & 1u)) run_gemm(lds, BIG, Wd, TT, DM, DFF, EpiResid<false, false, 2>{nullptr, nullptr, XN, nullptr});
    SYNC(2);
    if (IN(3)) { run_gemm(lds, XN, Win, TT, PW, DM, EpiWin{BIG, rcos, rsin, SSQ + 1 * TT}); if ((DUPMASK >> 3) & 1u) { run_gemm(lds, XN, Win, TT, PW, DM, EpiWin{BIG, rcos, rsin, SSQ + 1 * TT}); } }
    SYNC(3);
    if (IN(4)) REP(4) {
        const bool do_ret = !(rep_ == 1 && ((DUPMASK >> 22) & 1u)), do_s5 = !(rep_ == 1 && ((DUPMASK >> 21) & 1u));
        unsigned mask = 0u; int bh = 0, lin = -1, s5i = vcu, s5g = G; bool s5 = true;
        if (G == 256) {
            if (vcu < 128) { bh = vcu >> 1; mask = (vcu & 1) ? 0x03FDu : 0xE402u; s5 = false; }
            else { const int j = vcu - 128; bh = j >> 1; mask = 1u << (11 + (j & 1)); s5i = j; s5g = 128; }
        } else lin = vcu;
        if (s5 && do_s5) s5_phase(lds, ws, BIG, P.in[13], P.in[14], P.in[15], ZB, s5i, s5g, wave, lane);
        __syncthreads();
        if (do_ret) for (;;) {
            int ub;
            if (lin < 0) { if (!mask) break; ub = 31 - __clz((int)mask); mask &= ~(1u << ub); }
            else { if (lin >= 1024) break; bh = lin >> 4; ub = 15 - (lin & 15); lin += G; }
            const int b = bh >> 2, h = bh & 3;
            attn_unit<0>(lds, BIG, PW, 1024 + h * 256, 2048 + h * 256, b, h, ub, YC, BIG, nullptr, 0.f);
        }
    }
    SYNC(4);
    if (IN(5)) run_gemm(lds, ZB, Wglu, TT, 1024, 1024, EpiGlu{ZB, P.in[17], YC});
    SYNC(5);
    if (IN(6)) run_gemm(lds, YC, Wout, TT, DM, DM, EpiResid<false, false, 0>{nullptr, nullptr, XN, SSQ + 2 * TT});
    if (IN(6) && ((DUPMASK >> 6) & 1u)) run_gemm(lds, YC, Wout, TT, DM, DM, EpiResid<false, false, 2>{nullptr, nullptr, XN, nullptr});
    SYNC(6);
    if (IN(7)) { run_gemm(lds, XN, Wgu + (size_t)1 * NGU * DM, TT, NGU, DM, EpiSwiglu{BIG, DFF, SSQ + 2 * TT}); if ((DUPMASK >> 7) & 1u) { run_gemm(lds, XN, Wgu + (size_t)1 * NGU * DM, TT, NGU, DM, EpiSwiglu{BIG, DFF, SSQ + 2 * TT}); } }
    SYNC(7);
    if (IN(8)) run_gemm(lds, BIG, Wd + (size_t)1 * DM * DFF, TT, DM, DFF, EpiResid<false, false, 1>{nullptr, nullptr, XN, SSQ + 3 * TT}, WGM_DOWN);
    if (IN(8) && ((DUPMASK >> 8) & 1u)) run_gemm(lds, BIG, Wd + (size_t)1 * DM * DFF, TT, DM, DFF, EpiResid<false, false, 2>{nullptr, nullptr, XN, nullptr});
    SYNC(8);
    if (IN(9)) { run_gemm(lds, XN, Wgu + (size_t)2 * NGU * DM, TT, NGU, DM, EpiSwiglu{BIG, DFF, SSQ + 3 * TT}); if ((DUPMASK >> 9) & 1u) { run_gemm(lds, XN, Wgu + (size_t)2 * NGU * DM, TT, NGU, DM, EpiSwiglu{BIG, DFF, SSQ + 3 * TT}); } }
    SYNC(9);
    if (IN(10)) run_gemm(lds, BIG, Wd + (size_t)2 * DM * DFF, TT, DM, DFF, EpiResid<false, false, 1>{nullptr, nullptr, XN, SSQ + 4 * TT}, WGM_DOWN);
    if (IN(10) && ((DUPMASK >> 10) & 1u)) run_gemm(lds, BIG, Wd + (size_t)2 * DM * DFF, TT, DM, DFF, EpiResid<false, false, 2>{nullptr, nullptr, XN, nullptr});
    SYNC(10);
    if (IN(11)) { run_gemm(lds, XN, Wqkv, TT, QW, DM, EpiQkv{BIG, acos_, asin_, SSQ + 4 * TT}); if ((DUPMASK >> 11) & 1u) { run_gemm(lds, XN, Wqkv, TT, QW, DM, EpiQkv{BIG, acos_, asin_, SSQ + 4 * TT}); } }
    SYNC(11);
#ifndef NO_A1
    if (IN(12)) REP(12) { const float lam = ((const float*)(ws + WS_CTL))[0]; attn_phase<1>(lds, BIG, QW, 2048, 4096, 8, YC, nullptr, P.in[24], lam, vcu, G); }
#endif
    SYNC(12);
    if (IN(13)) run_gemm(lds, YC, Wco, TT, DM, DM, EpiResid<false, false, 0>{nullptr, nullptr, XN, SSQ + 5 * TT});
    if (IN(13) && ((DUPMASK >> 13) & 1u)) run_gemm(lds, YC, Wco, TT, DM, DM, EpiResid<false, false, 2>{nullptr, nullptr, XN, nullptr});
    SYNC(13);
    if (IN(14)) { run_gemm(lds, XN, Wgu + (size_t)3 * NGU * DM, TT, NGU, DM, EpiSwiglu{BIG, DFF, SSQ + 5 * TT}); if ((DUPMASK >> 14) & 1u) { run_gemm(lds, XN, Wgu + (size_t)3 * NGU * DM, TT, NGU, DM, EpiSwiglu{BIG, DFF, SSQ + 5 * TT}); } }
    SYNC(14);
    if (IN(15)) run_gemm(lds, BIG, Wd + (size_t)3 * DM * DFF, TT, DM, DFF, EpiResid<false, false, 1>{nullptr, nullptr, XN, SSQ + 6 * TT}, WGM_DOWN);
    if (IN(15) && ((DUPMASK >> 15) & 1u)) run_gemm(lds, BIG, Wd + (size_t)3 * DM * DFF, TT, DM, DFF, EpiResid<false, false, 2>{nullptr, nullptr, XN, nullptr});
    SYNC(15);
    if (IN(16)) final_phase(XN, SSQ + 6 * TT, P.in[25], out, gw, NGW, lane);
#undef IN
#undef SYNC
}

extern "C" void kernel_launch(void* const* d_in, const int* in_sizes, int n_in, void* d_out, int out_size, void* d_ws, size_t ws_size, hipStream_t stream) {
    static int grid = 0;
    if (grid == 0) {
        if (n_in != 26 || out_size != TT * DM || ws_size < WS_END) { fprintf(stderr, "kernel_launch: unexpected shapes (n_in %d, out %d, ws %zu < %zu)\n", n_in, out_size, ws_size, (size_t)WS_END); grid = -1; return; }
        int dev = 0, cus = 0, per_cu = 0;
        hipGetDevice(&dev); hipDeviceGetAttribute(&cus, hipDeviceAttributeMultiprocessorCount, dev);
        if (hipFuncSetAttribute((const void*)fwd_megakernel, hipFuncAttributeMaxDynamicSharedMemorySize, LDS_BYTES) != hipSuccess) { fprintf(stderr, "kernel_launch: hipFuncSetAttribute failed\n"); grid = -1; return; }
        if (hipOccupancyMaxActiveBlocksPerMultiprocessor(&per_cu, (const void*)fwd_megakernel, 512, LDS_BYTES) != hipSuccess || per_cu < 1) { fprintf(stderr, "kernel_launch: occupancy query says %d\n", per_cu); per_cu = 1; }
        (void)hipGetLastError();
        grid = cus * per_cu;
        fprintf(stderr, "kernel_launch: grid %d (cus %d x %d)\n", grid, cus, per_cu);
    }
    if (grid < 0) return;
    if (hipMemsetAsync((char*)d_ws + WS_BAR, 0, BAR_BYTES, stream) != hipSuccess) { fprintf(stderr, "kernel_launch: hipMemsetAsync failed\n"); return; }
    Params p{};
    for (int i = 0; i < 26; ++i) p.in[i] = (const float*)d_in[i];
    p.out = (float*)d_out; p.ws = (unsigned char*)d_ws;
#if MK_PER_PHASE
    for (int k = 0; k < NPHASE; ++k) { p.lo = k; p.hi = k + 1; hipLaunchKernelGGL(fwd_megakernel, dim3(grid), dim3(512), LDS_BYTES, stream, p); }
#else
    p.lo = 0; p.hi = NPHASE;
    void* args[] = {&p};
    hipError_t e = hipLaunchCooperativeKernel((const void*)fwd_megakernel, dim3(grid), dim3(512), args, LDS_BYTES, stream);
    if (e != hipSuccess) fprintf(stderr, "cooperative launch failed: %s (grid %d)\n", hipGetErrorString(e), grid);
#endif
}
```

```cpp
#include <hip/hip_runtime.h>
#include <hip/hip_cooperative_groups.h>
#include <cstdio>
#include <cstdint>
namespace cg = cooperative_groups;

#define LAS __attribute__((address_space(3)))
typedef unsigned short bf16_t;
typedef unsigned u64_t;
constexpr float SSQ_FIX = 1024.0f, SSQ_INV = 1.0f / 1024.0f;
typedef short bf16x8 __attribute__((ext_vector_type(8)));
typedef short s16x4 __attribute__((ext_vector_type(4)));
typedef float f32x4 __attribute__((ext_vector_type(4)));
typedef float f32x2 __attribute__((ext_vector_type(2)));
typedef float f32x16 __attribute__((ext_vector_type(16)));
typedef unsigned u32x4 __attribute__((ext_vector_type(4)));
typedef unsigned u32x2 __attribute__((ext_vector_type(2)));

#ifndef MK_PER_PHASE
#define MK_PER_PHASE 0
#endif

constexpr int TT = 32768, SEQ = 2048, DM = 2048, DFF = 5504, NGU = 2 * DFF;
constexpr int PW = 5120, QW = 6144;
constexpr float EPS = 1e-6f;
constexpr float LAMBDA_INIT = 0.35550906759f;
constexpr float QSCALE = 0.08838834764831845f * 1.4426950408889634f;

constexpr size_t MiB = 1u << 20;
constexpr size_t WS_CTL = 0, WS_BAR = 4096, BAR_BYTES = 16384;
constexpr size_t WS_RCOS = 1 * MiB, WS_RSIN = 2 * MiB, WS_ACOS = 3 * MiB, WS_ASIN = 3 * MiB + 128 * 1024, WS_S5A = 3 * MiB + 512 * 1024, WS_S5BB = 4 * MiB;
constexpr size_t WS_W = 8 * MiB;
constexpr size_t SZ_WGU = (size_t)NGU * DM * 2, SZ_WD = (size_t)DM * DFF * 2;
constexpr size_t WS_WGU = WS_W, WS_WD = WS_WGU + 4 * SZ_WGU, WS_WIN = WS_WD + 4 * SZ_WD, WS_WOUT = WS_WIN + (size_t)PW * DM * 2,
                 WS_WGLU = WS_WOUT + (size_t)DM * DM * 2, WS_WQKV = WS_WGLU + (size_t)1024 * 1024 * 2, WS_WCO = WS_WQKV + (size_t)QW * DM * 2,
                 WS_WEND = WS_WCO + (size_t)DM * DM * 2;
constexpr size_t WS_XN = 328 * MiB;
constexpr size_t WS_BIG = 456 * MiB;
constexpr size_t WS_Z = WS_BIG + (size_t)TT * PW * 2;
constexpr size_t WS_YC = WS_BIG + (size_t)TT * QW * 2;
constexpr size_t WS_END = WS_YC + (size_t)TT * DM * 2;
constexpr size_t WS_SSQ = 5 * MiB;
static_assert(WS_WEND <= WS_XN && WS_XN + (size_t)TT * DM * 2 <= WS_BIG && WS_Z + (size_t)TT * 1024 * 2 <= WS_END, "ws map");

constexpr int LDS_BYTES = 147456;

namespace pg8 {
constexpr int BM = 256, BK = 64, HALF = 128, HTB = HALF * BK * 2, STAGE_BYTES = 8 * HTB, NXCD = 8;
__host__ __device__ __forceinline__ int lds_byte(int r, int c) { const int st = (r >> 4) * 2 + (c >> 5), rr = r & 15, cc = c & 31, ob = rr * 64 + cc * 2; return st * 1024 + (ob ^ (((ob >> 9) & 1) << 5)); }
__host__ __device__ __forceinline__ void stage_rc(int b, int& R, int& C) { const int st = b / 1024, sb = b % 1024, swz = sb ^ (((sb >> 9) & 1) << 5); R = (st >> 1) * 16 + swz / 64; C = (st & 1) * 32 + (swz % 64) / 2; }
__host__ __device__ __forceinline__ int perm32(int rho) { const int n = rho >> 4, i = rho & 15; return 8 * (i >> 2) + 4 * n + (i & 3); }
struct Unit { int pm, pn; };
struct Gemm { const bf16_t* A; const bf16_t* Bt; int M, N, K; };
struct StaticOrder {
    int nM, nN, nwg, G, c, WGM;
    __host__ __device__ void init(int M, int N, int G_, int c_, int wgm_ = 8) { nM = M / BM; nN = N / BM; nwg = nM * nN; G = G_; c = c_; WGM = wgm_; }
    __host__ __device__ bool next(int i, Unit& u) const {
        const long L = (long)i * G + c; if (L >= nwg) return false;
        int wgid = (int)L; { const int q = nwg / NXCD, r = nwg % NXCD, xcd = wgid % NXCD, off = wgid / NXCD; wgid = (xcd < r ? xcd * (q + 1) : r * (q + 1) + (xcd - r) * q) + off; }
        const int nig = WGM * nN, gid = wgid / nig, fm = gid * WGM, gsz = (nM - fm) < WGM ? (nM - fm) : WGM;
        u.pm = fm + ((wgid % nig) % gsz); u.pn = (wgid % nig) / gsz; return true;
    }
    __device__ __forceinline__ void a_ready(const Unit&) const {}
    __device__ __forceinline__ void done(const Unit&) const {}
};
__device__ __forceinline__ unsigned cvt_pk_bf16(float lo, float hi) { unsigned r; asm volatile("v_cvt_pk_bf16_f32 %0, %1, %2" : "=v"(r) : "v"(lo), "v"(hi)); return r; }

template <class Epi, class Sched, bool ALIGN_EPI = false, bool SP2 = false>
__device__ __forceinline__ void gemm_phase(LAS unsigned char* lds, const Gemm g, const Sched S, const Epi E) {
    const int tid = threadIdx.x, wid = __builtin_amdgcn_readfirstlane(tid >> 6), lane = tid & 63, wr = wid >> 2, wc = wid & 3, fr = lane & 15, fq = lane >> 4;
    const int K = g.K, nt = K / BK;
    unsigned voffA[2], voffB[2];
#pragma unroll
    for (int i = 0; i < 2; ++i) { int R, C; stage_rc(tid * 16 + i * 8192, R, C); const int Rb = Epi::PERM ? ((R & ~31) + perm32(R & 31)) : R;
        voffA[i] = (unsigned)(R * K + C) * 2u; voffB[i] = (unsigned)(Rb * K + C) * 2u; }
    const size_t kstep = (size_t)(BK * 2);
    const size_t hstep = (size_t)HALF * K * 2;
    const size_t tstep = 2 * hstep;
    const unsigned ldsw = (unsigned)wid * 1024u;
    const int aoff = lds_byte(wr * 64 + fr, fq * 8), boff = lds_byte(wc * 32 + fr, fq * 8);
#define PG8_SA(b, h) (((b) * 2 + (h)) * HTB)
#define PG8_SB(b, h) ((4 + (b) * 2 + (h)) * HTB)
#define PG8_STAGE(bufoff, gbase, voff) do { _Pragma("unroll") for (int _i = 0; _i < 2; ++_i) \
        __builtin_amdgcn_global_load_lds((const unsigned*)((const char*)(gbase) + (voff)[_i]), (LAS unsigned*)(lds + (bufoff) + ldsw + _i * 8192), 16, 0, 0); } while (0)
#define PG8_LDA(dst, b, h) do { _Pragma("unroll") for (int m = 0; m < 4; ++m) _Pragma("unroll") for (int k = 0; k < 2; ++k) dst[m][k] = *(const LAS bf16x8*)(lds + PG8_SA(b, h) + aoff + m * 2048 + k * 1024); } while (0)
#define PG8_LDB(dst, b, h) do { _Pragma("unroll") for (int n = 0; n < 2; ++n) _Pragma("unroll") for (int k = 0; k < 2; ++k) dst[n][k] = *(const LAS bf16x8*)(lds + PG8_SB(b, h) + boff + n * 2048 + k * 1024); } while (0)
#define PG8_MMA(ai, bj, At, Bt) do { __builtin_amdgcn_s_setprio(1); _Pragma("unroll") for (int m = 0; m < 4; ++m) _Pragma("unroll") for (int n = 0; n < 2; ++n) _Pragma("unroll") for (int k = 0; k < 2; ++k) \
        acc[ai][bj][m][n] = __builtin_amdgcn_mfma_f32_16x16x32_bf16(Bt[n][k], At[m][k], acc[ai][bj][m][n], 0, 0, 0); __builtin_amdgcn_s_setprio(0); } while (0)
#define PG8_WAIT_V(n) asm volatile("s_waitcnt vmcnt(" #n ")" ::: "memory")
#define PG8_WAIT_L(n) asm volatile("s_waitcnt lgkmcnt(" #n ")" ::: "memory")
#define PG8_BAR __builtin_amdgcn_s_barrier()
#define PG8_SCHED __builtin_amdgcn_sched_barrier(0)
    Unit cur, nxt; int ui = 0;
    if (!S.next(0, cur)) return;
    f32x4 acc[2][2][4][2];
#pragma unroll
    for (int a = 0; a < 2; ++a)
#pragma unroll
        for (int b = 0; b < 2; ++b)
#pragma unroll
            for (int m = 0; m < 4; ++m)
#pragma unroll
                for (int n = 0; n < 2; ++n) acc[a][b][m][n] = (f32x4){0.f, 0.f, 0.f, 0.f};
    bf16x8 At[4][2], B0[2][2], B1[2][2];
    typename Epi::Pre pre;
    const char* cA = (const char*)g.A + (size_t)cur.pm * tstep; const char* cB = (const char*)g.Bt + (size_t)cur.pn * tstep;
    S.a_ready(cur);
    if constexpr (SP2) {
        PG8_STAGE(PG8_SB(0, 0), cB, voffB); PG8_STAGE(PG8_SB(0, 1), cB + hstep, voffB); PG8_STAGE(PG8_SA(0, 0), cA, voffA); PG8_STAGE(PG8_SA(0, 1), cA + hstep, voffA);
        if (wr == 1) PG8_BAR;
        PG8_WAIT_V(2); PG8_BAR;
        PG8_STAGE(PG8_SB(1, 0), cB + kstep, voffB); PG8_STAGE(PG8_SA(1, 0), cA + kstep, voffA); PG8_STAGE(PG8_SB(1, 1), cB + hstep + kstep, voffB);
        PG8_WAIT_V(6); PG8_BAR;
    } else {
        PG8_STAGE(PG8_SB(0, 0), cB, voffB); PG8_STAGE(PG8_SA(0, 0), cA, voffA); PG8_STAGE(PG8_SB(0, 1), cB + hstep, voffB); PG8_STAGE(PG8_SA(0, 1), cA + hstep, voffA);
        if (wr == 1) PG8_BAR;
        PG8_WAIT_V(4); PG8_BAR;
        PG8_STAGE(PG8_SB(1, 0), cB + kstep, voffB); PG8_STAGE(PG8_SA(1, 0), cA + kstep, voffA); PG8_STAGE(PG8_SB(1, 1), cB + hstep + kstep, voffB);
        PG8_WAIT_V(6); PG8_BAR;
    }
    for (;;) {
        const bool has_next = S.next(ui + 1, nxt);
        const char* nA = has_next ? (const char*)g.A + (size_t)nxt.pm * tstep : cA; const char* nB = has_next ? (const char*)g.Bt + (size_t)nxt.pn * tstep : cB;
        for (int t = 0; t < nt; t += 2) {
            const bool last = (t == nt - 2);
            const char* a1 = cA + (size_t)(t + 1) * kstep;
            const char* a2 = last ? nA : cA + (size_t)(t + 2) * kstep; const char* b2 = last ? nB : cB + (size_t)(t + 2) * kstep;
            const char* a3 = a2 + kstep; const char* b3 = b2 + kstep;
            if (last && has_next) S.a_ready(nxt);
            if (last) E.prefetch(cur, wr, fr, pre);
            if constexpr (SP2) {
            PG8_LDB(B0, 0, 0); PG8_LDB(B1, 0, 1); PG8_SCHED; PG8_LDA(At, 0, 0); PG8_STAGE(PG8_SA(1, 1), a1 + hstep, voffA);
            PG8_WAIT_V(8); PG8_WAIT_L(0); PG8_BAR; PG8_MMA(0, 0, At, B0); PG8_MMA(0, 1, At, B1); PG8_BAR; PG8_SCHED;
            PG8_LDA(At, 0, 1); PG8_STAGE(PG8_SB(0, 0), b2, voffB); PG8_STAGE(PG8_SB(0, 1), b2 + hstep, voffB); PG8_STAGE(PG8_SA(0, 0), a2, voffA);
            PG8_WAIT_V(8); PG8_WAIT_L(0); PG8_BAR; PG8_MMA(1, 0, At, B0); PG8_MMA(1, 1, At, B1); PG8_BAR; PG8_SCHED;
            PG8_LDB(B0, 1, 0); PG8_LDB(B1, 1, 1); PG8_SCHED; PG8_LDA(At, 1, 0); PG8_STAGE(PG8_SA(0, 1), a2 + hstep, voffA);
            PG8_WAIT_V(8); PG8_WAIT_L(0); PG8_BAR; PG8_MMA(0, 0, At, B0); PG8_MMA(0, 1, At, B1); PG8_BAR; PG8_SCHED;
            PG8_LDA(At, 1, 1); PG8_STAGE(PG8_SB(1, 0), b3, voffB); PG8_STAGE(PG8_SB(1, 1), b3 + hstep, voffB); PG8_STAGE(PG8_SA(1, 0), a3, voffA);
            PG8_WAIT_V(8); PG8_WAIT_L(0); PG8_BAR; PG8_MMA(1, 0, At, B0); PG8_MMA(1, 1, At, B1); PG8_BAR; PG8_SCHED;
            } else {
            PG8_LDB(B0, 0, 0); PG8_SCHED; PG8_LDA(At, 0, 0); PG8_STAGE(PG8_SA(1, 1), a1 + hstep, voffA);
            PG8_WAIT_L(8); PG8_BAR; PG8_WAIT_L(0); PG8_MMA(0, 0, At, B0); PG8_BAR; PG8_SCHED;
            PG8_LDB(B1, 0, 1); PG8_STAGE(PG8_SB(0, 0), b2, voffB);
            PG8_BAR; PG8_WAIT_L(0); PG8_MMA(0, 1, At, B1); PG8_BAR;
            PG8_LDA(At, 0, 1); PG8_STAGE(PG8_SA(0, 0), a2, voffA);
            PG8_BAR; PG8_WAIT_L(0); PG8_MMA(1, 0, At, B0); PG8_BAR; PG8_SCHED;
            PG8_STAGE(PG8_SB(0, 1), b2 + hstep, voffB);
            PG8_WAIT_V(6); PG8_BAR; PG8_MMA(1, 1, At, B1); PG8_BAR;
            PG8_LDB(B0, 1, 0); PG8_SCHED; PG8_LDA(At, 1, 0); PG8_STAGE(PG8_SA(0, 1), a2 + hstep, voffA);
            PG8_WAIT_L(8); PG8_BAR; PG8_WAIT_L(0); PG8_MMA(0, 0, At, B0); PG8_BAR; PG8_SCHED;
            PG8_LDB(B1, 1, 1); PG8_STAGE(PG8_SB(1, 0), b3, voffB);
            PG8_BAR; PG8_WAIT_L(0); PG8_MMA(0, 1, At, B1); PG8_BAR;
            PG8_LDA(At, 1, 1); PG8_STAGE(PG8_SA(1, 0), a3, voffA);
            PG8_BAR; PG8_WAIT_L(0); PG8_MMA(1, 0, At, B0); PG8_BAR; PG8_SCHED;
            PG8_STAGE(PG8_SB(1, 1), b3 + hstep, voffB);
            PG8_WAIT_V(6); PG8_BAR; PG8_MMA(1, 1, At, B1); PG8_BAR;
            }
        }
        if constexpr (ALIGN_EPI) { if (wr == 0) PG8_BAR; }
        if constexpr (!Epi::AFTER_DRAIN) { E(acc, cur, wr, wc, fr, fq, pre); S.done(cur); }
        if (!has_next) break;
#pragma unroll
        for (int a = 0; a < 2; ++a)
#pragma unroll
            for (int b = 0; b < 2; ++b)
#pragma unroll
                for (int m = 0; m < 4; ++m)
#pragma unroll
                    for (int n = 0; n < 2; ++n) acc[a][b][m][n] = (f32x4){0.f, 0.f, 0.f, 0.f};
        cur = nxt; cA = nA; cB = nB; ++ui;
        if constexpr (ALIGN_EPI) { if (wr == 1) PG8_BAR; }
    }
    PG8_WAIT_V(0);
    if constexpr (!ALIGN_EPI) { if (wr == 0) PG8_BAR; }
    PG8_BAR;
#undef PG8_SA
#undef PG8_SB
#undef PG8_STAGE
#undef PG8_LDA
#undef PG8_LDB
#undef PG8_MMA
#undef PG8_WAIT_V
#undef PG8_WAIT_L
#undef PG8_BAR
#undef PG8_SCHED
}
}

__device__ __forceinline__ unsigned f2bf(float f) { unsigned u = __builtin_bit_cast(unsigned, f); return (u + 0x7fffu + ((u >> 16) & 1u)) >> 16; }
__device__ __forceinline__ unsigned pk2(float lo, float hi) { return f2bf(lo) | (f2bf(hi) << 16); }
__device__ __forceinline__ float bf2f(unsigned short b) { return __builtin_bit_cast(float, (unsigned)b << 16); }
__device__ __forceinline__ float bflo(unsigned w) { return __builtin_bit_cast(float, w << 16); }
__device__ __forceinline__ float bfhi(unsigned w) { return __builtin_bit_cast(float, w & 0xffff0000u); }
__device__ __forceinline__ float fast_sigmoid(float x) { return __builtin_amdgcn_rcpf(1.0f + __builtin_amdgcn_exp2f(-1.4426950408889634f * x)); }
__device__ __forceinline__ float silu_f(float x) { return x * fast_sigmoid(x); }
__device__ __forceinline__ float gelu_tanh_f(float y) { return y * fast_sigmoid(1.5957691216057308f * (y + 0.044715f * y * y * y)); }
__device__ __forceinline__ float wave_sum(float v) {
#pragma unroll
    for (int o = 1; o < 64; o <<= 1) v += __shfl_xor(v, o);
    return v;
}
__device__ __forceinline__ void sincos_d(double a, double& s, double& c) {
    const double k = rint(a * 0.15915494309189535);
    const double r = fma(-k, 6.283185307179586, a), r2 = r * r;
    double ts = r, tc = 1.0; s = r; c = 1.0;
    for (int n = 1; n <= 13; ++n) { tc *= -r2 / (double)((2 * n - 1) * (2 * n)); c += tc; ts *= -r2 / (double)((2 * n) * (2 * n + 1)); s += ts; }
}

using pg8::Unit; using pg8::cvt_pk_bf16;
struct PreSsq { unsigned v[2][4]; };
struct PreNone { };
struct EpiSwiglu {
    static constexpr bool PERM = true, AFTER_DRAIN = false;
    bf16_t* O; int ldo; const u64_t* ssq;
    typedef PreSsq Pre;
    __device__ __forceinline__ void prefetch(const Unit& u, int wr, int fr, Pre& pre) const {
        const int row0 = u.pm * 256 + wr * 64 + fr;
#pragma unroll
        for (int ai = 0; ai < 2; ++ai)
#pragma unroll
            for (int m = 0; m < 4; ++m) pre.v[ai][m] = ssq[row0 + ai * 128 + m * 16];
    }
    __device__ __forceinline__ void operator()(const f32x4 (&acc)[2][2][4][2], const Unit& u, int wr, int wc, int fr, int fq, const Pre& pre) const {
        const int row0 = u.pm * 256 + wr * 64 + fr, col0 = u.pn * 128 + wc * 32 + 8 * fq;
        float rsv[2][4];
#pragma unroll
        for (int ai = 0; ai < 2; ++ai)
#pragma unroll
            for (int m = 0; m < 4; ++m) rsv[ai][m] = (float)pre.v[ai][m] * SSQ_INV;
#pragma unroll
        for (int ai = 0; ai < 2; ++ai)
#pragma unroll
            for (int m = 0; m < 4; ++m) {
                const int row = row0 + ai * 128 + m * 16;
                const float rs = __builtin_amdgcn_rsqf(rsv[ai][m] * (1.0f / DM) + EPS);
                bf16_t* rowp = O + (size_t)row * ldo + col0;
                const f32x4 g0 = acc[ai][0][m][0] * rs, g1 = acc[ai][0][m][1] * rs, u0 = acc[ai][1][m][0] * rs, u1 = acc[ai][1][m][1] * rs;
                u32x4 w;
                w.x = cvt_pk_bf16(silu_f(g0[0]) * u0[0], silu_f(g0[1]) * u0[1]); w.y = cvt_pk_bf16(silu_f(g0[2]) * u0[2], silu_f(g0[3]) * u0[3]);
                w.z = cvt_pk_bf16(silu_f(g1[0]) * u1[0], silu_f(g1[1]) * u1[1]); w.w = cvt_pk_bf16(silu_f(g1[2]) * u1[2], silu_f(g1[3]) * u1[3]);
                *(u32x4*)rowp = w;
            }
    }
};
template <bool BASE_F32, bool OUT_F32, int SCALE> struct EpiResid {
    static constexpr bool PERM = false, AFTER_DRAIN = false;
    const float* basef; float* outf; bf16_t* xb; u64_t* ssq;
    typedef PreNone Pre;
    __device__ __forceinline__ void prefetch(const Unit&, int, int, Pre&) const {}
    __device__ __forceinline__ void operator()(const f32x4 (&acc)[2][2][4][2], const Unit& u, int wr, int wc, int fr, int fq, const Pre&) const {
        const int col0 = u.pn * 256 + wc * 32 + 4 * fq;
        constexpr float sc = (SCALE == 2 ? 0.0f : SCALE == 1 ? 0.5f : 1.0f);
#pragma unroll
        for (int ai = 0; ai < 2; ++ai) {
            f32x4 pre[4][2][2];
#pragma unroll
            for (int m = 0; m < 4; ++m) { const size_t off = (size_t)(u.pm * 256 + ai * 128 + wr * 64 + m * 16 + fr) * DM + col0;
#pragma unroll
                for (int bj = 0; bj < 2; ++bj)
#pragma unroll
                    for (int n = 0; n < 2; ++n) {
                        if constexpr (BASE_F32) pre[m][bj][n] = *(const f32x4*)(basef + off + bj * 128 + n * 16);
                        else { const u32x2 w = *(const u32x2*)(xb + off + bj * 128 + n * 16); pre[m][bj][n] = (f32x4){bflo(w.x), bfhi(w.x), bflo(w.y), bfhi(w.y)}; } } }
#pragma unroll
            for (int m = 0; m < 4; ++m) {
                const int row = u.pm * 256 + ai * 128 + wr * 64 + m * 16 + fr;
                const size_t off = (size_t)row * DM + col0;
                float sq = 0.f;
#pragma unroll
                for (int bj = 0; bj < 2; ++bj)
#pragma unroll
                    for (int n = 0; n < 2; ++n) { const f32x4 v = pre[m][bj][n] + acc[ai][bj][m][n] * sc;
                        if constexpr (OUT_F32) *(f32x4*)(outf + off + bj * 128 + n * 16) = v;
                        else { u32x2 w; w.x = cvt_pk_bf16(v[0], v[1]); w.y = cvt_pk_bf16(v[2], v[3]); *(u32x2*)(xb + off + bj * 128 + n * 16) = w;
                               sq += (v[0] * v[0] + v[1] * v[1]) + (v[2] * v[2] + v[3] * v[3]); } }
                if constexpr (!OUT_F32 && SCALE != 2) { sq += __shfl_xor(sq, 16); sq += __shfl_xor(sq, 32); if (fq == 0) atomicAdd(ssq + row, (u64_t)(sq * SSQ_FIX)); }
            }
        }
    }
};
struct EpiWin {
    static constexpr bool PERM = true, AFTER_DRAIN = false;
    bf16_t* O; const float* cs; const float* sn; const u64_t* ssq;
    typedef PreSsq Pre;
    __device__ __forceinline__ void prefetch(const Unit& u, int wr, int fr, Pre& pre) const {
        const int row0 = u.pm * 256 + wr * 64 + fr;
#pragma unroll
        for (int ai = 0; ai < 2; ++ai)
#pragma unroll
            for (int m = 0; m < 4; ++m) pre.v[ai][m] = ssq[row0 + ai * 128 + m * 16];
    }
    __device__ __forceinline__ void operator()(const f32x4 (&acc)[2][2][4][2], const Unit& u, int wr, int wc, int fr, int fq, const Pre& pre) const {
        const int row0 = u.pm * 256 + wr * 64 + fr, col0 = u.pn * 256 + wc * 32 + 8 * fq;
        const bool rot = u.pn < 8;
        float rsv[2][4];
#pragma unroll
        for (int ai = 0; ai < 2; ++ai)
#pragma unroll
            for (int m = 0; m < 4; ++m) rsv[ai][m] = (float)pre.v[ai][m] * SSQ_INV;
#pragma unroll
        for (int ai = 0; ai < 2; ++ai) {
            f32x4 cc[4][2], sv[4][2];
#pragma unroll
            for (int m = 0; m < 4; ++m) {
                if (rot) { const int pos = (row0 + ai * 128 + m * 16) & (SEQ - 1);
                    const float* cp = cs + pos * 128 + wc * 32 + 8 * fq; const float* sp = sn + pos * 128 + wc * 32 + 8 * fq;
                    cc[m][0] = *(const f32x4*)cp; cc[m][1] = *(const f32x4*)(cp + 4); sv[m][0] = *(const f32x4*)sp; sv[m][1] = *(const f32x4*)(sp + 4); }
                else { cc[m][0] = cc[m][1] = (f32x4){1.f, 1.f, 1.f, 1.f}; sv[m][0] = sv[m][1] = (f32x4){0.f, 0.f, 0.f, 0.f}; }
            }
#pragma unroll
            for (int m = 0; m < 4; ++m) {
                const int row = row0 + ai * 128 + m * 16;
                const float rs = __builtin_amdgcn_rsqf(rsv[ai][m] * (1.0f / DM) + EPS);
                const f32x4 a0 = acc[ai][0][m][0] * rs, a1 = acc[ai][0][m][1] * rs, b0 = acc[ai][1][m][0] * rs, b1 = acc[ai][1][m][1] * rs;
                const f32x4 na0 = a0 * cc[m][0] - b0 * sv[m][0], nb0 = b0 * cc[m][0] + a0 * sv[m][0], na1 = a1 * cc[m][1] - b1 * sv[m][1], nb1 = b1 * cc[m][1] + a1 * sv[m][1];
                bf16_t* rowp = O + (size_t)row * PW + col0;
                u32x4 w; w.x = cvt_pk_bf16(na0[0], na0[1]); w.y = cvt_pk_bf16(na0[2], na0[3]); w.z = cvt_pk_bf16(na1[0], na1[1]); w.w = cvt_pk_bf16(na1[2], na1[3]);
                *(u32x4*)rowp = w;
                u32x4 v; v.x = cvt_pk_bf16(nb0[0], nb0[1]); v.y = cvt_pk_bf16(nb0[2], nb0[3]); v.z = cvt_pk_bf16(nb1[0], nb1[1]); v.w = cvt_pk_bf16(nb1[2], nb1[3]);
                *(u32x4*)(rowp + 128) = v;
            }
        }
    }
};
struct EpiQkv {
    static constexpr bool PERM = false, AFTER_DRAIN = false;
    bf16_t* O; const float* cs; const float* sn; const u64_t* ssq;
    typedef PreSsq Pre;
    __device__ __forceinline__ void prefetch(const Unit& u, int wr, int fr, Pre& pre) const {
#pragma unroll
        for (int ai = 0; ai < 2; ++ai)
#pragma unroll
            for (int m = 0; m < 4; ++m) pre.v[ai][m] = ssq[u.pm * 256 + ai * 128 + wr * 64 + m * 16 + fr];
    }
    __device__ __forceinline__ void operator()(const f32x4 (&acc)[2][2][4][2], const Unit& u, int wr, int wc, int fr, int fq, const Pre& pre) const {
        const int col0 = u.pn * 256 + wc * 32 + 4 * fq;
        const bool rot = (u.pn < 16) && (wc == 0);
        const float sc0 = (u.pn < 8) ? QSCALE : 1.0f;
        float rsv[2][4]; f32x4 cv[2][4], sv[2][4];
#pragma unroll
        for (int ai = 0; ai < 2; ++ai)
#pragma unroll
            for (int m = 0; m < 4; ++m) { const int row = u.pm * 256 + ai * 128 + wr * 64 + m * 16 + fr; rsv[ai][m] = (float)pre.v[ai][m] * SSQ_INV;
                if (rot) { const int pos = row & (SEQ - 1); cv[ai][m] = *(const f32x4*)(cs + pos * 16 + 4 * fq); sv[ai][m] = *(const f32x4*)(sn + pos * 16 + 4 * fq); }
                else { cv[ai][m] = (f32x4){1.f, 1.f, 1.f, 1.f}; sv[ai][m] = (f32x4){0.f, 0.f, 0.f, 0.f}; } }
#pragma unroll
        for (int ai = 0; ai < 2; ++ai)
#pragma unroll
            for (int m = 0; m < 4; ++m) {
                const int row = u.pm * 256 + ai * 128 + wr * 64 + m * 16 + fr;
                const float sc = sc0 * __builtin_amdgcn_rsqf(rsv[ai][m] * (1.0f / DM) + EPS);
                const f32x4 c = cv[ai][m], s = sv[ai][m];
#pragma unroll
                for (int bj = 0; bj < 2; ++bj) {
                    const f32x4 x0 = acc[ai][bj][m][0], x1 = acc[ai][bj][m][1];
                    const f32x4 n0 = (x0 * c - x1 * s) * sc, n1 = (x1 * c + x0 * s) * sc;
                    bf16_t* p = O + (size_t)row * QW + col0 + bj * 128;
                    u32x2 w0; w0.x = cvt_pk_bf16(n0[0], n0[1]); w0.y = cvt_pk_bf16(n0[2], n0[3]); *(u32x2*)p = w0;
                    u32x2 w1; w1.x = cvt_pk_bf16(n1[0], n1[1]); w1.y = cvt_pk_bf16(n1[2], n1[3]); *(u32x2*)(p + 16) = w1;
                }
            }
    }
};
struct EpiGlu {
    static constexpr bool PERM = true, AFTER_DRAIN = false;
    const bf16_t* Z; const float* bias; bf16_t* Y;
    typedef PreNone Pre;
    __device__ __forceinline__ void prefetch(const Unit&, int, int, Pre&) const {}
    __device__ __forceinline__ void operator()(const f32x4 (&acc)[2][2][4][2], const Unit& u, int wr, int wc, int fr, int fq, const Pre&) const {
        const int row0 = u.pm * 256 + wr * 64 + fr, col0 = u.pn * 256 + wc * 32 + 8 * fq;
#pragma unroll
        for (int bj = 0; bj < 2; ++bj) {
            const f32x4 bv0 = *(const f32x4*)(bias + col0 + bj * 128), bv1 = *(const f32x4*)(bias + col0 + bj * 128 + 4);
            u32x4 zz[2][4];
#pragma unroll
            for (int ai = 0; ai < 2; ++ai)
#pragma unroll
                for (int m = 0; m < 4; ++m) zz[ai][m] = *(const u32x4*)(Z + (size_t)(row0 + ai * 128 + m * 16) * 1024 + col0 + bj * 128);
#pragma unroll
            for (int ai = 0; ai < 2; ++ai)
#pragma unroll
                for (int m = 0; m < 4; ++m) {
                    const int row = row0 + ai * 128 + m * 16;
                    const u32x4 z4 = zz[ai][m];
                    const f32x4 v0 = acc[ai][bj][m][0] + bv0, v1 = acc[ai][bj][m][1] + bv1;
                    u32x4 w;
                    w.x = cvt_pk_bf16(bflo(z4.x) * fast_sigmoid(v0[0]), bfhi(z4.x) * fast_sigmoid(v0[1]));
                    w.y = cvt_pk_bf16(bflo(z4.y) * fast_sigmoid(v0[2]), bfhi(z4.y) * fast_sigmoid(v0[3]));
                    w.z = cvt_pk_bf16(bflo(z4.z) * fast_sigmoid(v1[0]), bfhi(z4.z) * fast_sigmoid(v1[1]));
                    w.w = cvt_pk_bf16(bflo(z4.w) * fast_sigmoid(v1[2]), bfhi(z4.w) * fast_sigmoid(v1[3]));
                    *(u32x4*)(Y + (size_t)row * DM + 1024 + col0 + bj * 128) = w;
                }
        }
    }
};

template <class Epi>
__device__ __forceinline__ void run_gemm(LAS unsigned char* lds, const bf16_t* A, const bf16_t* Bt, int M, int N, int K, const Epi E, int wgm = 8) {
    pg8::Gemm g{A, Bt, M, N, K}; pg8::StaticOrder S; S.init(M, N, (int)gridDim.x, (int)blockIdx.x, wgm);
    pg8::gemm_phase<Epi, pg8::StaticOrder, true, true>(lds, g, S, E);
}

__device__ __forceinline__ void conv_matrix(const float* __restrict__ W, bf16_t* __restrict__ WT, int K, int N, int mode, const float* __restrict__ gain, LAS float* scr, int gw, int NGW, int lane) {
    const int nblk = N / 64, nitems = (K / 64) * nblk;
    for (int item = gw; item < nitems; item += NGW) {
        const int kb = item / nblk, nb = item % nblk, k0 = 64 * kb, n0 = 64 * nb;
        const float gv = gain ? gain[k0 + lane] : 1.0f;
        const float* wp = W + (size_t)k0 * N + n0 + lane;
#pragma unroll
        for (int hb = 0; hb < 2; ++hb) {
            float v[32];
#pragma unroll
            for (int i = 0; i < 32; ++i) v[i] = wp[(size_t)(32 * hb + i) * N];
            asm volatile("" ::: "memory");
#pragma unroll
            for (int i = 0; i < 32; ++i) scr[(32 * hb + i) * 65 + lane] = v[i] * __builtin_bit_cast(float, __builtin_amdgcn_readlane(__builtin_bit_cast(int, gv), 32 * hb + i));
        }
        asm volatile("s_waitcnt lgkmcnt(0)" ::: "memory");
        const int c = lane & 7, ns = lane >> 3;
        const int rbase = (mode == 0) ? n0 : ((n0 >> 7) * 256 + (n0 & 127) + (mode == 2 ? 128 : 0));
#pragma unroll
        for (int j = 0; j < 8; ++j) { const int n = ns + 8 * j; const LAS float* sp = scr + (8 * c) * 65 + n;
            u32x4 o; o.x = pk2(sp[0 * 65], sp[1 * 65]); o.y = pk2(sp[2 * 65], sp[3 * 65]); o.z = pk2(sp[4 * 65], sp[5 * 65]); o.w = pk2(sp[6 * 65], sp[7 * 65]);
            *(u32x4*)(WT + (size_t)(rbase + n) * K + k0 + 8 * c) = o; }
        asm volatile("s_waitcnt lgkmcnt(0)" ::: "memory");
    }
}

template <bool TO_BF16>
__device__ __forceinline__ void rmsnorm_phase(const float* in, const float* __restrict__ g, bf16_t* outb, float* outf, int gw, int NGW, int lane) {
    f32x4 gv[8];
#pragma unroll
    for (int j = 0; j < 8; ++j) gv[j] = ((const f32x4*)g)[lane + 64 * j];
    for (int row = gw; row < TT; row += NGW) {
        const f32x4* xr = (const f32x4*)(in + (size_t)row * DM) + lane;
        f32x4 v[8]; float ss = 0.f;
#pragma unroll
        for (int j = 0; j < 8; ++j) { v[j] = xr[64 * j]; ss += (v[j][0] * v[j][0] + v[j][1] * v[j][1]) + (v[j][2] * v[j][2] + v[j][3] * v[j][3]); }
        const float rs = 1.0f / sqrtf(wave_sum(ss) * (1.0f / DM) + EPS);
#pragma unroll
        for (int j = 0; j < 8; ++j) {
            const f32x4 y = v[j] * rs * gv[j];
            if constexpr (TO_BF16) { u32x2 w; w.x = pk2(y[0], y[1]); w.y = pk2(y[2], y[3]); *((u32x2*)(outb + (size_t)row * DM) + lane + 64 * j) = w; }
            else { *((f32x4*)(outf + (size_t)row * DM) + lane + 64 * j) = y; }
        }
    }
}

__device__ __forceinline__ void cast_phase(const float* in, bf16_t* outb, u64_t* ssq, int gw, int NGW, int lane) {
    for (int row = gw; row < TT; row += NGW) {
        const f32x4* xr = (const f32x4*)(in + (size_t)row * DM) + lane;
        f32x4 v[8]; float ss = 0.f;
#pragma unroll
        for (int j = 0; j < 8; ++j) { v[j] = xr[64 * j]; ss += (v[j][0] * v[j][0] + v[j][1] * v[j][1]) + (v[j][2] * v[j][2] + v[j][3] * v[j][3]); }
        ss = wave_sum(ss);
        if (lane == 0) ssq[row] = (u64_t)(ss * SSQ_FIX);
#pragma unroll
        for (int j = 0; j < 8; ++j) { u32x2 w; w.x = pk2(v[j][0], v[j][1]); w.y = pk2(v[j][2], v[j][3]); *((u32x2*)(outb + (size_t)row * DM) + lane + 64 * j) = w; }
    }
}

__device__ __forceinline__ void final_phase(const bf16_t* xb, const u64_t* ssq, const float* __restrict__ g, float* outf, int gw, int NGW, int lane) {
    f32x4 gv[4][2];
#pragma unroll
    for (int j = 0; j < 4; ++j) { gv[j][0] = *(const f32x4*)(g + 8 * (lane + 64 * j)); gv[j][1] = *(const f32x4*)(g + 8 * (lane + 64 * j) + 4); }
    for (int row = gw; row < TT; row += NGW) {
        const float rs = __builtin_amdgcn_rsqf((float)ssq[row] * SSQ_INV * (1.0f / DM) + EPS);
        const u32x4* xr = (const u32x4*)(xb + (size_t)row * DM) + lane;
        u32x4 v[4];
#pragma unroll
        for (int j = 0; j < 4; ++j) v[j] = xr[64 * j];
#pragma unroll
        for (int j = 0; j < 4; ++j) {
            float* op = outf + (size_t)row * DM + 8 * (lane + 64 * j);
            *(f32x4*)op = (f32x4){bflo(v[j].x), bfhi(v[j].x), bflo(v[j].y), bfhi(v[j].y)} * rs * gv[j][0];
            *(f32x4*)(op + 4) = (f32x4){bflo(v[j].z), bfhi(v[j].z), bflo(v[j].w), bfhi(v[j].w)} * rs * gv[j][1];
        }
    }
}

__device__ __forceinline__ void tables_phase(unsigned char* ws, const float* const* in_unused, const float* lam_re, const float* lam_im, const float* log_step, const float* b_re, const float* b_im,
                                             const float* lq1, const float* lk1, const float* lq2, const float* lk2, int gtid, int NT_) {
    float* rcos = (float*)(ws + WS_RCOS); float* rsin = (float*)(ws + WS_RSIN); float* acos_ = (float*)(ws + WS_ACOS); float* asin_ = (float*)(ws + WS_ASIN);
    float* s5a = (float*)(ws + WS_S5A); float* s5bb = (float*)(ws + WS_S5BB);
    for (int i = gtid; i < SEQ * 128; i += NT_) {
        const int pos = i >> 7, f = i & 127;
        const float inv = (float)exp2(-((double)(2 * f) / 256.0) * 13.287712379549449);
        const float ang = (float)pos * inv; double s, c; sincos_d((double)ang, s, c); rcos[i] = (float)c; rsin[i] = (float)s;
    }
    for (int i = gtid; i < SEQ * 16; i += NT_) {
        const int pos = i >> 4, f = i & 15;
        const float inv = (float)exp2(-((double)(2 * f) / 32.0) * 18.931568569324174);
        const float ang = (float)pos * inv; double s, c; sincos_d((double)ang, s, c); acos_[i] = (float)c; asin_[i] = (float)s;
    }
    for (int i = gtid; i < 64 * 64; i += NT_) {
        const int g = i >> 6;
        const double step = exp((double)log_step[g]), lr = (double)lam_re[i], li = (double)lam_im[i];
        const double mag = exp(lr * step); double s, c; sincos_d(li * step, s, c);
        const double are = mag * c, aim = mag * s, den = lr * lr + li * li, nr = are - 1.0;
        const double fre = (nr * lr + aim * li) / den, fim = (aim * lr - nr * li) / den;
        s5a[2 * i] = (float)are; s5a[2 * i + 1] = (float)aim;
        for (int p = 0; p < 16; ++p) { const double br = (double)b_re[i * 16 + p], bi = (double)b_im[i * 16 + p];
            s5bb[(size_t)i * 32 + p] = (float)(fre * br - fim * bi); s5bb[(size_t)i * 32 + 16 + p] = (float)(fre * bi + fim * br); }
    }
    if (gtid == 0) { float s1 = 0.f, s2 = 0.f; for (int i = 0; i < 128; ++i) { s1 += lq1[i] * lk1[i]; s2 += lq2[i] * lk2[i]; }
        ((float*)(ws + WS_CTL))[0] = expf(s1) - expf(s2) + LAMBDA_INIT; }
}

__device__ __forceinline__ void s5_phase(LAS unsigned char* lds, const unsigned char* ws, const bf16_t* proj, const float* c_re, const float* c_im, const float* dskip, bf16_t* z,
                                         int vcu, int G, int wave, int lane) {
    const float* s5a = (const float*)(ws + WS_S5A); const float* s5bb = (const float*)(ws + WS_S5BB);
    LAS bf16_t* Hc = (LAS bf16_t*)(lds + wave * 8704);
    LAS float* Uc = (LAS float*)(lds + 8 * 8704 + wave * 2048);
    const int fr = lane & 15, fq = lane >> 4;
    for (int seq = vcu * 8 + wave; seq < 1024; seq += G * 8) {
        const int b = seq >> 6, g = seq & 63, n = lane;
        float bbre[16], bbim[16];
#pragma unroll
        for (int p = 0; p < 16; ++p) { bbre[p] = s5bb[(size_t)(g * 64 + n) * 32 + p]; bbim[p] = s5bb[(size_t)(g * 64 + n) * 32 + 16 + p]; }
        const float are = s5a[2 * (g * 64 + n)], aim = s5a[2 * (g * 64 + n) + 1];
        bf16x8 cf[4];
#pragma unroll
        for (int ks = 0; ks < 4; ++ks) { u32x4 w; unsigned* wp = (unsigned*)&w;
#pragma unroll
            for (int j2 = 0; j2 < 4; ++j2) { float v[2];
#pragma unroll
                for (int e = 0; e < 2; ++e) { const int k = 32 * ks + 8 * fq + 2 * j2 + e; v[e] = (k < 64) ? c_re[(size_t)(g * 16 + fr) * 64 + k] : -c_im[(size_t)(g * 16 + fr) * 64 + (k - 64)]; }
                wp[j2] = pk2(v[0], v[1]); }
            cf[ks] = __builtin_bit_cast(bf16x8, w); }
        const float dsk = dskip[g * 16 + fr];
        float hre = 0.f, him = 0.f;
        const bf16_t* ubase = proj + (size_t)b * SEQ * PW + 4096 + g * 16;
        u32x4 ua = *(const u32x4*)(ubase + (size_t)(lane & 31) * PW), ub = *(const u32x4*)(ubase + (size_t)(lane & 31) * PW + 8);
        unsigned short uu[2][4];
#pragma unroll
        for (int sb = 0; sb < 2; ++sb)
#pragma unroll
            for (int i = 0; i < 4; ++i) uu[sb][i] = ubase[(size_t)(16 * sb + 4 * fq + i) * PW + fr];
        for (int ch = 0; ch < SEQ / 32; ++ch) {
            const size_t row0 = (size_t)b * SEQ + ch * 32;
            const int chn = (ch + 1 < SEQ / 32) ? ch + 1 : ch;
            const bf16_t* unext = ubase + (size_t)chn * 32 * PW;
            const u32x4 ua_n = *(const u32x4*)(unext + (size_t)(lane & 31) * PW), ub_n = *(const u32x4*)(unext + (size_t)(lane & 31) * PW + 8);
            unsigned short uu_n[2][4];
#pragma unroll
            for (int sb = 0; sb < 2; ++sb)
#pragma unroll
                for (int i = 0; i < 4; ++i) uu_n[sb][i] = unext[(size_t)(16 * sb + 4 * fq + i) * PW + fr];
            if (lane < 32) {
                LAS f32x4* up4 = (LAS f32x4*)(Uc + lane * 16);
                up4[0] = (f32x4){bflo(ua.x), bfhi(ua.x), bflo(ua.y), bfhi(ua.y)}; up4[1] = (f32x4){bflo(ua.z), bfhi(ua.z), bflo(ua.w), bfhi(ua.w)};
                up4[2] = (f32x4){bflo(ub.x), bfhi(ub.x), bflo(ub.y), bfhi(ub.y)}; up4[3] = (f32x4){bflo(ub.z), bfhi(ub.z), bflo(ub.w), bfhi(ub.w)};
            }
#pragma unroll
            for (int k = 0; k < 32; ++k) {
                f32x2 xa = (f32x2){0.f, 0.f}, xb = (f32x2){0.f, 0.f};
#pragma unroll
                for (int q = 0; q < 4; ++q) { const f32x4 u4 = *(const LAS f32x4*)(Uc + k * 16 + 4 * q);
                    xa = __builtin_elementwise_fma((f32x2){u4[0], u4[0]}, (f32x2){bbre[4 * q], bbim[4 * q]}, xa);
                    xb = __builtin_elementwise_fma((f32x2){u4[1], u4[1]}, (f32x2){bbre[4 * q + 1], bbim[4 * q + 1]}, xb);
                    xa = __builtin_elementwise_fma((f32x2){u4[2], u4[2]}, (f32x2){bbre[4 * q + 2], bbim[4 * q + 2]}, xa);
                    xb = __builtin_elementwise_fma((f32x2){u4[3], u4[3]}, (f32x2){bbre[4 * q + 3], bbim[4 * q + 3]}, xb); }
                const f32x2 xx = xa + xb;
                const float nr = are * hre - aim * him + xx[0], ni = are * him + aim * hre + xx[1]; hre = nr; him = ni;
                Hc[k * 136 + n] = (bf16_t)f2bf(hre); Hc[k * 136 + 64 + n] = (bf16_t)f2bf(him);
            }
#pragma unroll
            for (int sb = 0; sb < 2; ++sb) {
                f32x4 y = (f32x4){0.f, 0.f, 0.f, 0.f};
#pragma unroll
                for (int ks = 0; ks < 4; ++ks) { const bf16x8 hf = *(const LAS bf16x8*)(Hc + (16 * sb + fr) * 136 + 32 * ks + 8 * fq); y = __builtin_amdgcn_mfma_f32_16x16x32_bf16(hf, cf[ks], y, 0, 0, 0); }
#pragma unroll
                for (int i = 0; i < 4; ++i) { const size_t row = row0 + 16 * sb + 4 * fq + i;
                    const float yy = y[i] + dsk * bf2f(uu[sb][i]);
                    z[row * 1024 + g * 16 + fr] = (bf16_t)f2bf(gelu_tanh_f(yy)); }
            }
            ua = ua_n; ub = ub_n;
#pragma unroll
            for (int sb = 0; sb < 2; ++sb)
#pragma unroll
                for (int i = 0; i < 4; ++i) uu[sb][i] = uu_n[sb][i];
        }
    }
}

#define MF32(a, b, c) __builtin_amdgcn_mfma_f32_32x32x16_bf16((a), (b), (c), 0, 0, 0)
#define AT_WAITV(n) asm volatile("s_waitcnt vmcnt(" #n ")" ::: "memory")
#define AT_BAR() asm volatile("s_waitcnt lgkmcnt(0)\n\ts_barrier" ::: "memory")
__device__ __forceinline__ s16x4 vtr(const LAS unsigned char* p) { typedef short v4i16_t __attribute__((ext_vector_type(4))); return __builtin_bit_cast(s16x4, __builtin_amdgcn_ds_read_tr16_b64_v4i16((LAS v4i16_t*)p)); }
__device__ __forceinline__ int crow(int i, int h) { return (i & 3) + 8 * (i >> 2) + 4 * h; }

template <int MODE>
__device__ __forceinline__ void attn_unit(LAS unsigned char* lds, const bf16_t* src, const int pitch, const int kcol, const int vcol, const int b, const int h, const int ub,
                                          bf16_t* outp, const bf16_t* gsrc, const float* subln, const float lam) {
    constexpr int NKS = MODE ? 8 : 16, NDB = 4, ROWS = MODE ? 64 : 128;
    const int tid = threadIdx.x, lane = tid & 63, r = lane & 31, hh = lane >> 5;
    const int wid = __builtin_amdgcn_readfirstlane(tid >> 6);
    const int rg = MODE ? (wid & 1) : (wid & 3), vh = MODE ? ((wid >> 1) & 1) : (wid >> 2), cc = MODE ? (wid >> 2) : 0;
    const size_t rowbase = (size_t)b * SEQ; const int q0 = ub * ROWS, NT = MODE ? (ub + 1) : (2 * ub + 2);
    const int qrow = q0 + rg * 32 + r;
    AT_WAITV(0);
#define AT_ISSUE(t, buf) do { const bf16_t* gk_ = src + (rowbase + (size_t)(t) * 64) * pitch; int rv_ = r; asm volatile("" : "+v"(rv_)); \
        _Pragma("unroll") for (int i_ = 0; i_ < 4; ++i_) { const int c_ = wid * 4 + i_; const int row_ = c_ * 2 + hh; \
            const unsigned ok_ = (unsigned)(row_ * pitch + kcol + ((rv_ ^ (row_ & 15)) << 3)); \
            __builtin_amdgcn_global_load_lds((const unsigned*)(gk_ + ok_), (LAS unsigned*)(lds + (buf) * 65536 + c_ * 1024), 16, 0, 0); \
            const unsigned ov_ = (unsigned)(row_ * pitch + vcol + ((rv_ ^ ((row_ & 3) << 2)) << 3)); \
            __builtin_amdgcn_global_load_lds((const unsigned*)(gk_ + ov_), (LAS unsigned*)(lds + (buf) * 65536 + 32768 + c_ * 1024), 16, 0, 0); } } while (0)
    AT_ISSUE(0, 0);
    bf16x8 qf[NKS];
    { const bf16_t* qp = src + (rowbase + qrow) * pitch + h * 256 + cc * 128 + 8 * hh;
#pragma unroll
      for (int d0 = 0; d0 < NKS; ++d0) qf[d0] = *(const bf16x8*)(qp + 16 * d0); }
    f32x16 O[NDB];
#pragma unroll
    for (int db = 0; db < NDB; ++db)
#pragma unroll
        for (int i = 0; i < 16; ++i) O[db][i] = 0.f;
    float mrun = 0.f, lrun = 0.f;
    const float lgam = __builtin_log2f(1.0f - __builtin_amdgcn_exp2f(-5.0f - (float)h));
    const int r15 = r & 15;
    const int kunit0 = cc * 16;
    const int q4 = (lane & 15) >> 2, p4 = lane & 3, blk16 = (lane >> 4) & 1;
    const int vlane = (4 * hh + q4) * 512 + ((2 * blk16 + (p4 >> 1)) << 4) + 8 * (p4 & 1);
    for (int t = 0; t < NT; ++t) {
        if (t + 1 < NT) { AT_ISSUE(t + 1, (t + 1) & 1); AT_WAITV(8); } else { AT_WAITV(0); }
        AT_BAR();
        const bool active = MODE ? true : !(t == NT - 1 && rg < 2);
        if (active) {
            const LAS unsigned char* Kb = lds + (t & 1) * 65536; const LAS unsigned char* Vb = Kb + 32768;
            int r15v = r15 ^ hh ^ kunit0, q4v = q4 << 2; asm volatile("" : "+v"(r15v), "+v"(q4v));
            bf16x8 pf[4];
            if constexpr (MODE) {
                f32x16 p0, p1;
#pragma unroll
                for (int i = 0; i < 16; ++i) { p0[i] = -mrun; p1[i] = -mrun; }
                { const LAS unsigned char* kr0 = Kb + r * 512; const LAS unsigned char* kr1 = Kb + (32 + r) * 512;
#pragma unroll
                  for (int d0 = 0; d0 < NKS; ++d0) { const int uo = ((2 * d0) ^ r15v) << 4;
                      const bf16x8 k0 = *(const LAS bf16x8*)(kr0 + uo); const bf16x8 k1 = *(const LAS bf16x8*)(kr1 + uo);
                      p0 = MF32(k0, qf[d0], p0); p1 = MF32(k1, qf[d0], p1);
                      if ((d0 & 3) == 3) __builtin_amdgcn_sched_barrier(0); } }
                float rm = p0[0];
#pragma unroll
                for (int i = 0; i < 16; ++i) { rm = fmaxf(rm, p0[i]); rm = fmaxf(rm, p1[i]); }
                rm = fmaxf(rm, __shfl_xor(rm, 32));
                if (t == 0 || __any(rm > 8.0f)) {
                    const float dl = (t == 0) ? rm : fmaxf(rm, 0.f); const float al = (t == 0) ? 1.0f : __builtin_amdgcn_exp2f(-dl); lrun *= al; mrun += dl;
#pragma unroll
                    for (int i = 0; i < 16; ++i) { p0[i] -= dl; p1[i] -= dl; }
#pragma unroll
                    for (int db = 0; db < NDB; ++db) O[db] = O[db] * al;
                }
                float sum = 0.f;
#pragma unroll
                for (int i = 0; i < 16; ++i) { p0[i] = __builtin_amdgcn_exp2f(p0[i]); p1[i] = __builtin_amdgcn_exp2f(p1[i]); sum += p0[i] + p1[i]; }
                lrun += sum;
                u32x4 w;
                w.x = cvt_pk_bf16(p0[0], p0[1]); w.y = cvt_pk_bf16(p0[2], p0[3]); w.z = cvt_pk_bf16(p0[4], p0[5]); w.w = cvt_pk_bf16(p0[6], p0[7]); pf[0] = __builtin_bit_cast(bf16x8, w);
                w.x = cvt_pk_bf16(p0[8], p0[9]); w.y = cvt_pk_bf16(p0[10], p0[11]); w.z = cvt_pk_bf16(p0[12], p0[13]); w.w = cvt_pk_bf16(p0[14], p0[15]); pf[1] = __builtin_bit_cast(bf16x8, w);
                w.x = cvt_pk_bf16(p1[0], p1[1]); w.y = cvt_pk_bf16(p1[2], p1[3]); w.z = cvt_pk_bf16(p1[4], p1[5]); w.w = cvt_pk_bf16(p1[6], p1[7]); pf[2] = __builtin_bit_cast(bf16x8, w);
                w.x = cvt_pk_bf16(p1[8], p1[9]); w.y = cvt_pk_bf16(p1[10], p1[11]); w.z = cvt_pk_bf16(p1[12], p1[13]); w.w = cvt_pk_bf16(p1[14], p1[15]); pf[3] = __builtin_bit_cast(bf16x8, w);
            } else {
#pragma unroll
                for (int blk = 0; blk < 2; ++blk) {
                    f32x16 p;
#pragma unroll
                    for (int i = 0; i < 16; ++i) p[i] = 0.f;
                    const LAS unsigned char* kr = Kb + (32 * blk + r) * 512;
#pragma unroll
                    for (int d0 = 0; d0 < NKS; ++d0) { const int uo = ((2 * d0) ^ r15v) << 4;
                        const bf16x8 k0 = *(const LAS bf16x8*)(kr + uo); p = MF32(k0, qf[d0], p);
                        if ((d0 & 3) == 3) __builtin_amdgcn_sched_barrier(0); }
                    const int kb = t * 64 + 32 * blk + 4 * hh;
#pragma unroll
                    for (int i = 0; i < 16; ++i) { const int kv = kb + (i & 3) + 8 * (i >> 2);
                        p[i] *= __builtin_amdgcn_exp2f(lgam * fabsf((float)(qrow - kv)) - 4.0f); }
                    u32x4 w;
                    w.x = cvt_pk_bf16(p[0], p[1]); w.y = cvt_pk_bf16(p[2], p[3]); w.z = cvt_pk_bf16(p[4], p[5]); w.w = cvt_pk_bf16(p[6], p[7]); pf[2 * blk] = __builtin_bit_cast(bf16x8, w);
                    w.x = cvt_pk_bf16(p[8], p[9]); w.y = cvt_pk_bf16(p[10], p[11]); w.z = cvt_pk_bf16(p[12], p[13]); w.w = cvt_pk_bf16(p[14], p[15]); pf[2 * blk + 1] = __builtin_bit_cast(bf16x8, w);
                    __builtin_amdgcn_sched_barrier(0);
                }
            }
            const LAS unsigned char* vb = Vb + vlane;
            __builtin_amdgcn_sched_barrier(0);
#pragma unroll
            for (int db = 0; db < NDB; ++db) {
                const int dunit = vh * 16 + 4 * db;
                const LAS unsigned char* vp = vb + ((dunit ^ q4v) << 4);
#pragma unroll
                for (int ks = 0; ks < 4; ++ks) {
                    const int kvb = 32 * (ks >> 1) + 16 * (ks & 1);
                    const s16x4 lo = vtr(vp + kvb * 512), hi = vtr(vp + (kvb + 8) * 512);
                    const bf16x8 vf = __builtin_shufflevector(lo, hi, 0, 1, 2, 3, 4, 5, 6, 7);
                    O[db] = MF32(vf, pf[ks], O[db]);
                }
                __builtin_amdgcn_sched_barrier(0);
            }
        }
        AT_BAR();
    }
    const size_t orow = rowbase + qrow;
    LAS float* SS = (LAS float*)(lds + 131072);
    if constexpr (MODE) {
        const float l = lrun + __shfl_xor(lrun, 32); const float inv = 1.0f / l;
        LAS float* X = (LAS float*)(lds + (wid & 3) * 16384);
        if (cc == 1) {
#pragma unroll
            for (int db = 0; db < NDB; ++db)
#pragma unroll
                for (int i = 0; i < 16; ++i) X[(db * 16 + i) * 64 + lane] = O[db][i] * inv;
        }
        AT_BAR();
        float ss = 0.f;
        if (cc == 0) {
#pragma unroll
            for (int db = 0; db < NDB; ++db)
#pragma unroll
                for (int i = 0; i < 16; ++i) { const float o = O[db][i] * inv - lam * X[(db * 16 + i) * 64 + lane]; O[db][i] = o; ss += o * o; }
        }
        ss += __shfl_xor(ss, 32);
        if (hh == 0) SS[wid * 32 + r] = ss;
        AT_BAR();
        if (cc == 0) {
            ss += SS[(wid ^ 2) * 32 + r];
            const float rs = (1.0f - LAMBDA_INIT) / sqrtf(ss * (1.0f / 256.0f) + EPS);
            bf16_t* op = outp + orow * DM + h * 256 + vh * 128 + 4 * hh;
            const float* slp = subln + vh * 128 + 4 * hh;
#pragma unroll
            for (int db = 0; db < NDB; ++db)
#pragma unroll
                for (int i4 = 0; i4 < 4; ++i4) { const int d = 32 * db + 8 * i4;
                    const f32x4 sl = *(const f32x4*)(slp + d);
                    u32x2 w; w.x = cvt_pk_bf16(O[db][4 * i4] * rs * sl[0], O[db][4 * i4 + 1] * rs * sl[1]); w.y = cvt_pk_bf16(O[db][4 * i4 + 2] * rs * sl[2], O[db][4 * i4 + 3] * rs * sl[3]);
                    *(u32x2*)(op + d) = w; }
        }
        AT_BAR();
    } else {
        float ss = 0.f;
#pragma unroll
        for (int db = 0; db < NDB; ++db)
#pragma unroll
            for (int i = 0; i < 16; ++i) ss += O[db][i] * O[db][i];
        ss += __shfl_xor(ss, 32);
        if (hh == 0) SS[wid * 32 + r] = ss;
        AT_BAR();
        ss += SS[(wid ^ 4) * 32 + r];
        const float rs = 1.0f / sqrtf(ss * (1.0f / 256.0f) + EPS);
        const bf16_t* gp = gsrc + orow * PW + 3072 + h * 256 + vh * 128 + 4 * hh;
        bf16_t* op = outp + orow * DM + h * 256 + vh * 128 + 4 * hh;
        u32x2 ggv[NDB][4];
#pragma unroll
        for (int db = 0; db < NDB; ++db)
#pragma unroll
            for (int i4 = 0; i4 < 4; ++i4) ggv[db][i4] = *(const u32x2*)(gp + 32 * db + 8 * i4);
#pragma unroll
        for (int db = 0; db < NDB; ++db)
#pragma unroll
            for (int i4 = 0; i4 < 4; ++i4) { const int d = 32 * db + 8 * i4;
                const u32x2 gg = ggv[db][i4];
                u32x2 w; w.x = cvt_pk_bf16(O[db][4 * i4] * rs * silu_f(bflo(gg.x)), O[db][4 * i4 + 1] * rs * silu_f(bfhi(gg.x)));
                w.y = cvt_pk_bf16(O[db][4 * i4 + 2] * rs * silu_f(bflo(gg.y)), O[db][4 * i4 + 3] * rs * silu_f(bfhi(gg.y)));
                *(u32x2*)(op + d) = w; }
        AT_BAR();
    }
#undef AT_ISSUE
}

__device__ __forceinline__ void attn_unit_diff128(LAS unsigned char* lds, const bf16_t* src, const int pitch, const int kcol, const int vcol, const int b, const int h, const int ub,
                                                  bf16_t* outp, const float* subln, const float lam) {
    constexpr int NKS = 8, NDB = 8;
    const int tid = threadIdx.x, lane = tid & 63, r = lane & 31, hh = lane >> 5;
    const int wid = __builtin_amdgcn_readfirstlane(tid >> 6);
    const int rg = wid & 3, cc = wid >> 2;
    const size_t rowbase = (size_t)b * SEQ; const int q0 = ub * 128, NT = 2 * ub + 2;
    const int qrow = q0 + rg * 32 + r;
    AT_WAITV(0);
#define AT_ISSUE(t, buf) do { const bf16_t* gk_ = src + (rowbase + (size_t)(t) * 64) * pitch; int rv_ = r; asm volatile("" : "+v"(rv_)); \
        _Pragma("unroll") for (int i_ = 0; i_ < 4; ++i_) { const int c_ = wid * 4 + i_; const int row_ = c_ * 2 + hh; \
            const unsigned ok_ = (unsigned)(row_ * pitch + kcol + ((rv_ ^ (row_ & 15)) << 3)); \
            __builtin_amdgcn_global_load_lds((const unsigned*)(gk_ + ok_), (LAS unsigned*)(lds + (buf) * 65536 + c_ * 1024), 16, 0, 0); \
            const unsigned ov_ = (unsigned)(row_ * pitch + vcol + ((rv_ ^ ((row_ & 3) << 2)) << 3)); \
            __builtin_amdgcn_global_load_lds((const unsigned*)(gk_ + ov_), (LAS unsigned*)(lds + (buf) * 65536 + 32768 + c_ * 1024), 16, 0, 0); } } while (0)
    AT_ISSUE(0, 0);
    bf16x8 qf[NKS];
    { const bf16_t* qp = src + (rowbase + qrow) * pitch + h * 256 + cc * 128 + 8 * hh;
#pragma unroll
      for (int d0 = 0; d0 < NKS; ++d0) qf[d0] = *(const bf16x8*)(qp + 16 * d0); }
    f32x16 O[NDB];
#pragma unroll
    for (int db = 0; db < NDB; ++db)
#pragma unroll
        for (int i = 0; i < 16; ++i) O[db][i] = 0.f;
    float mrun = 0.f, lrun = 0.f;
    const int r15 = r & 15, kunit0 = cc * 16;
    const int q4 = (lane & 15) >> 2, p4 = lane & 3, blk16 = (lane >> 4) & 1;
    const int vlane = (4 * hh + q4) * 512 + ((2 * blk16 + (p4 >> 1)) << 4) + 8 * (p4 & 1);
    for (int t = 0; t < NT; ++t) {
        if (t + 1 < NT) { AT_ISSUE(t + 1, (t + 1) & 1); AT_WAITV(8); } else { AT_WAITV(0); }
        AT_BAR();
        const bool active = !(t == NT - 1 && rg < 2);
        if (active) {
            const LAS unsigned char* Kb = lds + (t & 1) * 65536; const LAS unsigned char* Vb = Kb + 32768;
            int r15v = r15 ^ hh ^ kunit0, q4v = q4 << 2; asm volatile("" : "+v"(r15v), "+v"(q4v));
            const LAS unsigned char* vb = Vb + vlane;
#pragma unroll
            for (int blk = 0; blk < 2; ++blk) {
                f32x16 p;
#pragma unroll
                for (int i = 0; i < 16; ++i) p[i] = -mrun;
                const LAS unsigned char* kr = Kb + (32 * blk + r) * 512;
#pragma unroll
                for (int d0 = 0; d0 < NKS; ++d0) { const int uo = ((2 * d0) ^ r15v) << 4;
                    const bf16x8 k0 = *(const LAS bf16x8*)(kr + uo); p = MF32(k0, qf[d0], p);
                    if ((d0 & 3) == 3) __builtin_amdgcn_sched_barrier(0); }
                float rm = p[0];
#pragma unroll
                for (int i = 1; i < 16; ++i) rm = fmaxf(rm, p[i]);
                rm = fmaxf(rm, __shfl_xor(rm, 32));
                const bool first = (t == 0) && (blk == 0);
                if (first || __any(rm > 8.0f)) {
                    const float dl = first ? rm : fmaxf(rm, 0.f); const float al = first ? 1.0f : __builtin_amdgcn_exp2f(-dl); lrun *= al; mrun += dl;
#pragma unroll
                    for (int i = 0; i < 16; ++i) p[i] -= dl;
#pragma unroll
                    for (int db = 0; db < NDB; ++db) O[db] = O[db] * al;
                }
                float sum = 0.f;
#pragma unroll
                for (int i = 0; i < 16; ++i) { p[i] = __builtin_amdgcn_exp2f(p[i]); sum += p[i]; }
                lrun += sum;
                bf16x8 pf[2];
                { u32x4 w;
                  w.x = cvt_pk_bf16(p[0], p[1]); w.y = cvt_pk_bf16(p[2], p[3]); w.z = cvt_pk_bf16(p[4], p[5]); w.w = cvt_pk_bf16(p[6], p[7]); pf[0] = __builtin_bit_cast(bf16x8, w);
                  w.x = cvt_pk_bf16(p[8], p[9]); w.y = cvt_pk_bf16(p[10], p[11]); w.z = cvt_pk_bf16(p[12], p[13]); w.w = cvt_pk_bf16(p[14], p[15]); pf[1] = __builtin_bit_cast(bf16x8, w); }
                __builtin_amdgcn_sched_barrier(0);
#pragma unroll
                for (int db = 0; db < NDB; ++db) {
                    const LAS unsigned char* vp = vb + (((4 * db) ^ q4v) << 4);
#pragma unroll
                    for (int ks = 0; ks < 2; ++ks) {
                        const int kvb = 32 * blk + 16 * ks;
                        const s16x4 lo = vtr(vp + kvb * 512), hi = vtr(vp + (kvb + 8) * 512);
                        const bf16x8 vf = __builtin_shufflevector(lo, hi, 0, 1, 2, 3, 4, 5, 6, 7);
                        O[db] = MF32(vf, pf[ks], O[db]);
                    }
                    if (db & 1) __builtin_amdgcn_sched_barrier(0);
                }
            }
        }
        AT_BAR();
    }
    const size_t orow = rowbase + qrow;
    const float l = lrun + __shfl_xor(lrun, 32); const float inv = 1.0f / l;
    LAS float* X = (LAS float*)(lds + rg * 32768);
    if (cc == 1) {
#pragma unroll
        for (int db = 0; db < NDB; ++db)
#pragma unroll
            for (int i = 0; i < 16; ++i) X[(db * 16 + i) * 64 + lane] = O[db][i] * inv;
    }
    AT_BAR();
    if (cc == 0) {
        float ss = 0.f;
#pragma unroll
        for (int db = 0; db < NDB; ++db)
#pragma unroll
            for (int i = 0; i < 16; ++i) { const float o = O[db][i] * inv - lam * X[(db * 16 + i) * 64 + lane]; O[db][i] = o; ss += o * o; }
        ss += __shfl_xor(ss, 32);
        const float rs = (1.0f - LAMBDA_INIT) / sqrtf(ss * (1.0f / 256.0f) + EPS);
        bf16_t* op = outp + orow * DM + h * 256 + 4 * hh;
        const LAS float* slp = (const LAS float*)(lds + 132096) + 4 * hh;
#pragma unroll
        for (int db = 0; db < NDB; ++db)
#pragma unroll
            for (int i4 = 0; i4 < 4; ++i4) { const int d = 32 * db + 8 * i4;
                const f32x4 sl = *(const LAS f32x4*)(slp + d);
                u32x2 w; w.x = cvt_pk_bf16(O[db][4 * i4] * rs * sl[0], O[db][4 * i4 + 1] * rs * sl[1]); w.y = cvt_pk_bf16(O[db][4 * i4 + 2] * rs * sl[2], O[db][4 * i4 + 3] * rs * sl[3]);
                *(u32x2*)(op + d) = w; }
    }
    AT_BAR();
#undef AT_ISSUE
}

template <int MODE>
__device__ __forceinline__ void attn_phase(LAS unsigned char* lds, const bf16_t* src, int pitch, int kcol0, int vcol0, int nheads, bf16_t* outp, const bf16_t* gsrc, const float* subln, float lam, int vcu, int G) {
    constexpr int NU = 16;
    const int npairs = 16 * nheads * (NU / 2);
    if constexpr (MODE) { if (threadIdx.x < 256) ((LAS float*)(lds + 132096))[threadIdx.x] = subln[threadIdx.x]; __syncthreads(); }
    for (int pr = vcu; pr < npairs; pr += G) {
        const int bh = pr / (NU / 2), p = pr % (NU / 2), b = bh / nheads, h = bh % nheads;
        if constexpr (MODE) {
            attn_unit_diff128(lds, src, pitch, kcol0 + h * 256, vcol0 + h * 256, b, h, NU - 1 - p, outp, subln, lam);
            attn_unit_diff128(lds, src, pitch, kcol0 + h * 256, vcol0 + h * 256, b, h, p, outp, subln, lam);
        } else {
            attn_unit<0>(lds, src, pitch, kcol0 + h * 256, vcol0 + h * 256, b, h, NU - 1 - p, outp, gsrc, subln, lam);
            attn_unit<0>(lds, src, pitch, kcol0 + h * 256, vcol0 + h * 256, b, h, p, outp, gsrc, subln, lam);
        }
    }
}

#define XB_TMO      128
#define XB_XCNT(j)  (256  + 64 * (j))
#define XB_XSUB(j)  (1280 + 64 * (j))
#define XB_XGEN(j)  (2304 + 64 * (j))
#define XB_TOP      3328
#define XB_TOPGEN   3392
#define XCD_BAR_WORDS 3456
#define XB_SPIN_CAP (1u << 18)
__device__ __forceinline__ unsigned xb_ld(unsigned* p)              { return __hip_atomic_load(p, __ATOMIC_RELAXED, __HIP_MEMORY_SCOPE_AGENT); }
__device__ __forceinline__ unsigned xb_add(unsigned* p, unsigned v) { return __hip_atomic_fetch_add(p, v, __ATOMIC_RELAXED, __HIP_MEMORY_SCOPE_AGENT); }
__device__ __forceinline__ unsigned xb_xcc_id() { return (unsigned)__builtin_amdgcn_s_getreg((3 << 11) | 20) & 0xFu; }
#define XB_SPIN(cond, bar) do { unsigned _sp = 0; while (cond) { __builtin_amdgcn_s_sleep(1); \
    if ((++_sp & 255u) == 0u) { if (xb_ld(&(bar)[XB_TMO])) break; if (_sp > XB_SPIN_CAP) { atomicAdd(&(bar)[XB_TMO], 1u); break; } } } } while (0)
struct XcdBarrier { unsigned* bar; unsigned x; volatile LAS unsigned* st; };
__device__ __forceinline__ XcdBarrier xcd_barrier_post(unsigned* bar, volatile LAS unsigned* st) {
    XcdBarrier b; b.bar = bar; b.x = xb_xcc_id(); b.st = st;
    if (threadIdx.x == 0) (void)xb_add(&bar[XB_XCNT(b.x)], 1u);
    return b;
}
__device__ __forceinline__ void xcd_barrier_complete(unsigned* bar, unsigned x, unsigned& nloc, unsigned& nx) {
    const unsigned G = gridDim.x * gridDim.y * gridDim.z;
    unsigned sum, cnt, mine, sp = 0u;
    for (;;) {
        sum = 0u; cnt = 0u; mine = 0u;
#pragma unroll
        for (unsigned j = 0; j < 16; ++j) { const unsigned c = xb_ld(&bar[XB_XCNT(j)]); sum += c; cnt += (c > 0u) ? 1u : 0u; mine = (j == x) ? c : mine; }
        if (sum == G) break;
        __builtin_amdgcn_s_sleep(1);
        if ((++sp & 255u) == 0u) { if (xb_ld(&bar[XB_TMO])) break; if (sp > XB_SPIN_CAP) { atomicAdd(&bar[XB_TMO], 1u); break; } }
    }
    nloc = mine > 0u ? mine : 1u; nx = cnt > 0u ? cnt : 1u;
}
__device__ __forceinline__ void xcd_barrier(const XcdBarrier& b) {
    asm volatile("s_waitcnt vmcnt(0)" ::: "memory");
    __syncthreads();
    if (threadIdx.x == 0) {
        unsigned* bar = b.bar;
        __builtin_amdgcn_s_waitcnt(0);
        unsigned nloc = b.st[0], nx = b.st[1];
        if (nloc == 0u) { xcd_barrier_complete(bar, b.x, nloc, nx); b.st[0] = nloc; b.st[1] = nx; }
        const unsigned old = xb_add(&bar[XB_XSUB(b.x)], 1u);
        const unsigned gen = old / nloc;
        if (old + 1u == (gen + 1u) * nloc) {
            __builtin_amdgcn_fence(__ATOMIC_RELEASE, "agent");
            asm volatile("s_waitcnt vmcnt(0)" ::: "memory");
            const unsigned og = xb_add(&bar[XB_TOP], 1u);
            const unsigned tg = og / nx;
            if (og + 1u == (tg + 1u) * nx) xb_add(&bar[XB_TOPGEN], 1u);
            else XB_SPIN(xb_ld(&bar[XB_TOPGEN]) == tg, bar);
            __builtin_amdgcn_fence(__ATOMIC_ACQUIRE, "agent");
            xb_add(&bar[XB_XGEN(b.x)], 1u);
            asm volatile("s_waitcnt vmcnt(0)" ::: "memory");
        } else {
            XB_SPIN(xb_ld(&bar[XB_XGEN(b.x)]) == gen, bar);
            __builtin_amdgcn_fence(__ATOMIC_ACQUIRE, "agent");
            asm volatile("s_waitcnt vmcnt(0)" ::: "memory");
        }
    }
    __syncthreads();
}

struct Params { const float* in[26]; float* out; unsigned char* ws; int lo, hi; };
constexpr int NPHASE = 17;

__global__ void __launch_bounds__(512) fwd_megakernel(Params P) {
    extern __shared__ __attribute__((aligned(16))) unsigned char lds_raw[];
    LAS unsigned char* lds = (LAS unsigned char*)lds_raw;
    const int tid = threadIdx.x, lane = tid & 63, wave = __builtin_amdgcn_readfirstlane(tid >> 6);
    const int G = gridDim.x, bx = blockIdx.x;
    const int vcu = (G % 8 == 0) ? (bx % 8) * (G / 8) + bx / 8 : bx;
    const int gw = vcu * 8 + wave, NGW = G * 8;
    unsigned char* ws = P.ws;
    float* out = P.out;
    bf16_t* Wgu = (bf16_t*)(ws + WS_WGU); bf16_t* Wd = (bf16_t*)(ws + WS_WD); bf16_t* Win = (bf16_t*)(ws + WS_WIN); bf16_t* Wout = (bf16_t*)(ws + WS_WOUT);
    bf16_t* Wglu = (bf16_t*)(ws + WS_WGLU); bf16_t* Wqkv = (bf16_t*)(ws + WS_WQKV); bf16_t* Wco = (bf16_t*)(ws + WS_WCO);
    bf16_t* XN = (bf16_t*)(ws + WS_XN); bf16_t* BIG = (bf16_t*)(ws + WS_BIG); bf16_t* ZB = (bf16_t*)(ws + WS_Z);
    const float* x = P.in[0]; const float* ffn_norm = P.in[1]; const float* mix_norm = P.in[5];
#if MK_PER_PHASE
#define SYNC(k) do { } while (0)
#else
    cg::grid_group grid = cg::this_grid();
    { volatile LAS unsigned* st0 = (volatile LAS unsigned*)(lds + 139264); if (tid < 2) st0[tid] = 0u; }
    __syncthreads();
    const XcdBarrier xbar = xcd_barrier_post((unsigned*)(ws + WS_BAR), (volatile LAS unsigned*)(lds + 139264));
#define SYNC(k) do { if (P.lo <= (k) && (k) + 1 < P.hi) { if ((k) == 0) grid.sync(); else xcd_barrier(xbar); } } while (0)
#endif
#ifndef WGM_DOWN
#define WGM_DOWN 4
#endif
#ifndef DUPMASK
#define DUPMASK 0u
#endif
#define IN(k) (P.lo <= (k) && (k) < P.hi)
#define REP(k) for (int rep_ = 0; rep_ < (((DUPMASK >> (k)) & 1u) ? 2 : 1); ++rep_)

    u64_t* SSQ = (u64_t*)(ws + WS_SSQ);
    bf16_t* YC = (bf16_t*)(ws + WS_YC);
    const float* rcos = (const float*)(ws + WS_RCOS); const float* rsin = (const float*)(ws + WS_RSIN);
    const float* acos_ = (const float*)(ws + WS_ACOS); const float* asin_ = (const float*)(ws + WS_ASIN);
    if (IN(0)) REP(0) {
        LAS float* scr = (LAS float*)(lds + wave * 16640);
        const size_t gsz = (size_t)DM * DFF;
#pragma unroll 1
        for (int i = 0; i < 4; ++i) {
            conv_matrix(P.in[2] + i * gsz, Wgu + (size_t)i * NGU * DM, DM, DFF, 1, ffn_norm + i * DM, scr, gw, NGW, lane);
            conv_matrix(P.in[3] + i * gsz, Wgu + (size_t)i * NGU * DM, DM, DFF, 2, ffn_norm + i * DM, scr, gw, NGW, lane);
            conv_matrix(P.in[4] + i * gsz, Wd + (size_t)i * DM * DFF, DFF, DM, 0, nullptr, scr, gw, NGW, lane);
        }
        conv_matrix(P.in[6], Win, DM, PW, 0, mix_norm, scr, gw, NGW, lane);
        conv_matrix(P.in[7], Wout, DM, DM, 0, nullptr, scr, gw, NGW, lane);
        conv_matrix(P.in[16], Wglu, 1024, 1024, 0, nullptr, scr, gw, NGW, lane);
        conv_matrix(P.in[18], Wqkv, DM, QW, 0, mix_norm + DM, scr, gw, NGW, lane);
        conv_matrix(P.in[19], Wco, DM, DM, 0, nullptr, scr, gw, NGW, lane);
        tables_phase(ws, nullptr, P.in[8], P.in[9], P.in[10], P.in[11], P.in[12], P.in[20], P.in[21], P.in[22], P.in[23], vcu * 512 + tid, G * 512);
        for (int i = vcu * 512 + tid; i < 6 * TT; i += G * 512) SSQ[TT + i] = 0u;
        cast_phase(x, XN, SSQ, gw, NGW, lane);
    }
    SYNC(0);
#if !MK_PER_PHASE
    if ((DUPMASK >> 20) & 1u) { for (int q_ = 0; q_ < 32; ++q_) grid.sync(); }
#endif
    if (IN(1)) { run_gemm(lds, XN, Wgu, TT, NGU, DM, EpiSwiglu{BIG, DFF, SSQ}); if ((DUPMASK >> 1) & 1u) { run_gemm(lds, XN, Wgu, TT, NGU, DM, EpiSwiglu{BIG, DFF, SSQ}); } }
    SYNC(1);
    if (IN(2)) run_gemm(lds, BIG, Wd, TT, DM, DFF, EpiResid<true, false, 1>{x, nullptr, XN, SSQ + 1 * TT}, WGM_DOWN);
    if (IN(2) && ((DUPMASK >> 2) & 1u)) run_gemm(lds, BIG, Wd, TT, DM, DFF, EpiResid<false, false, 2>{nullptr, nullptr, XN, nullptr});
    SYNC(2);
    if (IN(3)) { run_gemm(lds, XN, Win, TT, PW, DM, EpiWin{BIG, rcos, rsin, SSQ + 1 * TT}); if ((DUPMASK >> 3) & 1u) { run_gemm(lds, XN, Win, TT, PW, DM, EpiWin{BIG, rcos, rsin, SSQ + 1 * TT}); } }
    SYNC(3);
    if (IN(4)) REP(4) {
        const bool do_ret = !(rep_ == 1 && ((DUPMASK >> 22) & 1u)), do_s5 = !(rep_ == 1 && ((DUPMASK >> 21) & 1u));
        unsigned mask = 0u; int bh = 0, lin = -1, s5i = vcu, s5g = G; bool s5 = true;
        if (G == 256) {
            if (vcu < 128) { bh = vcu >> 1; mask = (vcu & 1) ? 0x03FDu : 0xE402u; s5 = false; }
            else { const int j = vcu - 128; bh = j >> 1; mask = 1u << (11 + (j & 1)); s5i = j; s5g = 128; }
        } else lin = vcu;
        if (s5 && do_s5) s5_phase(lds, ws, BIG, P.in[13], P.in[14], P.in[15], ZB, s5i, s5g, wave, lane);
        __syncthreads();
        if (do_ret) for (;;) {
            int ub;
            if (lin < 0) { if (!mask) break; ub = 31 - __clz((int)mask); mask &= ~(1u << ub); }
            else { if (lin >= 1024) break; bh = lin >> 4; ub = 15 - (lin & 15); lin += G; }
            const int b = bh >> 2, h = bh & 3;
            attn_unit<0>(lds, BIG, PW, 1024 + h * 256, 2048 + h * 256, b, h, ub, YC, BIG, nullptr, 0.f);
        }
    }
    SYNC(4);
    if (IN(5)) run_gemm(lds, ZB, Wglu, TT, 1024, 1024, EpiGlu{ZB, P.in[17], YC});
    SYNC(5);
    if (IN(6)) run_gemm(lds, YC, Wout, TT, DM, DM, EpiResid<false, false, 0>{nullptr, nullptr, XN, SSQ + 2 * TT});
    if (IN(6) && ((DUPMASK >> 6) & 1u)) run_gemm(lds, YC, Wout, TT, DM, DM, EpiResid<false, false, 2>{nullptr, nullptr, XN, nullptr});
    SYNC(6);
    if (IN(7)) { run_gemm(lds, XN, Wgu + (size_t)1 * NGU * DM, TT, NGU, DM, EpiSwiglu{BIG, DFF, SSQ + 2 * TT}); if ((DUPMASK >> 7) & 1u) { run_gemm(lds, XN, Wgu + (size_t)1 * NGU * DM, TT, NGU, DM, EpiSwiglu{BIG, DFF, SSQ + 2 * TT}); } }
    SYNC(7);
    if (IN(8)) run_gemm(lds, BIG, Wd + (size_t)1 * DM * DFF, TT, DM, DFF, EpiResid<false, false, 1>{nullptr, nullptr, XN, SSQ + 3 * TT}, WGM_DOWN);
    if (IN(8) && ((DUPMASK >> 8) & 1u)) run_gemm(lds, BIG, Wd + (size_t)1 * DM * DFF, TT, DM, DFF, EpiResid<false, false, 2>{nullptr, nullptr, XN, nullptr});
    SYNC(8);
    if (IN(9)) { run_gemm(lds, XN, Wgu + (size_t)2 * NGU * DM, TT, NGU, DM, EpiSwiglu{BIG, DFF, SSQ + 3 * TT}); if ((DUPMASK >> 9) & 1u) { run_gemm(lds, XN, Wgu + (size_t)2 * NGU * DM, TT, NGU, DM, EpiSwiglu{BIG, DFF, SSQ + 3 * TT}); } }
    SYNC(9);
    if (IN(10)) run_gemm(lds, BIG, Wd + (size_t)2 * DM * DFF, TT, DM, DFF, EpiResid<false, false, 1>{nullptr, nullptr, XN, SSQ + 4 * TT}, WGM_DOWN);
    if (IN(10) && ((DUPMASK >> 10) & 1u)) run_gemm(lds, BIG, Wd + (size_t)2 * DM * DFF, TT, DM, DFF, EpiResid<false, false, 2>{nullptr, nullptr, XN, nullptr});
    SYNC(10);
    if (IN(11)) { run_gemm(lds, XN, Wqkv, TT, QW, DM, EpiQkv{BIG, acos_, asin_, SSQ + 4 * TT}); if ((DUPMASK >> 11) & 1u) { run_gemm(lds, XN, Wqkv, TT, QW, DM, EpiQkv{BIG, acos_, asin_, SSQ + 4 * TT}); } }
    SYNC(11);
#ifndef NO_A1
    if (IN(12)) REP(12) { const float lam = ((const float*)(ws + WS_CTL))[0]; attn_phase<1>(lds, BIG, QW, 2048, 4096, 8, YC, nullptr, P.in[24], lam, vcu, G); }
#endif
    SYNC(12);
    if (IN(13)) run_gemm(lds, YC, Wco, TT, DM, DM, EpiResid<false, false, 0>{nullptr, nullptr, XN, SSQ + 5 * TT});
    if (IN(13) && ((DUPMASK >> 13) & 1u)) run_gemm(lds, YC, Wco, TT, DM, DM, EpiResid<false, false, 2>{nullptr, nullptr, XN, nullptr});
    SYNC(13);
    if (IN(14)) { run_gemm(lds, XN, Wgu + (size_t)3 * NGU * DM, TT, NGU, DM, EpiSwiglu{BIG, DFF, SSQ + 5 * TT}); if ((DUPMASK >> 14) & 1u) { run_gemm(lds, XN, Wgu + (size_t)3 * NGU * DM, TT, NGU, DM, EpiSwiglu{BIG, DFF, SSQ + 5 * TT}); } }
    SYNC(14);
    if (IN(15)) run_gemm(lds, BIG, Wd + (size_t)3 * DM * DFF, TT, DM, DFF, EpiResid<false, false, 1>{nullptr, nullptr, XN, SSQ + 6 * TT}, WGM_DOWN);
    if (IN(15) && ((DUPMASK >> 15) & 1u)) run_gemm(lds, BIG, Wd + (size_t)3 * DM * DFF, TT, DM, DFF, EpiResid<false, false, 2>{nullptr, nullptr, XN, nullptr});
    SYNC(15);
    if (IN(16)) final_phase(XN, SSQ + 6 * TT, P.in[25], out, gw, NGW, lane);
#undef IN
#undef SYNC
}

extern "C" void kernel_launch(void* const* d_in, const int* in_sizes, int n_in, void* d_out, int out_size, void* d_ws, size_t ws_size, hipStream_t stream) {
    static int grid = 0;
    if (grid == 0) {
        if (n_in != 26 || out_size != TT * DM || ws_size < WS_END) { fprintf(stderr, "kernel_launch: unexpected shapes (n_in %d, out %d, ws %zu < %zu)\n", n_in, out_size, ws_size, (size_t)WS_END); grid = -1; return; }
        int dev = 0, cus = 0, per_cu = 0;
        hipGetDevice(&dev); hipDeviceGetAttribute(&cus, hipDeviceAttributeMultiprocessorCount, dev);
        if (hipFuncSetAttribute((const void*)fwd_megakernel, hipFuncAttributeMaxDynamicSharedMemorySize, LDS_BYTES) != hipSuccess) { fprintf(stderr, "kernel_launch: hipFuncSetAttribute failed\n"); grid = -1; return; }
        if (hipOccupancyMaxActiveBlocksPerMultiprocessor(&per_cu, (const void*)fwd_megakernel, 512, LDS_BYTES) != hipSuccess || per_cu < 1) { fprintf(stderr, "kernel_launch: occupancy query says %d\n", per_cu); per_cu = 1; }
        (void)hipGetLastError();
        grid = cus * per_cu;
        fprintf(stderr, "kernel_launch: grid %d (cus %d x %d)\n", grid, cus, per_cu);
    }
    if (grid < 0) return;
    if (hipMemsetAsync((char*)d_ws + WS_BAR, 0, BAR_BYTES, stream) != hipSuccess) { fprintf(stderr, "kernel_launch: hipMemsetAsync failed\n"); return; }
    Params p{};
    for (int i = 0; i < 26; ++i) p.in[i] = (const float*)d_in[i];
    p.out = (float*)d_out; p.ws = (unsigned char*)d_ws;
#if MK_PER_PHASE
    for (int k = 0; k < NPHASE; ++k) { p.lo = k; p.hi = k + 1; hipLaunchKernelGGL(fwd_megakernel, dim3(grid), dim3(512), LDS_BYTES, stream, p); }
#else
    p.lo = 0; p.hi = NPHASE;
    void* args[] = {&p};
    hipError_t e = hipLaunchCooperativeKernel((const void*)fwd_megakernel, dim3(grid), dim3(512), args, LDS_BYTES, stream);
    if (e != hipSuccess) fprintf(stderr, "cooperative launch failed: %s (grid %d)\n", hipGetErrorString(e), grid);
#endif
}
```

```cpp
#include <hip/hip_runtime.h>
#include <hip/hip_cooperative_groups.h>
#include <cstdio>
#include <cstdint>
namespace cg = cooperative_groups;

#define LAS __attribute__((address_space(3)))
typedef unsigned short bf16_t;
typedef unsigned u64_t;
constexpr float SSQ_FIX = 1024.0f, SSQ_INV = 1.0f / 1024.0f;
typedef short bf16x8 __attribute__((ext_vector_type(8)));
typedef short s16x4 __attribute__((ext_vector_type(4)));
typedef float f32x4 __attribute__((ext_vector_type(4)));
typedef float f32x2 __attribute__((ext_vector_type(2)));
typedef float f32x16 __attribute__((ext_vector_type(16)));
typedef unsigned u32x4 __attribute__((ext_vector_type(4)));
typedef unsigned u32x2 __attribute__((ext_vector_type(2)));

#ifndef MK_PER_PHASE
#define MK_PER_PHASE 0
#endif

constexpr int TT = 32768, SEQ = 2048, DM = 2048, DFF = 5504, NGU = 2 * DFF;
constexpr int PW = 5120, QW = 6144;
constexpr float EPS = 1e-6f;
constexpr float LAMBDA_INIT = 0.35550906759f;
constexpr float QSCALE = 0.08838834764831845f * 1.4426950408889634f;

constexpr size_t MiB = 1u << 20;
constexpr size_t WS_CTL = 0, WS_BAR = 4096, BAR_BYTES = 16384;
constexpr size_t WS_RCOS = 1 * MiB, WS_RSIN = 2 * MiB, WS_ACOS = 3 * MiB, WS_ASIN = 3 * MiB + 128 * 1024, WS_S5A = 3 * MiB + 512 * 1024, WS_S5BB = 4 * MiB;
constexpr size_t WS_W = 8 * MiB;
constexpr size_t SZ_WGU = (size_t)NGU * DM * 2, SZ_WD = (size_t)DM * DFF * 2;
constexpr size_t WS_WGU = WS_W, WS_WD = WS_WGU + 4 * SZ_WGU, WS_WIN = WS_WD + 4 * SZ_WD, WS_WOUT = WS_WIN + (size_t)PW * DM * 2,
                 WS_WGLU = WS_WOUT + (size_t)DM * DM * 2, WS_WQKV = WS_WGLU + (size_t)1024 * 1024 * 2, WS_WCO = WS_WQKV + (size_t)QW * DM * 2,
                 WS_WEND = WS_WCO + (size_t)DM * DM * 2;
constexpr size_t WS_XN = 328 * MiB;
constexpr size_t WS_BIG = 456 * MiB;
constexpr size_t WS_Z = WS_BIG + (size_t)TT * PW * 2;
constexpr size_t WS_YC = WS_BIG + (size_t)TT * QW * 2;
constexpr size_t WS_END = WS_YC + (size_t)TT * DM * 2;
constexpr size_t WS_SSQ = 5 * MiB;
static_assert(WS_WEND <= WS_XN && WS_XN + (size_t)TT * DM * 2 <= WS_BIG && WS_Z + (size_t)TT * 1024 * 2 <= WS_END, "ws map");

constexpr int LDS_BYTES = 147456;

namespace pg8 {
constexpr int BM = 256, BK = 64, HALF = 128, HTB = HALF * BK * 2, STAGE_BYTES = 8 * HTB, NXCD = 8;
__host__ __device__ __forceinline__ int lds_byte(int r, int c) { const int st = (r >> 4) * 2 + (c >> 5), rr = r & 15, cc = c & 31, ob = rr * 64 + cc * 2; return st * 1024 + (ob ^ (((ob >> 9) & 1) << 5)); }
__host__ __device__ __forceinline__ void stage_rc(int b, int& R, int& C) { const int st = b / 1024, sb = b % 1024, swz = sb ^ (((sb >> 9) & 1) << 5); R = (st >> 1) * 16 + swz / 64; C = (st & 1) * 32 + (swz % 64) / 2; }
__host__ __device__ __forceinline__ int perm32(int rho) { const int n = rho >> 4, i = rho & 15; return 8 * (i >> 2) + 4 * n + (i & 3); }
struct Unit { int pm, pn; };
struct Gemm { const bf16_t* A; const bf16_t* Bt; int M, N, K; };
struct StaticOrder {
    int nM, nN, nwg, G, c, WGM;
    __host__ __device__ void init(int M, int N, int G_, int c_, int wgm_ = 8) { nM = M / BM; nN = N / BM; nwg = nM * nN; G = G_; c = c_; WGM = wgm_; }
    __host__ __device__ bool next(int i, Unit& u) const {
        const long L = (long)i * G + c; if (L >= nwg) return false;
        int wgid = (int)L; { const int q = nwg / NXCD, r = nwg % NXCD, xcd = wgid % NXCD, off = wgid / NXCD; wgid = (xcd < r ? xcd * (q + 1) : r * (q + 1) + (xcd - r) * q) + off; }
        const int nig = WGM * nN, gid = wgid / nig, fm = gid * WGM, gsz = (nM - fm) < WGM ? (nM - fm) : WGM;
        u.pm = fm + ((wgid % nig) % gsz); u.pn = (wgid % nig) / gsz; return true;
    }
    __device__ __forceinline__ void a_ready(const Unit&) const {}
    __device__ __forceinline__ void done(const Unit&) const {}
};
__device__ __forceinline__ unsigned cvt_pk_bf16(float lo, float hi) { unsigned r; asm volatile("v_cvt_pk_bf16_f32 %0, %1, %2" : "=v"(r) : "v"(lo), "v"(hi)); return r; }

template <class Epi, class Sched, bool ALIGN_EPI = false, bool SP2 = false>
__device__ __forceinline__ void gemm_phase(LAS unsigned char* lds, const Gemm g, const Sched S, const Epi E) {
    const int tid = threadIdx.x, wid = __builtin_amdgcn_readfirstlane(tid >> 6), lane = tid & 63, wr = wid >> 2, wc = wid & 3, fr = lane & 15, fq = lane >> 4;
    const int K = g.K, nt = K / BK;
    unsigned voffA[2], voffB[2];
#pragma unroll
    for (int i = 0; i < 2; ++i) { int R, C; stage_rc(tid * 16 + i * 8192, R, C); const int Rb = Epi::PERM ? ((R & ~31) + perm32(R & 31)) : R;
        voffA[i] = (unsigned)(R * K + C) * 2u; voffB[i] = (unsigned)(Rb * K + C) * 2u; }
    const size_t kstep = (size_t)(BK * 2);
    const size_t hstep = (size_t)HALF * K * 2;
    const size_t tstep = 2 * hstep;
    const unsigned ldsw = (unsigned)wid * 1024u;
    const int aoff = lds_byte(wr * 64 + fr, fq * 8), boff = lds_byte(wc * 32 + fr, fq * 8);
#define PG8_SA(b, h) (((b) * 2 + (h)) * HTB)
#define PG8_SB(b, h) ((4 + (b) * 2 + (h)) * HTB)
#define PG8_STAGE(bufoff, gbase, voff) do { _Pragma("unroll") for (int _i = 0; _i < 2; ++_i) \
        __builtin_amdgcn_global_load_lds((const unsigned*)((const char*)(gbase) + (voff)[_i]), (LAS unsigned*)(lds + (bufoff) + ldsw + _i * 8192), 16, 0, 0); } while (0)
#define PG8_LDA(dst, b, h) do { _Pragma("unroll") for (int m = 0; m < 4; ++m) _Pragma("unroll") for (int k = 0; k < 2; ++k) dst[m][k] = *(const LAS bf16x8*)(lds + PG8_SA(b, h) + aoff + m * 2048 + k * 1024); } while (0)
#define PG8_LDB(dst, b, h) do { _Pragma("unroll") for (int n = 0; n < 2; ++n) _Pragma("unroll") for (int k = 0; k < 2; ++k) dst[n][k] = *(const LAS bf16x8*)(lds + PG8_SB(b, h) + boff + n * 2048 + k * 1024); } while (0)
#define PG8_MMA(ai, bj, At, Bt) do { __builtin_amdgcn_s_setprio(1); _Pragma("unroll") for (int m = 0; m < 4; ++m) _Pragma("unroll") for (int n = 0; n < 2; ++n) _Pragma("unroll") for (int k = 0; k < 2; ++k) \
        acc[ai][bj][m][n] = __builtin_amdgcn_mfma_f32_16x16x32_bf16(Bt[n][k], At[m][k], acc[ai][bj][m][n], 0, 0, 0); __builtin_amdgcn_s_setprio(0); } while (0)
#define PG8_WAIT_V(n) asm volatile("s_waitcnt vmcnt(" #n ")" ::: "memory")
#define PG8_WAIT_L(n) asm volatile("s_waitcnt lgkmcnt(" #n ")" ::: "memory")
#define PG8_BAR __builtin_amdgcn_s_barrier()
#define PG8_SCHED __builtin_amdgcn_sched_barrier(0)
    Unit cur, nxt; int ui = 0;
    if (!S.next(0, cur)) return;
    f32x4 acc[2][2][4][2];
#pragma unroll
    for (int a = 0; a < 2; ++a)
#pragma unroll
        for (int b = 0; b < 2; ++b)
#pragma unroll
            for (int m = 0; m < 4; ++m)
#pragma unroll
                for (int n = 0; n < 2; ++n) acc[a][b][m][n] = (f32x4){0.f, 0.f, 0.f, 0.f};
    bf16x8 At[4][2], B0[2][2], B1[2][2];
    typename Epi::Pre pre;
    const char* cA = (const char*)g.A + (size_t)cur.pm * tstep; const char* cB = (const char*)g.Bt + (size_t)cur.pn * tstep;
    S.a_ready(cur);
    if constexpr (SP2) {
        PG8_STAGE(PG8_SB(0, 0), cB, voffB); PG8_STAGE(PG8_SB(0, 1), cB + hstep, voffB); PG8_STAGE(PG8_SA(0, 0), cA, voffA); PG8_STAGE(PG8_SA(0, 1), cA + hstep, voffA);
        if (wr == 1) PG8_BAR;
        PG8_WAIT_V(2); PG8_BAR;
        PG8_STAGE(PG8_SB(1, 0), cB + kstep, voffB); PG8_STAGE(PG8_SA(1, 0), cA + kstep, voffA); PG8_STAGE(PG8_SB(1, 1), cB + hstep + kstep, voffB);
        PG8_WAIT_V(6); PG8_BAR;
    } else {
        PG8_STAGE(PG8_SB(0, 0), cB, voffB); PG8_STAGE(PG8_SA(0, 0), cA, voffA); PG8_STAGE(PG8_SB(0, 1), cB + hstep, voffB); PG8_STAGE(PG8_SA(0, 1), cA + hstep, voffA);
        if (wr == 1) PG8_BAR;
        PG8_WAIT_V(4); PG8_BAR;
        PG8_STAGE(PG8_SB(1, 0), cB + kstep, voffB); PG8_STAGE(PG8_SA(1, 0), cA + kstep, voffA); PG8_STAGE(PG8_SB(1, 1), cB + hstep + kstep, voffB);
        PG8_WAIT_V(6); PG8_BAR;
    }
    for (;;) {
        const bool has_next = S.next(ui + 1, nxt);
        const char* nA = has_next ? (const char*)g.A + (size_t)nxt.pm * tstep : cA; const char* nB = has_next ? (const char*)g.Bt + (size_t)nxt.pn * tstep : cB;
        for (int t = 0; t < nt; t += 2) {
            const bool last = (t == nt - 2);
            const char* a1 = cA + (size_t)(t + 1) * kstep;
            const char* a2 = last ? nA : cA + (size_t)(t + 2) * kstep; const char* b2 = last ? nB : cB + (size_t)(t + 2) * kstep;
            const char* a3 = a2 + kstep; const char* b3 = b2 + kstep;
            if (last && has_next) S.a_ready(nxt);
            if (last) E.prefetch(cur, wr, fr, pre);
            if constexpr (SP2) {
            PG8_LDB(B0, 0, 0); PG8_LDB(B1, 0, 1); PG8_SCHED; PG8_LDA(At, 0, 0); PG8_STAGE(PG8_SA(1, 1), a1 + hstep, voffA);
            PG8_WAIT_V(8); PG8_WAIT_L(0); PG8_BAR; PG8_MMA(0, 0, At, B0); PG8_MMA(0, 1, At, B1); PG8_BAR; PG8_SCHED;
            PG8_LDA(At, 0, 1); PG8_STAGE(PG8_SB(0, 0), b2, voffB); PG8_STAGE(PG8_SB(0, 1), b2 + hstep, voffB); PG8_STAGE(PG8_SA(0, 0), a2, voffA);
            PG8_WAIT_V(8); PG8_WAIT_L(0); PG8_BAR; PG8_MMA(1, 0, At, B0); PG8_MMA(1, 1, At, B1); PG8_BAR; PG8_SCHED;
            PG8_LDB(B0, 1, 0); PG8_LDB(B1, 1, 1); PG8_SCHED; PG8_LDA(At, 1, 0); PG8_STAGE(PG8_SA(0, 1), a2 + hstep, voffA);
            PG8_WAIT_V(8); PG8_WAIT_L(0); PG8_BAR; PG8_MMA(0, 0, At, B0); PG8_MMA(0, 1, At, B1); PG8_BAR; PG8_SCHED;
            PG8_LDA(At, 1, 1); PG8_STAGE(PG8_SB(1, 0), b3, voffB); PG8_STAGE(PG8_SB(1, 1), b3 + hstep, voffB); PG8_STAGE(PG8_SA(1, 0), a3, voffA);
            PG8_WAIT_V(8); PG8_WAIT_L(0); PG8_BAR; PG8_MMA(1, 0, At, B0); PG8_MMA(1, 1, At, B1); PG8_BAR; PG8_SCHED;
            } else {
            PG8_LDB(B0, 0, 0); PG8_SCHED; PG8_LDA(At, 0, 0); PG8_STAGE(PG8_SA(1, 1), a1 + hstep, voffA);
            PG8_WAIT_L(8); PG8_BAR; PG8_WAIT_L(0); PG8_MMA(0, 0, At, B0); PG8_BAR; PG8_SCHED;
            PG8_LDB(B1, 0, 1); PG8_STAGE(PG8_SB(0, 0), b2, voffB);
            PG8_BAR; PG8_WAIT_L(0); PG8_MMA(0, 1, At, B1); PG8_BAR;
            PG8_LDA(At, 0, 1); PG8_STAGE(PG8_SA(0, 0), a2, voffA);
            PG8_BAR; PG8_WAIT_L(0); PG8_MMA(1, 0, At, B0); PG8_BAR; PG8_SCHED;
            PG8_STAGE(PG8_SB(0, 1), b2 + hstep, voffB);
            PG8_WAIT_V(6); PG8_BAR; PG8_MMA(1, 1, At, B1); PG8_BAR;
            PG8_LDB(B0, 1, 0); PG8_SCHED; PG8_LDA(At, 1, 0); PG8_STAGE(PG8_SA(0, 1), a2 + hstep, voffA);
            PG8_WAIT_L(8); PG8_BAR; PG8_WAIT_L(0); PG8_MMA(0, 0, At, B0); PG8_BAR; PG8_SCHED;
            PG8_LDB(B1, 1, 1); PG8_STAGE(PG8_SB(1, 0), b3, voffB);
            PG8_BAR; PG8_WAIT_L(0); PG8_MMA(0, 1, At, B1); PG8_BAR;
            PG8_LDA(At, 1, 1); PG8_STAGE(PG8_SA(1, 0), a3, voffA);
            PG8_BAR; PG8_WAIT_L(0); PG8_MMA(1, 0, At, B0); PG8_BAR; PG8_SCHED;
            PG8_STAGE(PG8_SB(1, 1), b3 + hstep, voffB);
            PG8_WAIT_V(6); PG8_BAR; PG8_MMA(1, 1, At, B1); PG8_BAR;
            }
        }
        if constexpr (ALIGN_EPI) { if (wr == 0) PG8_BAR; }
        if constexpr (!Epi::AFTER_DRAIN) { E(acc, cur, wr, wc, fr, fq, pre); S.done(cur); }
        if (!has_next) break;
#pragma unroll
        for (int a = 0; a < 2; ++a)
#pragma unroll
            for (int b = 0; b < 2; ++b)
#pragma unroll
                for (int m = 0; m < 4; ++m)
#pragma unroll
                    for (int n = 0; n < 2; ++n) acc[a][b][m][n] = (f32x4){0.f, 0.f, 0.f, 0.f};
        cur = nxt; cA = nA; cB = nB; ++ui;
        if constexpr (ALIGN_EPI) { if (wr == 1) PG8_BAR; }
    }
    PG8_WAIT_V(0);
    if constexpr (!ALIGN_EPI) { if (wr == 0) PG8_BAR; }
    PG8_BAR;
#undef PG8_SA
#undef PG8_SB
#undef PG8_STAGE
#undef PG8_LDA
#undef PG8_LDB
#undef PG8_MMA
#undef PG8_WAIT_V
#undef PG8_WAIT_L
#undef PG8_BAR
#undef PG8_SCHED
}
}

__device__ __forceinline__ unsigned f2bf(float f) { unsigned u = __builtin_bit_cast(unsigned, f); return (u + 0x7fffu + ((u >> 16) & 1u)) >> 16; }
__device__ __forceinline__ unsigned pk2(float lo, float hi) { return f2bf(lo) | (f2bf(hi) << 16); }
__device__ __forceinline__ float bf2f(unsigned short b) { return __builtin_bit_cast(float, (unsigned)b << 16); }
__device__ __forceinline__ float bflo(unsigned w) { return __builtin_bit_cast(float, w << 16); }
__device__ __forceinline__ float bfhi(unsigned w) { return __builtin_bit_cast(float, w & 0xffff0000u); }
__device__ __forceinline__ float fast_sigmoid(float x) { return __builtin_amdgcn_rcpf(1.0f + __builtin_amdgcn_exp2f(-1.4426950408889634f * x)); }
__device__ __forceinline__ float silu_f(float x) { return x * fast_sigmoid(x); }
__device__ __forceinline__ float gelu_tanh_f(float y) { return y * fast_sigmoid(1.5957691216057308f * (y + 0.044715f * y * y * y)); }
__device__ __forceinline__ float wave_sum(float v) {
#pragma unroll
    for (int o = 1; o < 64; o <<= 1) v += __shfl_xor(v, o);
    return v;
}
__device__ __forceinline__ void sincos_d(double a, double& s, double& c) {
    const double k = rint(a * 0.15915494309189535);
    const double r = fma(-k, 6.283185307179586, a), r2 = r * r;
    double ts = r, tc = 1.0; s = r; c = 1.0;
    for (int n = 1; n <= 13; ++n) { tc *= -r2 / (double)((2 * n - 1) * (2 * n)); c += tc; ts *= -r2 / (double)((2 * n) * (2 * n + 1)); s += ts; }
}

using pg8::Unit; using pg8::cvt_pk_bf16;
struct PreSsq { unsigned v[2][4]; };
struct PreNone { };
struct EpiSwiglu {
    static constexpr bool PERM = true, AFTER_DRAIN = false;
    bf16_t* O; int ldo; const u64_t* ssq;
    typedef PreSsq Pre;
    __device__ __forceinline__ void prefetch(const Unit& u, int wr, int fr, Pre& pre) const {
        const int row0 = u.pm * 256 + wr * 64 + fr;
#pragma unroll
        for (int ai = 0; ai < 2; ++ai)
#pragma unroll
            for (int m = 0; m < 4; ++m) pre.v[ai][m] = ssq[row0 + ai * 128 + m * 16];
    }
    __device__ __forceinline__ void operator()(const f32x4 (&acc)[2][2][4][2], const Unit& u, int wr, int wc, int fr, int fq, const Pre& pre) const {
        const int row0 = u.pm * 256 + wr * 64 + fr, col0 = u.pn * 128 + wc * 32 + 8 * fq;
        float rsv[2][4];
#pragma unroll
        for (int ai = 0; ai < 2; ++ai)
#pragma unroll
            for (int m = 0; m < 4; ++m) rsv[ai][m] = (float)pre.v[ai][m] * SSQ_INV;
#pragma unroll
        for (int ai = 0; ai < 2; ++ai)
#pragma unroll
            for (int m = 0; m < 4; ++m) {
                const int row = row0 + ai * 128 + m * 16;
                const float rs = __builtin_amdgcn_rsqf(rsv[ai][m] * (1.0f / DM) + EPS);
                bf16_t* rowp = O + (size_t)row * ldo + col0;
                const f32x4 g0 = acc[ai][0][m][0] * rs, g1 = acc[ai][0][m][1] * rs, u0 = acc[ai][1][m][0] * rs, u1 = acc[ai][1][m][1] * rs;
                u32x4 w;
                w.x = cvt_pk_bf16(silu_f(g0[0]) * u0[0], silu_f(g0[1]) * u0[1]); w.y = cvt_pk_bf16(silu_f(g0[2]) * u0[2], silu_f(g0[3]) * u0[3]);
                w.z = cvt_pk_bf16(silu_f(g1[0]) * u1[0], silu_f(g1[1]) * u1[1]); w.w = cvt_pk_bf16(silu_f(g1[2]) * u1[2], silu_f(g1[3]) * u1[3]);
                *(u32x4*)rowp = w;
            }
    }
};
template <bool BASE_F32, bool OUT_F32, int SCALE> struct EpiResid {
    static constexpr bool PERM = false, AFTER_DRAIN = false;
    const float* basef; float* outf; bf16_t* xb; u64_t* ssq;
    typedef PreNone Pre;
    __device__ __forceinline__ void prefetch(const Unit&, int, int, Pre&) const {}
    __device__ __forceinline__ void operator()(const f32x4 (&acc)[2][2][4][2], const Unit& u, int wr, int wc, int fr, int fq, const Pre&) const {
        const int col0 = u.pn * 256 + wc * 32 + 4 * fq;
        constexpr float sc = (SCALE == 2 ? 0.0f : SCALE == 1 ? 0.5f : 1.0f);
#pragma unroll
        for (int ai = 0; ai < 2; ++ai) {
            f32x4 pre[4][2][2];
#pragma unroll
            for (int m = 0; m < 4; ++m) { const size_t off = (size_t)(u.pm * 256 + ai * 128 + wr * 64 + m * 16 + fr) * DM + col0;
#pragma unroll
                for (int bj = 0; bj < 2; ++bj)
#pragma unroll
                    for (int n = 0; n < 2; ++n) {
                        if constexpr (BASE_F32) pre[m][bj][n] = *(const f32x4*)(basef + off + bj * 128 + n * 16);
                        else { const u32x2 w = *(const u32x2*)(xb + off + bj * 128 + n * 16); pre[m][bj][n] = (f32x4){bflo(w.x), bfhi(w.x), bflo(w.y), bfhi(w.y)}; } } }
#pragma unroll
            for (int m = 0; m < 4; ++m) {
                const int row = u.pm * 256 + ai * 128 + wr * 64 + m * 16 + fr;
                const size_t off = (size_t)row * DM + col0;
                float sq = 0.f;
#pragma unroll
                for (int bj = 0; bj < 2; ++bj)
#pragma unroll
                    for (int n = 0; n < 2; ++n) { const f32x4 v = pre[m][bj][n] + acc[ai][bj][m][n] * sc;
                        if constexpr (OUT_F32) *(f32x4*)(outf + off + bj * 128 + n * 16) = v;
                        else { u32x2 w; w.x = cvt_pk_bf16(v[0], v[1]); w.y = cvt_pk_bf16(v[2], v[3]); *(u32x2*)(xb + off + bj * 128 + n * 16) = w;
                               sq += (v[0] * v[0] + v[1] * v[1]) + (v[2] * v[2] + v[3] * v[3]); } }
                if constexpr (!OUT_F32 && SCALE != 2) { sq += __shfl_xor(sq, 16); sq += __shfl_xor(sq, 32); if (fq == 0) atomicAdd(ssq + row, (u64_t)(sq * SSQ_FIX)); }
            }
        }
    }
};
struct EpiWin {
    static constexpr bool PERM = true, AFTER_DRAIN = false;
    bf16_t* O; const float* cs; const float* sn; const u64_t* ssq;
    typedef PreSsq Pre;
    __device__ __forceinline__ void prefetch(const Unit& u, int wr, int fr, Pre& pre) const {
        const int row0 = u.pm * 256 + wr * 64 + fr;
#pragma unroll
        for (int ai = 0; ai < 2; ++ai)
#pragma unroll
            for (int m = 0; m < 4; ++m) pre.v[ai][m] = ssq[row0 + ai * 128 + m * 16];
    }
    __device__ __forceinline__ void operator()(const f32x4 (&acc)[2][2][4][2], const Unit& u, int wr, int wc, int fr, int fq, const Pre& pre) const {
        const int row0 = u.pm * 256 + wr * 64 + fr, col0 = u.pn * 256 + wc * 32 + 8 * fq;
        const bool rot = u.pn < 8;
        float rsv[2][4];
#pragma unroll
        for (int ai = 0; ai < 2; ++ai)
#pragma unroll
            for (int m = 0; m < 4; ++m) rsv[ai][m] = (float)pre.v[ai][m] * SSQ_INV;
#pragma unroll
        for (int ai = 0; ai < 2; ++ai) {
            f32x4 cc[4][2], sv[4][2];
#pragma unroll
            for (int m = 0; m < 4; ++m) {
                if (rot) { const int pos = (row0 + ai * 128 + m * 16) & (SEQ - 1);
                    const float* cp = cs + pos * 128 + wc * 32 + 8 * fq; const float* sp = sn + pos * 128 + wc * 32 + 8 * fq;
                    cc[m][0] = *(const f32x4*)cp; cc[m][1] = *(const f32x4*)(cp + 4); sv[m][0] = *(const f32x4*)sp; sv[m][1] = *(const f32x4*)(sp + 4); }
                else { cc[m][0] = cc[m][1] = (f32x4){1.f, 1.f, 1.f, 1.f}; sv[m][0] = sv[m][1] = (f32x4){0.f, 0.f, 0.f, 0.f}; }
            }
#pragma unroll
            for (int m = 0; m < 4; ++m) {
                const int row = row0 + ai * 128 + m * 16;
                const float rs = __builtin_amdgcn_rsqf(rsv[ai][m] * (1.0f / DM) + EPS);
                const f32x4 a0 = acc[ai][0][m][0] * rs, a1 = acc[ai][0][m][1] * rs, b0 = acc[ai][1][m][0] * rs, b1 = acc[ai][1][m][1] * rs;
                const f32x4 na0 = a0 * cc[m][0] - b0 * sv[m][0], nb0 = b0 * cc[m][0] + a0 * sv[m][0], na1 = a1 * cc[m][1] - b1 * sv[m][1], nb1 = b1 * cc[m][1] + a1 * sv[m][1];
                bf16_t* rowp = O + (size_t)row * PW + col0;
                u32x4 w; w.x = cvt_pk_bf16(na0[0], na0[1]); w.y = cvt_pk_bf16(na0[2], na0[3]); w.z = cvt_pk_bf16(na1[0], na1[1]); w.w = cvt_pk_bf16(na1[2], na1[3]);
                *(u32x4*)rowp = w;
                u32x4 v; v.x = cvt_pk_bf16(nb0[0], nb0[1]); v.y = cvt_pk_bf16(nb0[2], nb0[3]); v.z = cvt_pk_bf16(nb1[0], nb1[1]); v.w = cvt_pk_bf16(nb1[2], nb1[3]);
                *(u32x4*)(rowp + 128) = v;
            }
        }
    }
};
struct EpiQkv {
    static constexpr bool PERM = false, AFTER_DRAIN = false;
    bf16_t* O; const float* cs; const float* sn; const u64_t* ssq;
    typedef PreSsq Pre;
    __device__ __forceinline__ void prefetch(const Unit& u, int wr, int fr, Pre& pre) const {
#pragma unroll
        for (int ai = 0; ai < 2; ++ai)
#pragma unroll
            for (int m = 0; m < 4; ++m) pre.v[ai][m] = ssq[u.pm * 256 + ai * 128 + wr * 64 + m * 16 + fr];
    }
    __device__ __forceinline__ void operator()(const f32x4 (&acc)[2][2][4][2], const Unit& u, int wr, int wc, int fr, int fq, const Pre& pre) const {
        const int col0 = u.pn * 256 + wc * 32 + 4 * fq;
        const bool rot = (u.pn < 16) && (wc == 0);
        const float sc0 = (u.pn < 8) ? QSCALE : 1.0f;
        float rsv[2][4]; f32x4 cv[2][4], sv[2][4];
#pragma unroll
        for (int ai = 0; ai < 2; ++ai)
#pragma unroll
            for (int m = 0; m < 4; ++m) { const int row = u.pm * 256 + ai * 128 + wr * 64 + m * 16 + fr; rsv[ai][m] = (float)pre.v[ai][m] * SSQ_INV;
                if (rot) { const int pos = row & (SEQ - 1); cv[ai][m] = *(const f32x4*)(cs + pos * 16 + 4 * fq); sv[ai][m] = *(const f32x4*)(sn + pos * 16 + 4 * fq); }
                else { cv[ai][m] = (f32x4){1.f, 1.f, 1.f, 1.f}; sv[ai][m] = (f32x4){0.f, 0.f, 0.f, 0.f}; } }
#pragma unroll
        for (int ai = 0; ai < 2; ++ai)
#pragma unroll
            for (int m = 0; m < 4; ++m) {
                const int row = u.pm * 256 + ai * 128 + wr * 64 + m * 16 + fr;
                const float sc = sc0 * __builtin_amdgcn_rsqf(rsv[ai][m] * (1.0f / DM) + EPS);
                const f32x4 c = cv[ai][m], s = sv[ai][m];
#pragma unroll
                for (int bj = 0; bj < 2; ++bj) {
                    const f32x4 x0 = acc[ai][bj][m][0], x1 = acc[ai][bj][m][1];
                    const f32x4 n0 = (x0 * c - x1 * s) * sc, n1 = (x1 * c + x0 * s) * sc;
                    bf16_t* p = O + (size_t)row * QW + col0 + bj * 128;
                    u32x2 w0; w0.x = cvt_pk_bf16(n0[0], n0[1]); w0.y = cvt_pk_bf16(n0[2], n0[3]); *(u32x2*)p = w0;
                    u32x2 w1; w1.x = cvt_pk_bf16(n1[0], n1[1]); w1.y = cvt_pk_bf16(n1[2], n1[3]); *(u32x2*)(p + 16) = w1;
                }
            }
    }
};
struct EpiGlu {
    static constexpr bool PERM = true, AFTER_DRAIN = false;
    const bf16_t* Z; const float* bias; bf16_t* Y;
    typedef PreNone Pre;
    __device__ __forceinline__ void prefetch(const Unit&, int, int, Pre&) const {}
    __device__ __forceinline__ void operator()(const f32x4 (&acc)[2][2][4][2], const Unit& u, int wr, int wc, int fr, int fq, const Pre&) const {
        const int row0 = u.pm * 256 + wr * 64 + fr, col0 = u.pn * 256 + wc * 32 + 8 * fq;
#pragma unroll
        for (int bj = 0; bj < 2; ++bj) {
            const f32x4 bv0 = *(const f32x4*)(bias + col0 + bj * 128), bv1 = *(const f32x4*)(bias + col0 + bj * 128 + 4);
            u32x4 zz[2][4];
#pragma unroll
            for (int ai = 0; ai < 2; ++ai)
#pragma unroll
                for (int m = 0; m < 4; ++m) zz[ai][m] = *(const u32x4*)(Z + (size_t)(row0 + ai * 128 + m * 16) * 1024 + col0 + bj * 128);
#pragma unroll
            for (int ai = 0; ai < 2; ++ai)
#pragma unroll
                for (int m = 0; m < 4; ++m) {
                    const int row = row0 + ai * 128 + m * 16;
                    const u32x4 z4 = zz[ai][m];
                    const f32x4 v0 = acc[ai][bj][m][0] + bv0, v1 = acc[ai][bj][m][1] + bv1;
                    u32x4 w;
                    w.x = cvt_pk_bf16(bflo(z4.x) * fast_sigmoid(v0[0]), bfhi(z4.x) * fast_sigmoid(v0[1]));
                    w.y = cvt_pk_bf16(bflo(z4.y) * fast_sigmoid(v0[2]), bfhi(z4.y) * fast_sigmoid(v0[3]));
                    w.z = cvt_pk_bf16(bflo(z4.z) * fast_sigmoid(v1[0]), bfhi(z4.z) * fast_sigmoid(v1[1]));
                    w.w = cvt_pk_bf16(bflo(z4.w) * fast_sigmoid(v1[2]), bfhi(z4.w) * fast_sigmoid(v1[3]));
                    *(u32x4*)(Y + (size_t)row * DM + 1024 + col0 + bj * 128) = w;
                }
        }
    }
};

template <class Epi>
__device__ __forceinline__ void run_gemm(LAS unsigned char* lds, const bf16_t* A, const bf16_t* Bt, int M, int N, int K, const Epi E, int wgm = 8) {
    pg8::Gemm g{A, Bt, M, N, K}; pg8::StaticOrder S; S.init(M, N, (int)gridDim.x, (int)blockIdx.x, wgm);
    pg8::gemm_phase<Epi, pg8::StaticOrder, true, true>(lds, g, S, E);
}

__device__ __forceinline__ void conv_matrix(const float* __restrict__ W, bf16_t* __restrict__ WT, int K, int N, int mode, const float* __restrict__ gain, LAS float* scr, int gw, int NGW, int lane) {
    const int nblk = N / 64, nitems = (K / 64) * nblk;
    for (int item = gw; item < nitems; item += NGW) {
        const int kb = item / nblk, nb = item % nblk, k0 = 64 * kb, n0 = 64 * nb;
        const float gv = gain ? gain[k0 + lane] : 1.0f;
        const float* wp = W + (size_t)k0 * N + n0 + lane;
#pragma unroll
        for (int hb = 0; hb < 2; ++hb) {
            float v[32];
#pragma unroll
            for (int i = 0; i < 32; ++i) v[i] = wp[(size_t)(32 * hb + i) * N];
            asm volatile("" ::: "memory");
#pragma unroll
            for (int i = 0; i < 32; ++i) scr[(32 * hb + i) * 65 + lane] = v[i] * __builtin_bit_cast(float, __builtin_amdgcn_readlane(__builtin_bit_cast(int, gv), 32 * hb + i));
        }
        asm volatile("s_waitcnt lgkmcnt(0)" ::: "memory");
        const int c = lane & 7, ns = lane >> 3;
        const int rbase = (mode == 0) ? n0 : ((n0 >> 7) * 256 + (n0 & 127) + (mode == 2 ? 128 : 0));
#pragma unroll
        for (int j = 0; j < 8; ++j) { const int n = ns + 8 * j; const LAS float* sp = scr + (8 * c) * 65 + n;
            u32x4 o; o.x = pk2(sp[0 * 65], sp[1 * 65]); o.y = pk2(sp[2 * 65], sp[3 * 65]); o.z = pk2(sp[4 * 65], sp[5 * 65]); o.w = pk2(sp[6 * 65], sp[7 * 65]);
            *(u32x4*)(WT + (size_t)(rbase + n) * K + k0 + 8 * c) = o; }
        asm volatile("s_waitcnt lgkmcnt(0)" ::: "memory");
    }
}

template <bool TO_BF16>
__device__ __forceinline__ void rmsnorm_phase(const float* in, const float* __restrict__ g, bf16_t* outb, float* outf, int gw, int NGW, int lane) {
    f32x4 gv[8];
#pragma unroll
    for (int j = 0; j < 8; ++j) gv[j] = ((const f32x4*)g)[lane + 64 * j];
    for (int row = gw; row < TT; row += NGW) {
        const f32x4* xr = (const f32x4*)(in + (size_t)row * DM) + lane;
        f32x4 v[8]; float ss = 0.f;
#pragma unroll
        for (int j = 0; j < 8; ++j) { v[j] = xr[64 * j]; ss += (v[j][0] * v[j][0] + v[j][1] * v[j][1]) + (v[j][2] * v[j][2] + v[j][3] * v[j][3]); }
        const float rs = 1.0f / sqrtf(wave_sum(ss) * (1.0f / DM) + EPS);
#pragma unroll
        for (int j = 0; j < 8; ++j) {
            const f32x4 y = v[j] * rs * gv[j];
            if constexpr (TO_BF16) { u32x2 w; w.x = pk2(y[0], y[1]); w.y = pk2(y[2], y[3]); *((u32x2*)(outb + (size_t)row * DM) + lane + 64 * j) = w; }
            else { *((f32x4*)(outf + (size_t)row * DM) + lane + 64 * j) = y; }
        }
    }
}

__device__ __forceinline__ void cast_phase(const float* in, bf16_t* outb, u64_t* ssq, int gw, int NGW, int lane) {
    for (int row = gw; row < TT; row += NGW) {
        const f32x4* xr = (const f32x4*)(in + (size_t)row * DM) + lane;
        f32x4 v[8]; float ss = 0.f;
#pragma unroll
        for (int j = 0; j < 8; ++j) { v[j] = xr[64 * j]; ss += (v[j][0] * v[j][0] + v[j][1] * v[j][1]) + (v[j][2] * v[j][2] + v[j][3] * v[j][3]); }
        ss = wave_sum(ss);
        if (lane == 0) ssq[row] = (u64_t)(ss * SSQ_FIX);
#pragma unroll
        for (int j = 0; j < 8; ++j) { u32x2 w; w.x = pk2(v[j][0], v[j][1]); w.y = pk2(v[j][2], v[j][3]); *((u32x2*)(outb + (size_t)row * DM) + lane + 64 * j) = w; }
    }
}

__device__ __forceinline__ void final_phase(const bf16_t* xb, const u64_t* ssq, const float* __restrict__ g, float* outf, int gw, int NGW, int lane) {
    f32x4 gv[4][2];
#pragma unroll
    for (int j = 0; j < 4; ++j) { gv[j][0] = *(const f32x4*)(g + 8 * (lane + 64 * j)); gv[j][1] = *(const f32x4*)(g + 8 * (lane + 64 * j) + 4); }
    for (int row = gw; row < TT; row += NGW) {
        const float rs = __builtin_amdgcn_rsqf((float)ssq[row] * SSQ_INV * (1.0f / DM) + EPS);
        const u32x4* xr = (const u32x4*)(xb + (size_t)row * DM) + lane;
        u32x4 v[4];
#pragma unroll
        for (int j = 0; j < 4; ++j) v[j] = xr[64 * j];
#pragma unroll
        for (int j = 0; j < 4; ++j) {
            float* op = outf + (size_t)row * DM + 8 * (lane + 64 * j);
            *(f32x4*)op = (f32x4){bflo(v[j].x), bfhi(v[j].x), bflo(v[j].y), bfhi(v[j].y)} * rs * gv[j][0];
            *(f32x4*)(op + 4) = (f32x4){bflo(v[j].z), bfhi(v[j].z), bflo(v[j].w), bfhi(v[j].w)} * rs * gv[j][1];
        }
    }
}

__device__ __forceinline__ void tables_phase(unsigned char* ws, const float* const* in_unused, const float* lam_re, const float* lam_im, const float* log_step, const float* b_re, const float* b_im,
                                             const float* lq1, const float* lk1, const float* lq2, const float* lk2, int gtid, int NT_) {
    float* rcos = (float*)(ws + WS_RCOS); float* rsin = (float*)(ws + WS_RSIN); float* acos_ = (float*)(ws + WS_ACOS); float* asin_ = (float*)(ws + WS_ASIN);
    float* s5a = (float*)(ws + WS_S5A); float* s5bb = (float*)(ws + WS_S5BB);
    for (int i = gtid; i < SEQ * 128; i += NT_) {
        const int pos = i >> 7, f = i & 127;
        const float inv = (float)exp2(-((double)(2 * f) / 256.0) * 13.287712379549449);
        const float ang = (float)pos * inv; double s, c; sincos_d((double)ang, s, c); rcos[i] = (float)c; rsin[i] = (float)s;
    }
    for (int i = gtid; i < SEQ * 16; i += NT_) {
        const int pos = i >> 4, f = i & 15;
        const float inv = (float)exp2(-((double)(2 * f) / 32.0) * 18.931568569324174);
        const float ang = (float)pos * inv; double s, c; sincos_d((double)ang, s, c); acos_[i] = (float)c; asin_[i] = (float)s;
    }
    for (int i = gtid; i < 64 * 64; i += NT_) {
        const int g = i >> 6;
        const double step = exp((double)log_step[g]), lr = (double)lam_re[i], li = (double)lam_im[i];
        const double mag = exp(lr * step); double s, c; sincos_d(li * step, s, c);
        const double are = mag * c, aim = mag * s, den = lr * lr + li * li, nr = are - 1.0;
        const double fre = (nr * lr + aim * li) / den, fim = (aim * lr - nr * li) / den;
        s5a[2 * i] = (float)are; s5a[2 * i + 1] = (float)aim;
        for (int p = 0; p < 16; ++p) { const double br = (double)b_re[i * 16 + p], bi = (double)b_im[i * 16 + p];
            s5bb[(size_t)i * 32 + p] = (float)(fre * br - fim * bi); s5bb[(size_t)i * 32 + 16 + p] = (float)(fre * bi + fim * br); }
    }
    if (gtid == 0) { float s1 = 0.f, s2 = 0.f; for (int i = 0; i < 128; ++i) { s1 += lq1[i] * lk1[i]; s2 += lq2[i] * lk2[i]; }
        ((float*)(ws + WS_CTL))[0] = expf(s1) - expf(s2) + LAMBDA_INIT; }
}

__device__ __forceinline__ void s5_phase(LAS unsigned char* lds, const unsigned char* ws, const bf16_t* proj, const float* c_re, const float* c_im, const float* dskip, bf16_t* z,
                                         int vcu, int G, int wave, int lane) {
    const float* s5a = (const float*)(ws + WS_S5A); const float* s5bb = (const float*)(ws + WS_S5BB);
    LAS bf16_t* Hc = (LAS bf16_t*)(lds + wave * 8704);
    LAS float* Uc = (LAS float*)(lds + 8 * 8704 + wave * 2048);
    const int fr = lane & 15, fq = lane >> 4;
    for (int seq = vcu * 8 + wave; seq < 1024; seq += G * 8) {
        const int b = seq >> 6, g = seq & 63, n = lane;
        float bbre[16], bbim[16];
#pragma unroll
        for (int p = 0; p < 16; ++p) { bbre[p] = s5bb[(size_t)(g * 64 + n) * 32 + p]; bbim[p] = s5bb[(size_t)(g * 64 + n) * 32 + 16 + p]; }
        const float are = s5a[2 * (g * 64 + n)], aim = s5a[2 * (g * 64 + n) + 1];
        bf16x8 cf[4];
#pragma unroll
        for (int ks = 0; ks < 4; ++ks) { u32x4 w; unsigned* wp = (unsigned*)&w;
#pragma unroll
            for (int j2 = 0; j2 < 4; ++j2) { float v[2];
#pragma unroll
                for (int e = 0; e < 2; ++e) { const int k = 32 * ks + 8 * fq + 2 * j2 + e; v[e] = (k < 64) ? c_re[(size_t)(g * 16 + fr) * 64 + k] : -c_im[(size_t)(g * 16 + fr) * 64 + (k - 64)]; }
                wp[j2] = pk2(v[0], v[1]); }
            cf[ks] = __builtin_bit_cast(bf16x8, w); }
        const float dsk = dskip[g * 16 + fr];
        float hre = 0.f, him = 0.f;
        const bf16_t* ubase = proj + (size_t)b * SEQ * PW + 4096 + g * 16;
        u32x4 ua = *(const u32x4*)(ubase + (size_t)(lane & 31) * PW), ub = *(const u32x4*)(ubase + (size_t)(lane & 31) * PW + 8);
        unsigned short uu[2][4];
#pragma unroll
        for (int sb = 0; sb < 2; ++sb)
#pragma unroll
            for (int i = 0; i < 4; ++i) uu[sb][i] = ubase[(size_t)(16 * sb + 4 * fq + i) * PW + fr];
        for (int ch = 0; ch < SEQ / 32; ++ch) {
            const size_t row0 = (size_t)b * SEQ + ch * 32;
            const int chn = (ch + 1 < SEQ / 32) ? ch + 1 : ch;
            const bf16_t* unext = ubase + (size_t)chn * 32 * PW;
            const u32x4 ua_n = *(const u32x4*)(unext + (size_t)(lane & 31) * PW), ub_n = *(const u32x4*)(unext + (size_t)(lane & 31) * PW + 8);
            unsigned short uu_n[2][4];
#pragma unroll
            for (int sb = 0; sb < 2; ++sb)
#pragma unroll
                for (int i = 0; i < 4; ++i) uu_n[sb][i] = unext[(size_t)(16 * sb + 4 * fq + i) * PW + fr];
            if (lane < 32) {
                LAS f32x4* up4 = (LAS f32x4*)(Uc + lane * 16);
                up4[0] = (f32x4){bflo(ua.x), bfhi(ua.x), bflo(ua.y), bfhi(ua.y)}; up4[1] = (f32x4){bflo(ua.z), bfhi(ua.z), bflo(ua.w), bfhi(ua.w)};
                up4[2] = (f32x4){bflo(ub.x), bfhi(ub.x), bflo(ub.y), bfhi(ub.y)}; up4[3] = (f32x4){bflo(ub.z), bfhi(ub.z), bflo(ub.w), bfhi(ub.w)};
            }
#pragma unroll
            for (int k = 0; k < 32; ++k) {
                f32x2 xa = (f32x2){0.f, 0.f}, xb = (f32x2){0.f, 0.f};
#pragma unroll
                for (int q = 0; q < 4; ++q) { const f32x4 u4 = *(const LAS f32x4*)(Uc + k * 16 + 4 * q);
                    xa = __builtin_elementwise_fma((f32x2){u4[0], u4[0]}, (f32x2){bbre[4 * q], bbim[4 * q]}, xa);
                    xb = __builtin_elementwise_fma((f32x2){u4[1], u4[1]}, (f32x2){bbre[4 * q + 1], bbim[4 * q + 1]}, xb);
                    xa = __builtin_elementwise_fma((f32x2){u4[2], u4[2]}, (f32x2){bbre[4 * q + 2], bbim[4 * q + 2]}, xa);
                    xb = __builtin_elementwise_fma((f32x2){u4[3], u4[3]}, (f32x2){bbre[4 * q + 3], bbim[4 * q + 3]}, xb); }
                const f32x2 xx = xa + xb;
                const float nr = are * hre - aim * him + xx[0], ni = are * him + aim * hre + xx[1]; hre = nr; him = ni;
                Hc[k * 136 + n] = (bf16_t)f2bf(hre); Hc[k * 136 + 64 + n] = (bf16_t)f2bf(him);
            }
#pragma unroll
            for (int sb = 0; sb < 2; ++sb) {
                f32x4 y = (f32x4){0.f, 0.f, 0.f, 0.f};
#pragma unroll
                for (int ks = 0; ks < 4; ++ks) { const bf16x8 hf = *(const LAS bf16x8*)(Hc + (16 * sb + fr) * 136 + 32 * ks + 8 * fq); y = __builtin_amdgcn_mfma_f32_16x16x32_bf16(hf, cf[ks], y, 0, 0, 0); }
#pragma unroll
                for (int i = 0; i < 4; ++i) { const size_t row = row0 + 16 * sb + 4 * fq + i;
                    const float yy = y[i] + dsk * bf2f(uu[sb][i]);
                    z[row * 1024 + g * 16 + fr] = (bf16_t)f2bf(gelu_tanh_f(yy)); }
            }
            ua = ua_n; ub = ub_n;
#pragma unroll
            for (int sb = 0; sb < 2; ++sb)
#pragma unroll
                for (int i = 0; i < 4; ++i) uu[sb][i] = uu_n[sb][i];
        }
    }
}

#define MF32(a, b, c) __builtin_amdgcn_mfma_f32_32x32x16_bf16((a), (b), (c), 0, 0, 0)
#define AT_WAITV(n) asm volatile("s_waitcnt vmcnt(" #n ")" ::: "memory")
#define AT_BAR() asm volatile("s_waitcnt lgkmcnt(0)\n\ts_barrier" ::: "memory")
__device__ __forceinline__ s16x4 vtr(const LAS unsigned char* p) { typedef short v4i16_t __attribute__((ext_vector_type(4))); return __builtin_bit_cast(s16x4, __builtin_amdgcn_ds_read_tr16_b64_v4i16((LAS v4i16_t*)p)); }
__device__ __forceinline__ int crow(int i, int h) { return (i & 3) + 8 * (i >> 2) + 4 * h; }

template <int MODE>
__device__ __forceinline__ void attn_unit(LAS unsigned char* lds, const bf16_t* src, const int pitch, const int kcol, const int vcol, const int b, const int h, const int ub,
                                          bf16_t* outp, const bf16_t* gsrc, const float* subln, const float lam) {
    constexpr int NKS = MODE ? 8 : 16, NDB = 4, ROWS = MODE ? 64 : 128;
    const int tid = threadIdx.x, lane = tid & 63, r = lane & 31, hh = lane >> 5;
    const int wid = __builtin_amdgcn_readfirstlane(tid >> 6);
    const int rg = MODE ? (wid & 1) : (wid & 3), vh = MODE ? ((wid >> 1) & 1) : (wid >> 2), cc = MODE ? (wid >> 2) : 0;
    const size_t rowbase = (size_t)b * SEQ; const int q0 = ub * ROWS, NT = MODE ? (ub + 1) : (2 * ub + 2);
    const int qrow = q0 + rg * 32 + r;
    AT_WAITV(0);
#define AT_ISSUE(t, buf) do { const bf16_t* gk_ = src + (rowbase + (size_t)(t) * 64) * pitch; int rv_ = r; asm volatile("" : "+v"(rv_)); \
        _Pragma("unroll") for (int i_ = 0; i_ < 4; ++i_) { const int c_ = wid * 4 + i_; const int row_ = c_ * 2 + hh; \
            const unsigned ok_ = (unsigned)(row_ * pitch + kcol + ((rv_ ^ (row_ & 15)) << 3)); \
            __builtin_amdgcn_global_load_lds((const unsigned*)(gk_ + ok_), (LAS unsigned*)(lds + (buf) * 65536 + c_ * 1024), 16, 0, 0); \
            const unsigned ov_ = (unsigned)(row_ * pitch + vcol + ((rv_ ^ ((row_ & 3) << 2)) << 3)); \
            __builtin_amdgcn_global_load_lds((const unsigned*)(gk_ + ov_), (LAS unsigned*)(lds + (buf) * 65536 + 32768 + c_ * 1024), 16, 0, 0); } } while (0)
    AT_ISSUE(0, 0);
    bf16x8 qf[NKS];
    { const bf16_t* qp = src + (rowbase + qrow) * pitch + h * 256 + cc * 128 + 8 * hh;
#pragma unroll
      for (int d0 = 0; d0 < NKS; ++d0) qf[d0] = *(const bf16x8*)(qp + 16 * d0); }
    f32x16 O[NDB];
#pragma unroll
    for (int db = 0; db < NDB; ++db)
#pragma unroll
        for (int i = 0; i < 16; ++i) O[db][i] = 0.f;
    float mrun = 0.f, lrun = 0.f;
    const float lgam = __builtin_log2f(1.0f - __builtin_amdgcn_exp2f(-5.0f - (float)h));
    const int r15 = r & 15;
    const int kunit0 = cc * 16;
    const int q4 = (lane & 15) >> 2, p4 = lane & 3, blk16 = (lane >> 4) & 1;
    const int vlane = (4 * hh + q4) * 512 + ((2 * blk16 + (p4 >> 1)) << 4) + 8 * (p4 & 1);
    for (int t = 0; t < NT; ++t) {
        if (t + 1 < NT) { AT_ISSUE(t + 1, (t + 1) & 1); AT_WAITV(8); } else { AT_WAITV(0); }
        AT_BAR();
        const bool active = MODE ? true : !(t == NT - 1 && rg < 2);
        if (active) {
            const LAS unsigned char* Kb = lds + (t & 1) * 65536; const LAS unsigned char* Vb = Kb + 32768;
            int r15v = r15 ^ hh ^ kunit0, q4v = q4 << 2; asm volatile("" : "+v"(r15v), "+v"(q4v));
            bf16x8 pf[4];
            if constexpr (MODE) {
                f32x16 p0, p1;
#pragma unroll
                for (int i = 0; i < 16; ++i) { p0[i] = -mrun; p1[i] = -mrun; }
                { const LAS unsigned char* kr0 = Kb + r * 512; const LAS unsigned char* kr1 = Kb + (32 + r) * 512;
#pragma unroll
                  for (int d0 = 0; d0 < NKS; ++d0) { const int uo = ((2 * d0) ^ r15v) << 4;
                      const bf16x8 k0 = *(const LAS bf16x8*)(kr0 + uo); const bf16x8 k1 = *(const LAS bf16x8*)(kr1 + uo);
                      p0 = MF32(k0, qf[d0], p0); p1 = MF32(k1, qf[d0], p1);
                      if ((d0 & 3) == 3) __builtin_amdgcn_sched_barrier(0); } }
                float rm = p0[0];
#pragma unroll
                for (int i = 0; i < 16; ++i) { rm = fmaxf(rm, p0[i]); rm = fmaxf(rm, p1[i]); }
                rm = fmaxf(rm, __shfl_xor(rm, 32));
                if (t == 0 || __any(rm > 8.0f)) {
                    const float dl = (t == 0) ? rm : fmaxf(rm, 0.f); const float al = (t == 0) ? 1.0f : __builtin_amdgcn_exp2f(-dl); lrun *= al; mrun += dl;
#pragma unroll
                    for (int i = 0; i < 16; ++i) { p0[i] -= dl; p1[i] -= dl; }
#pragma unroll
                    for (int db = 0; db < NDB; ++db) O[db] = O[db] * al;
                }
                float sum = 0.f;
#pragma unroll
                for (int i = 0; i < 16; ++i) { p0[i] = __builtin_amdgcn_exp2f(p0[i]); p1[i] = __builtin_amdgcn_exp2f(p1[i]); sum += p0[i] + p1[i]; }
                lrun += sum;
                u32x4 w;
                w.x = cvt_pk_bf16(p0[0], p0[1]); w.y = cvt_pk_bf16(p0[2], p0[3]); w.z = cvt_pk_bf16(p0[4], p0[5]); w.w = cvt_pk_bf16(p0[6], p0[7]); pf[0] = __builtin_bit_cast(bf16x8, w);
                w.x = cvt_pk_bf16(p0[8], p0[9]); w.y = cvt_pk_bf16(p0[10], p0[11]); w.z = cvt_pk_bf16(p0[12], p0[13]); w.w = cvt_pk_bf16(p0[14], p0[15]); pf[1] = __builtin_bit_cast(bf16x8, w);
                w.x = cvt_pk_bf16(p1[0], p1[1]); w.y = cvt_pk_bf16(p1[2], p1[3]); w.z = cvt_pk_bf16(p1[4], p1[5]); w.w = cvt_pk_bf16(p1[6], p1[7]); pf[2] = __builtin_bit_cast(bf16x8, w);
                w.x = cvt_pk_bf16(p1[8], p1[9]); w.y = cvt_pk_bf16(p1[10], p1[11]); w.z = cvt_pk_bf16(p1[12], p1[13]); w.w = cvt_pk_bf16(p1[14], p1[15]); pf[3] = __builtin_bit_cast(bf16x8, w);
            } else {
#pragma unroll
                for (int blk = 0; blk < 2; ++blk) {
                    f32x16 p;
#pragma unroll
                    for (int i = 0; i < 16; ++i) p[i] = 0.f;
                    const LAS unsigned char* kr = Kb + (32 * blk + r) * 512;
                    {
                        bf16x8 kq[2];
                        kq[0] = *(const LAS bf16x8*)(kr + ((0 ^ r15v) << 4));
#pragma unroll
                        for (int d0 = 0; d0 < NKS; ++d0) {
                            if (d0 + 1 < NKS) kq[(d0 + 1) & 1] = *(const LAS bf16x8*)(kr + (((2 * (d0 + 1)) ^ r15v) << 4));
                            __builtin_amdgcn_sched_barrier(0);
                            p = MF32(kq[d0 & 1], qf[d0], p);
                            __builtin_amdgcn_sched_barrier(0);
                        }
                    }
                    const int kb = t * 64 + 32 * blk + 4 * hh;
#pragma unroll
                    for (int i = 0; i < 16; ++i) { const int kv = kb + (i & 3) + 8 * (i >> 2);
                        p[i] *= __builtin_amdgcn_exp2f(lgam * fabsf((float)(qrow - kv)) - 4.0f); }
                    u32x4 w;
                    w.x = cvt_pk_bf16(p[0], p[1]); w.y = cvt_pk_bf16(p[2], p[3]); w.z = cvt_pk_bf16(p[4], p[5]); w.w = cvt_pk_bf16(p[6], p[7]); pf[2 * blk] = __builtin_bit_cast(bf16x8, w);
                    w.x = cvt_pk_bf16(p[8], p[9]); w.y = cvt_pk_bf16(p[10], p[11]); w.z = cvt_pk_bf16(p[12], p[13]); w.w = cvt_pk_bf16(p[14], p[15]); pf[2 * blk + 1] = __builtin_bit_cast(bf16x8, w);
                    __builtin_amdgcn_sched_barrier(0);
                }
            }
            const LAS unsigned char* vb = Vb + vlane;
            __builtin_amdgcn_sched_barrier(0);
            {
#define VFRAG(j) __builtin_shufflevector(vtr(vb + (((vh * 16 + 4 * ((j) >> 2)) ^ q4v) << 4) + (16 * ((j) & 3)) * 512), vtr(vb + (((vh * 16 + 4 * ((j) >> 2)) ^ q4v) << 4) + (16 * ((j) & 3) + 8) * 512), 0, 1, 2, 3, 4, 5, 6, 7)
                bf16x8 vq[3];
                vq[0] = VFRAG(0); vq[1] = VFRAG(1);
#pragma unroll
                for (int j = 0; j < 4 * NDB; ++j) {
                    if (j + 2 < 4 * NDB) vq[(j + 2) % 3] = VFRAG(j + 2);
                    __builtin_amdgcn_sched_barrier(0);
                    O[j >> 2] = MF32(vq[j % 3], pf[j & 3], O[j >> 2]);
                    __builtin_amdgcn_sched_barrier(0);
                }
#undef VFRAG
            }
        }
        AT_BAR();
    }
    const size_t orow = rowbase + qrow;
    LAS float* SS = (LAS float*)(lds + 131072);
    if constexpr (MODE) {
        const float l = lrun + __shfl_xor(lrun, 32); const float inv = 1.0f / l;
        LAS float* X = (LAS float*)(lds + (wid & 3) * 16384);
        if (cc == 1) {
#pragma unroll
            for (int db = 0; db < NDB; ++db)
#pragma unroll
                for (int i = 0; i < 16; ++i) X[(db * 16 + i) * 64 + lane] = O[db][i] * inv;
        }
        AT_BAR();
        float ss = 0.f;
        if (cc == 0) {
#pragma unroll
            for (int db = 0; db < NDB; ++db)
#pragma unroll
                for (int i = 0; i < 16; ++i) { const float o = O[db][i] * inv - lam * X[(db * 16 + i) * 64 + lane]; O[db][i] = o; ss += o * o; }
        }
        ss += __shfl_xor(ss, 32);
        if (hh == 0) SS[wid * 32 + r] = ss;
        AT_BAR();
        if (cc == 0) {
            ss += SS[(wid ^ 2) * 32 + r];
            const float rs = (1.0f - LAMBDA_INIT) / sqrtf(ss * (1.0f / 256.0f) + EPS);
            bf16_t* op = outp + orow * DM + h * 256 + vh * 128 + 4 * hh;
            const float* slp = subln + vh * 128 + 4 * hh;
#pragma unroll
            for (int db = 0; db < NDB; ++db)
#pragma unroll
                for (int i4 = 0; i4 < 4; ++i4) { const int d = 32 * db + 8 * i4;
                    const f32x4 sl = *(const f32x4*)(slp + d);
                    u32x2 w; w.x = cvt_pk_bf16(O[db][4 * i4] * rs * sl[0], O[db][4 * i4 + 1] * rs * sl[1]); w.y = cvt_pk_bf16(O[db][4 * i4 + 2] * rs * sl[2], O[db][4 * i4 + 3] * rs * sl[3]);
                    *(u32x2*)(op + d) = w; }
        }
        AT_BAR();
    } else {
        float ss = 0.f;
#pragma unroll
        for (int db = 0; db < NDB; ++db)
#pragma unroll
            for (int i = 0; i < 16; ++i) ss += O[db][i] * O[db][i];
        ss += __shfl_xor(ss, 32);
        if (hh == 0) SS[wid * 32 + r] = ss;
        AT_BAR();
        ss += SS[(wid ^ 4) * 32 + r];
        const float rs = 1.0f / sqrtf(ss * (1.0f / 256.0f) + EPS);
        const bf16_t* gp = gsrc + orow * PW + 3072 + h * 256 + vh * 128 + 4 * hh;
        bf16_t* op = outp + orow * DM + h * 256 + vh * 128 + 4 * hh;
        u32x2 ggv[NDB][4];
#pragma unroll
        for (int db = 0; db < NDB; ++db)
#pragma unroll
            for (int i4 = 0; i4 < 4; ++i4) ggv[db][i4] = *(const u32x2*)(gp + 32 * db + 8 * i4);
#pragma unroll
        for (int db = 0; db < NDB; ++db)
#pragma unroll
            for (int i4 = 0; i4 < 4; ++i4) { const int d = 32 * db + 8 * i4;
                const u32x2 gg = ggv[db][i4];
                u32x2 w; w.x = cvt_pk_bf16(O[db][4 * i4] * rs * silu_f(bflo(gg.x)), O[db][4 * i4 + 1] * rs * silu_f(bfhi(gg.x)));
                w.y = cvt_pk_bf16(O[db][4 * i4 + 2] * rs * silu_f(bflo(gg.y)), O[db][4 * i4 + 3] * rs * silu_f(bfhi(gg.y)));
                *(u32x2*)(op + d) = w; }
        AT_BAR();
    }
#undef AT_ISSUE
}

__device__ __forceinline__ void attn_unit_diff128(LAS unsigned char* lds, const bf16_t* src, const int pitch, const int kcol, const int vcol, const int b, const int h, const int ub,
                                                  bf16_t* outp, const float* subln, const float lam) {
    constexpr int NKS = 8, NDB = 8;
    const int tid = threadIdx.x, lane = tid & 63, r = lane & 31, hh = lane >> 5;
    const int wid = __builtin_amdgcn_readfirstlane(tid >> 6);
    const int rg = wid & 3, cc = wid >> 2;
    const size_t rowbase = (size_t)b * SEQ; const int q0 = ub * 128, NT = 2 * ub + 2;
    const int qrow = q0 + rg * 32 + r;
    AT_WAITV(0);
#define AT_ISSUE(t, buf) do { const bf16_t* gk_ = src + (rowbase + (size_t)(t) * 64) * pitch; int rv_ = r; asm volatile("" : "+v"(rv_)); \
        _Pragma("unroll") for (int i_ = 0; i_ < 4; ++i_) { const int c_ = wid * 4 + i_; const int row_ = c_ * 2 + hh; \
            const unsigned ok_ = (unsigned)(row_ * pitch + kcol + ((rv_ ^ (row_ & 15)) << 3)); \
            __builtin_amdgcn_global_load_lds((const unsigned*)(gk_ + ok_), (LAS unsigned*)(lds + (buf) * 65536 + c_ * 1024), 16, 0, 0); \
            const unsigned ov_ = (unsigned)(row_ * pitch + vcol + ((rv_ ^ ((row_ & 3) << 2)) << 3)); \
            __builtin_amdgcn_global_load_lds((const unsigned*)(gk_ + ov_), (LAS unsigned*)(lds + (buf) * 65536 + 32768 + c_ * 1024), 16, 0, 0); } } while (0)
    AT_ISSUE(0, 0);
    bf16x8 qf[NKS];
    { const bf16_t* qp = src + (rowbase + qrow) * pitch + h * 256 + cc * 128 + 8 * hh;
#pragma unroll
      for (int d0 = 0; d0 < NKS; ++d0) qf[d0] = *(const bf16x8*)(qp + 16 * d0); }
    f32x16 O[NDB];
#pragma unroll
    for (int db = 0; db < NDB; ++db)
#pragma unroll
        for (int i = 0; i < 16; ++i) O[db][i] = 0.f;
    float mrun = 0.f, lrun = 0.f;
    const int r15 = r & 15, kunit0 = cc * 16;
    const int q4 = (lane & 15) >> 2, p4 = lane & 3, blk16 = (lane >> 4) & 1;
    const int vlane = (4 * hh + q4) * 512 + ((2 * blk16 + (p4 >> 1)) << 4) + 8 * (p4 & 1);
    for (int t = 0; t < NT; ++t) {
        if (t + 1 < NT) { AT_ISSUE(t + 1, (t + 1) & 1); AT_WAITV(8); } else { AT_WAITV(0); }
        AT_BAR();
        const bool active = !(t == NT - 1 && rg < 2);
        if (active) {
            const LAS unsigned char* Kb = lds + (t & 1) * 65536; const LAS unsigned char* Vb = Kb + 32768;
            int r15v = r15 ^ hh ^ kunit0, q4v = q4 << 2; asm volatile("" : "+v"(r15v), "+v"(q4v));
            const LAS unsigned char* vb = Vb + vlane;
#pragma unroll
            for (int blk = 0; blk < 2; ++blk) {
                f32x16 p;
#pragma unroll
                for (int i = 0; i < 16; ++i) p[i] = -mrun;
                const LAS unsigned char* kr = Kb + (32 * blk + r) * 512;
                {
                    bf16x8 kq[2];
                    kq[0] = *(const LAS bf16x8*)(kr + ((0 ^ r15v) << 4));
#pragma unroll
                    for (int d0 = 0; d0 < NKS; ++d0) {
                        if (d0 + 1 < NKS) kq[(d0 + 1) & 1] = *(const LAS bf16x8*)(kr + (((2 * (d0 + 1)) ^ r15v) << 4));
                        __builtin_amdgcn_sched_barrier(0);
                        p = MF32(kq[d0 & 1], qf[d0], p);
                        __builtin_amdgcn_sched_barrier(0);
                    }
                }
                float rm = p[0];
#pragma unroll
                for (int i = 1; i < 16; ++i) rm = fmaxf(rm, p[i]);
                rm = fmaxf(rm, __shfl_xor(rm, 32));
                const bool first = (t == 0) && (blk == 0);
                if (first || __any(rm > 8.0f)) {
                    const float dl = first ? rm : fmaxf(rm, 0.f); const float al = first ? 1.0f : __builtin_amdgcn_exp2f(-dl); lrun *= al; mrun += dl;
#pragma unroll
                    for (int i = 0; i < 16; ++i) p[i] -= dl;
#pragma unroll
                    for (int db = 0; db < NDB; ++db) O[db] = O[db] * al;
                }
                float sum = 0.f;
#pragma unroll
                for (int i = 0; i < 16; ++i) { p[i] = __builtin_amdgcn_exp2f(p[i]); sum += p[i]; }
                lrun += sum;
                bf16x8 pf[2];
                { u32x4 w;
                  w.x = cvt_pk_bf16(p[0], p[1]); w.y = cvt_pk_bf16(p[2], p[3]); w.z = cvt_pk_bf16(p[4], p[5]); w.w = cvt_pk_bf16(p[6], p[7]); pf[0] = __builtin_bit_cast(bf16x8, w);
                  w.x = cvt_pk_bf16(p[8], p[9]); w.y = cvt_pk_bf16(p[10], p[11]); w.z = cvt_pk_bf16(p[12], p[13]); w.w = cvt_pk_bf16(p[14], p[15]); pf[1] = __builtin_bit_cast(bf16x8, w); }
                __builtin_amdgcn_sched_barrier(0);
                {
#define VFRAG(j) __builtin_shufflevector(vtr(vb + (((4 * ((j) >> 1)) ^ q4v) << 4) + (32 * blk + 16 * ((j) & 1)) * 512), vtr(vb + (((4 * ((j) >> 1)) ^ q4v) << 4) + (32 * blk + 16 * ((j) & 1) + 8) * 512), 0, 1, 2, 3, 4, 5, 6, 7)
                    bf16x8 vq[3];
                    vq[0] = VFRAG(0); vq[1] = VFRAG(1);
#pragma unroll
                    for (int j = 0; j < 2 * NDB; ++j) {
                        if (j + 2 < 2 * NDB) vq[(j + 2) % 3] = VFRAG(j + 2);
                        __builtin_amdgcn_sched_barrier(0);
                        O[j >> 1] = MF32(vq[j % 3], pf[j & 1], O[j >> 1]);
                        __builtin_amdgcn_sched_barrier(0);
                    }
#undef VFRAG
                }
            }
        }
        AT_BAR();
    }
    const size_t orow = rowbase + qrow;
    const float l = lrun + __shfl_xor(lrun, 32); const float inv = 1.0f / l;
    LAS float* X = (LAS float*)(lds + rg * 32768);
    if (cc == 1) {
#pragma unroll
        for (int db = 0; db < NDB; ++db)
#pragma unroll
            for (int i = 0; i < 16; ++i) X[(db * 16 + i) * 64 + lane] = O[db][i] * inv;
    }
    AT_BAR();
    if (cc == 0) {
        float ss = 0.f;
#pragma unroll
        for (int db = 0; db < NDB; ++db)
#pragma unroll
            for (int i = 0; i < 16; ++i) { const float o = O[db][i] * inv - lam * X[(db * 16 + i) * 64 + lane]; O[db][i] = o; ss += o * o; }
        ss += __shfl_xor(ss, 32);
        const float rs = (1.0f - LAMBDA_INIT) / sqrtf(ss * (1.0f / 256.0f) + EPS);
        bf16_t* op = outp + orow * DM + h * 256 + 4 * hh;
        const LAS float* slp = (const LAS float*)(lds + 132096) + 4 * hh;
#pragma unroll
        for (int db = 0; db < NDB; ++db)
#pragma unroll
            for (int i4 = 0; i4 < 4; ++i4) { const int d = 32 * db + 8 * i4;
                const f32x4 sl = *(const LAS f32x4*)(slp + d);
                u32x2 w; w.x = cvt_pk_bf16(O[db][4 * i4] * rs * sl[0], O[db][4 * i4 + 1] * rs * sl[1]); w.y = cvt_pk_bf16(O[db][4 * i4 + 2] * rs * sl[2], O[db][4 * i4 + 3] * rs * sl[3]);
                *(u32x2*)(op + d) = w; }
    }
    AT_BAR();
#undef AT_ISSUE
}

template <int MODE>
__device__ __forceinline__ void attn_phase(LAS unsigned char* lds, const bf16_t* src, int pitch, int kcol0, int vcol0, int nheads, bf16_t* outp, const bf16_t* gsrc, const float* subln, float lam, int vcu, int G) {
    constexpr int NU = 16;
    const int npairs = 16 * nheads * (NU / 2);
    if constexpr (MODE) { if (threadIdx.x < 256) ((LAS float*)(lds + 132096))[threadIdx.x] = subln[threadIdx.x]; __syncthreads(); }
    for (int pr = vcu; pr < npairs; pr += G) {
        const int bh = pr / (NU / 2), p = pr % (NU / 2), b = bh / nheads, h = bh % nheads;
        if constexpr (MODE) {
            attn_unit_diff128(lds, src, pitch, kcol0 + h * 256, vcol0 + h * 256, b, h, NU - 1 - p, outp, subln, lam);
            attn_unit_diff128(lds, src, pitch, kcol0 + h * 256, vcol0 + h * 256, b, h, p, outp, subln, lam);
        } else {
            attn_unit<0>(lds, src, pitch, kcol0 + h * 256, vcol0 + h * 256, b, h, NU - 1 - p, outp, gsrc, subln, lam);
            attn_unit<0>(lds, src, pitch, kcol0 + h * 256, vcol0 + h * 256, b, h, p, outp, gsrc, subln, lam);
        }
    }
}

#define XB_TMO      128
#define XB_XCNT(j)  (256  + 64 * (j))
#define XB_XSUB(j)  (1280 + 64 * (j))
#define XB_XGEN(j)  (2304 + 64 * (j))
#define XB_TOP      3328
#define XB_TOPGEN   3392
#define XCD_BAR_WORDS 3456
#define XB_SPIN_CAP (1u << 18)
__device__ __forceinline__ unsigned xb_ld(unsigned* p)              { return __hip_atomic_load(p, __ATOMIC_RELAXED, __HIP_MEMORY_SCOPE_AGENT); }
__device__ __forceinline__ unsigned xb_add(unsigned* p, unsigned v) { return __hip_atomic_fetch_add(p, v, __ATOMIC_RELAXED, __HIP_MEMORY_SCOPE_AGENT); }
__device__ __forceinline__ unsigned xb_xcc_id() { return (unsigned)__builtin_amdgcn_s_getreg((3 << 11) | 20) & 0xFu; }
#define XB_SPIN(cond, bar) do { unsigned _sp = 0; while (cond) { __builtin_amdgcn_s_sleep(1); \
    if ((++_sp & 255u) == 0u) { if (xb_ld(&(bar)[XB_TMO])) break; if (_sp > XB_SPIN_CAP) { atomicAdd(&(bar)[XB_TMO], 1u); break; } } } } while (0)
struct XcdBarrier { unsigned* bar; unsigned x; volatile LAS unsigned* st; };
__device__ __forceinline__ XcdBarrier xcd_barrier_post(unsigned* bar, volatile LAS unsigned* st) {
    XcdBarrier b; b.bar = bar; b.x = xb_xcc_id(); b.st = st;
    if (threadIdx.x == 0) (void)xb_add(&bar[XB_XCNT(b.x)], 1u);
    return b;
}
__device__ __forceinline__ void xcd_barrier_complete(unsigned* bar, unsigned x, unsigned& nloc, unsigned& nx) {
    const unsigned G = gridDim.x * gridDim.y * gridDim.z;
    unsigned sum, cnt, mine, sp = 0u;
    for (;;) {
        sum = 0u; cnt = 0u; mine = 0u;
#pragma unroll
        for (unsigned j = 0; j < 16; ++j) { const unsigned c = xb_ld(&bar[XB_XCNT(j)]); sum += c; cnt += (c > 0u) ? 1u : 0u; mine = (j == x) ? c : mine; }
        if (sum == G) break;
        __builtin_amdgcn_s_sleep(1);
        if ((++sp & 255u) == 0u) { if (xb_ld(&bar[XB_TMO])) break; if (sp > XB_SPIN_CAP) { atomicAdd(&bar[XB_TMO], 1u); break; } }
    }
    nloc = mine > 0u ? mine : 1u; nx = cnt > 0u ? cnt : 1u;
}
__device__ __forceinline__ void xcd_barrier(const XcdBarrier& b) {
    asm volatile("s_waitcnt vmcnt(0)" ::: "memory");
    __syncthreads();
    if (threadIdx.x == 0) {
        unsigned* bar = b.bar;
        __builtin_amdgcn_s_waitcnt(0);
        unsigned nloc = b.st[0], nx = b.st[1];
        if (nloc == 0u) { xcd_barrier_complete(bar, b.x, nloc, nx); b.st[0] = nloc; b.st[1] = nx; }
        const unsigned old = xb_add(&bar[XB_XSUB(b.x)], 1u);
        const unsigned gen = old / nloc;
        if (old + 1u == (gen + 1u) * nloc) {
            __builtin_amdgcn_fence(__ATOMIC_RELEASE, "agent");
            asm volatile("s_waitcnt vmcnt(0)" ::: "memory");
            const unsigned og = xb_add(&bar[XB_TOP], 1u);
            const unsigned tg = og / nx;
            if (og + 1u == (tg + 1u) * nx) xb_add(&bar[XB_TOPGEN], 1u);
            else XB_SPIN(xb_ld(&bar[XB_TOPGEN]) == tg, bar);
            __builtin_amdgcn_fence(__ATOMIC_ACQUIRE, "agent");
            xb_add(&bar[XB_XGEN(b.x)], 1u);
            asm volatile("s_waitcnt vmcnt(0)" ::: "memory");
        } else {
            XB_SPIN(xb_ld(&bar[XB_XGEN(b.x)]) == gen, bar);
            __builtin_amdgcn_fence(__ATOMIC_ACQUIRE, "agent");
            asm volatile("s_waitcnt vmcnt(0)" ::: "memory");
        }
    }
    __syncthreads();
}

struct Params { const float* in[26]; float* out; unsigned char* ws; int lo, hi; };
constexpr int NPHASE = 17;

__global__ void __launch_bounds__(512) fwd_megakernel(Params P) {
    extern __shared__ __attribute__((aligned(16))) unsigned char lds_raw[];
    LAS unsigned char* lds = (LAS unsigned char*)lds_raw;
    const int tid = threadIdx.x, lane = tid & 63, wave = __builtin_amdgcn_readfirstlane(tid >> 6);
    const int G = gridDim.x, bx = blockIdx.x;
    const int vcu = (G % 8 == 0) ? (bx % 8) * (G / 8) + bx / 8 : bx;
    const int gw = vcu * 8 + wave, NGW = G * 8;
    unsigned char* ws = P.ws;
    float* out = P.out;
    bf16_t* Wgu = (bf16_t*)(ws + WS_WGU); bf16_t* Wd = (bf16_t*)(ws + WS_WD); bf16_t* Win = (bf16_t*)(ws + WS_WIN); bf16_t* Wout = (bf16_t*)(ws + WS_WOUT);
    bf16_t* Wglu = (bf16_t*)(ws + WS_WGLU); bf16_t* Wqkv = (bf16_t*)(ws + WS_WQKV); bf16_t* Wco = (bf16_t*)(ws + WS_WCO);
    bf16_t* XN = (bf16_t*)(ws + WS_XN); bf16_t* BIG = (bf16_t*)(ws + WS_BIG); bf16_t* ZB = (bf16_t*)(ws + WS_Z);
    const float* x = P.in[0]; const float* ffn_norm = P.in[1]; const float* mix_norm = P.in[5];
#if MK_PER_PHASE
#define SYNC(k) do { } while (0)
#else
    cg::grid_group grid = cg::this_grid();
    { volatile LAS unsigned* st0 = (volatile LAS unsigned*)(lds + 139264); if (tid < 2) st0[tid] = 0u; }
    __syncthreads();
    const XcdBarrier xbar = xcd_barrier_post((unsigned*)(ws + WS_BAR), (volatile LAS unsigned*)(lds + 139264));
#define SYNC(k) do { if (P.lo <= (k) && (k) + 1 < P.hi) { if ((k) == 0) grid.sync(); else xcd_barrier(xbar); } } while (0)
#endif
#ifndef WGM_DOWN
#define WGM_DOWN 4
#endif
#ifndef DUPMASK
#define DUPMASK 0u
#endif
#define IN(k) (P.lo <= (k) && (k) < P.hi)
#define REP(k) for (int rep_ = 0; rep_ < (((DUPMASK >> (k)) & 1u) ? 2 : 1); ++rep_)

    u64_t* SSQ = (u64_t*)(ws + WS_SSQ);
    bf16_t* YC = (bf16_t*)(ws + WS_YC);
    const float* rcos = (const float*)(ws + WS_RCOS); const float* rsin = (const float*)(ws + WS_RSIN);
    const float* acos_ = (const float*)(ws + WS_ACOS); const float* asin_ = (const float*)(ws + WS_ASIN);
    if (IN(0)) REP(0) {
        LAS float* scr = (LAS float*)(lds + wave * 16640);
        const size_t gsz = (size_t)DM * DFF;
#pragma unroll 1
        for (int i = 0; i < 4; ++i) {
            conv_matrix(P.in[2] + i * gsz, Wgu + (size_t)i * NGU * DM, DM, DFF, 1, ffn_norm + i * DM, scr, gw, NGW, lane);
            conv_matrix(P.in[3] + i * gsz, Wgu + (size_t)i * NGU * DM, DM, DFF, 2, ffn_norm + i * DM, scr, gw, NGW, lane);
            conv_matrix(P.in[4] + i * gsz, Wd + (size_t)i * DM * DFF, DFF, DM, 0, nullptr, scr, gw, NGW, lane);
        }
        conv_matrix(P.in[6], Win, DM, PW, 0, mix_norm, scr, gw, NGW, lane);
        conv_matrix(P.in[7], Wout, DM, DM, 0, nullptr, scr, gw, NGW, lane);
        conv_matrix(P.in[16], Wglu, 1024, 1024, 0, nullptr, scr, gw, NGW, lane);
        conv_matrix(P.in[18], Wqkv, DM, QW, 0, mix_norm + DM, scr, gw, NGW, lane);
        conv_matrix(P.in[19], Wco, DM, DM, 0, nullptr, scr, gw, NGW, lane);
        tables_phase(ws, nullptr, P.in[8], P.in[9], P.in[10], P.in[11], P.in[12], P.in[20], P.in[21], P.in[22], P.in[23], vcu * 512 + tid, G * 512);
        for (int i = vcu * 512 + tid; i < 6 * TT; i += G * 512) SSQ[TT + i] = 0u;
        cast_phase(x, XN, SSQ, gw, NGW, lane);
    }
    SYNC(0);
#if !MK_PER_PHASE
    if ((DUPMASK >> 20) & 1u) { for (int q_ = 0; q_ < 32; ++q_) grid.sync(); }
#endif
    if (IN(1)) { run_gemm(lds, XN, Wgu, TT, NGU, DM, EpiSwiglu{BIG, DFF, SSQ}); if ((DUPMASK >> 1) & 1u) { run_gemm(lds, XN, Wgu, TT, NGU, DM, EpiSwiglu{BIG, DFF, SSQ}); } }
    SYNC(1);
    if (IN(2)) run_gemm(lds, BIG, Wd, TT, DM, DFF, EpiResid<true, false, 1>{x, nullptr, XN, SSQ + 1 * TT}, WGM_DOWN);
    if (IN(2) && ((DUPMASK >> 2) & 1u)) run_gemm(lds, BIG, Wd, TT, DM, DFF, EpiResid<false, false, 2>{nullptr, nullptr, XN, nullptr});
    SYNC(2);
    if (IN(3)) { run_gemm(lds, XN, Win, TT, PW, DM, EpiWin{BIG, rcos, rsin, SSQ + 1 * TT}); if ((DUPMASK >> 3) & 1u) { run_gemm(lds, XN, Win, TT, PW, DM, EpiWin{BIG, rcos, rsin, SSQ + 1 * TT}); } }
    SYNC(3);
    if (IN(4)) REP(4) {
        const bool do_ret = !(rep_ == 1 && ((DUPMASK >> 22) & 1u)), do_s5 = !(rep_ == 1 && ((DUPMASK >> 21) & 1u));
        unsigned mask = 0u; int bh = 0, lin = -1, s5i = vcu, s5g = G; bool s5 = true;
        if (G == 256) {
            if (vcu < 128) { bh = vcu >> 1; mask = (vcu & 1) ? 0x03FDu : 0xE402u; s5 = false; }
            else { const int j = vcu - 128; bh = j >> 1; mask = 1u << (11 + (j & 1)); s5i = j; s5g = 128; }
        } else lin = vcu;
        if (s5 && do_s5) s5_phase(lds, ws, BIG, P.in[13], P.in[14], P.in[15], ZB, s5i, s5g, wave, lane);
        __syncthreads();
        if (do_ret) for (;;) {
            int ub;
            if (lin < 0) { if (!mask) break; ub = 31 - __clz((int)mask); mask &= ~(1u << ub); }
            else { if (lin >= 1024) break; bh = lin >> 4; ub = 15 - (lin & 15); lin += G; }
            const int b = bh >> 2, h = bh & 3;
            attn_unit<0>(lds, BIG, PW, 1024 + h * 256, 2048 + h * 256, b, h, ub, YC, BIG, nullptr, 0.f);
        }
    }
    SYNC(4);
    if (IN(5)) run_gemm(lds, ZB, Wglu, TT, 1024, 1024, EpiGlu{ZB, P.in[17], YC});
    SYNC(5);
    if (IN(6)) run_gemm(lds, YC, Wout, TT, DM, DM, EpiResid<false, false, 0>{nullptr, nullptr, XN, SSQ + 2 * TT});
    if (IN(6) && ((DUPMASK >> 6) & 1u)) run_gemm(lds, YC, Wout, TT, DM, DM, EpiResid<false, false, 2>{nullptr, nullptr, XN, nullptr});
    SYNC(6);
    if (IN(7)) { run_gemm(lds, XN, Wgu + (size_t)1 * NGU * DM, TT, NGU, DM, EpiSwiglu{BIG, DFF, SSQ + 2 * TT}); if ((DUPMASK >> 7) & 1u) { run_gemm(lds, XN, Wgu + (size_t)1 * NGU * DM, TT, NGU, DM, EpiSwiglu{BIG, DFF, SSQ + 2 * TT}); } }
    SYNC(7);
    if (IN(8)) run_gemm(lds, BIG, Wd + (size_t)1 * DM * DFF, TT, DM, DFF, EpiResid<false, false, 1>{nullptr, nullptr, XN, SSQ + 3 * TT}, WGM_DOWN);
    if (IN(8) && ((DUPMASK >> 8) & 1u)) run_gemm(lds, BIG, Wd + (size_t)1 * DM * DFF, TT, DM, DFF, EpiResid<false, false, 2>{nullptr, nullptr, XN, nullptr});
    SYNC(8);
    if (IN(9)) { run_gemm(lds, XN, Wgu + (size_t)2 * NGU * DM, TT, NGU, DM, EpiSwiglu{BIG, DFF, SSQ + 3 * TT}); if ((DUPMASK >> 9) & 1u) { run_gemm(lds, XN, Wgu + (size_t)2 * NGU * DM, TT, NGU, DM, EpiSwiglu{BIG, DFF, SSQ + 3 * TT}); } }
    SYNC(9);
    if (IN(10)) run_gemm(lds, BIG, Wd + (size_t)2 * DM * DFF, TT, DM, DFF, EpiResid<false, false, 1>{nullptr, nullptr, XN, SSQ + 4 * TT}, WGM_DOWN);
    if (IN(10) && ((DUPMASK >> 10) & 1u)) run_gemm(lds, BIG, Wd + (size_t)2 * DM * DFF, TT, DM, DFF, EpiResid<false, false, 2>{nullptr, nullptr, XN, nullptr});
    SYNC(10);
    if (IN(11)) { run_gemm(lds, XN, Wqkv, TT, QW, DM, EpiQkv{BIG, acos_, asin_, SSQ + 4 * TT}); if ((DUPMASK >> 11) & 1u) { run_gemm(lds, XN, Wqkv, TT, QW, DM, EpiQkv{BIG, acos_, asin_, SSQ + 4 * TT}); } }
    SYNC(11);
#ifndef NO_A1
    if (IN(12)) REP(12) { const float lam = ((const float*)(ws + WS_CTL))[0]; attn_phase<1>(lds, BIG, QW, 2048, 4096, 8, YC, nullptr, P.in[24], lam, vcu, G); }
#endif
    SYNC(12);
    if (IN(13)) run_gemm(lds, YC, Wco, TT, DM, DM, EpiResid<false, false, 0>{nullptr, nullptr, XN, SSQ + 5 * TT});
    if (IN(13) && ((DUPMASK >> 13) & 1u)) run_gemm(lds, YC, Wco, TT, DM, DM, EpiResid<false, false, 2>{nullptr, nullptr, XN, nullptr});
    SYNC(13);
    if (IN(14)) { run_gemm(lds, XN, Wgu + (size_t)3 * NGU * DM, TT, NGU, DM, EpiSwiglu{BIG, DFF, SSQ + 5 * TT}); if ((DUPMASK >> 14) & 1u) { run_gemm(lds, XN, Wgu + (size_t)3 * NGU * DM, TT, NGU, DM, EpiSwiglu{BIG, DFF, SSQ + 5 * TT}); } }
    SYNC(14);
    if (IN(15)) run_gemm(lds, BIG, Wd + (size_t)3 * DM * DFF, TT, DM, DFF, EpiResid<false, false, 1>{nullptr, nullptr, XN, SSQ + 6 * TT}, WGM_DOWN);
    if (IN(15) && ((DUPMASK >> 15) & 1u)) run_gemm(lds, BIG, Wd + (size_t)3 * DM * DFF, TT, DM, DFF, EpiResid<false, false, 2>{nullptr, nullptr, XN, nullptr});
    SYNC(15);
    if (IN(16)) final_phase(XN, SSQ + 6 * TT, P.in[25], out, gw, NGW, lane);
#undef IN
#undef SYNC
}

extern "C" void kernel_launch(void* const* d_in, const int* in_sizes, int n_in, void* d_out, int out_size, void* d_ws, size_t ws_size, hipStream_t stream) {
    static int grid = 0;
    if (grid == 0) {
        if (n_in != 26 || out_size != TT * DM || ws_size < WS_END) { fprintf(stderr, "kernel_launch: unexpected shapes (n_in %d, out %d, ws %zu < %zu)\n", n_in, out_size, ws_size, (size_t)WS_END); grid = -1; return; }
        int dev = 0, cus = 0, per_cu = 0;
        hipGetDevice(&dev); hipDeviceGetAttribute(&cus, hipDeviceAttributeMultiprocessorCount, dev);
        if (hipFuncSetAttribute((const void*)fwd_megakernel, hipFuncAttributeMaxDynamicSharedMemorySize, LDS_BYTES) != hipSuccess) { fprintf(stderr, "kernel_launch: hipFuncSetAttribute failed\n"); grid = -1; return; }
        if (hipOccupancyMaxActiveBlocksPerMultiprocessor(&per_cu, (const void*)fwd_megakernel, 512, LDS_BYTES) != hipSuccess || per_cu < 1) { fprintf(stderr, "kernel_launch: occupancy query says %d\n", per_cu); per_cu = 1; }
        (void)hipGetLastError();
        grid = cus * per_cu;
        fprintf(stderr, "kernel_launch: grid %d (cus %d x %d)\n", grid, cus, per_cu);
    }
    if (grid < 0) return;
    if (hipMemsetAsync((char*)d_ws + WS_BAR, 0, BAR_BYTES, stream) != hipSuccess) { fprintf(stderr, "kernel_launch: hipMemsetAsync failed\n"); return; }
    Params p{};
    for (int i = 0; i < 26; ++i) p.in[i] = (const float*)d_in[i];
    p.out = (float*)d_out; p.ws = (unsigned char*)d_ws;
#if MK_PER_PHASE
    for (int k = 0; k < NPHASE; ++k) { p.lo = k; p.hi = k + 1; hipLaunchKernelGGL(fwd_megakernel, dim3(grid), dim3(512), LDS_BYTES, stream, p); }
#else
    p.lo = 0; p.hi = NPHASE;
    void* args[] = {&p};
    hipError_t e = hipLaunchCooperativeKernel((const void*)fwd_megakernel, dim3(grid), dim3(512), args, LDS_BYTES, stream);
    if (e != hipSuccess) fprintf(stderr, "cooperative launch failed: %s (grid %d)\n", hipGetErrorString(e), grid);
#endif
}
```

```cpp
#include <hip/hip_runtime.h>
#include <hip/hip_cooperative_groups.h>
#include <cstdio>
#include <cstdint>
namespace cg = cooperative_groups;

#define LAS __attribute__((address_space(3)))
typedef unsigned short bf16_t;
typedef unsigned u64_t;
constexpr float SSQ_FIX = 1024.0f, SSQ_INV = 1.0f / 1024.0f;
typedef short bf16x8 __attribute__((ext_vector_type(8)));
typedef short s16x4 __attribute__((ext_vector_type(4)));
typedef float f32x4 __attribute__((ext_vector_type(4)));
typedef float f32x2 __attribute__((ext_vector_type(2)));
typedef float f32x16 __attribute__((ext_vector_type(16)));
typedef unsigned u32x4 __attribute__((ext_vector_type(4)));
typedef unsigned u32x2 __attribute__((ext_vector_type(2)));

#ifndef MK_PER_PHASE
#define MK_PER_PHASE 0
#endif

constexpr int TT = 32768, SEQ = 2048, DM = 2048, DFF = 5504, NGU = 2 * DFF;
constexpr int PW = 5120, QW = 6144;
constexpr float EPS = 1e-6f;
constexpr float LAMBDA_INIT = 0.35550906759f;
constexpr float QSCALE = 0.08838834764831845f * 1.4426950408889634f;

constexpr size_t MiB = 1u << 20;
constexpr size_t WS_CTL = 0, WS_BAR = 4096, BAR_BYTES = 16384;
constexpr size_t WS_RCOS = 1 * MiB, WS_RSIN = 2 * MiB, WS_ACOS = 3 * MiB, WS_ASIN = 3 * MiB + 128 * 1024, WS_S5A = 3 * MiB + 512 * 1024, WS_S5BB = 4 * MiB;
constexpr size_t WS_W = 8 * MiB;
constexpr size_t SZ_WGU = (size_t)NGU * DM * 2, SZ_WD = (size_t)DM * DFF * 2;
constexpr size_t WS_WGU = WS_W, WS_WD = WS_WGU + 4 * SZ_WGU, WS_WIN = WS_WD + 4 * SZ_WD, WS_WOUT = WS_WIN + (size_t)PW * DM * 2,
                 WS_WGLU = WS_WOUT + (size_t)DM * DM * 2, WS_WQKV = WS_WGLU + (size_t)1024 * 1024 * 2, WS_WCO = WS_WQKV + (size_t)QW * DM * 2,
                 WS_WEND = WS_WCO + (size_t)DM * DM * 2;
constexpr size_t WS_XN = 328 * MiB;
constexpr size_t WS_BIG = 456 * MiB;
constexpr size_t WS_Z = WS_BIG + (size_t)TT * PW * 2;
constexpr size_t WS_YC = WS_BIG + (size_t)TT * QW * 2;
constexpr size_t WS_END = WS_YC + (size_t)TT * DM * 2;
constexpr size_t WS_SSQ = 5 * MiB;
static_assert(WS_WEND <= WS_XN && WS_XN + (size_t)TT * DM * 2 <= WS_BIG && WS_Z + (size_t)TT * 1024 * 2 <= WS_END, "ws map");

constexpr int LDS_BYTES = 147456;

namespace pg8 {
constexpr int BM = 256, BK = 64, HALF = 128, HTB = HALF * BK * 2, STAGE_BYTES = 8 * HTB, NXCD = 8;
__host__ __device__ __forceinline__ int lds_byte(int r, int c) { const int st = (r >> 4) * 2 + (c >> 5), rr = r & 15, cc = c & 31, ob = rr * 64 + cc * 2; return st * 1024 + (ob ^ (((ob >> 9) & 1) << 5)); }
__host__ __device__ __forceinline__ void stage_rc(int b, int& R, int& C) { const int st = b / 1024, sb = b % 1024, swz = sb ^ (((sb >> 9) & 1) << 5); R = (st >> 1) * 16 + swz / 64; C = (st & 1) * 32 + (swz % 64) / 2; }
__host__ __device__ __forceinline__ int perm32(int rho) { const int n = rho >> 4, i = rho & 15; return 8 * (i >> 2) + 4 * n + (i & 3); }
struct Unit { int pm, pn; };
struct Gemm { const bf16_t* A; const bf16_t* Bt; int M, N, K; };
struct StaticOrder {
    int nM, nN, nwg, G, c, WGM;
    __host__ __device__ void init(int M, int N, int G_, int c_, int wgm_ = 8) { nM = M / BM; nN = N / BM; nwg = nM * nN; G = G_; c = c_; WGM = wgm_; }
    __host__ __device__ bool next(int i, Unit& u) const {
        const long L = (long)i * G + c; if (L >= nwg) return false;
        int wgid = (int)L; { const int q = nwg / NXCD, r = nwg % NXCD, xcd = wgid % NXCD, off = wgid / NXCD; wgid = (xcd < r ? xcd * (q + 1) : r * (q + 1) + (xcd - r) * q) + off; }
        const int nig = WGM * nN, gid = wgid / nig, fm = gid * WGM, gsz = (nM - fm) < WGM ? (nM - fm) : WGM;
        u.pm = fm + ((wgid % nig) % gsz); u.pn = (wgid % nig) / gsz; return true;
    }
    __device__ __forceinline__ void a_ready(const Unit&) const {}
    __device__ __forceinline__ void done(const Unit&) const {}
};
__device__ __forceinline__ unsigned cvt_pk_bf16(float lo, float hi) { unsigned r; asm volatile("v_cvt_pk_bf16_f32 %0, %1, %2" : "=v"(r) : "v"(lo), "v"(hi)); return r; }

template <class Epi, class Sched, bool ALIGN_EPI = false, bool SP2 = false>
__device__ __forceinline__ void gemm_phase(LAS unsigned char* lds, const Gemm g, const Sched S, const Epi E) {
    const int tid = threadIdx.x, wid = __builtin_amdgcn_readfirstlane(tid >> 6), lane = tid & 63, wr = wid >> 2, wc = wid & 3, fr = lane & 15, fq = lane >> 4;
    const int K = g.K, nt = K / BK;
    unsigned voffA[2], voffB[2];
#pragma unroll
    for (int i = 0; i < 2; ++i) { int R, C; stage_rc(tid * 16 + i * 8192, R, C); const int Rb = Epi::PERM ? ((R & ~31) + perm32(R & 31)) : R;
        voffA[i] = (unsigned)(R * K + C) * 2u; voffB[i] = (unsigned)(Rb * K + C) * 2u; }
    const size_t kstep = (size_t)(BK * 2);
    const size_t hstep = (size_t)HALF * K * 2;
    const size_t tstep = 2 * hstep;
    const unsigned ldsw = (unsigned)wid * 1024u;
    const int aoff = lds_byte(wr * 64 + fr, fq * 8), boff = lds_byte(wc * 32 + fr, fq * 8);
#define PG8_SA(b, h) (((b) * 2 + (h)) * HTB)
#define PG8_SB(b, h) ((4 + (b) * 2 + (h)) * HTB)
#define PG8_STAGE(bufoff, gbase, voff) do { _Pragma("unroll") for (int _i = 0; _i < 2; ++_i) \
        __builtin_amdgcn_global_load_lds((const unsigned*)((const char*)(gbase) + (voff)[_i]), (LAS unsigned*)(lds + (bufoff) + ldsw + _i * 8192), 16, 0, 0); } while (0)
#define PG8_LDA(dst, b, h) do { _Pragma("unroll") for (int m = 0; m < 4; ++m) _Pragma("unroll") for (int k = 0; k < 2; ++k) dst[m][k] = *(const LAS bf16x8*)(lds + PG8_SA(b, h) + aoff + m * 2048 + k * 1024); } while (0)
#define PG8_LDB(dst, b, h) do { _Pragma("unroll") for (int n = 0; n < 2; ++n) _Pragma("unroll") for (int k = 0; k < 2; ++k) dst[n][k] = *(const LAS bf16x8*)(lds + PG8_SB(b, h) + boff + n * 2048 + k * 1024); } while (0)
#define PG8_MMA(ai, bj, At, Bt) do { __builtin_amdgcn_s_setprio(1); _Pragma("unroll") for (int m = 0; m < 4; ++m) _Pragma("unroll") for (int n = 0; n < 2; ++n) _Pragma("unroll") for (int k = 0; k < 2; ++k) \
        acc[ai][bj][m][n] = __builtin_amdgcn_mfma_f32_16x16x32_bf16(Bt[n][k], At[m][k], acc[ai][bj][m][n], 0, 0, 0); __builtin_amdgcn_s_setprio(0); } while (0)
#define PG8_WAIT_V(n) asm volatile("s_waitcnt vmcnt(" #n ")" ::: "memory")
#define PG8_WAIT_L(n) asm volatile("s_waitcnt lgkmcnt(" #n ")" ::: "memory")
#define PG8_BAR __builtin_amdgcn_s_barrier()
#define PG8_SCHED __builtin_amdgcn_sched_barrier(0)
    Unit cur, nxt; int ui = 0;
    if (!S.next(0, cur)) return;
    f32x4 acc[2][2][4][2];
#pragma unroll
    for (int a = 0; a < 2; ++a)
#pragma unroll
        for (int b = 0; b < 2; ++b)
#pragma unroll
            for (int m = 0; m < 4; ++m)
#pragma unroll
                for (int n = 0; n < 2; ++n) acc[a][b][m][n] = (f32x4){0.f, 0.f, 0.f, 0.f};
    bf16x8 At[4][2], B0[2][2], B1[2][2];
    typename Epi::Pre pre;
    const char* cA = (const char*)g.A + (size_t)cur.pm * tstep; const char* cB = (const char*)g.Bt + (size_t)cur.pn * tstep;
    S.a_ready(cur);
    if constexpr (SP2) {
        PG8_STAGE(PG8_SB(0, 0), cB, voffB); PG8_STAGE(PG8_SB(0, 1), cB + hstep, voffB); PG8_STAGE(PG8_SA(0, 0), cA, voffA); PG8_STAGE(PG8_SA(0, 1), cA + hstep, voffA);
        if (wr == 1) PG8_BAR;
        PG8_WAIT_V(2); PG8_BAR;
        PG8_STAGE(PG8_SB(1, 0), cB + kstep, voffB); PG8_STAGE(PG8_SA(1, 0), cA + kstep, voffA); PG8_STAGE(PG8_SB(1, 1), cB + hstep + kstep, voffB);
        PG8_WAIT_V(6); PG8_BAR;
    } else {
        PG8_STAGE(PG8_SB(0, 0), cB, voffB); PG8_STAGE(PG8_SA(0, 0), cA, voffA); PG8_STAGE(PG8_SB(0, 1), cB + hstep, voffB); PG8_STAGE(PG8_SA(0, 1), cA + hstep, voffA);
        if (wr == 1) PG8_BAR;
        PG8_WAIT_V(4); PG8_BAR;
        PG8_STAGE(PG8_SB(1, 0), cB + kstep, voffB); PG8_STAGE(PG8_SA(1, 0), cA + kstep, voffA); PG8_STAGE(PG8_SB(1, 1), cB + hstep + kstep, voffB);
        PG8_WAIT_V(6); PG8_BAR;
    }
    for (;;) {
        const bool has_next = S.next(ui + 1, nxt);
        const char* nA = has_next ? (const char*)g.A + (size_t)nxt.pm * tstep : cA; const char* nB = has_next ? (const char*)g.Bt + (size_t)nxt.pn * tstep : cB;
        for (int t = 0; t < nt; t += 2) {
            const bool last = (t == nt - 2);
            const char* a1 = cA + (size_t)(t + 1) * kstep;
            const char* a2 = last ? nA : cA + (size_t)(t + 2) * kstep; const char* b2 = last ? nB : cB + (size_t)(t + 2) * kstep;
            const char* a3 = a2 + kstep; const char* b3 = b2 + kstep;
            if (last && has_next) S.a_ready(nxt);
            if (last) E.prefetch(cur, wr, fr, pre);
            if constexpr (SP2) {
            PG8_LDB(B0, 0, 0); PG8_LDB(B1, 0, 1); PG8_SCHED; PG8_LDA(At, 0, 0); PG8_STAGE(PG8_SA(1, 1), a1 + hstep, voffA);
            PG8_WAIT_V(8); PG8_WAIT_L(0); PG8_BAR; PG8_MMA(0, 0, At, B0); PG8_MMA(0, 1, At, B1); PG8_BAR; PG8_SCHED;
            PG8_LDA(At, 0, 1); PG8_STAGE(PG8_SB(0, 0), b2, voffB); PG8_STAGE(PG8_SB(0, 1), b2 + hstep, voffB); PG8_STAGE(PG8_SA(0, 0), a2, voffA);
            PG8_WAIT_V(8); PG8_WAIT_L(0); PG8_BAR; PG8_MMA(1, 0, At, B0); PG8_MMA(1, 1, At, B1); PG8_BAR; PG8_SCHED;
            PG8_LDB(B0, 1, 0); PG8_LDB(B1, 1, 1); PG8_SCHED; PG8_LDA(At, 1, 0); PG8_STAGE(PG8_SA(0, 1), a2 + hstep, voffA);
            PG8_WAIT_V(8); PG8_WAIT_L(0); PG8_BAR; PG8_MMA(0, 0, At, B0); PG8_MMA(0, 1, At, B1); PG8_BAR; PG8_SCHED;
            PG8_LDA(At, 1, 1); PG8_STAGE(PG8_SB(1, 0), b3, voffB); PG8_STAGE(PG8_SB(1, 1), b3 + hstep, voffB); PG8_STAGE(PG8_SA(1, 0), a3, voffA);
            PG8_WAIT_V(8); PG8_WAIT_L(0); PG8_BAR; PG8_MMA(1, 0, At, B0); PG8_MMA(1, 1, At, B1); PG8_BAR; PG8_SCHED;
            } else {
            PG8_LDB(B0, 0, 0); PG8_SCHED; PG8_LDA(At, 0, 0); PG8_STAGE(PG8_SA(1, 1), a1 + hstep, voffA);
            PG8_WAIT_L(8); PG8_BAR; PG8_WAIT_L(0); PG8_MMA(0, 0, At, B0); PG8_BAR; PG8_SCHED;
            PG8_LDB(B1, 0, 1); PG8_STAGE(PG8_SB(0, 0), b2, voffB);
            PG8_BAR; PG8_WAIT_L(0); PG8_MMA(0, 1, At, B1); PG8_BAR;
            PG8_LDA(At, 0, 1); PG8_STAGE(PG8_SA(0, 0), a2, voffA);
            PG8_BAR; PG8_WAIT_L(0); PG8_MMA(1, 0, At, B0); PG8_BAR; PG8_SCHED;
            PG8_STAGE(PG8_SB(0, 1), b2 + hstep, voffB);
            PG8_WAIT_V(6); PG8_BAR; PG8_MMA(1, 1, At, B1); PG8_BAR;
            PG8_LDB(B0, 1, 0); PG8_SCHED; PG8_LDA(At, 1, 0); PG8_STAGE(PG8_SA(0, 1), a2 + hstep, voffA);
            PG8_WAIT_L(8); PG8_BAR; PG8_WAIT_L(0); PG8_MMA(0, 0, At, B0); PG8_BAR; PG8_SCHED;
            PG8_LDB(B1, 1, 1); PG8_STAGE(PG8_SB(1, 0), b3, voffB);
            PG8_BAR; PG8_WAIT_L(0); PG8_MMA(0, 1, At, B1); PG8_BAR;
            PG8_LDA(At, 1, 1); PG8_STAGE(PG8_SA(1, 0), a3, voffA);
            PG8_BAR; PG8_WAIT_L(0); PG8_MMA(1, 0, At, B0); PG8_BAR; PG8_SCHED;
            PG8_STAGE(PG8_SB(1, 1), b3 + hstep, voffB);
            PG8_WAIT_V(6); PG8_BAR; PG8_MMA(1, 1, At, B1); PG8_BAR;
            }
        }
        if constexpr (ALIGN_EPI) { if (wr == 0) PG8_BAR; }
        if constexpr (!Epi::AFTER_DRAIN) { E(acc, cur, wr, wc, fr, fq, pre); S.done(cur); }
        if (!has_next) break;
#pragma unroll
        for (int a = 0; a < 2; ++a)
#pragma unroll
            for (int b = 0; b < 2; ++b)
#pragma unroll
                for (int m = 0; m < 4; ++m)
#pragma unroll
                    for (int n = 0; n < 2; ++n) acc[a][b][m][n] = (f32x4){0.f, 0.f, 0.f, 0.f};
        cur = nxt; cA = nA; cB = nB; ++ui;
        if constexpr (ALIGN_EPI) { if (wr == 1) PG8_BAR; }
    }
    PG8_WAIT_V(0);
    if constexpr (!ALIGN_EPI) { if (wr == 0) PG8_BAR; }
    PG8_BAR;
#undef PG8_SA
#undef PG8_SB
#undef PG8_STAGE
#undef PG8_LDA
#undef PG8_LDB
#undef PG8_MMA
#undef PG8_WAIT_V
#undef PG8_WAIT_L
#undef PG8_BAR
#undef PG8_SCHED
}
}

__device__ __forceinline__ unsigned f2bf(float f) { unsigned u = __builtin_bit_cast(unsigned, f); return (u + 0x7fffu + ((u >> 16) & 1u)) >> 16; }
__device__ __forceinline__ unsigned pk2(float lo, float hi) { return f2bf(lo) | (f2bf(hi) << 16); }
__device__ __forceinline__ float bf2f(unsigned short b) { return __builtin_bit_cast(float, (unsigned)b << 16); }
__device__ __forceinline__ float bflo(unsigned w) { return __builtin_bit_cast(float, w << 16); }
__device__ __forceinline__ float bfhi(unsigned w) { return __builtin_bit_cast(float, w & 0xffff0000u); }
__device__ __forceinline__ float fast_sigmoid(float x) { return __builtin_amdgcn_rcpf(1.0f + __builtin_amdgcn_exp2f(-1.4426950408889634f * x)); }
__device__ __forceinline__ float silu_f(float x) { return x * fast_sigmoid(x); }
__device__ __forceinline__ float gelu_tanh_f(float y) { return y * fast_sigmoid(1.5957691216057308f * (y + 0.044715f * y * y * y)); }
__device__ __forceinline__ float wave_sum(float v) {
#pragma unroll
    for (int o = 1; o < 64; o <<= 1) v += __shfl_xor(v, o);
    return v;
}
__device__ __forceinline__ void sincos_d(double a, double& s, double& c) {
    const double k = rint(a * 0.15915494309189535);
    const double r = fma(-k, 6.283185307179586, a), r2 = r * r;
    double ts = r, tc = 1.0; s = r; c = 1.0;
    for (int n = 1; n <= 13; ++n) { tc *= -r2 / (double)((2 * n - 1) * (2 * n)); c += tc; ts *= -r2 / (double)((2 * n) * (2 * n + 1)); s += ts; }
}

using pg8::Unit; using pg8::cvt_pk_bf16;
struct PreSsq { unsigned v[2][4]; };
struct PreNone { };
struct EpiSwiglu {
    static constexpr bool PERM = true, AFTER_DRAIN = false;
    bf16_t* O; int ldo; const u64_t* ssq;
    typedef PreSsq Pre;
    __device__ __forceinline__ void prefetch(const Unit& u, int wr, int fr, Pre& pre) const {
        const int row0 = u.pm * 256 + wr * 64 + fr;
#pragma unroll
        for (int ai = 0; ai < 2; ++ai)
#pragma unroll
            for (int m = 0; m < 4; ++m) pre.v[ai][m] = ssq[row0 + ai * 128 + m * 16];
    }
    __device__ __forceinline__ void operator()(const f32x4 (&acc)[2][2][4][2], const Unit& u, int wr, int wc, int fr, int fq, const Pre& pre) const {
        const int row0 = u.pm * 256 + wr * 64 + fr, col0 = u.pn * 128 + wc * 32 + 8 * fq;
        float rsv[2][4];
#pragma unroll
        for (int ai = 0; ai < 2; ++ai)
#pragma unroll
            for (int m = 0; m < 4; ++m) rsv[ai][m] = (float)pre.v[ai][m] * SSQ_INV;
#pragma unroll
        for (int ai = 0; ai < 2; ++ai)
#pragma unroll
            for (int m = 0; m < 4; ++m) {
                const int row = row0 + ai * 128 + m * 16;
                const float rs = __builtin_amdgcn_rsqf(rsv[ai][m] * (1.0f / DM) + EPS);
                bf16_t* rowp = O + (size_t)row * ldo + col0;
                const f32x4 g0 = acc[ai][0][m][0] * rs, g1 = acc[ai][0][m][1] * rs, u0 = acc[ai][1][m][0] * rs, u1 = acc[ai][1][m][1] * rs;
                u32x4 w;
                w.x = cvt_pk_bf16(silu_f(g0[0]) * u0[0], silu_f(g0[1]) * u0[1]); w.y = cvt_pk_bf16(silu_f(g0[2]) * u0[2], silu_f(g0[3]) * u0[3]);
                w.z = cvt_pk_bf16(silu_f(g1[0]) * u1[0], silu_f(g1[1]) * u1[1]); w.w = cvt_pk_bf16(silu_f(g1[2]) * u1[2], silu_f(g1[3]) * u1[3]);
                *(u32x4*)rowp = w;
            }
    }
};
template <bool BASE_F32, bool OUT_F32, int SCALE> struct EpiResid {
    static constexpr bool PERM = false, AFTER_DRAIN = false;
    const float* basef; float* outf; bf16_t* xb; u64_t* ssq;
    typedef PreNone Pre;
    __device__ __forceinline__ void prefetch(const Unit&, int, int, Pre&) const {}
    __device__ __forceinline__ void operator()(const f32x4 (&acc)[2][2][4][2], const Unit& u, int wr, int wc, int fr, int fq, const Pre&) const {
        const int col0 = u.pn * 256 + wc * 32 + 4 * fq;
        constexpr float sc = (SCALE == 2 ? 0.0f : SCALE == 1 ? 0.5f : 1.0f);
#pragma unroll
        for (int ai = 0; ai < 2; ++ai) {
            f32x4 pre[4][2][2];
#pragma unroll
            for (int m = 0; m < 4; ++m) { const size_t off = (size_t)(u.pm * 256 + ai * 128 + wr * 64 + m * 16 + fr) * DM + col0;
#pragma unroll
                for (int bj = 0; bj < 2; ++bj)
#pragma unroll
                    for (int n = 0; n < 2; ++n) {
                        if constexpr (BASE_F32) pre[m][bj][n] = *(const f32x4*)(basef + off + bj * 128 + n * 16);
                        else { const u32x2 w = *(const u32x2*)(xb + off + bj * 128 + n * 16); pre[m][bj][n] = (f32x4){bflo(w.x), bfhi(w.x), bflo(w.y), bfhi(w.y)}; } } }
#pragma unroll
            for (int m = 0; m < 4; ++m) {
                const int row = u.pm * 256 + ai * 128 + wr * 64 + m * 16 + fr;
                const size_t off = (size_t)row * DM + col0;
                float sq = 0.f;
#pragma unroll
                for (int bj = 0; bj < 2; ++bj)
#pragma unroll
                    for (int n = 0; n < 2; ++n) { const f32x4 v = pre[m][bj][n] + acc[ai][bj][m][n] * sc;
                        if constexpr (OUT_F32) *(f32x4*)(outf + off + bj * 128 + n * 16) = v;
                        else { u32x2 w; w.x = cvt_pk_bf16(v[0], v[1]); w.y = cvt_pk_bf16(v[2], v[3]); *(u32x2*)(xb + off + bj * 128 + n * 16) = w;
                               sq += (v[0] * v[0] + v[1] * v[1]) + (v[2] * v[2] + v[3] * v[3]); } }
                if constexpr (!OUT_F32 && SCALE != 2) { sq += __shfl_xor(sq, 16); sq += __shfl_xor(sq, 32); if (fq == 0) atomicAdd(ssq + row, (u64_t)(sq * SSQ_FIX)); }
            }
        }
    }
};
struct EpiWin {
    static constexpr bool PERM = true, AFTER_DRAIN = false;
    bf16_t* O; const float* cs; const float* sn; const u64_t* ssq;
    typedef PreSsq Pre;
    __device__ __forceinline__ void prefetch(const Unit& u, int wr, int fr, Pre& pre) const {
        const int row0 = u.pm * 256 + wr * 64 + fr;
#pragma unroll
        for (int ai = 0; ai < 2; ++ai)
#pragma unroll
            for (int m = 0; m < 4; ++m) pre.v[ai][m] = ssq[row0 + ai * 128 + m * 16];
    }
    __device__ __forceinline__ void operator()(const f32x4 (&acc)[2][2][4][2], const Unit& u, int wr, int wc, int fr, int fq, const Pre& pre) const {
        const int row0 = u.pm * 256 + wr * 64 + fr, col0 = u.pn * 256 + wc * 32 + 8 * fq;
        const bool rot = u.pn < 8;
        float rsv[2][4];
#pragma unroll
        for (int ai = 0; ai < 2; ++ai)
#pragma unroll
            for (int m = 0; m < 4; ++m) rsv[ai][m] = (float)pre.v[ai][m] * SSQ_INV;
#pragma unroll
        for (int ai = 0; ai < 2; ++ai) {
            f32x4 cc[4][2], sv[4][2];
#pragma unroll
            for (int m = 0; m < 4; ++m) {
                if (rot) { const int pos = (row0 + ai * 128 + m * 16) & (SEQ - 1);
                    const float* cp = cs + pos * 128 + wc * 32 + 8 * fq; const float* sp = sn + pos * 128 + wc * 32 + 8 * fq;
                    cc[m][0] = *(const f32x4*)cp; cc[m][1] = *(const f32x4*)(cp + 4); sv[m][0] = *(const f32x4*)sp; sv[m][1] = *(const f32x4*)(sp + 4); }
                else { cc[m][0] = cc[m][1] = (f32x4){1.f, 1.f, 1.f, 1.f}; sv[m][0] = sv[m][1] = (f32x4){0.f, 0.f, 0.f, 0.f}; }
            }
#pragma unroll
            for (int m = 0; m < 4; ++m) {
                const int row = row0 + ai * 128 + m * 16;
                const float rs = __builtin_amdgcn_rsqf(rsv[ai][m] * (1.0f / DM) + EPS);
                const f32x4 a0 = acc[ai][0][m][0] * rs, a1 = acc[ai][0][m][1] * rs, b0 = acc[ai][1][m][0] * rs, b1 = acc[ai][1][m][1] * rs;
                const f32x4 na0 = a0 * cc[m][0] - b0 * sv[m][0], nb0 = b0 * cc[m][0] + a0 * sv[m][0], na1 = a1 * cc[m][1] - b1 * sv[m][1], nb1 = b1 * cc[m][1] + a1 * sv[m][1];
                bf16_t* rowp = O + (size_t)row * PW + col0;
                u32x4 w; w.x = cvt_pk_bf16(na0[0], na0[1]); w.y = cvt_pk_bf16(na0[2], na0[3]); w.z = cvt_pk_bf16(na1[0], na1[1]); w.w = cvt_pk_bf16(na1[2], na1[3]);
                *(u32x4*)rowp = w;
                u32x4 v; v.x = cvt_pk_bf16(nb0[0], nb0[1]); v.y = cvt_pk_bf16(nb0[2], nb0[3]); v.z = cvt_pk_bf16(nb1[0], nb1[1]); v.w = cvt_pk_bf16(nb1[2], nb1[3]);
                *(u32x4*)(rowp + 128) = v;
            }
        }
    }
};
struct EpiQkv {
    static constexpr bool PERM = false, AFTER_DRAIN = false;
    bf16_t* O; const float* cs; const float* sn; const u64_t* ssq;
    typedef PreSsq Pre;
    __device__ __forceinline__ void prefetch(const Unit& u, int wr, int fr, Pre& pre) const {
#pragma unroll
        for (int ai = 0; ai < 2; ++ai)
#pragma unroll
            for (int m = 0; m < 4; ++m) pre.v[ai][m] = ssq[u.pm * 256 + ai * 128 + wr * 64 + m * 16 + fr];
    }
    __device__ __forceinline__ void operator()(const f32x4 (&acc)[2][2][4][2], const Unit& u, int wr, int wc, int fr, int fq, const Pre& pre) const {
        const int col0 = u.pn * 256 + wc * 32 + 4 * fq;
        const bool rot = (u.pn < 16) && (wc == 0);
        const float sc0 = (u.pn < 8) ? QSCALE : 1.0f;
        float rsv[2][4]; f32x4 cv[2][4], sv[2][4];
#pragma unroll
        for (int ai = 0; ai < 2; ++ai)
#pragma unroll
            for (int m = 0; m < 4; ++m) { const int row = u.pm * 256 + ai * 128 + wr * 64 + m * 16 + fr; rsv[ai][m] = (float)pre.v[ai][m] * SSQ_INV;
                if (rot) { const int pos = row & (SEQ - 1); cv[ai][m] = *(const f32x4*)(cs + pos * 16 + 4 * fq); sv[ai][m] = *(const f32x4*)(sn + pos * 16 + 4 * fq); }
                else { cv[ai][m] = (f32x4){1.f, 1.f, 1.f, 1.f}; sv[ai][m] = (f32x4){0.f, 0.f, 0.f, 0.f}; } }
#pragma unroll
        for (int ai = 0; ai < 2; ++ai)
#pragma unroll
            for (int m = 0; m < 4; ++m) {
                const int row = u.pm * 256 + ai * 128 + wr * 64 + m * 16 + fr;
                const float sc = sc0 * __builtin_amdgcn_rsqf(rsv[ai][m] * (1.0f / DM) + EPS);
                const f32x4 c = cv[ai][m], s = sv[ai][m];
#pragma unroll
                for (int bj = 0; bj < 2; ++bj) {
                    const f32x4 x0 = acc[ai][bj][m][0], x1 = acc[ai][bj][m][1];
                    const f32x4 n0 = (x0 * c - x1 * s) * sc, n1 = (x1 * c + x0 * s) * sc;
                    bf16_t* p = O + (size_t)row * QW + col0 + bj * 128;
                    u32x2 w0; w0.x = cvt_pk_bf16(n0[0], n0[1]); w0.y = cvt_pk_bf16(n0[2], n0[3]); *(u32x2*)p = w0;
                    u32x2 w1; w1.x = cvt_pk_bf16(n1[0], n1[1]); w1.y = cvt_pk_bf16(n1[2], n1[3]); *(u32x2*)(p + 16) = w1;
                }
            }
    }
};
struct EpiGlu {
    static constexpr bool PERM = true, AFTER_DRAIN = false;
    const bf16_t* Z; const float* bias; bf16_t* Y;
    typedef PreNone Pre;
    __device__ __forceinline__ void prefetch(const Unit&, int, int, Pre&) const {}
    __device__ __forceinline__ void operator()(const f32x4 (&acc)[2][2][4][2], const Unit& u, int wr, int wc, int fr, int fq, const Pre&) const {
        const int row0 = u.pm * 256 + wr * 64 + fr, col0 = u.pn * 256 + wc * 32 + 8 * fq;
#pragma unroll
        for (int bj = 0; bj < 2; ++bj) {
            const f32x4 bv0 = *(const f32x4*)(bias + col0 + bj * 128), bv1 = *(const f32x4*)(bias + col0 + bj * 128 + 4);
            u32x4 zz[2][4];
#pragma unroll
            for (int ai = 0; ai < 2; ++ai)
#pragma unroll
                for (int m = 0; m < 4; ++m) zz[ai][m] = *(const u32x4*)(Z + (size_t)(row0 + ai * 128 + m * 16) * 1024 + col0 + bj * 128);
#pragma unroll
            for (int ai = 0; ai < 2; ++ai)
#pragma unroll
                for (int m = 0; m < 4; ++m) {
                    const int row = row0 + ai * 128 + m * 16;
                    const u32x4 z4 = zz[ai][m];
                    const f32x4 v0 = acc[ai][bj][m][0] + bv0, v1 = acc[ai][bj][m][1] + bv1;
                    u32x4 w;
                    w.x = cvt_pk_bf16(bflo(z4.x) * fast_sigmoid(v0[0]), bfhi(z4.x) * fast_sigmoid(v0[1]));
                    w.y = cvt_pk_bf16(bflo(z4.y) * fast_sigmoid(v0[2]), bfhi(z4.y) * fast_sigmoid(v0[3]));
                    w.z = cvt_pk_bf16(bflo(z4.z) * fast_sigmoid(v1[0]), bfhi(z4.z) * fast_sigmoid(v1[1]));
                    w.w = cvt_pk_bf16(bflo(z4.w) * fast_sigmoid(v1[2]), bfhi(z4.w) * fast_sigmoid(v1[3]));
                    *(u32x4*)(Y + (size_t)row * DM + 1024 + col0 + bj * 128) = w;
                }
        }
    }
};

template <class Epi>
__device__ __forceinline__ void run_gemm(LAS unsigned char* lds, const bf16_t* A, const bf16_t* Bt, int M, int N, int K, const Epi E, int wgm = 8) {
    pg8::Gemm g{A, Bt, M, N, K}; pg8::StaticOrder S; S.init(M, N, (int)gridDim.x, (int)blockIdx.x, wgm);
    pg8::gemm_phase<Epi, pg8::StaticOrder, true, true>(lds, g, S, E);
}

__device__ __forceinline__ void conv_matrix(const float* __restrict__ W, bf16_t* __restrict__ WT, int K, int N, int mode, const float* __restrict__ gain, LAS float* scr, int gw, int NGW, int lane) {
    const int nblk = N / 64, nitems = (K / 64) * nblk;
    for (int item = gw; item < nitems; item += NGW) {
        const int kb = item / nblk, nb = item % nblk, k0 = 64 * kb, n0 = 64 * nb;
        const float gv = gain ? gain[k0 + lane] : 1.0f;
        const float* wp = W + (size_t)k0 * N + n0 + lane;
#pragma unroll
        for (int hb = 0; hb < 2; ++hb) {
            float v[32];
#pragma unroll
            for (int i = 0; i < 32; ++i) v[i] = wp[(size_t)(32 * hb + i) * N];
            asm volatile("" ::: "memory");
#pragma unroll
            for (int i = 0; i < 32; ++i) scr[(32 * hb + i) * 65 + lane] = v[i] * __builtin_bit_cast(float, __builtin_amdgcn_readlane(__builtin_bit_cast(int, gv), 32 * hb + i));
        }
        asm volatile("s_waitcnt lgkmcnt(0)" ::: "memory");
        const int c = lane & 7, ns = lane >> 3;
        const int rbase = (mode == 0) ? n0 : ((n0 >> 7) * 256 + (n0 & 127) + (mode == 2 ? 128 : 0));
#pragma unroll
        for (int j = 0; j < 8; ++j) { const int n = ns + 8 * j; const LAS float* sp = scr + (8 * c) * 65 + n;
            u32x4 o; o.x = pk2(sp[0 * 65], sp[1 * 65]); o.y = pk2(sp[2 * 65], sp[3 * 65]); o.z = pk2(sp[4 * 65], sp[5 * 65]); o.w = pk2(sp[6 * 65], sp[7 * 65]);
            *(u32x4*)(WT + (size_t)(rbase + n) * K + k0 + 8 * c) = o; }
        asm volatile("s_waitcnt lgkmcnt(0)" ::: "memory");
    }
}

template <bool TO_BF16>
__device__ __forceinline__ void rmsnorm_phase(const float* in, const float* __restrict__ g, bf16_t* outb, float* outf, int gw, int NGW, int lane) {
    f32x4 gv[8];
#pragma unroll
    for (int j = 0; j < 8; ++j) gv[j] = ((const f32x4*)g)[lane + 64 * j];
    for (int row = gw; row < TT; row += NGW) {
        const f32x4* xr = (const f32x4*)(in + (size_t)row * DM) + lane;
        f32x4 v[8]; float ss = 0.f;
#pragma unroll
        for (int j = 0; j < 8; ++j) { v[j] = xr[64 * j]; ss += (v[j][0] * v[j][0] + v[j][1] * v[j][1]) + (v[j][2] * v[j][2] + v[j][3] * v[j][3]); }
        const float rs = 1.0f / sqrtf(wave_sum(ss) * (1.0f / DM) + EPS);
#pragma unroll
        for (int j = 0; j < 8; ++j) {
            const f32x4 y = v[j] * rs * gv[j];
            if constexpr (TO_BF16) { u32x2 w; w.x = pk2(y[0], y[1]); w.y = pk2(y[2], y[3]); *((u32x2*)(outb + (size_t)row * DM) + lane + 64 * j) = w; }
            else { *((f32x4*)(outf + (size_t)row * DM) + lane + 64 * j) = y; }
        }
    }
}

__device__ __forceinline__ void cast_phase(const float* in, bf16_t* outb, u64_t* ssq, int gw, int NGW, int lane) {
    if (gw >= TT) return;
    f32x4 v[8];
    { const f32x4* xr = (const f32x4*)(in + (size_t)gw * DM) + lane;
#pragma unroll
      for (int j = 0; j < 8; ++j) v[j] = xr[64 * j]; }
    for (int row = gw; row < TT; row += NGW) {
        const int rn = (row + NGW < TT) ? row + NGW : row;
        const f32x4* xn = (const f32x4*)(in + (size_t)rn * DM) + lane;
        f32x4 w[8];
#pragma unroll
        for (int j = 0; j < 8; ++j) w[j] = xn[64 * j];
        float ss = 0.f;
#pragma unroll
        for (int j = 0; j < 8; ++j) ss += (v[j][0] * v[j][0] + v[j][1] * v[j][1]) + (v[j][2] * v[j][2] + v[j][3] * v[j][3]);
        ss = wave_sum(ss);
        if (lane == 0) ssq[row] = (u64_t)(ss * SSQ_FIX);
#pragma unroll
        for (int j = 0; j < 8; ++j) { u32x2 o; o.x = pk2(v[j][0], v[j][1]); o.y = pk2(v[j][2], v[j][3]); *((u32x2*)(outb + (size_t)row * DM) + lane + 64 * j) = o; }
#pragma unroll
        for (int j = 0; j < 8; ++j) v[j] = w[j];
    }
}

__device__ __forceinline__ void final_phase(const bf16_t* xb, const u64_t* ssq, const float* __restrict__ g, float* outf, int gw, int NGW, int lane) {
    if (gw >= TT) return;
    f32x4 gv[4][2];
#pragma unroll
    for (int j = 0; j < 4; ++j) { gv[j][0] = *(const f32x4*)(g + 8 * (lane + 64 * j)); gv[j][1] = *(const f32x4*)(g + 8 * (lane + 64 * j) + 4); }
    u32x4 v[4]; unsigned sv;
    { const u32x4* xr = (const u32x4*)(xb + (size_t)gw * DM) + lane;
#pragma unroll
      for (int j = 0; j < 4; ++j) v[j] = xr[64 * j];
      sv = ssq[gw]; }
    for (int row = gw; row < TT; row += NGW) {
        const int rn = (row + NGW < TT) ? row + NGW : row;
        const u32x4* xn = (const u32x4*)(xb + (size_t)rn * DM) + lane;
        u32x4 w[4];
#pragma unroll
        for (int j = 0; j < 4; ++j) w[j] = xn[64 * j];
        const unsigned sn = ssq[rn];
        const float rs = __builtin_amdgcn_rsqf((float)sv * SSQ_INV * (1.0f / DM) + EPS);
#pragma unroll
        for (int j = 0; j < 4; ++j) {
            float* op = outf + (size_t)row * DM + 8 * (lane + 64 * j);
            *(f32x4*)op = (f32x4){bflo(v[j].x), bfhi(v[j].x), bflo(v[j].y), bfhi(v[j].y)} * rs * gv[j][0];
            *(f32x4*)(op + 4) = (f32x4){bflo(v[j].z), bfhi(v[j].z), bflo(v[j].w), bfhi(v[j].w)} * rs * gv[j][1];
        }
#pragma unroll
        for (int j = 0; j < 4; ++j) v[j] = w[j];
        sv = sn;
    }
}

__device__ __forceinline__ void tables_phase(unsigned char* ws, const float* const* in_unused, const float* lam_re, const float* lam_im, const float* log_step, const float* b_re, const float* b_im,
                                             const float* lq1, const float* lk1, const float* lq2, const float* lk2, int gtid, int NT_) {
    float* rcos = (float*)(ws + WS_RCOS); float* rsin = (float*)(ws + WS_RSIN); float* acos_ = (float*)(ws + WS_ACOS); float* asin_ = (float*)(ws + WS_ASIN);
    float* s5a = (float*)(ws + WS_S5A); float* s5bb = (float*)(ws + WS_S5BB);
    for (int i = gtid; i < SEQ * 128; i += NT_) {
        const int pos = i >> 7, f = i & 127;
        const float inv = (float)exp2(-((double)(2 * f) / 256.0) * 13.287712379549449);
        const float ang = (float)pos * inv; double s, c; sincos_d((double)ang, s, c); rcos[i] = (float)c; rsin[i] = (float)s;
    }
    for (int i = gtid; i < SEQ * 16; i += NT_) {
        const int pos = i >> 4, f = i & 15;
        const float inv = (float)exp2(-((double)(2 * f) / 32.0) * 18.931568569324174);
        const float ang = (float)pos * inv; double s, c; sincos_d((double)ang, s, c); acos_[i] = (float)c; asin_[i] = (float)s;
    }
    for (int i = gtid; i < 64 * 64; i += NT_) {
        const int g = i >> 6;
        const double step = exp((double)log_step[g]), lr = (double)lam_re[i], li = (double)lam_im[i];
        const double mag = exp(lr * step); double s, c; sincos_d(li * step, s, c);
        const double are = mag * c, aim = mag * s, den = lr * lr + li * li, nr = are - 1.0;
        const double fre = (nr * lr + aim * li) / den, fim = (aim * lr - nr * li) / den;
        s5a[2 * i] = (float)are; s5a[2 * i + 1] = (float)aim;
        for (int p = 0; p < 16; ++p) { const double br = (double)b_re[i * 16 + p], bi = (double)b_im[i * 16 + p];
            s5bb[(size_t)i * 32 + p] = (float)(fre * br - fim * bi); s5bb[(size_t)i * 32 + 16 + p] = (float)(fre * bi + fim * br); }
    }
    if (gtid == 0) { float s1 = 0.f, s2 = 0.f; for (int i = 0; i < 128; ++i) { s1 += lq1[i] * lk1[i]; s2 += lq2[i] * lk2[i]; }
        ((float*)(ws + WS_CTL))[0] = expf(s1) - expf(s2) + LAMBDA_INIT; }
}

__device__ __forceinline__ void s5_phase(LAS unsigned char* lds, const unsigned char* ws, const bf16_t* proj, const float* c_re, const float* c_im, const float* dskip, bf16_t* z,
                                         int vcu, int G, int wave, int lane) {
    const float* s5a = (const float*)(ws + WS_S5A); const float* s5bb = (const float*)(ws + WS_S5BB);
    LAS bf16_t* Hc = (LAS bf16_t*)(lds + wave * 8704);
    LAS float* Uc = (LAS float*)(lds + 8 * 8704 + wave * 2048);
    const int fr = lane & 15, fq = lane >> 4;
    for (int seq = vcu * 8 + wave; seq < 1024; seq += G * 8) {
        const int b = seq >> 6, g = seq & 63, n = lane;
        float bbre[16], bbim[16];
#pragma unroll
        for (int p = 0; p < 16; ++p) { bbre[p] = s5bb[(size_t)(g * 64 + n) * 32 + p]; bbim[p] = s5bb[(size_t)(g * 64 + n) * 32 + 16 + p]; }
        const float are = s5a[2 * (g * 64 + n)], aim = s5a[2 * (g * 64 + n) + 1];
        bf16x8 cf[4];
#pragma unroll
        for (int ks = 0; ks < 4; ++ks) { u32x4 w; unsigned* wp = (unsigned*)&w;
#pragma unroll
            for (int j2 = 0; j2 < 4; ++j2) { float v[2];
#pragma unroll
                for (int e = 0; e < 2; ++e) { const int k = 32 * ks + 8 * fq + 2 * j2 + e; v[e] = (k < 64) ? c_re[(size_t)(g * 16 + fr) * 64 + k] : -c_im[(size_t)(g * 16 + fr) * 64 + (k - 64)]; }
                wp[j2] = pk2(v[0], v[1]); }
            cf[ks] = __builtin_bit_cast(bf16x8, w); }
        const float dsk = dskip[g * 16 + fr];
        float hre = 0.f, him = 0.f;
        const bf16_t* ubase = proj + (size_t)b * SEQ * PW + 4096 + g * 16;
        u32x4 ua = *(const u32x4*)(ubase + (size_t)(lane & 31) * PW), ub = *(const u32x4*)(ubase + (size_t)(lane & 31) * PW + 8);
        unsigned short uu[2][4];
#pragma unroll
        for (int sb = 0; sb < 2; ++sb)
#pragma unroll
            for (int i = 0; i < 4; ++i) uu[sb][i] = ubase[(size_t)(16 * sb + 4 * fq + i) * PW + fr];
        for (int ch = 0; ch < SEQ / 32; ++ch) {
            const size_t row0 = (size_t)b * SEQ + ch * 32;
            const int chn = (ch + 1 < SEQ / 32) ? ch + 1 : ch;
            const bf16_t* unext = ubase + (size_t)chn * 32 * PW;
            const u32x4 ua_n = *(const u32x4*)(unext + (size_t)(lane & 31) * PW), ub_n = *(const u32x4*)(unext + (size_t)(lane & 31) * PW + 8);
            unsigned short uu_n[2][4];
#pragma unroll
            for (int sb = 0; sb < 2; ++sb)
#pragma unroll
                for (int i = 0; i < 4; ++i) uu_n[sb][i] = unext[(size_t)(16 * sb + 4 * fq + i) * PW + fr];
            if (lane < 32) {
                LAS f32x4* up4 = (LAS f32x4*)(Uc + lane * 16);
                up4[0] = (f32x4){bflo(ua.x), bfhi(ua.x), bflo(ua.y), bfhi(ua.y)}; up4[1] = (f32x4){bflo(ua.z), bfhi(ua.z), bflo(ua.w), bfhi(ua.w)};
                up4[2] = (f32x4){bflo(ub.x), bfhi(ub.x), bflo(ub.y), bfhi(ub.y)}; up4[3] = (f32x4){bflo(ub.z), bfhi(ub.z), bflo(ub.w), bfhi(ub.w)};
            }
#pragma unroll
            for (int k = 0; k < 32; ++k) {
                f32x2 xa = (f32x2){0.f, 0.f}, xb = (f32x2){0.f, 0.f};
#pragma unroll
                for (int q = 0; q < 4; ++q) { const f32x4 u4 = *(const LAS f32x4*)(Uc + k * 16 + 4 * q);
                    xa = __builtin_elementwise_fma((f32x2){u4[0], u4[0]}, (f32x2){bbre[4 * q], bbim[4 * q]}, xa);
                    xb = __builtin_elementwise_fma((f32x2){u4[1], u4[1]}, (f32x2){bbre[4 * q + 1], bbim[4 * q + 1]}, xb);
                    xa = __builtin_elementwise_fma((f32x2){u4[2], u4[2]}, (f32x2){bbre[4 * q + 2], bbim[4 * q + 2]}, xa);
                    xb = __builtin_elementwise_fma((f32x2){u4[3], u4[3]}, (f32x2){bbre[4 * q + 3], bbim[4 * q + 3]}, xb); }
                const f32x2 xx = xa + xb;
                const float nr = are * hre - aim * him + xx[0], ni = are * him + aim * hre + xx[1]; hre = nr; him = ni;
                Hc[k * 136 + n] = (bf16_t)f2bf(hre); Hc[k * 136 + 64 + n] = (bf16_t)f2bf(him);
            }
#pragma unroll
            for (int sb = 0; sb < 2; ++sb) {
                f32x4 y = (f32x4){0.f, 0.f, 0.f, 0.f};
#pragma unroll
                for (int ks = 0; ks < 4; ++ks) { const bf16x8 hf = *(const LAS bf16x8*)(Hc + (16 * sb + fr) * 136 + 32 * ks + 8 * fq); y = __builtin_amdgcn_mfma_f32_16x16x32_bf16(hf, cf[ks], y, 0, 0, 0); }
#pragma unroll
                for (int i = 0; i < 4; ++i) { const size_t row = row0 + 16 * sb + 4 * fq + i;
                    const float yy = y[i] + dsk * bf2f(uu[sb][i]);
                    z[row * 1024 + g * 16 + fr] = (bf16_t)f2bf(gelu_tanh_f(yy)); }
            }
            ua = ua_n; ub = ub_n;
#pragma unroll
            for (int sb = 0; sb < 2; ++sb)
#pragma unroll
                for (int i = 0; i < 4; ++i) uu[sb][i] = uu_n[sb][i];
        }
    }
}

#define MF32(a, b, c) __builtin_amdgcn_mfma_f32_32x32x16_bf16((a), (b), (c), 0, 0, 0)
#define AT_WAITV(n) asm volatile("s_waitcnt vmcnt(" #n ")" ::: "memory")
#define AT_BAR() asm volatile("s_waitcnt lgkmcnt(0)\n\ts_barrier" ::: "memory")
__device__ __forceinline__ s16x4 vtr(const LAS unsigned char* p) { typedef short v4i16_t __attribute__((ext_vector_type(4))); return __builtin_bit_cast(s16x4, __builtin_amdgcn_ds_read_tr16_b64_v4i16((LAS v4i16_t*)p)); }
__device__ __forceinline__ int crow(int i, int h) { return (i & 3) + 8 * (i >> 2) + 4 * h; }

template <int MODE>
__device__ __forceinline__ void attn_unit(LAS unsigned char* lds, const bf16_t* src, const int pitch, const int kcol, const int vcol, const int b, const int h, const int ub,
                                          bf16_t* outp, const bf16_t* gsrc, const float* subln, const float lam) {
    constexpr int NKS = MODE ? 8 : 16, NDB = 4, ROWS = MODE ? 64 : 128;
    const int tid = threadIdx.x, lane = tid & 63, r = lane & 31, hh = lane >> 5;
    const int wid = __builtin_amdgcn_readfirstlane(tid >> 6);
    const int rg = MODE ? (wid & 1) : (wid & 3), vh = MODE ? ((wid >> 1) & 1) : (wid >> 2), cc = MODE ? (wid >> 2) : 0;
    const size_t rowbase = (size_t)b * SEQ; const int q0 = ub * ROWS, NT = MODE ? (ub + 1) : (2 * ub + 2);
    const int qrow = q0 + rg * 32 + r;
    AT_WAITV(0);
#define AT_ISSUE(t, buf) do { const bf16_t* gk_ = src + (rowbase + (size_t)(t) * 64) * pitch; int rv_ = r; asm volatile("" : "+v"(rv_)); \
        _Pragma("unroll") for (int i_ = 0; i_ < 4; ++i_) { const int c_ = wid * 4 + i_; const int row_ = c_ * 2 + hh; \
            const unsigned ok_ = (unsigned)(row_ * pitch + kcol + ((rv_ ^ (row_ & 15)) << 3)); \
            __builtin_amdgcn_global_load_lds((const unsigned*)(gk_ + ok_), (LAS unsigned*)(lds + (buf) * 65536 + c_ * 1024), 16, 0, 0); \
            const unsigned ov_ = (unsigned)(row_ * pitch + vcol + ((rv_ ^ ((row_ & 3) << 2)) << 3)); \
            __builtin_amdgcn_global_load_lds((const unsigned*)(gk_ + ov_), (LAS unsigned*)(lds + (buf) * 65536 + 32768 + c_ * 1024), 16, 0, 0); } } while (0)
    AT_ISSUE(0, 0);
    bf16x8 qf[NKS];
    { const bf16_t* qp = src + (rowbase + qrow) * pitch + h * 256 + cc * 128 + 8 * hh;
#pragma unroll
      for (int d0 = 0; d0 < NKS; ++d0) qf[d0] = *(const bf16x8*)(qp + 16 * d0); }
    f32x16 O[NDB];
#pragma unroll
    for (int db = 0; db < NDB; ++db)
#pragma unroll
        for (int i = 0; i < 16; ++i) O[db][i] = 0.f;
    float mrun = 0.f, lrun = 0.f;
    const float lgam = __builtin_log2f(1.0f - __builtin_amdgcn_exp2f(-5.0f - (float)h));
    const int r15 = r & 15;
    const int kunit0 = cc * 16;
    const int q4 = (lane & 15) >> 2, p4 = lane & 3, blk16 = (lane >> 4) & 1;
    const int vlane = (4 * hh + q4) * 512 + ((2 * blk16 + (p4 >> 1)) << 4) + 8 * (p4 & 1);
    for (int t = 0; t < NT; ++t) {
        if (t + 1 < NT) { AT_ISSUE(t + 1, (t + 1) & 1); AT_WAITV(8); } else { AT_WAITV(0); }
        AT_BAR();
        const bool active = MODE ? true : !(t == NT - 1 && rg < 2);
        if (active) {
            const LAS unsigned char* Kb = lds + (t & 1) * 65536; const LAS unsigned char* Vb = Kb + 32768;
            int r15v = r15 ^ hh ^ kunit0, q4v = q4 << 2; asm volatile("" : "+v"(r15v), "+v"(q4v));
            bf16x8 pf[4];
            if constexpr (MODE) {
                f32x16 p0, p1;
#pragma unroll
                for (int i = 0; i < 16; ++i) { p0[i] = -mrun; p1[i] = -mrun; }
                { const LAS unsigned char* kr0 = Kb + r * 512; const LAS unsigned char* kr1 = Kb + (32 + r) * 512;
#pragma unroll
                  for (int d0 = 0; d0 < NKS; ++d0) { const int uo = ((2 * d0) ^ r15v) << 4;
                      const bf16x8 k0 = *(const LAS bf16x8*)(kr0 + uo); const bf16x8 k1 = *(const LAS bf16x8*)(kr1 + uo);
                      p0 = MF32(k0, qf[d0], p0); p1 = MF32(k1, qf[d0], p1);
                      if ((d0 & 3) == 3) __builtin_amdgcn_sched_barrier(0); } }
                float rm = p0[0];
#pragma unroll
                for (int i = 0; i < 16; ++i) { rm = fmaxf(rm, p0[i]); rm = fmaxf(rm, p1[i]); }
                rm = fmaxf(rm, __shfl_xor(rm, 32));
                if (t == 0 || __any(rm > 8.0f)) {
                    const float dl = (t == 0) ? rm : fmaxf(rm, 0.f); const float al = (t == 0) ? 1.0f : __builtin_amdgcn_exp2f(-dl); lrun *= al; mrun += dl;
#pragma unroll
                    for (int i = 0; i < 16; ++i) { p0[i] -= dl; p1[i] -= dl; }
#pragma unroll
                    for (int db = 0; db < NDB; ++db) O[db] = O[db] * al;
                }
                float sum = 0.f;
#pragma unroll
                for (int i = 0; i < 16; ++i) { p0[i] = __builtin_amdgcn_exp2f(p0[i]); p1[i] = __builtin_amdgcn_exp2f(p1[i]); sum += p0[i] + p1[i]; }
                lrun += sum;
                u32x4 w;
                w.x = cvt_pk_bf16(p0[0], p0[1]); w.y = cvt_pk_bf16(p0[2], p0[3]); w.z = cvt_pk_bf16(p0[4], p0[5]); w.w = cvt_pk_bf16(p0[6], p0[7]); pf[0] = __builtin_bit_cast(bf16x8, w);
                w.x = cvt_pk_bf16(p0[8], p0[9]); w.y = cvt_pk_bf16(p0[10], p0[11]); w.z = cvt_pk_bf16(p0[12], p0[13]); w.w = cvt_pk_bf16(p0[14], p0[15]); pf[1] = __builtin_bit_cast(bf16x8, w);
                w.x = cvt_pk_bf16(p1[0], p1[1]); w.y = cvt_pk_bf16(p1[2], p1[3]); w.z = cvt_pk_bf16(p1[4], p1[5]); w.w = cvt_pk_bf16(p1[6], p1[7]); pf[2] = __builtin_bit_cast(bf16x8, w);
                w.x = cvt_pk_bf16(p1[8], p1[9]); w.y = cvt_pk_bf16(p1[10], p1[11]); w.z = cvt_pk_bf16(p1[12], p1[13]); w.w = cvt_pk_bf16(p1[14], p1[15]); pf[3] = __builtin_bit_cast(bf16x8, w);
            } else {
#pragma unroll
                for (int blk = 0; blk < 2; ++blk) {
                    f32x16 p;
#pragma unroll
                    for (int i = 0; i < 16; ++i) p[i] = 0.f;
                    const LAS unsigned char* kr = Kb + (32 * blk + r) * 512;
                    {
                        bf16x8 kq[2];
                        kq[0] = *(const LAS bf16x8*)(kr + ((0 ^ r15v) << 4));
#pragma unroll
                        for (int d0 = 0; d0 < NKS; ++d0) {
                            if (d0 + 1 < NKS) kq[(d0 + 1) & 1] = *(const LAS bf16x8*)(kr + (((2 * (d0 + 1)) ^ r15v) << 4));
                            __builtin_amdgcn_sched_barrier(0);
                            p = MF32(kq[d0 & 1], qf[d0], p);
                            __builtin_amdgcn_sched_barrier(0);
                        }
                    }
                    const int kb = t * 64 + 32 * blk + 4 * hh;
#pragma unroll
                    for (int i = 0; i < 16; ++i) { const int kv = kb + (i & 3) + 8 * (i >> 2);
                        p[i] *= __builtin_amdgcn_exp2f(lgam * fabsf((float)(qrow - kv)) - 4.0f); }
                    u32x4 w;
                    w.x = cvt_pk_bf16(p[0], p[1]); w.y = cvt_pk_bf16(p[2], p[3]); w.z = cvt_pk_bf16(p[4], p[5]); w.w = cvt_pk_bf16(p[6], p[7]); pf[2 * blk] = __builtin_bit_cast(bf16x8, w);
                    w.x = cvt_pk_bf16(p[8], p[9]); w.y = cvt_pk_bf16(p[10], p[11]); w.z = cvt_pk_bf16(p[12], p[13]); w.w = cvt_pk_bf16(p[14], p[15]); pf[2 * blk + 1] = __builtin_bit_cast(bf16x8, w);
                    __builtin_amdgcn_sched_barrier(0);
                }
            }
            const LAS unsigned char* vb = Vb + vlane;
            __builtin_amdgcn_sched_barrier(0);
            {
#define VFRAG(j) __builtin_shufflevector(vtr(vb + (((vh * 16 + 4 * ((j) >> 2)) ^ q4v) << 4) + (16 * ((j) & 3)) * 512), vtr(vb + (((vh * 16 + 4 * ((j) >> 2)) ^ q4v) << 4) + (16 * ((j) & 3) + 8) * 512), 0, 1, 2, 3, 4, 5, 6, 7)
                bf16x8 vq[3];
                vq[0] = VFRAG(0); vq[1] = VFRAG(1);
#pragma unroll
                for (int j = 0; j < 4 * NDB; ++j) {
                    if (j + 2 < 4 * NDB) vq[(j + 2) % 3] = VFRAG(j + 2);
                    __builtin_amdgcn_sched_barrier(0);
                    O[j >> 2] = MF32(vq[j % 3], pf[j & 3], O[j >> 2]);
                    __builtin_amdgcn_sched_barrier(0);
                }
#undef VFRAG
            }
        }
        AT_BAR();
    }
    const size_t orow = rowbase + qrow;
    LAS float* SS = (LAS float*)(lds + 131072);
    if constexpr (MODE) {
        const float l = lrun + __shfl_xor(lrun, 32); const float inv = 1.0f / l;
        LAS float* X = (LAS float*)(lds + (wid & 3) * 16384);
        if (cc == 1) {
#pragma unroll
            for (int db = 0; db < NDB; ++db)
#pragma unroll
                for (int i = 0; i < 16; ++i) X[(db * 16 + i) * 64 + lane] = O[db][i] * inv;
        }
        AT_BAR();
        float ss = 0.f;
        if (cc == 0) {
#pragma unroll
            for (int db = 0; db < NDB; ++db)
#pragma unroll
                for (int i = 0; i < 16; ++i) { const float o = O[db][i] * inv - lam * X[(db * 16 + i) * 64 + lane]; O[db][i] = o; ss += o * o; }
        }
        ss += __shfl_xor(ss, 32);
        if (hh == 0) SS[wid * 32 + r] = ss;
        AT_BAR();
        if (cc == 0) {
            ss += SS[(wid ^ 2) * 32 + r];
            const float rs = (1.0f - LAMBDA_INIT) / sqrtf(ss * (1.0f / 256.0f) + EPS);
            bf16_t* op = outp + orow * DM + h * 256 + vh * 128 + 4 * hh;
            const float* slp = subln + vh * 128 + 4 * hh;
#pragma unroll
            for (int db = 0; db < NDB; ++db)
#pragma unroll
                for (int i4 = 0; i4 < 4; ++i4) { const int d = 32 * db + 8 * i4;
                    const f32x4 sl = *(const f32x4*)(slp + d);
                    u32x2 w; w.x = cvt_pk_bf16(O[db][4 * i4] * rs * sl[0], O[db][4 * i4 + 1] * rs * sl[1]); w.y = cvt_pk_bf16(O[db][4 * i4 + 2] * rs * sl[2], O[db][4 * i4 + 3] * rs * sl[3]);
                    *(u32x2*)(op + d) = w; }
        }
        AT_BAR();
    } else {
        float ss = 0.f;
#pragma unroll
        for (int db = 0; db < NDB; ++db)
#pragma unroll
            for (int i = 0; i < 16; ++i) ss += O[db][i] * O[db][i];
        ss += __shfl_xor(ss, 32);
        if (hh == 0) SS[wid * 32 + r] = ss;
        AT_BAR();
        ss += SS[(wid ^ 4) * 32 + r];
        const float rs = 1.0f / sqrtf(ss * (1.0f / 256.0f) + EPS);
        const bf16_t* gp = gsrc + orow * PW + 3072 + h * 256 + vh * 128 + 4 * hh;
        bf16_t* op = outp + orow * DM + h * 256 + vh * 128 + 4 * hh;
        u32x2 ggv[NDB][4];
#pragma unroll
        for (int db = 0; db < NDB; ++db)
#pragma unroll
            for (int i4 = 0; i4 < 4; ++i4) ggv[db][i4] = *(const u32x2*)(gp + 32 * db + 8 * i4);
#pragma unroll
        for (int db = 0; db < NDB; ++db)
#pragma unroll
            for (int i4 = 0; i4 < 4; ++i4) { const int d = 32 * db + 8 * i4;
                const u32x2 gg = ggv[db][i4];
                u32x2 w; w.x = cvt_pk_bf16(O[db][4 * i4] * rs * silu_f(bflo(gg.x)), O[db][4 * i4 + 1] * rs * silu_f(bfhi(gg.x)));
                w.y = cvt_pk_bf16(O[db][4 * i4 + 2] * rs * silu_f(bflo(gg.y)), O[db][4 * i4 + 3] * rs * silu_f(bfhi(gg.y)));
                *(u32x2*)(op + d) = w; }
        AT_BAR();
    }
#undef AT_ISSUE
}

__device__ __forceinline__ void attn_unit_diff128(LAS unsigned char* lds, const bf16_t* src, const int pitch, const int kcol, const int vcol, const int b, const int h, const int ub,
                                                  bf16_t* outp, const float* subln, const float lam) {
    constexpr int NKS = 8, NDB = 8;
    const int tid = threadIdx.x, lane = tid & 63, r = lane & 31, hh = lane >> 5;
    const int wid = __builtin_amdgcn_readfirstlane(tid >> 6);
    const int rg = wid & 3, cc = wid >> 2;
    const size_t rowbase = (size_t)b * SEQ; const int q0 = ub * 128, NT = 2 * ub + 2;
    const int qrow = q0 + rg * 32 + r;
    AT_WAITV(0);
#define AT_ISSUE(t, buf) do { const bf16_t* gk_ = src + (rowbase + (size_t)(t) * 64) * pitch; int rv_ = r; asm volatile("" : "+v"(rv_)); \
        _Pragma("unroll") for (int i_ = 0; i_ < 4; ++i_) { const int c_ = wid * 4 + i_; const int row_ = c_ * 2 + hh; \
            const unsigned ok_ = (unsigned)(row_ * pitch + kcol + ((rv_ ^ (row_ & 15)) << 3)); \
            __builtin_amdgcn_global_load_lds((const unsigned*)(gk_ + ok_), (LAS unsigned*)(lds + (buf) * 65536 + c_ * 1024), 16, 0, 0); \
            const unsigned ov_ = (unsigned)(row_ * pitch + vcol + ((rv_ ^ ((row_ & 3) << 2)) << 3)); \
            __builtin_amdgcn_global_load_lds((const unsigned*)(gk_ + ov_), (LAS unsigned*)(lds + (buf) * 65536 + 32768 + c_ * 1024), 16, 0, 0); } } while (0)
    AT_ISSUE(0, 0);
    bf16x8 qf[NKS];
    { const bf16_t* qp = src + (rowbase + qrow) * pitch + h * 256 + cc * 128 + 8 * hh;
#pragma unroll
      for (int d0 = 0; d0 < NKS; ++d0) qf[d0] = *(const bf16x8*)(qp + 16 * d0); }
    f32x16 O[NDB];
#pragma unroll
    for (int db = 0; db < NDB; ++db)
#pragma unroll
        for (int i = 0; i < 16; ++i) O[db][i] = 0.f;
    float mrun = 0.f, lrun = 0.f;
    const int r15 = r & 15, kunit0 = cc * 16;
    const int q4 = (lane & 15) >> 2, p4 = lane & 3, blk16 = (lane >> 4) & 1;
    const int vlane = (4 * hh + q4) * 512 + ((2 * blk16 + (p4 >> 1)) << 4) + 8 * (p4 & 1);
    for (int t = 0; t < NT; ++t) {
        if (t + 1 < NT) { AT_ISSUE(t + 1, (t + 1) & 1); AT_WAITV(8); } else { AT_WAITV(0); }
        AT_BAR();
        const bool active = !(t == NT - 1 && rg < 2);
        if (active) {
            const LAS unsigned char* Kb = lds + (t & 1) * 65536; const LAS unsigned char* Vb = Kb + 32768;
            int r15v = r15 ^ hh ^ kunit0, q4v = q4 << 2; asm volatile("" : "+v"(r15v), "+v"(q4v));
            const LAS unsigned char* vb = Vb + vlane;
#pragma unroll
            for (int blk = 0; blk < 2; ++blk) {
                f32x16 p;
#pragma unroll
                for (int i = 0; i < 16; ++i) p[i] = -mrun;
                const LAS unsigned char* kr = Kb + (32 * blk + r) * 512;
                {
                    bf16x8 kq[2];
                    kq[0] = *(const LAS bf16x8*)(kr + ((0 ^ r15v) << 4));
#pragma unroll
                    for (int d0 = 0; d0 < NKS; ++d0) {
                        if (d0 + 1 < NKS) kq[(d0 + 1) & 1] = *(const LAS bf16x8*)(kr + (((2 * (d0 + 1)) ^ r15v) << 4));
                        __builtin_amdgcn_sched_barrier(0);
                        p = MF32(kq[d0 & 1], qf[d0], p);
                        __builtin_amdgcn_sched_barrier(0);
                    }
                }
                float rm = p[0];
#pragma unroll
                for (int i = 1; i < 16; ++i) rm = fmaxf(rm, p[i]);
                rm = fmaxf(rm, __shfl_xor(rm, 32));
                const bool first = (t == 0) && (blk == 0);
                if (first || __any(rm > 8.0f)) {
                    const float dl = first ? rm : fmaxf(rm, 0.f); const float al = first ? 1.0f : __builtin_amdgcn_exp2f(-dl); lrun *= al; mrun += dl;
#pragma unroll
                    for (int i = 0; i < 16; ++i) p[i] -= dl;
#pragma unroll
                    for (int db = 0; db < NDB; ++db) O[db] = O[db] * al;
                }
                float sum = 0.f;
#pragma unroll
                for (int i = 0; i < 16; ++i) { p[i] = __builtin_amdgcn_exp2f(p[i]); sum += p[i]; }
                lrun += sum;
                bf16x8 pf[2];
                { u32x4 w;
                  w.x = cvt_pk_bf16(p[0], p[1]); w.y = cvt_pk_bf16(p[2], p[3]); w.z = cvt_pk_bf16(p[4], p[5]); w.w = cvt_pk_bf16(p[6], p[7]); pf[0] = __builtin_bit_cast(bf16x8, w);
                  w.x = cvt_pk_bf16(p[8], p[9]); w.y = cvt_pk_bf16(p[10], p[11]); w.z = cvt_pk_bf16(p[12], p[13]); w.w = cvt_pk_bf16(p[14], p[15]); pf[1] = __builtin_bit_cast(bf16x8, w); }
                __builtin_amdgcn_sched_barrier(0);
                {
#define VFRAG(j) __builtin_shufflevector(vtr(vb + (((4 * ((j) >> 1)) ^ q4v) << 4) + (32 * blk + 16 * ((j) & 1)) * 512), vtr(vb + (((4 * ((j) >> 1)) ^ q4v) << 4) + (32 * blk + 16 * ((j) & 1) + 8) * 512), 0, 1, 2, 3, 4, 5, 6, 7)
                    bf16x8 vq[3];
                    vq[0] = VFRAG(0); vq[1] = VFRAG(1);
#pragma unroll
                    for (int j = 0; j < 2 * NDB; ++j) {
                        if (j + 2 < 2 * NDB) vq[(j + 2) % 3] = VFRAG(j + 2);
                        __builtin_amdgcn_sched_barrier(0);
                        O[j >> 1] = MF32(vq[j % 3], pf[j & 1], O[j >> 1]);
                        __builtin_amdgcn_sched_barrier(0);
                    }
#undef VFRAG
                }
            }
        }
        AT_BAR();
    }
    const size_t orow = rowbase + qrow;
    const float l = lrun + __shfl_xor(lrun, 32); const float inv = 1.0f / l;
    LAS float* X = (LAS float*)(lds + rg * 32768);
    if (cc == 1) {
#pragma unroll
        for (int db = 0; db < NDB; ++db)
#pragma unroll
            for (int i = 0; i < 16; ++i) X[(db * 16 + i) * 64 + lane] = O[db][i] * inv;
    }
    AT_BAR();
    if (cc == 0) {
        float ss = 0.f;
#pragma unroll
        for (int db = 0; db < NDB; ++db)
#pragma unroll
            for (int i = 0; i < 16; ++i) { const float o = O[db][i] * inv - lam * X[(db * 16 + i) * 64 + lane]; O[db][i] = o; ss += o * o; }
        ss += __shfl_xor(ss, 32);
        const float rs = (1.0f - LAMBDA_INIT) / sqrtf(ss * (1.0f / 256.0f) + EPS);
        bf16_t* op = outp + orow * DM + h * 256 + 4 * hh;
        const LAS float* slp = (const LAS float*)(lds + 132096) + 4 * hh;
#pragma unroll
        for (int db = 0; db < NDB; ++db)
#pragma unroll
            for (int i4 = 0; i4 < 4; ++i4) { const int d = 32 * db + 8 * i4;
                const f32x4 sl = *(const LAS f32x4*)(slp + d);
                u32x2 w; w.x = cvt_pk_bf16(O[db][4 * i4] * rs * sl[0], O[db][4 * i4 + 1] * rs * sl[1]); w.y = cvt_pk_bf16(O[db][4 * i4 + 2] * rs * sl[2], O[db][4 * i4 + 3] * rs * sl[3]);
                *(u32x2*)(op + d) = w; }
    }
    AT_BAR();
#undef AT_ISSUE
}

template <int MODE>
__device__ __forceinline__ void attn_phase(LAS unsigned char* lds, const bf16_t* src, int pitch, int kcol0, int vcol0, int nheads, bf16_t* outp, const bf16_t* gsrc, const float* subln, float lam, int vcu, int G) {
    constexpr int NU = 16;
    const int npairs = 16 * nheads * (NU / 2);
    if constexpr (MODE) { if (threadIdx.x < 256) ((LAS float*)(lds + 132096))[threadIdx.x] = subln[threadIdx.x]; __syncthreads(); }
    for (int pr = vcu; pr < npairs; pr += G) {
        const int bh = pr / (NU / 2), p = pr % (NU / 2), b = bh / nheads, h = bh % nheads;
        if constexpr (MODE) {
            attn_unit_diff128(lds, src, pitch, kcol0 + h * 256, vcol0 + h * 256, b, h, NU - 1 - p, outp, subln, lam);
            attn_unit_diff128(lds, src, pitch, kcol0 + h * 256, vcol0 + h * 256, b, h, p, outp, subln, lam);
        } else {
            attn_unit<0>(lds, src, pitch, kcol0 + h * 256, vcol0 + h * 256, b, h, NU - 1 - p, outp, gsrc, subln, lam);
            attn_unit<0>(lds, src, pitch, kcol0 + h * 256, vcol0 + h * 256, b, h, p, outp, gsrc, subln, lam);
        }
    }
}

#define XB_TMO      128
#define XB_XCNT(j)  (256  + 64 * (j))
#define XB_XSUB(j)  (1280 + 64 * (j))
#define XB_XGEN(j)  (2304 + 64 * (j))
#define XB_TOP      3328
#define XB_TOPGEN   3392
#define XCD_BAR_WORDS 3456
#define XB_SPIN_CAP (1u << 18)
__device__ __forceinline__ unsigned xb_ld(unsigned* p)              { return __hip_atomic_load(p, __ATOMIC_RELAXED, __HIP_MEMORY_SCOPE_AGENT); }
__device__ __forceinline__ unsigned xb_add(unsigned* p, unsigned v) { return __hip_atomic_fetch_add(p, v, __ATOMIC_RELAXED, __HIP_MEMORY_SCOPE_AGENT); }
__device__ __forceinline__ unsigned xb_xcc_id() { return (unsigned)__builtin_amdgcn_s_getreg((3 << 11) | 20) & 0xFu; }
#define XB_SPIN(cond, bar) do { unsigned _sp = 0; while (cond) { __builtin_amdgcn_s_sleep(1); \
    if ((++_sp & 255u) == 0u) { if (xb_ld(&(bar)[XB_TMO])) break; if (_sp > XB_SPIN_CAP) { atomicAdd(&(bar)[XB_TMO], 1u); break; } } } } while (0)
struct XcdBarrier { unsigned* bar; unsigned x; volatile LAS unsigned* st; };
__device__ __forceinline__ XcdBarrier xcd_barrier_post(unsigned* bar, volatile LAS unsigned* st) {
    XcdBarrier b; b.bar = bar; b.x = xb_xcc_id(); b.st = st;
    if (threadIdx.x == 0) (void)xb_add(&bar[XB_XCNT(b.x)], 1u);
    return b;
}
__device__ __forceinline__ void xcd_barrier_complete(unsigned* bar, unsigned x, unsigned& nloc, unsigned& nx) {
    const unsigned G = gridDim.x * gridDim.y * gridDim.z;
    unsigned sum, cnt, mine, sp = 0u;
    for (;;) {
        sum = 0u; cnt = 0u; mine = 0u;
#pragma unroll
        for (unsigned j = 0; j < 16; ++j) { const unsigned c = xb_ld(&bar[XB_XCNT(j)]); sum += c; cnt += (c > 0u) ? 1u : 0u; mine = (j == x) ? c : mine; }
        if (sum == G) break;
        __builtin_amdgcn_s_sleep(1);
        if ((++sp & 255u) == 0u) { if (xb_ld(&bar[XB_TMO])) break; if (sp > XB_SPIN_CAP) { atomicAdd(&bar[XB_TMO], 1u); break; } }
    }
    nloc = mine > 0u ? mine : 1u; nx = cnt > 0u ? cnt : 1u;
}
__device__ __forceinline__ void xcd_barrier(const XcdBarrier& b) {
    asm volatile("s_waitcnt vmcnt(0)" ::: "memory");
    __syncthreads();
    if (threadIdx.x == 0) {
        unsigned* bar = b.bar;
        __builtin_amdgcn_s_waitcnt(0);
        unsigned nloc = b.st[0], nx = b.st[1];
        if (nloc == 0u) { xcd_barrier_complete(bar, b.x, nloc, nx); b.st[0] = nloc; b.st[1] = nx; }
        const unsigned old = xb_add(&bar[XB_XSUB(b.x)], 1u);
        const unsigned gen = old / nloc;
        if (old + 1u == (gen + 1u) * nloc) {
            __builtin_amdgcn_fence(__ATOMIC_RELEASE, "agent");
            asm volatile("s_waitcnt vmcnt(0)" ::: "memory");
            const unsigned og = xb_add(&bar[XB_TOP], 1u);
            const unsigned tg = og / nx;
            if (og + 1u == (tg + 1u) * nx) xb_add(&bar[XB_TOPGEN], 1u);
            else XB_SPIN(xb_ld(&bar[XB_TOPGEN]) == tg, bar);
            __builtin_amdgcn_fence(__ATOMIC_ACQUIRE, "agent");
            xb_add(&bar[XB_XGEN(b.x)], 1u);
            asm volatile("s_waitcnt vmcnt(0)" ::: "memory");
        } else {
            XB_SPIN(xb_ld(&bar[XB_XGEN(b.x)]) == gen, bar);
            __builtin_amdgcn_fence(__ATOMIC_ACQUIRE, "agent");
            asm volatile("s_waitcnt vmcnt(0)" ::: "memory");
        }
    }
    __syncthreads();
}

struct Params { const float* in[26]; float* out; unsigned char* ws; int lo, hi; };
constexpr int NPHASE = 17;

__global__ void __launch_bounds__(512) fwd_megakernel(Params P) {
    extern __shared__ __attribute__((aligned(16))) unsigned char lds_raw[];
    LAS unsigned char* lds = (LAS unsigned char*)lds_raw;
    const int tid = threadIdx.x, lane = tid & 63, wave = __builtin_amdgcn_readfirstlane(tid >> 6);
    const int G = gridDim.x, bx = blockIdx.x;
    const int vcu = (G % 8 == 0) ? (bx % 8) * (G / 8) + bx / 8 : bx;
    const int gw = vcu * 8 + wave, NGW = G * 8;
    unsigned char* ws = P.ws;
    float* out = P.out;
    bf16_t* Wgu = (bf16_t*)(ws + WS_WGU); bf16_t* Wd = (bf16_t*)(ws + WS_WD); bf16_t* Win = (bf16_t*)(ws + WS_WIN); bf16_t* Wout = (bf16_t*)(ws + WS_WOUT);
    bf16_t* Wglu = (bf16_t*)(ws + WS_WGLU); bf16_t* Wqkv = (bf16_t*)(ws + WS_WQKV); bf16_t* Wco = (bf16_t*)(ws + WS_WCO);
    bf16_t* XN = (bf16_t*)(ws + WS_XN); bf16_t* BIG = (bf16_t*)(ws + WS_BIG); bf16_t* ZB = (bf16_t*)(ws + WS_Z);
    const float* x = P.in[0]; const float* ffn_norm = P.in[1]; const float* mix_norm = P.in[5];
#if MK_PER_PHASE
#define SYNC(k) do { } while (0)
#else
    cg::grid_group grid = cg::this_grid();
    { volatile LAS unsigned* st0 = (volatile LAS unsigned*)(lds + 139264); if (tid < 2) st0[tid] = 0u; }
    __syncthreads();
    const XcdBarrier xbar = xcd_barrier_post((unsigned*)(ws + WS_BAR), (volatile LAS unsigned*)(lds + 139264));
#define SYNC(k) do { if (P.lo <= (k) && (k) + 1 < P.hi) { if ((k) == 0) grid.sync(); else xcd_barrier(xbar); } } while (0)
#endif
#ifndef WGM_DOWN
#define WGM_DOWN 4
#endif
#ifndef DUPMASK
#define DUPMASK 0u
#endif
#define IN(k) (P.lo <= (k) && (k) < P.hi)
#define REP(k) for (int rep_ = 0; rep_ < (((DUPMASK >> (k)) & 1u) ? 2 : 1); ++rep_)

    u64_t* SSQ = (u64_t*)(ws + WS_SSQ);
    bf16_t* YC = (bf16_t*)(ws + WS_YC);
    const float* rcos = (const float*)(ws + WS_RCOS); const float* rsin = (const float*)(ws + WS_RSIN);
    const float* acos_ = (const float*)(ws + WS_ACOS); const float* asin_ = (const float*)(ws + WS_ASIN);
    if (IN(0)) REP(0) {
        LAS float* scr = (LAS float*)(lds + wave * 16640);
        const size_t gsz = (size_t)DM * DFF;
#pragma unroll 1
        for (int i = 0; i < 4; ++i) {
            conv_matrix(P.in[2] + i * gsz, Wgu + (size_t)i * NGU * DM, DM, DFF, 1, ffn_norm + i * DM, scr, gw, NGW, lane);
            conv_matrix(P.in[3] + i * gsz, Wgu + (size_t)i * NGU * DM, DM, DFF, 2, ffn_norm + i * DM, scr, gw, NGW, lane);
            conv_matrix(P.in[4] + i * gsz, Wd + (size_t)i * DM * DFF, DFF, DM, 0, nullptr, scr, gw, NGW, lane);
        }
        conv_matrix(P.in[6], Win, DM, PW, 0, mix_norm, scr, gw, NGW, lane);
        conv_matrix(P.in[7], Wout, DM, DM, 0, nullptr, scr, gw, NGW, lane);
        conv_matrix(P.in[16], Wglu, 1024, 1024, 0, nullptr, scr, gw, NGW, lane);
        conv_matrix(P.in[18], Wqkv, DM, QW, 0, mix_norm + DM, scr, gw, NGW, lane);
        conv_matrix(P.in[19], Wco, DM, DM, 0, nullptr, scr, gw, NGW, lane);
        tables_phase(ws, nullptr, P.in[8], P.in[9], P.in[10], P.in[11], P.in[12], P.in[20], P.in[21], P.in[22], P.in[23], vcu * 512 + tid, G * 512);
        for (int i = vcu * 512 + tid; i < 6 * TT; i += G * 512) SSQ[TT + i] = 0u;
        cast_phase(x, XN, SSQ, gw, NGW, lane);
    }
    SYNC(0);
#if !MK_PER_PHASE
    if ((DUPMASK >> 20) & 1u) { for (int q_ = 0; q_ < 32; ++q_) grid.sync(); }
#endif
    if (IN(1)) { run_gemm(lds, XN, Wgu, TT, NGU, DM, EpiSwiglu{BIG, DFF, SSQ}); if ((DUPMASK >> 1) & 1u) { run_gemm(lds, XN, Wgu, TT, NGU, DM, EpiSwiglu{BIG, DFF, SSQ}); } }
    SYNC(1);
    if (IN(2)) run_gemm(lds, BIG, Wd, TT, DM, DFF, EpiResid<true, false, 1>{x, nullptr, XN, SSQ + 1 * TT}, WGM_DOWN);
    if (IN(2) && ((DUPMASK >> 2) & 1u)) run_gemm(lds, BIG, Wd, TT, DM, DFF, EpiResid<false, false, 2>{nullptr, nullptr, XN, nullptr});
    SYNC(2);
    if (IN(3)) { run_gemm(lds, XN, Win, TT, PW, DM, EpiWin{BIG, rcos, rsin, SSQ + 1 * TT}); if ((DUPMASK >> 3) & 1u) { run_gemm(lds, XN, Win, TT, PW, DM, EpiWin{BIG, rcos, rsin, SSQ + 1 * TT}); } }
    SYNC(3);
    if (IN(4)) REP(4) {
        const bool do_ret = !(rep_ == 1 && ((DUPMASK >> 22) & 1u)), do_s5 = !(rep_ == 1 && ((DUPMASK >> 21) & 1u));
        unsigned mask = 0u; int bh = 0, lin = -1, s5i = vcu, s5g = G; bool s5 = true;
        if (G == 256) {
            if (vcu < 128) { bh = vcu >> 1; mask = (vcu & 1) ? 0x03FDu : 0xE402u; s5 = false; }
            else { const int j = vcu - 128; bh = j >> 1; mask = 1u << (11 + (j & 1)); s5i = j; s5g = 128; }
        } else lin = vcu;
        if (s5 && do_s5) s5_phase(lds, ws, BIG, P.in[13], P.in[14], P.in[15], ZB, s5i, s5g, wave, lane);
        __syncthreads();
        if (do_ret) for (;;) {
            int ub;
            if (lin < 0) { if (!mask) break; ub = 31 - __clz((int)mask); mask &= ~(1u << ub); }
            else { if (lin >= 1024) break; bh = lin >> 4; ub = 15 - (lin & 15); lin += G; }
            const int b = bh >> 2, h = bh & 3;
            attn_unit<0>(lds, BIG, PW, 1024 + h * 256, 2048 + h * 256, b, h, ub, YC, BIG, nullptr, 0.f);
        }
    }
    SYNC(4);
    if (IN(5)) run_gemm(lds, ZB, Wglu, TT, 1024, 1024, EpiGlu{ZB, P.in[17], YC});
    SYNC(5);
    if (IN(6)) run_gemm(lds, YC, Wout, TT, DM, DM, EpiResid<false, false, 0>{nullptr, nullptr, XN, SSQ + 2 * TT});
    if (IN(6) && ((DUPMASK >> 6) & 1u)) run_gemm(lds, YC, Wout, TT, DM, DM, EpiResid<false, false, 2>{nullptr, nullptr, XN, nullptr});
    SYNC(6);
    if (IN(7)) { run_gemm(lds, XN, Wgu + (size_t)1 * NGU * DM, TT, NGU, DM, EpiSwiglu{BIG, DFF, SSQ + 2 * TT}); if ((DUPMASK >> 7) & 1u) { run_gemm(lds, XN, Wgu + (size_t)1 * NGU * DM, TT, NGU, DM, EpiSwiglu{BIG, DFF, SSQ + 2 * TT}); } }
    SYNC(7);
    if (IN(8)) run_gemm(lds, BIG, Wd + (size_t)1 * DM * DFF, TT, DM, DFF, EpiResid<false, false, 1>{nullptr, nullptr, XN, SSQ + 3 * TT}, WGM_DOWN);
    if (IN(8) && ((DUPMASK >> 8) & 1u)) run_gemm(lds, BIG, Wd + (size_t)1 * DM * DFF, TT, DM, DFF, EpiResid<false, false, 2>{nullptr, nullptr, XN, nullptr});
    SYNC(8);
    if (IN(9)) { run_gemm(lds, XN, Wgu + (size_t)2 * NGU * DM, TT, NGU, DM, EpiSwiglu{BIG, DFF, SSQ + 3 * TT}); if ((DUPMASK >> 9) & 1u) { run_gemm(lds, XN, Wgu + (size_t)2 * NGU * DM, TT, NGU, DM, EpiSwiglu{BIG, DFF, SSQ + 3 * TT}); } }
    SYNC(9);
    if (IN(10)) run_gemm(lds, BIG, Wd + (size_t)2 * DM * DFF, TT, DM, DFF, EpiResid<false, false, 1>{nullptr, nullptr, XN, SSQ + 4 * TT}, WGM_DOWN);
    if (IN(10) && ((DUPMASK >> 10) & 1u)) run_gemm(lds, BIG, Wd + (size_t)2 * DM * DFF, TT, DM, DFF, EpiResid<false, false, 2>{nullptr, nullptr, XN, nullptr});
    SYNC(10);
    if (IN(11)) { run_gemm(lds, XN, Wqkv, TT, QW, DM, EpiQkv{BIG, acos_, asin_, SSQ + 4 * TT}); if ((DUPMASK >> 11) & 1u) { run_gemm(lds, XN, Wqkv, TT, QW, DM, EpiQkv{BIG, acos_, asin_, SSQ + 4 * TT}); } }
    SYNC(11);
#ifndef NO_A1
    if (IN(12)) REP(12) { const float lam = ((const float*)(ws + WS_CTL))[0]; attn_phase<1>(lds, BIG, QW, 2048, 4096, 8, YC, nullptr, P.in[24], lam, vcu, G); }
#endif
    SYNC(12);
    if (IN(13)) run_gemm(lds, YC, Wco, TT, DM, DM, EpiResid<false, false, 0>{nullptr, nullptr, XN, SSQ + 5 * TT});
    if (IN(13) && ((DUPMASK >> 13) & 1u)) run_gemm(lds, YC, Wco, TT, DM, DM, EpiResid<false, false, 2>{nullptr, nullptr, XN, nullptr});
    SYNC(13);
    if (IN(14)) { run_gemm(lds, XN, Wgu + (size_t)3 * NGU * DM, TT, NGU, DM, EpiSwiglu{BIG, DFF, SSQ + 5 * TT}); if ((DUPMASK >> 14) & 1u) { run_gemm(lds, XN, Wgu + (size_t)3 * NGU * DM, TT, NGU, DM, EpiSwiglu{BIG, DFF, SSQ + 5 * TT}); } }
    SYNC(14);
    if (IN(15)) run_gemm(lds, BIG, Wd + (size_t)3 * DM * DFF, TT, DM, DFF, EpiResid<false, false, 1>{nullptr, nullptr, XN, SSQ + 6 * TT}, WGM_DOWN);
    if (IN(15) && ((DUPMASK >> 15) & 1u)) run_gemm(lds, BIG, Wd + (size_t)3 * DM * DFF, TT, DM, DFF, EpiResid<false, false, 2>{nullptr, nullptr, XN, nullptr});
    SYNC(15);
    if (IN(16)) final_phase(XN, SSQ + 6 * TT, P.in[25], out, gw, NGW, lane);
#undef IN
#undef SYNC
}

extern "C" void kernel_launch(void* const* d_in, const int* in_sizes, int n_in, void* d_out, int out_size, void* d_ws, size_t ws_size, hipStream_t stream) {
    static int grid = 0;
    if (grid == 0) {
        if (n_in != 26 || out_size != TT * DM || ws_size < WS_END) { fprintf(stderr, "kernel_launch: unexpected shapes (n_in %d, out %d, ws %zu < %zu)\n", n_in, out_size, ws_size, (size_t)WS_END); grid = -1; return; }
        int dev = 0, cus = 0, per_cu = 0;
        hipGetDevice(&dev); hipDeviceGetAttribute(&cus, hipDeviceAttributeMultiprocessorCount, dev);
        if (hipFuncSetAttribute((const void*)fwd_megakernel, hipFuncAttributeMaxDynamicSharedMemorySize, LDS_BYTES) != hipSuccess) { fprintf(stderr, "kernel_launch: hipFuncSetAttribute failed\n"); grid = -1; return; }
        if (hipOccupancyMaxActiveBlocksPerMultiprocessor(&per_cu, (const void*)fwd_megakernel, 512, LDS_BYTES) != hipSuccess || per_cu < 1) { fprintf(stderr, "kernel_launch: occupancy query says %d\n", per_cu); per_cu = 1; }
        (void)hipGetLastError();
        grid = cus * per_cu;
        fprintf(stderr, "kernel_launch: grid %d (cus %d x %d)\n", grid, cus, per_cu);
    }
    if (grid < 0) return;
    if (hipMemsetAsync((char*)d_ws + WS_BAR, 0, BAR_BYTES, stream) != hipSuccess) { fprintf(stderr, "kernel_launch: hipMemsetAsync failed\n"); return; }
    Params p{};
    for (int i = 0; i < 26; ++i) p.in[i] = (const float*)d_in[i];
    p.out = (float*)d_out; p.ws = (unsigned char*)d_ws;
#if MK_PER_PHASE
    for (int k = 0; k < NPHASE; ++k) { p.lo = k; p.hi = k + 1; hipLaunchKernelGGL(fwd_megakernel, dim3(grid), dim3(512), LDS_BYTES, stream, p); }
#else
    p.lo = 0; p.hi = NPHASE;
    void* args[] = {&p};
    hipError_t e = hipLaunchCooperativeKernel((const void*)fwd_megakernel, dim3(grid), dim3(512), args, LDS_BYTES, stream);
    if (e != hipSuccess) fprintf(stderr, "cooperative launch failed: %s (grid %d)\n", hipGetErrorString(e), grid);
#endif
}
```

```cpp
#include <hip/hip_runtime.h>
#include <hip/hip_cooperative_groups.h>
#include <cstdio>
#include <cstdint>
namespace cg = cooperative_groups;

#define LAS __attribute__((address_space(3)))
typedef unsigned short bf16_t;
typedef unsigned u64_t;
constexpr float SSQ_FIX = 1024.0f, SSQ_INV = 1.0f / 1024.0f;
typedef short bf16x8 __attribute__((ext_vector_type(8)));
typedef short s16x4 __attribute__((ext_vector_type(4)));
typedef float f32x4 __attribute__((ext_vector_type(4)));
typedef float f32x2 __attribute__((ext_vector_type(2)));
typedef float f32x16 __attribute__((ext_vector_type(16)));
typedef unsigned u32x4 __attribute__((ext_vector_type(4)));
typedef unsigned u32x2 __attribute__((ext_vector_type(2)));

#ifndef MK_PER_PHASE
#define MK_PER_PHASE 0
#endif

constexpr int TT = 32768, SEQ = 2048, DM = 2048, DFF = 5504, NGU = 2 * DFF;
constexpr int PW = 5120, QW = 6144;
constexpr float EPS = 1e-6f;
constexpr float LAMBDA_INIT = 0.35550906759f;
constexpr float QSCALE = 0.08838834764831845f * 1.4426950408889634f;

constexpr size_t MiB = 1u << 20;
constexpr size_t WS_CTL = 0, WS_BAR = 4096, BAR_BYTES = 16384;
constexpr size_t WS_RCOS = 1 * MiB, WS_RSIN = 2 * MiB, WS_ACOS = 3 * MiB, WS_ASIN = 3 * MiB + 128 * 1024, WS_S5A = 3 * MiB + 512 * 1024, WS_S5BB = 4 * MiB;
constexpr size_t WS_W = 8 * MiB;
constexpr size_t SZ_WGU = (size_t)NGU * DM * 2, SZ_WD = (size_t)DM * DFF * 2;
constexpr size_t WS_WGU = WS_W, WS_WD = WS_WGU + 4 * SZ_WGU, WS_WIN = WS_WD + 4 * SZ_WD, WS_WOUT = WS_WIN + (size_t)PW * DM * 2,
                 WS_WGLU = WS_WOUT + (size_t)DM * DM * 2, WS_WQKV = WS_WGLU + (size_t)1024 * 1024 * 2, WS_WCO = WS_WQKV + (size_t)QW * DM * 2,
                 WS_WEND = WS_WCO + (size_t)DM * DM * 2;
constexpr size_t WS_XN = 328 * MiB;
constexpr size_t WS_BIG = 456 * MiB;
constexpr size_t WS_Z = WS_BIG + (size_t)TT * PW * 2;
constexpr size_t WS_YC = WS_BIG + (size_t)TT * QW * 2;
constexpr size_t WS_END = WS_YC + (size_t)TT * DM * 2;
constexpr size_t WS_SSQ = 5 * MiB;
static_assert(WS_WEND <= WS_XN && WS_XN + (size_t)TT * DM * 2 <= WS_BIG && WS_Z + (size_t)TT * 1024 * 2 <= WS_END, "ws map");

constexpr int LDS_BYTES = 147456;

namespace pg8 {
constexpr int BM = 256, BK = 64, HALF = 128, HTB = HALF * BK * 2, STAGE_BYTES = 8 * HTB, NXCD = 8;
__host__ __device__ __forceinline__ int lds_byte(int r, int c) { const int st = (r >> 4) * 2 + (c >> 5), rr = r & 15, cc = c & 31, ob = rr * 64 + cc * 2; return st * 1024 + (ob ^ (((ob >> 9) & 1) << 5)); }
__host__ __device__ __forceinline__ void stage_rc(int b, int& R, int& C) { const int st = b / 1024, sb = b % 1024, swz = sb ^ (((sb >> 9) & 1) << 5); R = (st >> 1) * 16 + swz / 64; C = (st & 1) * 32 + (swz % 64) / 2; }
__host__ __device__ __forceinline__ int perm32(int rho) { const int n = rho >> 4, i = rho & 15; return 8 * (i >> 2) + 4 * n + (i & 3); }
struct Unit { int pm, pn; };
struct Gemm { const bf16_t* A; const bf16_t* Bt; int M, N, K; };
struct StaticOrder {
    int nM, nN, nwg, G, c, WGM, rev;
    __host__ __device__ void init(int M, int N, int G_, int c_, int wgm_ = 8, int rev_ = 0) { nM = M / BM; nN = N / BM; nwg = nM * nN; G = G_; c = c_; WGM = wgm_; rev = rev_; }
    __host__ __device__ bool next(int i, Unit& u) const {
        const long L = (long)i * G + c; if (L >= nwg) return false;
        int wgid = (int)L; { const int q = nwg / NXCD, r = nwg % NXCD, xcd = wgid % NXCD, off = wgid / NXCD; wgid = (xcd < r ? xcd * (q + 1) : r * (q + 1) + (xcd - r) * q) + off; }
        const int nig = WGM * nN, gid = wgid / nig, fm = gid * WGM, gsz = (nM - fm) < WGM ? (nM - fm) : WGM;
        u.pm = fm + ((wgid % nig) % gsz); u.pn = (wgid % nig) / gsz; if (rev) u.pm = nM - 1 - u.pm; return true;
    }
    __device__ __forceinline__ void a_ready(const Unit&) const {}
    __device__ __forceinline__ void done(const Unit&) const {}
};
__device__ __forceinline__ unsigned cvt_pk_bf16(float lo, float hi) { unsigned r; asm volatile("v_cvt_pk_bf16_f32 %0, %1, %2" : "=v"(r) : "v"(lo), "v"(hi)); return r; }

template <class Epi, class Sched, bool ALIGN_EPI = false, bool SP2 = false>
__device__ __forceinline__ void gemm_phase(LAS unsigned char* lds, const Gemm g, const Sched S, const Epi E) {
    const int tid = threadIdx.x, wid = __builtin_amdgcn_readfirstlane(tid >> 6), lane = tid & 63, wr = wid >> 2, wc = wid & 3, fr = lane & 15, fq = lane >> 4;
    const int K = g.K, nt = K / BK;
    unsigned voffA[2], voffB[2];
#pragma unroll
    for (int i = 0; i < 2; ++i) { int R, C; stage_rc(tid * 16 + i * 8192, R, C); const int Rb = Epi::PERM ? ((R & ~31) + perm32(R & 31)) : R;
        voffA[i] = (unsigned)(R * K + C) * 2u; voffB[i] = (unsigned)(Rb * K + C) * 2u; }
    const size_t kstep = (size_t)(BK * 2);
    const size_t hstep = (size_t)HALF * K * 2;
    const size_t tstep = 2 * hstep;
    const unsigned ldsw = (unsigned)wid * 1024u;
    const int aoff = lds_byte(wr * 64 + fr, fq * 8), boff = lds_byte(wc * 32 + fr, fq * 8);
#define PG8_SA(b, h) (((b) * 2 + (h)) * HTB)
#define PG8_SB(b, h) ((4 + (b) * 2 + (h)) * HTB)
#define PG8_STAGE(bufoff, gbase, voff) do { _Pragma("unroll") for (int _i = 0; _i < 2; ++_i) \
        __builtin_amdgcn_global_load_lds((const unsigned*)((const char*)(gbase) + (voff)[_i]), (LAS unsigned*)(lds + (bufoff) + ldsw + _i * 8192), 16, 0, 0); } while (0)
#define PG8_LDA(dst, b, h) do { _Pragma("unroll") for (int m = 0; m < 4; ++m) _Pragma("unroll") for (int k = 0; k < 2; ++k) dst[m][k] = *(const LAS bf16x8*)(lds + PG8_SA(b, h) + aoff + m * 2048 + k * 1024); } while (0)
#define PG8_LDB(dst, b, h) do { _Pragma("unroll") for (int n = 0; n < 2; ++n) _Pragma("unroll") for (int k = 0; k < 2; ++k) dst[n][k] = *(const LAS bf16x8*)(lds + PG8_SB(b, h) + boff + n * 2048 + k * 1024); } while (0)
#define PG8_MMA(ai, bj, At, Bt) do { __builtin_amdgcn_s_setprio(1); _Pragma("unroll") for (int m = 0; m < 4; ++m) _Pragma("unroll") for (int n = 0; n < 2; ++n) _Pragma("unroll") for (int k = 0; k < 2; ++k) \
        acc[ai][bj][m][n] = __builtin_amdgcn_mfma_f32_16x16x32_bf16(Bt[n][k], At[m][k], acc[ai][bj][m][n], 0, 0, 0); __builtin_amdgcn_s_setprio(0); } while (0)
#define PG8_WAIT_V(n) asm volatile("s_waitcnt vmcnt(" #n ")" ::: "memory")
#define PG8_WAIT_L(n) asm volatile("s_waitcnt lgkmcnt(" #n ")" ::: "memory")
#define PG8_BAR __builtin_amdgcn_s_barrier()
#define PG8_SCHED __builtin_amdgcn_sched_barrier(0)
    Unit cur, nxt; int ui = 0;
    if (!S.next(0, cur)) return;
    f32x4 acc[2][2][4][2];
#pragma unroll
    for (int a = 0; a < 2; ++a)
#pragma unroll
        for (int b = 0; b < 2; ++b)
#pragma unroll
            for (int m = 0; m < 4; ++m)
#pragma unroll
                for (int n = 0; n < 2; ++n) acc[a][b][m][n] = (f32x4){0.f, 0.f, 0.f, 0.f};
    bf16x8 At[4][2], B0[2][2], B1[2][2];
    typename Epi::Pre pre;
    const char* cA = (const char*)g.A + (size_t)cur.pm * tstep; const char* cB = (const char*)g.Bt + (size_t)cur.pn * tstep;
    S.a_ready(cur);
    if constexpr (SP2) {
        PG8_STAGE(PG8_SB(0, 0), cB, voffB); PG8_STAGE(PG8_SB(0, 1), cB + hstep, voffB); PG8_STAGE(PG8_SA(0, 0), cA, voffA); PG8_STAGE(PG8_SA(0, 1), cA + hstep, voffA);
        if (wr == 1) PG8_BAR;
        PG8_WAIT_V(2); PG8_BAR;
        PG8_STAGE(PG8_SB(1, 0), cB + kstep, voffB); PG8_STAGE(PG8_SA(1, 0), cA + kstep, voffA); PG8_STAGE(PG8_SB(1, 1), cB + hstep + kstep, voffB);
        PG8_WAIT_V(6); PG8_BAR;
    } else {
        PG8_STAGE(PG8_SB(0, 0), cB, voffB); PG8_STAGE(PG8_SA(0, 0), cA, voffA); PG8_STAGE(PG8_SB(0, 1), cB + hstep, voffB); PG8_STAGE(PG8_SA(0, 1), cA + hstep, voffA);
        if (wr == 1) PG8_BAR;
        PG8_WAIT_V(4); PG8_BAR;
        PG8_STAGE(PG8_SB(1, 0), cB + kstep, voffB); PG8_STAGE(PG8_SA(1, 0), cA + kstep, voffA); PG8_STAGE(PG8_SB(1, 1), cB + hstep + kstep, voffB);
        PG8_WAIT_V(6); PG8_BAR;
    }
    for (;;) {
        const bool has_next = S.next(ui + 1, nxt);
        const char* nA = has_next ? (const char*)g.A + (size_t)nxt.pm * tstep : cA; const char* nB = has_next ? (const char*)g.Bt + (size_t)nxt.pn * tstep : cB;
        for (int t = 0; t < nt; t += 2) {
            const bool last = (t == nt - 2);
            const char* a1 = cA + (size_t)(t + 1) * kstep;
            const char* a2 = last ? nA : cA + (size_t)(t + 2) * kstep; const char* b2 = last ? nB : cB + (size_t)(t + 2) * kstep;
            const char* a3 = a2 + kstep; const char* b3 = b2 + kstep;
            if (last && has_next) S.a_ready(nxt);
            if (last) E.prefetch(cur, wr, fr, pre);
            if constexpr (SP2) {
            PG8_LDB(B0, 0, 0); PG8_LDB(B1, 0, 1); PG8_SCHED; PG8_LDA(At, 0, 0); PG8_STAGE(PG8_SA(1, 1), a1 + hstep, voffA);
            PG8_WAIT_V(8); PG8_WAIT_L(0); PG8_BAR; PG8_MMA(0, 0, At, B0); PG8_MMA(0, 1, At, B1); PG8_BAR; PG8_SCHED;
            PG8_LDA(At, 0, 1); PG8_STAGE(PG8_SB(0, 0), b2, voffB); PG8_STAGE(PG8_SB(0, 1), b2 + hstep, voffB); PG8_STAGE(PG8_SA(0, 0), a2, voffA);
            PG8_WAIT_V(8); PG8_WAIT_L(0); PG8_BAR; PG8_MMA(1, 0, At, B0); PG8_MMA(1, 1, At, B1); PG8_BAR; PG8_SCHED;
            PG8_LDB(B0, 1, 0); PG8_LDB(B1, 1, 1); PG8_SCHED; PG8_LDA(At, 1, 0); PG8_STAGE(PG8_SA(0, 1), a2 + hstep, voffA);
            PG8_WAIT_V(8); PG8_WAIT_L(0); PG8_BAR; PG8_MMA(0, 0, At, B0); PG8_MMA(0, 1, At, B1); PG8_BAR; PG8_SCHED;
            PG8_LDA(At, 1, 1); PG8_STAGE(PG8_SB(1, 0), b3, voffB); PG8_STAGE(PG8_SB(1, 1), b3 + hstep, voffB); PG8_STAGE(PG8_SA(1, 0), a3, voffA);
            PG8_WAIT_V(8); PG8_WAIT_L(0); PG8_BAR; PG8_MMA(1, 0, At, B0); PG8_MMA(1, 1, At, B1); PG8_BAR; PG8_SCHED;
            } else {
            PG8_LDB(B0, 0, 0); PG8_SCHED; PG8_LDA(At, 0, 0); PG8_STAGE(PG8_SA(1, 1), a1 + hstep, voffA);
            PG8_WAIT_L(8); PG8_BAR; PG8_WAIT_L(0); PG8_MMA(0, 0, At, B0); PG8_BAR; PG8_SCHED;
            PG8_LDB(B1, 0, 1); PG8_STAGE(PG8_SB(0, 0), b2, voffB);
            PG8_BAR; PG8_WAIT_L(0); PG8_MMA(0, 1, At, B1); PG8_BAR;
            PG8_LDA(At, 0, 1); PG8_STAGE(PG8_SA(0, 0), a2, voffA);
            PG8_BAR; PG8_WAIT_L(0); PG8_MMA(1, 0, At, B0); PG8_BAR; PG8_SCHED;
            PG8_STAGE(PG8_SB(0, 1), b2 + hstep, voffB);
            PG8_WAIT_V(6); PG8_BAR; PG8_MMA(1, 1, At, B1); PG8_BAR;
            PG8_LDB(B0, 1, 0); PG8_SCHED; PG8_LDA(At, 1, 0); PG8_STAGE(PG8_SA(0, 1), a2 + hstep, voffA);
            PG8_WAIT_L(8); PG8_BAR; PG8_WAIT_L(0); PG8_MMA(0, 0, At, B0); PG8_BAR; PG8_SCHED;
            PG8_LDB(B1, 1, 1); PG8_STAGE(PG8_SB(1, 0), b3, voffB);
            PG8_BAR; PG8_WAIT_L(0); PG8_MMA(0, 1, At, B1); PG8_BAR;
            PG8_LDA(At, 1, 1); PG8_STAGE(PG8_SA(1, 0), a3, voffA);
            PG8_BAR; PG8_WAIT_L(0); PG8_MMA(1, 0, At, B0); PG8_BAR; PG8_SCHED;
            PG8_STAGE(PG8_SB(1, 1), b3 + hstep, voffB);
            PG8_WAIT_V(6); PG8_BAR; PG8_MMA(1, 1, At, B1); PG8_BAR;
            }
        }
        if constexpr (ALIGN_EPI) { if (wr == 0) PG8_BAR; }
        if constexpr (!Epi::AFTER_DRAIN) { E(acc, cur, wr, wc, fr, fq, pre); S.done(cur); }
        if (!has_next) break;
#pragma unroll
        for (int a = 0; a < 2; ++a)
#pragma unroll
            for (int b = 0; b < 2; ++b)
#pragma unroll
                for (int m = 0; m < 4; ++m)
#pragma unroll
                    for (int n = 0; n < 2; ++n) acc[a][b][m][n] = (f32x4){0.f, 0.f, 0.f, 0.f};
        cur = nxt; cA = nA; cB = nB; ++ui;
        if constexpr (ALIGN_EPI) { if (wr == 1) PG8_BAR; }
    }
    PG8_WAIT_V(0);
    if constexpr (!ALIGN_EPI) { if (wr == 0) PG8_BAR; }
    PG8_BAR;
#undef PG8_SA
#undef PG8_SB
#undef PG8_STAGE
#undef PG8_LDA
#undef PG8_LDB
#undef PG8_MMA
#undef PG8_WAIT_V
#undef PG8_WAIT_L
#undef PG8_BAR
#undef PG8_SCHED
}
}

__device__ __forceinline__ unsigned f2bf(float f) { unsigned u = __builtin_bit_cast(unsigned, f); return (u + 0x7fffu + ((u >> 16) & 1u)) >> 16; }
__device__ __forceinline__ unsigned pk2(float lo, float hi) { return f2bf(lo) | (f2bf(hi) << 16); }
__device__ __forceinline__ float bf2f(unsigned short b) { return __builtin_bit_cast(float, (unsigned)b << 16); }
__device__ __forceinline__ float bflo(unsigned w) { return __builtin_bit_cast(float, w << 16); }
__device__ __forceinline__ float bfhi(unsigned w) { return __builtin_bit_cast(float, w & 0xffff0000u); }
__device__ __forceinline__ float fast_sigmoid(float x) { return __builtin_amdgcn_rcpf(1.0f + __builtin_amdgcn_exp2f(-1.4426950408889634f * x)); }
__device__ __forceinline__ float silu_f(float x) { return x * fast_sigmoid(x); }
__device__ __forceinline__ float gelu_tanh_f(float y) { return y * fast_sigmoid(1.5957691216057308f * (y + 0.044715f * y * y * y)); }
__device__ __forceinline__ float wave_sum(float v) {
#pragma unroll
    for (int o = 1; o < 64; o <<= 1) v += __shfl_xor(v, o);
    return v;
}
__device__ __forceinline__ void sincos_d(double a, double& s, double& c) {
    const double k = rint(a * 0.15915494309189535);
    const double r = fma(-k, 6.283185307179586, a), r2 = r * r;
    double ts = r, tc = 1.0; s = r; c = 1.0;
    for (int n = 1; n <= 13; ++n) { tc *= -r2 / (double)((2 * n - 1) * (2 * n)); c += tc; ts *= -r2 / (double)((2 * n) * (2 * n + 1)); s += ts; }
}

using pg8::Unit; using pg8::cvt_pk_bf16;
struct PreSsq { unsigned v[2][4]; };
struct PreNone { };
struct EpiSwiglu {
    static constexpr bool PERM = true, AFTER_DRAIN = false;
    bf16_t* O; int ldo; const u64_t* ssq;
    typedef PreSsq Pre;
    __device__ __forceinline__ void prefetch(const Unit& u, int wr, int fr, Pre& pre) const {
        const int row0 = u.pm * 256 + wr * 64 + fr;
#pragma unroll
        for (int ai = 0; ai < 2; ++ai)
#pragma unroll
            for (int m = 0; m < 4; ++m) pre.v[ai][m] = ssq[row0 + ai * 128 + m * 16];
    }
    __device__ __forceinline__ void operator()(const f32x4 (&acc)[2][2][4][2], const Unit& u, int wr, int wc, int fr, int fq, const Pre& pre) const {
        const int row0 = u.pm * 256 + wr * 64 + fr, col0 = u.pn * 128 + wc * 32 + 8 * fq;
        float rsv[2][4];
#pragma unroll
        for (int ai = 0; ai < 2; ++ai)
#pragma unroll
            for (int m = 0; m < 4; ++m) rsv[ai][m] = (float)pre.v[ai][m] * SSQ_INV;
#pragma unroll
        for (int ai = 0; ai < 2; ++ai)
#pragma unroll
            for (int m = 0; m < 4; ++m) {
                const int row = row0 + ai * 128 + m * 16;
                const float rs = __builtin_amdgcn_rsqf(rsv[ai][m] * (1.0f / DM) + EPS);
                bf16_t* rowp = O + (size_t)row * ldo + col0;
                const f32x4 g0 = acc[ai][0][m][0] * rs, g1 = acc[ai][0][m][1] * rs, u0 = acc[ai][1][m][0] * rs, u1 = acc[ai][1][m][1] * rs;
                u32x4 w;
                w.x = cvt_pk_bf16(silu_f(g0[0]) * u0[0], silu_f(g0[1]) * u0[1]); w.y = cvt_pk_bf16(silu_f(g0[2]) * u0[2], silu_f(g0[3]) * u0[3]);
                w.z = cvt_pk_bf16(silu_f(g1[0]) * u1[0], silu_f(g1[1]) * u1[1]); w.w = cvt_pk_bf16(silu_f(g1[2]) * u1[2], silu_f(g1[3]) * u1[3]);
                *(u32x4*)rowp = w;
            }
    }
};
template <bool BASE_F32, bool OUT_F32, int SCALE> struct EpiResid {
    static constexpr bool PERM = false, AFTER_DRAIN = false;
    const float* basef; float* outf; bf16_t* xb; u64_t* ssq;
    typedef PreNone Pre;
    __device__ __forceinline__ void prefetch(const Unit&, int, int, Pre&) const {}
    __device__ __forceinline__ void operator()(const f32x4 (&acc)[2][2][4][2], const Unit& u, int wr, int wc, int fr, int fq, const Pre&) const {
        const int col0 = u.pn * 256 + wc * 32 + 4 * fq;
        constexpr float sc = (SCALE == 2 ? 0.0f : SCALE == 1 ? 0.5f : 1.0f);
#pragma unroll
        for (int ai = 0; ai < 2; ++ai) {
            f32x4 pre[4][2][2];
#pragma unroll
            for (int m = 0; m < 4; ++m) { const size_t off = (size_t)(u.pm * 256 + ai * 128 + wr * 64 + m * 16 + fr) * DM + col0;
#pragma unroll
                for (int bj = 0; bj < 2; ++bj)
#pragma unroll
                    for (int n = 0; n < 2; ++n) {
                        if constexpr (BASE_F32) pre[m][bj][n] = *(const f32x4*)(basef + off + bj * 128 + n * 16);
                        else { const u32x2 w = *(const u32x2*)(xb + off + bj * 128 + n * 16); pre[m][bj][n] = (f32x4){bflo(w.x), bfhi(w.x), bflo(w.y), bfhi(w.y)}; } } }
#pragma unroll
            for (int m = 0; m < 4; ++m) {
                const int row = u.pm * 256 + ai * 128 + wr * 64 + m * 16 + fr;
                const size_t off = (size_t)row * DM + col0;
                float sq = 0.f;
#pragma unroll
                for (int bj = 0; bj < 2; ++bj)
#pragma unroll
                    for (int n = 0; n < 2; ++n) { const f32x4 v = pre[m][bj][n] + acc[ai][bj][m][n] * sc;
                        if constexpr (OUT_F32) *(f32x4*)(outf + off + bj * 128 + n * 16) = v;
                        else { u32x2 w; w.x = cvt_pk_bf16(v[0], v[1]); w.y = cvt_pk_bf16(v[2], v[3]); *(u32x2*)(xb + off + bj * 128 + n * 16) = w;
                               sq += (v[0] * v[0] + v[1] * v[1]) + (v[2] * v[2] + v[3] * v[3]); } }
                if constexpr (!OUT_F32 && SCALE != 2) { sq += __shfl_xor(sq, 16); sq += __shfl_xor(sq, 32); if (fq == 0) atomicAdd(ssq + row, (u64_t)(sq * SSQ_FIX)); }
            }
        }
    }
};
struct EpiWin {
    static constexpr bool PERM = true, AFTER_DRAIN = false;
    bf16_t* O; const float* cs; const float* sn; const u64_t* ssq;
    typedef PreSsq Pre;
    __device__ __forceinline__ void prefetch(const Unit& u, int wr, int fr, Pre& pre) const {
        const int row0 = u.pm * 256 + wr * 64 + fr;
#pragma unroll
        for (int ai = 0; ai < 2; ++ai)
#pragma unroll
            for (int m = 0; m < 4; ++m) pre.v[ai][m] = ssq[row0 + ai * 128 + m * 16];
    }
    __device__ __forceinline__ void operator()(const f32x4 (&acc)[2][2][4][2], const Unit& u, int wr, int wc, int fr, int fq, const Pre& pre) const {
        const int row0 = u.pm * 256 + wr * 64 + fr, col0 = u.pn * 256 + wc * 32 + 8 * fq;
        const bool rot = u.pn < 8;
        float rsv[2][4];
#pragma unroll
        for (int ai = 0; ai < 2; ++ai)
#pragma unroll
            for (int m = 0; m < 4; ++m) rsv[ai][m] = (float)pre.v[ai][m] * SSQ_INV;
#pragma unroll
        for (int ai = 0; ai < 2; ++ai) {
            f32x4 cc[4][2], sv[4][2];
#pragma unroll
            for (int m = 0; m < 4; ++m) {
                if (rot) { const int pos = (row0 + ai * 128 + m * 16) & (SEQ - 1);
                    const float* cp = cs + pos * 128 + wc * 32 + 8 * fq; const float* sp = sn + pos * 128 + wc * 32 + 8 * fq;
                    cc[m][0] = *(const f32x4*)cp; cc[m][1] = *(const f32x4*)(cp + 4); sv[m][0] = *(const f32x4*)sp; sv[m][1] = *(const f32x4*)(sp + 4); }
                else { cc[m][0] = cc[m][1] = (f32x4){1.f, 1.f, 1.f, 1.f}; sv[m][0] = sv[m][1] = (f32x4){0.f, 0.f, 0.f, 0.f}; }
            }
#pragma unroll
            for (int m = 0; m < 4; ++m) {
                const int row = row0 + ai * 128 + m * 16;
                const float rs = __builtin_amdgcn_rsqf(rsv[ai][m] * (1.0f / DM) + EPS);
                const f32x4 a0 = acc[ai][0][m][0] * rs, a1 = acc[ai][0][m][1] * rs, b0 = acc[ai][1][m][0] * rs, b1 = acc[ai][1][m][1] * rs;
                const f32x4 na0 = a0 * cc[m][0] - b0 * sv[m][0], nb0 = b0 * cc[m][0] + a0 * sv[m][0], na1 = a1 * cc[m][1] - b1 * sv[m][1], nb1 = b1 * cc[m][1] + a1 * sv[m][1];
                bf16_t* rowp = O + (size_t)row * PW + col0;
                u32x4 w; w.x = cvt_pk_bf16(na0[0], na0[1]); w.y = cvt_pk_bf16(na0[2], na0[3]); w.z = cvt_pk_bf16(na1[0], na1[1]); w.w = cvt_pk_bf16(na1[2], na1[3]);
                *(u32x4*)rowp = w;
                u32x4 v; v.x = cvt_pk_bf16(nb0[0], nb0[1]); v.y = cvt_pk_bf16(nb0[2], nb0[3]); v.z = cvt_pk_bf16(nb1[0], nb1[1]); v.w = cvt_pk_bf16(nb1[2], nb1[3]);
                *(u32x4*)(rowp + 128) = v;
            }
        }
    }
};
struct EpiQkv {
    static constexpr bool PERM = false, AFTER_DRAIN = false;
    bf16_t* O; const float* cs; const float* sn; const u64_t* ssq;
    typedef PreSsq Pre;
    __device__ __forceinline__ void prefetch(const Unit& u, int wr, int fr, Pre& pre) const {
#pragma unroll
        for (int ai = 0; ai < 2; ++ai)
#pragma unroll
            for (int m = 0; m < 4; ++m) pre.v[ai][m] = ssq[u.pm * 256 + ai * 128 + wr * 64 + m * 16 + fr];
    }
    __device__ __forceinline__ void operator()(const f32x4 (&acc)[2][2][4][2], const Unit& u, int wr, int wc, int fr, int fq, const Pre& pre) const {
        const int col0 = u.pn * 256 + wc * 32 + 4 * fq;
        const bool rot = (u.pn < 16) && (wc == 0);
        const float sc0 = (u.pn < 8) ? QSCALE : 1.0f;
        float rsv[2][4]; f32x4 cv[2][4], sv[2][4];
#pragma unroll
        for (int ai = 0; ai < 2; ++ai)
#pragma unroll
            for (int m = 0; m < 4; ++m) { const int row = u.pm * 256 + ai * 128 + wr * 64 + m * 16 + fr; rsv[ai][m] = (float)pre.v[ai][m] * SSQ_INV;
                if (rot) { const int pos = row & (SEQ - 1); cv[ai][m] = *(const f32x4*)(cs + pos * 16 + 4 * fq); sv[ai][m] = *(const f32x4*)(sn + pos * 16 + 4 * fq); }
                else { cv[ai][m] = (f32x4){1.f, 1.f, 1.f, 1.f}; sv[ai][m] = (f32x4){0.f, 0.f, 0.f, 0.f}; } }
#pragma unroll
        for (int ai = 0; ai < 2; ++ai)
#pragma unroll
            for (int m = 0; m < 4; ++m) {
                const int row = u.pm * 256 + ai * 128 + wr * 64 + m * 16 + fr;
                const float sc = sc0 * __builtin_amdgcn_rsqf(rsv[ai][m] * (1.0f / DM) + EPS);
                const f32x4 c = cv[ai][m], s = sv[ai][m];
#pragma unroll
                for (int bj = 0; bj < 2; ++bj) {
                    const f32x4 x0 = acc[ai][bj][m][0], x1 = acc[ai][bj][m][1];
                    const f32x4 n0 = (x0 * c - x1 * s) * sc, n1 = (x1 * c + x0 * s) * sc;
                    bf16_t* p = O + (size_t)row * QW + col0 + bj * 128;
                    u32x2 w0; w0.x = cvt_pk_bf16(n0[0], n0[1]); w0.y = cvt_pk_bf16(n0[2], n0[3]); *(u32x2*)p = w0;
                    u32x2 w1; w1.x = cvt_pk_bf16(n1[0], n1[1]); w1.y = cvt_pk_bf16(n1[2], n1[3]); *(u32x2*)(p + 16) = w1;
                }
            }
    }
};
struct EpiGlu {
    static constexpr bool PERM = true, AFTER_DRAIN = false;
    const bf16_t* Z; const float* bias; bf16_t* Y;
    typedef PreNone Pre;
    __device__ __forceinline__ void prefetch(const Unit&, int, int, Pre&) const {}
    __device__ __forceinline__ void operator()(const f32x4 (&acc)[2][2][4][2], const Unit& u, int wr, int wc, int fr, int fq, const Pre&) const {
        const int row0 = u.pm * 256 + wr * 64 + fr, col0 = u.pn * 256 + wc * 32 + 8 * fq;
#pragma unroll
        for (int bj = 0; bj < 2; ++bj) {
            const f32x4 bv0 = *(const f32x4*)(bias + col0 + bj * 128), bv1 = *(const f32x4*)(bias + col0 + bj * 128 + 4);
            u32x4 zz[2][4];
#pragma unroll
            for (int ai = 0; ai < 2; ++ai)
#pragma unroll
                for (int m = 0; m < 4; ++m) zz[ai][m] = *(const u32x4*)(Z + (size_t)(row0 + ai * 128 + m * 16) * 1024 + col0 + bj * 128);
#pragma unroll
            for (int ai = 0; ai < 2; ++ai)
#pragma unroll
                for (int m = 0; m < 4; ++m) {
                    const int row = row0 + ai * 128 + m * 16;
                    const u32x4 z4 = zz[ai][m];
                    const f32x4 v0 = acc[ai][bj][m][0] + bv0, v1 = acc[ai][bj][m][1] + bv1;
                    u32x4 w;
                    w.x = cvt_pk_bf16(bflo(z4.x) * fast_sigmoid(v0[0]), bfhi(z4.x) * fast_sigmoid(v0[1]));
                    w.y = cvt_pk_bf16(bflo(z4.y) * fast_sigmoid(v0[2]), bfhi(z4.y) * fast_sigmoid(v0[3]));
                    w.z = cvt_pk_bf16(bflo(z4.z) * fast_sigmoid(v1[0]), bfhi(z4.z) * fast_sigmoid(v1[1]));
                    w.w = cvt_pk_bf16(bflo(z4.w) * fast_sigmoid(v1[2]), bfhi(z4.w) * fast_sigmoid(v1[3]));
                    *(u32x4*)(Y + (size_t)row * DM + 1024 + col0 + bj * 128) = w;
                }
        }
    }
};

template <class Epi>
__device__ __forceinline__ void run_gemm(LAS unsigned char* lds, const bf16_t* A, const bf16_t* Bt, int M, int N, int K, const Epi E, int wgm = 8, int rev = 0) {
    pg8::Gemm g{A, Bt, M, N, K}; pg8::StaticOrder S; S.init(M, N, (int)gridDim.x, (int)blockIdx.x, wgm, rev);
    pg8::gemm_phase<Epi, pg8::StaticOrder, true, true>(lds, g, S, E);
}

__device__ __forceinline__ void conv_matrix(const float* __restrict__ W, bf16_t* __restrict__ WT, int K, int N, int mode, const float* __restrict__ gain, LAS float* scr, int gw, int NGW, int lane) {
    const int nblk = N / 64, nitems = (K / 64) * nblk;
    for (int item = gw; item < nitems; item += NGW) {
        const int kb = item / nblk, nb = item % nblk, k0 = 64 * kb, n0 = 64 * nb;
        const float gv = gain ? gain[k0 + lane] : 1.0f;
        const float* wp = W + (size_t)k0 * N + n0 + lane;
#pragma unroll
        for (int hb = 0; hb < 2; ++hb) {
            float v[32];
#pragma unroll
            for (int i = 0; i < 32; ++i) v[i] = wp[(size_t)(32 * hb + i) * N];
            asm volatile("" ::: "memory");
#pragma unroll
            for (int i = 0; i < 32; ++i) scr[(32 * hb + i) * 65 + lane] = v[i] * __builtin_bit_cast(float, __builtin_amdgcn_readlane(__builtin_bit_cast(int, gv), 32 * hb + i));
        }
        asm volatile("s_waitcnt lgkmcnt(0)" ::: "memory");
        const int c = lane & 7, ns = lane >> 3;
        const int rbase = (mode == 0) ? n0 : ((n0 >> 7) * 256 + (n0 & 127) + (mode == 2 ? 128 : 0));
#pragma unroll
        for (int j = 0; j < 8; ++j) { const int n = ns + 8 * j; const LAS float* sp = scr + (8 * c) * 65 + n;
            u32x4 o; o.x = pk2(sp[0 * 65], sp[1 * 65]); o.y = pk2(sp[2 * 65], sp[3 * 65]); o.z = pk2(sp[4 * 65], sp[5 * 65]); o.w = pk2(sp[6 * 65], sp[7 * 65]);
            *(u32x4*)(WT + (size_t)(rbase + n) * K + k0 + 8 * c) = o; }
        asm volatile("s_waitcnt lgkmcnt(0)" ::: "memory");
    }
}

template <bool TO_BF16>
__device__ __forceinline__ void rmsnorm_phase(const float* in, const float* __restrict__ g, bf16_t* outb, float* outf, int gw, int NGW, int lane) {
    f32x4 gv[8];
#pragma unroll
    for (int j = 0; j < 8; ++j) gv[j] = ((const f32x4*)g)[lane + 64 * j];
    for (int row = gw; row < TT; row += NGW) {
        const f32x4* xr = (const f32x4*)(in + (size_t)row * DM) + lane;
        f32x4 v[8]; float ss = 0.f;
#pragma unroll
        for (int j = 0; j < 8; ++j) { v[j] = xr[64 * j]; ss += (v[j][0] * v[j][0] + v[j][1] * v[j][1]) + (v[j][2] * v[j][2] + v[j][3] * v[j][3]); }
        const float rs = 1.0f / sqrtf(wave_sum(ss) * (1.0f / DM) + EPS);
#pragma unroll
        for (int j = 0; j < 8; ++j) {
            const f32x4 y = v[j] * rs * gv[j];
            if constexpr (TO_BF16) { u32x2 w; w.x = pk2(y[0], y[1]); w.y = pk2(y[2], y[3]); *((u32x2*)(outb + (size_t)row * DM) + lane + 64 * j) = w; }
            else { *((f32x4*)(outf + (size_t)row * DM) + lane + 64 * j) = y; }
        }
    }
}

__device__ __forceinline__ void cast_phase(const float* in, bf16_t* outb, u64_t* ssq, int gw, int NGW, int lane) {
    if (gw >= TT) return;
    f32x4 v[8];
    { const f32x4* xr = (const f32x4*)(in + (size_t)gw * DM) + lane;
#pragma unroll
      for (int j = 0; j < 8; ++j) v[j] = xr[64 * j]; }
    for (int row = gw; row < TT; row += NGW) {
        const int rn = (row + NGW < TT) ? row + NGW : row;
        const f32x4* xn = (const f32x4*)(in + (size_t)rn * DM) + lane;
        f32x4 w[8];
#pragma unroll
        for (int j = 0; j < 8; ++j) w[j] = xn[64 * j];
        float ss = 0.f;
#pragma unroll
        for (int j = 0; j < 8; ++j) ss += (v[j][0] * v[j][0] + v[j][1] * v[j][1]) + (v[j][2] * v[j][2] + v[j][3] * v[j][3]);
        ss = wave_sum(ss);
        if (lane == 0) ssq[row] = (u64_t)(ss * SSQ_FIX);
#pragma unroll
        for (int j = 0; j < 8; ++j) { u32x2 o; o.x = pk2(v[j][0], v[j][1]); o.y = pk2(v[j][2], v[j][3]); *((u32x2*)(outb + (size_t)row * DM) + lane + 64 * j) = o; }
#pragma unroll
        for (int j = 0; j < 8; ++j) v[j] = w[j];
    }
}

__device__ __forceinline__ void final_phase(const bf16_t* xb, const u64_t* ssq, const float* __restrict__ g, float* outf, int gw, int NGW, int lane) {
    if (gw >= TT) return;
    f32x4 gv[4][2];
#pragma unroll
    for (int j = 0; j < 4; ++j) { gv[j][0] = *(const f32x4*)(g + 8 * (lane + 64 * j)); gv[j][1] = *(const f32x4*)(g + 8 * (lane + 64 * j) + 4); }
    u32x4 v[4]; unsigned sv;
    { const u32x4* xr = (const u32x4*)(xb + (size_t)gw * DM) + lane;
#pragma unroll
      for (int j = 0; j < 4; ++j) v[j] = xr[64 * j];
      sv = ssq[gw]; }
    for (int row = gw; row < TT; row += NGW) {
        const int rn = (row + NGW < TT) ? row + NGW : row;
        const u32x4* xn = (const u32x4*)(xb + (size_t)rn * DM) + lane;
        u32x4 w[4];
#pragma unroll
        for (int j = 0; j < 4; ++j) w[j] = xn[64 * j];
        const unsigned sn = ssq[rn];
        const float rs = __builtin_amdgcn_rsqf((float)sv * SSQ_INV * (1.0f / DM) + EPS);
#pragma unroll
        for (int j = 0; j < 4; ++j) {
            float* op = outf + (size_t)row * DM + 8 * (lane + 64 * j);
            *(f32x4*)op = (f32x4){bflo(v[j].x), bfhi(v[j].x), bflo(v[j].y), bfhi(v[j].y)} * rs * gv[j][0];
            *(f32x4*)(op + 4) = (f32x4){bflo(v[j].z), bfhi(v[j].z), bflo(v[j].w), bfhi(v[j].w)} * rs * gv[j][1];
        }
#pragma unroll
        for (int j = 0; j < 4; ++j) v[j] = w[j];
        sv = sn;
    }
}

__device__ __forceinline__ void tables_phase(unsigned char* ws, const float* const* in_unused, const float* lam_re, const float* lam_im, const float* log_step, const float* b_re, const float* b_im,
                                             const float* lq1, const float* lk1, const float* lq2, const float* lk2, int gtid, int NT_) {
    float* rcos = (float*)(ws + WS_RCOS); float* rsin = (float*)(ws + WS_RSIN); float* acos_ = (float*)(ws + WS_ACOS); float* asin_ = (float*)(ws + WS_ASIN);
    float* s5a = (float*)(ws + WS_S5A); float* s5bb = (float*)(ws + WS_S5BB);
    for (int i = gtid; i < SEQ * 128; i += NT_) {
        const int pos = i >> 7, f = i & 127;
        const float inv = (float)exp2(-((double)(2 * f) / 256.0) * 13.287712379549449);
        const float ang = (float)pos * inv; double s, c; sincos_d((double)ang, s, c); rcos[i] = (float)c; rsin[i] = (float)s;
    }
    for (int i = gtid; i < SEQ * 16; i += NT_) {
        const int pos = i >> 4, f = i & 15;
        const float inv = (float)exp2(-((double)(2 * f) / 32.0) * 18.931568569324174);
        const float ang = (float)pos * inv; double s, c; sincos_d((double)ang, s, c); acos_[i] = (float)c; asin_[i] = (float)s;
    }
    for (int i = gtid; i < 64 * 64; i += NT_) {
        const int g = i >> 6;
        const double step = exp((double)log_step[g]), lr = (double)lam_re[i], li = (double)lam_im[i];
        const double mag = exp(lr * step); double s, c; sincos_d(li * step, s, c);
        const double are = mag * c, aim = mag * s, den = lr * lr + li * li, nr = are - 1.0;
        const double fre = (nr * lr + aim * li) / den, fim = (aim * lr - nr * li) / den;
        s5a[2 * i] = (float)are; s5a[2 * i + 1] = (float)aim;
        for (int p = 0; p < 16; ++p) { const double br = (double)b_re[i * 16 + p], bi = (double)b_im[i * 16 + p];
            s5bb[(size_t)i * 32 + p] = (float)(fre * br - fim * bi); s5bb[(size_t)i * 32 + 16 + p] = (float)(fre * bi + fim * br); }
    }
    if (gtid == 0) { float s1 = 0.f, s2 = 0.f; for (int i = 0; i < 128; ++i) { s1 += lq1[i] * lk1[i]; s2 += lq2[i] * lk2[i]; }
        ((float*)(ws + WS_CTL))[0] = expf(s1) - expf(s2) + LAMBDA_INIT; }
}

__device__ __forceinline__ void s5_phase(LAS unsigned char* lds, const unsigned char* ws, const bf16_t* proj, const float* c_re, const float* c_im, const float* dskip, bf16_t* z,
                                         int vcu, int G, int wave, int lane) {
    const float* s5a = (const float*)(ws + WS_S5A); const float* s5bb = (const float*)(ws + WS_S5BB);
    LAS bf16_t* Hc = (LAS bf16_t*)(lds + wave * 8704);
    LAS float* Uc = (LAS float*)(lds + 8 * 8704 + wave * 2048);
    const int fr = lane & 15, fq = lane >> 4;
    for (int seq = vcu * 8 + wave; seq < 1024; seq += G * 8) {
        const int b = seq >> 6, g = seq & 63, n = lane;
        float bbre[16], bbim[16];
#pragma unroll
        for (int p = 0; p < 16; ++p) { bbre[p] = s5bb[(size_t)(g * 64 + n) * 32 + p]; bbim[p] = s5bb[(size_t)(g * 64 + n) * 32 + 16 + p]; }
        const float are = s5a[2 * (g * 64 + n)], aim = s5a[2 * (g * 64 + n) + 1];
        bf16x8 cf[4];
#pragma unroll
        for (int ks = 0; ks < 4; ++ks) { u32x4 w; unsigned* wp = (unsigned*)&w;
#pragma unroll
            for (int j2 = 0; j2 < 4; ++j2) { float v[2];
#pragma unroll
                for (int e = 0; e < 2; ++e) { const int k = 32 * ks + 8 * fq + 2 * j2 + e; v[e] = (k < 64) ? c_re[(size_t)(g * 16 + fr) * 64 + k] : -c_im[(size_t)(g * 16 + fr) * 64 + (k - 64)]; }
                wp[j2] = pk2(v[0], v[1]); }
            cf[ks] = __builtin_bit_cast(bf16x8, w); }
        const float dsk = dskip[g * 16 + fr];
        float hre = 0.f, him = 0.f;
        const bf16_t* ubase = proj + (size_t)b * SEQ * PW + 4096 + g * 16;
        u32x4 ua = *(const u32x4*)(ubase + (size_t)(lane & 31) * PW), ub = *(const u32x4*)(ubase + (size_t)(lane & 31) * PW + 8);
        unsigned short uu[2][4];
#pragma unroll
        for (int sb = 0; sb < 2; ++sb)
#pragma unroll
            for (int i = 0; i < 4; ++i) uu[sb][i] = ubase[(size_t)(16 * sb + 4 * fq + i) * PW + fr];
        for (int ch = 0; ch < SEQ / 32; ++ch) {
            const size_t row0 = (size_t)b * SEQ + ch * 32;
            const int chn = (ch + 1 < SEQ / 32) ? ch + 1 : ch;
            const bf16_t* unext = ubase + (size_t)chn * 32 * PW;
            const u32x4 ua_n = *(const u32x4*)(unext + (size_t)(lane & 31) * PW), ub_n = *(const u32x4*)(unext + (size_t)(lane & 31) * PW + 8);
            unsigned short uu_n[2][4];
#pragma unroll
            for (int sb = 0; sb < 2; ++sb)
#pragma unroll
                for (int i = 0; i < 4; ++i) uu_n[sb][i] = unext[(size_t)(16 * sb + 4 * fq + i) * PW + fr];
            if (lane < 32) {
                LAS f32x4* up4 = (LAS f32x4*)(Uc + lane * 16);
                up4[0] = (f32x4){bflo(ua.x), bfhi(ua.x), bflo(ua.y), bfhi(ua.y)}; up4[1] = (f32x4){bflo(ua.z), bfhi(ua.z), bflo(ua.w), bfhi(ua.w)};
                up4[2] = (f32x4){bflo(ub.x), bfhi(ub.x), bflo(ub.y), bfhi(ub.y)}; up4[3] = (f32x4){bflo(ub.z), bfhi(ub.z), bflo(ub.w), bfhi(ub.w)};
            }
#pragma unroll
            for (int k = 0; k < 32; ++k) {
                f32x2 xa = (f32x2){0.f, 0.f}, xb = (f32x2){0.f, 0.f};
#pragma unroll
                for (int q = 0; q < 4; ++q) { const f32x4 u4 = *(const LAS f32x4*)(Uc + k * 16 + 4 * q);
                    xa = __builtin_elementwise_fma((f32x2){u4[0], u4[0]}, (f32x2){bbre[4 * q], bbim[4 * q]}, xa);
                    xb = __builtin_elementwise_fma((f32x2){u4[1], u4[1]}, (f32x2){bbre[4 * q + 1], bbim[4 * q + 1]}, xb);
                    xa = __builtin_elementwise_fma((f32x2){u4[2], u4[2]}, (f32x2){bbre[4 * q + 2], bbim[4 * q + 2]}, xa);
                    xb = __builtin_elementwise_fma((f32x2){u4[3], u4[3]}, (f32x2){bbre[4 * q + 3], bbim[4 * q + 3]}, xb); }
                const f32x2 xx = xa + xb;
                const float nr = are * hre - aim * him + xx[0], ni = are * him + aim * hre + xx[1]; hre = nr; him = ni;
                Hc[k * 136 + n] = (bf16_t)f2bf(hre); Hc[k * 136 + 64 + n] = (bf16_t)f2bf(him);
            }
#pragma unroll
            for (int sb = 0; sb < 2; ++sb) {
                f32x4 y = (f32x4){0.f, 0.f, 0.f, 0.f};
#pragma unroll
                for (int ks = 0; ks < 4; ++ks) { const bf16x8 hf = *(const LAS bf16x8*)(Hc + (16 * sb + fr) * 136 + 32 * ks + 8 * fq); y = __builtin_amdgcn_mfma_f32_16x16x32_bf16(hf, cf[ks], y, 0, 0, 0); }
#pragma unroll
                for (int i = 0; i < 4; ++i) { const size_t row = row0 + 16 * sb + 4 * fq + i;
                    const float yy = y[i] + dsk * bf2f(uu[sb][i]);
                    z[row * 1024 + g * 16 + fr] = (bf16_t)f2bf(gelu_tanh_f(yy)); }
            }
            ua = ua_n; ub = ub_n;
#pragma unroll
            for (int sb = 0; sb < 2; ++sb)
#pragma unroll
                for (int i = 0; i < 4; ++i) uu[sb][i] = uu_n[sb][i];
        }
    }
}

#define MF32(a, b, c) __builtin_amdgcn_mfma_f32_32x32x16_bf16((a), (b), (c), 0, 0, 0)
#define AT_WAITV(n) asm volatile("s_waitcnt vmcnt(" #n ")" ::: "memory")
#define AT_BAR() asm volatile("s_waitcnt lgkmcnt(0)\n\ts_barrier" ::: "memory")
__device__ __forceinline__ s16x4 vtr(const LAS unsigned char* p) { typedef short v4i16_t __attribute__((ext_vector_type(4))); return __builtin_bit_cast(s16x4, __builtin_amdgcn_ds_read_tr16_b64_v4i16((LAS v4i16_t*)p)); }
__device__ __forceinline__ int crow(int i, int h) { return (i & 3) + 8 * (i >> 2) + 4 * h; }

template <int MODE>
__device__ __forceinline__ void attn_unit(LAS unsigned char* lds, const bf16_t* src, const int pitch, const int kcol, const int vcol, const int b, const int h, const int ub,
                                          bf16_t* outp, const bf16_t* gsrc, const float* subln, const float lam) {
    constexpr int NKS = MODE ? 8 : 16, NDB = 4, ROWS = MODE ? 64 : 128;
    const int tid = threadIdx.x, lane = tid & 63, r = lane & 31, hh = lane >> 5;
    const int wid = __builtin_amdgcn_readfirstlane(tid >> 6);
    const int rg = MODE ? (wid & 1) : (wid & 3), vh = MODE ? ((wid >> 1) & 1) : (wid >> 2), cc = MODE ? (wid >> 2) : 0;
    const size_t rowbase = (size_t)b * SEQ; const int q0 = ub * ROWS, NT = MODE ? (ub + 1) : (2 * ub + 2);
    const int qrow = q0 + rg * 32 + r;
    AT_WAITV(0);
#define AT_ISSUE(t, buf) do { const bf16_t* gk_ = src + (rowbase + (size_t)(t) * 64) * pitch; int rv_ = r; asm volatile("" : "+v"(rv_)); \
        _Pragma("unroll") for (int i_ = 0; i_ < 4; ++i_) { const int c_ = wid * 4 + i_; const int row_ = c_ * 2 + hh; \
            const unsigned ok_ = (unsigned)(row_ * pitch + kcol + ((rv_ ^ (row_ & 15)) << 3)); \
            __builtin_amdgcn_global_load_lds((const unsigned*)(gk_ + ok_), (LAS unsigned*)(lds + (buf) * 65536 + c_ * 1024), 16, 0, 0); \
            const unsigned ov_ = (unsigned)(row_ * pitch + vcol + ((rv_ ^ ((row_ & 3) << 2)) << 3)); \
            __builtin_amdgcn_global_load_lds((const unsigned*)(gk_ + ov_), (LAS unsigned*)(lds + (buf) * 65536 + 32768 + c_ * 1024), 16, 0, 0); } } while (0)
    AT_ISSUE(0, 0);
    bf16x8 qf[NKS];
    { const bf16_t* qp = src + (rowbase + qrow) * pitch + h * 256 + cc * 128 + 8 * hh;
#pragma unroll
      for (int d0 = 0; d0 < NKS; ++d0) qf[d0] = *(const bf16x8*)(qp + 16 * d0); }
    f32x16 O[NDB];
#pragma unroll
    for (int db = 0; db < NDB; ++db)
#pragma unroll
        for (int i = 0; i < 16; ++i) O[db][i] = 0.f;
    float mrun = 0.f, lrun = 0.f;
    const float lgam = __builtin_log2f(1.0f - __builtin_amdgcn_exp2f(-5.0f - (float)h));
    const int r15 = r & 15;
    const int kunit0 = cc * 16;
    const int q4 = (lane & 15) >> 2, p4 = lane & 3, blk16 = (lane >> 4) & 1;
    const int vlane = (4 * hh + q4) * 512 + ((2 * blk16 + (p4 >> 1)) << 4) + 8 * (p4 & 1);
    for (int t = 0; t < NT; ++t) {
        if (t + 1 < NT) { AT_ISSUE(t + 1, (t + 1) & 1); AT_WAITV(8); } else { AT_WAITV(0); }
        AT_BAR();
        const bool active = MODE ? true : !(t == NT - 1 && rg < 2);
        if (active) {
            const LAS unsigned char* Kb = lds + (t & 1) * 65536; const LAS unsigned char* Vb = Kb + 32768;
            int r15v = r15 ^ hh ^ kunit0, q4v = q4 << 2; asm volatile("" : "+v"(r15v), "+v"(q4v));
            bf16x8 pf[4];
            if constexpr (MODE) {
                f32x16 p0, p1;
#pragma unroll
                for (int i = 0; i < 16; ++i) { p0[i] = -mrun; p1[i] = -mrun; }
                { const LAS unsigned char* kr0 = Kb + r * 512; const LAS unsigned char* kr1 = Kb + (32 + r) * 512;
#pragma unroll
                  for (int d0 = 0; d0 < NKS; ++d0) { const int uo = ((2 * d0) ^ r15v) << 4;
                      const bf16x8 k0 = *(const LAS bf16x8*)(kr0 + uo); const bf16x8 k1 = *(const LAS bf16x8*)(kr1 + uo);
                      p0 = MF32(k0, qf[d0], p0); p1 = MF32(k1, qf[d0], p1);
                      if ((d0 & 3) == 3) __builtin_amdgcn_sched_barrier(0); } }
                float rm = p0[0];
#pragma unroll
                for (int i = 0; i < 16; ++i) { rm = fmaxf(rm, p0[i]); rm = fmaxf(rm, p1[i]); }
                rm = fmaxf(rm, __shfl_xor(rm, 32));
                if (t == 0 || __any(rm > 8.0f)) {
                    const float dl = (t == 0) ? rm : fmaxf(rm, 0.f); const float al = (t == 0) ? 1.0f : __builtin_amdgcn_exp2f(-dl); lrun *= al; mrun += dl;
#pragma unroll
                    for (int i = 0; i < 16; ++i) { p0[i] -= dl; p1[i] -= dl; }
#pragma unroll
                    for (int db = 0; db < NDB; ++db) O[db] = O[db] * al;
                }
                float sum = 0.f;
#pragma unroll
                for (int i = 0; i < 16; ++i) { p0[i] = __builtin_amdgcn_exp2f(p0[i]); p1[i] = __builtin_amdgcn_exp2f(p1[i]); sum += p0[i] + p1[i]; }
                lrun += sum;
                u32x4 w;
                w.x = cvt_pk_bf16(p0[0], p0[1]); w.y = cvt_pk_bf16(p0[2], p0[3]); w.z = cvt_pk_bf16(p0[4], p0[5]); w.w = cvt_pk_bf16(p0[6], p0[7]); pf[0] = __builtin_bit_cast(bf16x8, w);
                w.x = cvt_pk_bf16(p0[8], p0[9]); w.y = cvt_pk_bf16(p0[10], p0[11]); w.z = cvt_pk_bf16(p0[12], p0[13]); w.w = cvt_pk_bf16(p0[14], p0[15]); pf[1] = __builtin_bit_cast(bf16x8, w);
                w.x = cvt_pk_bf16(p1[0], p1[1]); w.y = cvt_pk_bf16(p1[2], p1[3]); w.z = cvt_pk_bf16(p1[4], p1[5]); w.w = cvt_pk_bf16(p1[6], p1[7]); pf[2] = __builtin_bit_cast(bf16x8, w);
                w.x = cvt_pk_bf16(p1[8], p1[9]); w.y = cvt_pk_bf16(p1[10], p1[11]); w.z = cvt_pk_bf16(p1[12], p1[13]); w.w = cvt_pk_bf16(p1[14], p1[15]); pf[3] = __builtin_bit_cast(bf16x8, w);
            } else {
#pragma unroll
                for (int blk = 0; blk < 2; ++blk) {
                    f32x16 p;
#pragma unroll
                    for (int i = 0; i < 16; ++i) p[i] = 0.f;
                    const LAS unsigned char* kr = Kb + (32 * blk + r) * 512;
                    {
                        bf16x8 kq[2];
                        kq[0] = *(const LAS bf16x8*)(kr + ((0 ^ r15v) << 4));
#pragma unroll
                        for (int d0 = 0; d0 < NKS; ++d0) {
                            if (d0 + 1 < NKS) kq[(d0 + 1) & 1] = *(const LAS bf16x8*)(kr + (((2 * (d0 + 1)) ^ r15v) << 4));
                            __builtin_amdgcn_sched_barrier(0);
                            p = MF32(kq[d0 & 1], qf[d0], p);
                            __builtin_amdgcn_sched_barrier(0);
                        }
                    }
                    const int kb = t * 64 + 32 * blk + 4 * hh;
#pragma unroll
                    for (int i = 0; i < 16; ++i) { const int kv = kb + (i & 3) + 8 * (i >> 2);
                        p[i] *= __builtin_amdgcn_exp2f(lgam * fabsf((float)(qrow - kv)) - 4.0f); }
                    u32x4 w;
                    w.x = cvt_pk_bf16(p[0], p[1]); w.y = cvt_pk_bf16(p[2], p[3]); w.z = cvt_pk_bf16(p[4], p[5]); w.w = cvt_pk_bf16(p[6], p[7]); pf[2 * blk] = __builtin_bit_cast(bf16x8, w);
                    w.x = cvt_pk_bf16(p[8], p[9]); w.y = cvt_pk_bf16(p[10], p[11]); w.z = cvt_pk_bf16(p[12], p[13]); w.w = cvt_pk_bf16(p[14], p[15]); pf[2 * blk + 1] = __builtin_bit_cast(bf16x8, w);
                    __builtin_amdgcn_sched_barrier(0);
                }
            }
            const LAS unsigned char* vb = Vb + vlane;
            __builtin_amdgcn_sched_barrier(0);
            {
#define VFRAG(j) __builtin_shufflevector(vtr(vb + (((vh * 16 + 4 * ((j) >> 2)) ^ q4v) << 4) + (16 * ((j) & 3)) * 512), vtr(vb + (((vh * 16 + 4 * ((j) >> 2)) ^ q4v) << 4) + (16 * ((j) & 3) + 8) * 512), 0, 1, 2, 3, 4, 5, 6, 7)
                bf16x8 vq[3];
                vq[0] = VFRAG(0); vq[1] = VFRAG(1);
#pragma unroll
                for (int j = 0; j < 4 * NDB; ++j) {
                    if (j + 2 < 4 * NDB) vq[(j + 2) % 3] = VFRAG(j + 2);
                    __builtin_amdgcn_sched_barrier(0);
                    O[j >> 2] = MF32(vq[j % 3], pf[j & 3], O[j >> 2]);
                    __builtin_amdgcn_sched_barrier(0);
                }
#undef VFRAG
            }
        }
        AT_BAR();
    }
    const size_t orow = rowbase + qrow;
    LAS float* SS = (LAS float*)(lds + 131072);
    if constexpr (MODE) {
        const float l = lrun + __shfl_xor(lrun, 32); const float inv = 1.0f / l;
        LAS float* X = (LAS float*)(lds + (wid & 3) * 16384);
        if (cc == 1) {
#pragma unroll
            for (int db = 0; db < NDB; ++db)
#pragma unroll
                for (int i = 0; i < 16; ++i) X[(db * 16 + i) * 64 + lane] = O[db][i] * inv;
        }
        AT_BAR();
        float ss = 0.f;
        if (cc == 0) {
#pragma unroll
            for (int db = 0; db < NDB; ++db)
#pragma unroll
                for (int i = 0; i < 16; ++i) { const float o = O[db][i] * inv - lam * X[(db * 16 + i) * 64 + lane]; O[db][i] = o; ss += o * o; }
        }
        ss += __shfl_xor(ss, 32);
        if (hh == 0) SS[wid * 32 + r] = ss;
        AT_BAR();
        if (cc == 0) {
            ss += SS[(wid ^ 2) * 32 + r];
            const float rs = (1.0f - LAMBDA_INIT) / sqrtf(ss * (1.0f / 256.0f) + EPS);
            bf16_t* op = outp + orow * DM + h * 256 + vh * 128 + 4 * hh;
            const float* slp = subln + vh * 128 + 4 * hh;
#pragma unroll
            for (int db = 0; db < NDB; ++db)
#pragma unroll
                for (int i4 = 0; i4 < 4; ++i4) { const int d = 32 * db + 8 * i4;
                    const f32x4 sl = *(const f32x4*)(slp + d);
                    u32x2 w; w.x = cvt_pk_bf16(O[db][4 * i4] * rs * sl[0], O[db][4 * i4 + 1] * rs * sl[1]); w.y = cvt_pk_bf16(O[db][4 * i4 + 2] * rs * sl[2], O[db][4 * i4 + 3] * rs * sl[3]);
                    *(u32x2*)(op + d) = w; }
        }
        AT_BAR();
    } else {
        float ss = 0.f;
#pragma unroll
        for (int db = 0; db < NDB; ++db)
#pragma unroll
            for (int i = 0; i < 16; ++i) ss += O[db][i] * O[db][i];
        ss += __shfl_xor(ss, 32);
        if (hh == 0) SS[wid * 32 + r] = ss;
        AT_BAR();
        ss += SS[(wid ^ 4) * 32 + r];
        const float rs = 1.0f / sqrtf(ss * (1.0f / 256.0f) + EPS);
        const bf16_t* gp = gsrc + orow * PW + 3072 + h * 256 + vh * 128 + 4 * hh;
        bf16_t* op = outp + orow * DM + h * 256 + vh * 128 + 4 * hh;
        u32x2 ggv[NDB][4];
#pragma unroll
        for (int db = 0; db < NDB; ++db)
#pragma unroll
            for (int i4 = 0; i4 < 4; ++i4) ggv[db][i4] = *(const u32x2*)(gp + 32 * db + 8 * i4);
#pragma unroll
        for (int db = 0; db < NDB; ++db)
#pragma unroll
            for (int i4 = 0; i4 < 4; ++i4) { const int d = 32 * db + 8 * i4;
                const u32x2 gg = ggv[db][i4];
                u32x2 w; w.x = cvt_pk_bf16(O[db][4 * i4] * rs * silu_f(bflo(gg.x)), O[db][4 * i4 + 1] * rs * silu_f(bfhi(gg.x)));
                w.y = cvt_pk_bf16(O[db][4 * i4 + 2] * rs * silu_f(bflo(gg.y)), O[db][4 * i4 + 3] * rs * silu_f(bfhi(gg.y)));
                *(u32x2*)(op + d) = w; }
        AT_BAR();
    }
#undef AT_ISSUE
}

__device__ __forceinline__ void attn_unit_diff128(LAS unsigned char* lds, const bf16_t* src, const int pitch, const int kcol, const int vcol, const int b, const int h, const int ub,
                                                  bf16_t* outp, const float* subln, const float lam) {
    constexpr int NKS = 8, NDB = 8;
    const int tid = threadIdx.x, lane = tid & 63, r = lane & 31, hh = lane >> 5;
    const int wid = __builtin_amdgcn_readfirstlane(tid >> 6);
    const int rg = wid & 3, cc = wid >> 2;
    const size_t rowbase = (size_t)b * SEQ; const int q0 = ub * 128, NT = 2 * ub + 2;
    const int qrow = q0 + rg * 32 + r;
    AT_WAITV(0);
#define AT_ISSUE(t, buf) do { const bf16_t* gk_ = src + (rowbase + (size_t)(t) * 64) * pitch; int rv_ = r; asm volatile("" : "+v"(rv_)); \
        _Pragma("unroll") for (int i_ = 0; i_ < 4; ++i_) { const int c_ = wid * 4 + i_; const int row_ = c_ * 2 + hh; \
            const unsigned ok_ = (unsigned)(row_ * pitch + kcol + ((rv_ ^ (row_ & 15)) << 3)); \
            __builtin_amdgcn_global_load_lds((const unsigned*)(gk_ + ok_), (LAS unsigned*)(lds + (buf) * 65536 + c_ * 1024), 16, 0, 0); \
            const unsigned ov_ = (unsigned)(row_ * pitch + vcol + ((rv_ ^ ((row_ & 3) << 2)) << 3)); \
            __builtin_amdgcn_global_load_lds((const unsigned*)(gk_ + ov_), (LAS unsigned*)(lds + (buf) * 65536 + 32768 + c_ * 1024), 16, 0, 0); } } while (0)
    AT_ISSUE(0, 0);
    bf16x8 qf[NKS];
    { const bf16_t* qp = src + (rowbase + qrow) * pitch + h * 256 + cc * 128 + 8 * hh;
#pragma unroll
      for (int d0 = 0; d0 < NKS; ++d0) qf[d0] = *(const bf16x8*)(qp + 16 * d0); }
    f32x16 O[NDB];
#pragma unroll
    for (int db = 0; db < NDB; ++db)
#pragma unroll
        for (int i = 0; i < 16; ++i) O[db][i] = 0.f;
    float mrun = 0.f, lrun = 0.f;
    const int r15 = r & 15, kunit0 = cc * 16;
    const int q4 = (lane & 15) >> 2, p4 = lane & 3, blk16 = (lane >> 4) & 1;
    const int vlane = (4 * hh + q4) * 512 + ((2 * blk16 + (p4 >> 1)) << 4) + 8 * (p4 & 1);
    for (int t = 0; t < NT; ++t) {
        if (t + 1 < NT) { AT_ISSUE(t + 1, (t + 1) & 1); AT_WAITV(8); } else { AT_WAITV(0); }
        AT_BAR();
        const bool active = !(t == NT - 1 && rg < 2);
        if (active) {
            const LAS unsigned char* Kb = lds + (t & 1) * 65536; const LAS unsigned char* Vb = Kb + 32768;
            int r15v = r15 ^ hh ^ kunit0, q4v = q4 << 2; asm volatile("" : "+v"(r15v), "+v"(q4v));
            const LAS unsigned char* vb = Vb + vlane;
#pragma unroll
            for (int blk = 0; blk < 2; ++blk) {
                f32x16 p;
#pragma unroll
                for (int i = 0; i < 16; ++i) p[i] = -mrun;
                const LAS unsigned char* kr = Kb + (32 * blk + r) * 512;
                {
                    bf16x8 kq[2];
                    kq[0] = *(const LAS bf16x8*)(kr + ((0 ^ r15v) << 4));
#pragma unroll
                    for (int d0 = 0; d0 < NKS; ++d0) {
                        if (d0 + 1 < NKS) kq[(d0 + 1) & 1] = *(const LAS bf16x8*)(kr + (((2 * (d0 + 1)) ^ r15v) << 4));
                        __builtin_amdgcn_sched_barrier(0);
                        p = MF32(kq[d0 & 1], qf[d0], p);
                        __builtin_amdgcn_sched_barrier(0);
                    }
                }
                float rm = p[0];
#pragma unroll
                for (int i = 1; i < 16; ++i) rm = fmaxf(rm, p[i]);
                rm = fmaxf(rm, __shfl_xor(rm, 32));
                const bool first = (t == 0) && (blk == 0);
                if (first || __any(rm > 8.0f)) {
                    const float dl = first ? rm : fmaxf(rm, 0.f); const float al = first ? 1.0f : __builtin_amdgcn_exp2f(-dl); lrun *= al; mrun += dl;
#pragma unroll
                    for (int i = 0; i < 16; ++i) p[i] -= dl;
#pragma unroll
                    for (int db = 0; db < NDB; ++db) O[db] = O[db] * al;
                }
                float sum = 0.f;
#pragma unroll
                for (int i = 0; i < 16; ++i) { p[i] = __builtin_amdgcn_exp2f(p[i]); sum += p[i]; }
                lrun += sum;
                bf16x8 pf[2];
                { u32x4 w;
                  w.x = cvt_pk_bf16(p[0], p[1]); w.y = cvt_pk_bf16(p[2], p[3]); w.z = cvt_pk_bf16(p[4], p[5]); w.w = cvt_pk_bf16(p[6], p[7]); pf[0] = __builtin_bit_cast(bf16x8, w);
                  w.x = cvt_pk_bf16(p[8], p[9]); w.y = cvt_pk_bf16(p[10], p[11]); w.z = cvt_pk_bf16(p[12], p[13]); w.w = cvt_pk_bf16(p[14], p[15]); pf[1] = __builtin_bit_cast(bf16x8, w); }
                __builtin_amdgcn_sched_barrier(0);
                {
#define VFRAG(j) __builtin_shufflevector(vtr(vb + (((4 * ((j) >> 1)) ^ q4v) << 4) + (32 * blk + 16 * ((j) & 1)) * 512), vtr(vb + (((4 * ((j) >> 1)) ^ q4v) << 4) + (32 * blk + 16 * ((j) & 1) + 8) * 512), 0, 1, 2, 3, 4, 5, 6, 7)
                    bf16x8 vq[3];
                    vq[0] = VFRAG(0); vq[1] = VFRAG(1);
#pragma unroll
                    for (int j = 0; j < 2 * NDB; ++j) {
                        if (j + 2 < 2 * NDB) vq[(j + 2) % 3] = VFRAG(j + 2);
                        __builtin_amdgcn_sched_barrier(0);
                        O[j >> 1] = MF32(vq[j % 3], pf[j & 1], O[j >> 1]);
                        __builtin_amdgcn_sched_barrier(0);
                    }
#undef VFRAG
                }
            }
        }
        AT_BAR();
    }
    const size_t orow = rowbase + qrow;
    const float l = lrun + __shfl_xor(lrun, 32); const float inv = 1.0f / l;
    LAS float* X = (LAS float*)(lds + rg * 32768);
    if (cc == 1) {
#pragma unroll
        for (int db = 0; db < NDB; ++db)
#pragma unroll
            for (int i = 0; i < 16; ++i) X[(db * 16 + i) * 64 + lane] = O[db][i] * inv;
    }
    AT_BAR();
    if (cc == 0) {
        float ss = 0.f;
#pragma unroll
        for (int db = 0; db < NDB; ++db)
#pragma unroll
            for (int i = 0; i < 16; ++i) { const float o = O[db][i] * inv - lam * X[(db * 16 + i) * 64 + lane]; O[db][i] = o; ss += o * o; }
        ss += __shfl_xor(ss, 32);
        const float rs = (1.0f - LAMBDA_INIT) / sqrtf(ss * (1.0f / 256.0f) + EPS);
        bf16_t* op = outp + orow * DM + h * 256 + 4 * hh;
        const LAS float* slp = (const LAS float*)(lds + 132096) + 4 * hh;
#pragma unroll
        for (int db = 0; db < NDB; ++db)
#pragma unroll
            for (int i4 = 0; i4 < 4; ++i4) { const int d = 32 * db + 8 * i4;
                const f32x4 sl = *(const LAS f32x4*)(slp + d);
                u32x2 w; w.x = cvt_pk_bf16(O[db][4 * i4] * rs * sl[0], O[db][4 * i4 + 1] * rs * sl[1]); w.y = cvt_pk_bf16(O[db][4 * i4 + 2] * rs * sl[2], O[db][4 * i4 + 3] * rs * sl[3]);
                *(u32x2*)(op + d) = w; }
    }
    AT_BAR();
#undef AT_ISSUE
}

template <int MODE>
__device__ __forceinline__ void attn_phase(LAS unsigned char* lds, const bf16_t* src, int pitch, int kcol0, int vcol0, int nheads, bf16_t* outp, const bf16_t* gsrc, const float* subln, float lam, int vcu, int G) {
    constexpr int NU = 16;
    const int npairs = 16 * nheads * (NU / 2);
    if constexpr (MODE) { if (threadIdx.x < 256) ((LAS float*)(lds + 132096))[threadIdx.x] = subln[threadIdx.x]; __syncthreads(); }
    for (int pr = vcu; pr < npairs; pr += G) {
        const int bh = pr / (NU / 2), p = pr % (NU / 2), b = bh / nheads, h = bh % nheads;
        if constexpr (MODE) {
            attn_unit_diff128(lds, src, pitch, kcol0 + h * 256, vcol0 + h * 256, b, h, NU - 1 - p, outp, subln, lam);
            attn_unit_diff128(lds, src, pitch, kcol0 + h * 256, vcol0 + h * 256, b, h, p, outp, subln, lam);
        } else {
            attn_unit<0>(lds, src, pitch, kcol0 + h * 256, vcol0 + h * 256, b, h, NU - 1 - p, outp, gsrc, subln, lam);
            attn_unit<0>(lds, src, pitch, kcol0 + h * 256, vcol0 + h * 256, b, h, p, outp, gsrc, subln, lam);
        }
    }
}

#define XB_TMO      128
#define XB_XCNT(j)  (256  + 64 * (j))
#define XB_XSUB(j)  (1280 + 64 * (j))
#define XB_XGEN(j)  (2304 + 64 * (j))
#define XB_TOP      3328
#define XB_TOPGEN   3392
#define XCD_BAR_WORDS 3456
#define XB_SPIN_CAP (1u << 18)
__device__ __forceinline__ unsigned xb_ld(unsigned* p)              { return __hip_atomic_load(p, __ATOMIC_RELAXED, __HIP_MEMORY_SCOPE_AGENT); }
__device__ __forceinline__ unsigned xb_add(unsigned* p, unsigned v) { return __hip_atomic_fetch_add(p, v, __ATOMIC_RELAXED, __HIP_MEMORY_SCOPE_AGENT); }
__device__ __forceinline__ unsigned xb_xcc_id() { return (unsigned)__builtin_amdgcn_s_getreg((3 << 11) | 20) & 0xFu; }
#define XB_SPIN(cond, bar) do { unsigned _sp = 0; while (cond) { __builtin_amdgcn_s_sleep(1); \
    if ((++_sp & 255u) == 0u) { if (xb_ld(&(bar)[XB_TMO])) break; if (_sp > XB_SPIN_CAP) { atomicAdd(&(bar)[XB_TMO], 1u); break; } } } } while (0)
struct XcdBarrier { unsigned* bar; unsigned x; volatile LAS unsigned* st; };
__device__ __forceinline__ XcdBarrier xcd_barrier_post(unsigned* bar, volatile LAS unsigned* st) {
    XcdBarrier b; b.bar = bar; b.x = xb_xcc_id(); b.st = st;
    if (threadIdx.x == 0) (void)xb_add(&bar[XB_XCNT(b.x)], 1u);
    return b;
}
__device__ __forceinline__ void xcd_barrier_complete(unsigned* bar, unsigned x, unsigned& nloc, unsigned& nx) {
    const unsigned G = gridDim.x * gridDim.y * gridDim.z;
    unsigned sum, cnt, mine, sp = 0u;
    for (;;) {
        sum = 0u; cnt = 0u; mine = 0u;
#pragma unroll
        for (unsigned j = 0; j < 16; ++j) { const unsigned c = xb_ld(&bar[XB_XCNT(j)]); sum += c; cnt += (c > 0u) ? 1u : 0u; mine = (j == x) ? c : mine; }
        if (sum == G) break;
        __builtin_amdgcn_s_sleep(1);
        if ((++sp & 255u) == 0u) { if (xb_ld(&bar[XB_TMO])) break; if (sp > XB_SPIN_CAP) { atomicAdd(&bar[XB_TMO], 1u); break; } }
    }
    nloc = mine > 0u ? mine : 1u; nx = cnt > 0u ? cnt : 1u;
}
__device__ __forceinline__ void xcd_barrier(const XcdBarrier& b) {
    asm volatile("s_waitcnt vmcnt(0)" ::: "memory");
    __syncthreads();
    if (threadIdx.x == 0) {
        unsigned* bar = b.bar;
        __builtin_amdgcn_s_waitcnt(0);
        unsigned nloc = b.st[0], nx = b.st[1];
        if (nloc == 0u) { xcd_barrier_complete(bar, b.x, nloc, nx); b.st[0] = nloc; b.st[1] = nx; }
        const unsigned old = xb_add(&bar[XB_XSUB(b.x)], 1u);
        const unsigned gen = old / nloc;
        if (old + 1u == (gen + 1u) * nloc) {
            __builtin_amdgcn_fence(__ATOMIC_RELEASE, "agent");
            asm volatile("s_waitcnt vmcnt(0)" ::: "memory");
            const unsigned og = xb_add(&bar[XB_TOP], 1u);
            const unsigned tg = og / nx;
            if (og + 1u == (tg + 1u) * nx) xb_add(&bar[XB_TOPGEN], 1u);
            else XB_SPIN(xb_ld(&bar[XB_TOPGEN]) == tg, bar);
            __builtin_amdgcn_fence(__ATOMIC_ACQUIRE, "agent");
            xb_add(&bar[XB_XGEN(b.x)], 1u);
            asm volatile("s_waitcnt vmcnt(0)" ::: "memory");
        } else {
            XB_SPIN(xb_ld(&bar[XB_XGEN(b.x)]) == gen, bar);
            __builtin_amdgcn_fence(__ATOMIC_ACQUIRE, "agent");
            asm volatile("s_waitcnt vmcnt(0)" ::: "memory");
        }
    }
    __syncthreads();
}

struct Params { const float* in[26]; float* out; unsigned char* ws; int lo, hi; };
constexpr int NPHASE = 17;

__global__ void __launch_bounds__(512) fwd_megakernel(Params P) {
    extern __shared__ __attribute__((aligned(16))) unsigned char lds_raw[];
    LAS unsigned char* lds = (LAS unsigned char*)lds_raw;
    const int tid = threadIdx.x, lane = tid & 63, wave = __builtin_amdgcn_readfirstlane(tid >> 6);
    const int G = gridDim.x, bx = blockIdx.x;
    const int vcu = (G % 8 == 0) ? (bx % 8) * (G / 8) + bx / 8 : bx;
    const int gw = vcu * 8 + wave, NGW = G * 8;
    unsigned char* ws = P.ws;
    float* out = P.out;
    bf16_t* Wgu = (bf16_t*)(ws + WS_WGU); bf16_t* Wd = (bf16_t*)(ws + WS_WD); bf16_t* Win = (bf16_t*)(ws + WS_WIN); bf16_t* Wout = (bf16_t*)(ws + WS_WOUT);
    bf16_t* Wglu = (bf16_t*)(ws + WS_WGLU); bf16_t* Wqkv = (bf16_t*)(ws + WS_WQKV); bf16_t* Wco = (bf16_t*)(ws + WS_WCO);
    bf16_t* XN = (bf16_t*)(ws + WS_XN); bf16_t* BIG = (bf16_t*)(ws + WS_BIG); bf16_t* ZB = (bf16_t*)(ws + WS_Z);
    const float* x = P.in[0]; const float* ffn_norm = P.in[1]; const float* mix_norm = P.in[5];
#if MK_PER_PHASE
#define SYNC(k) do { } while (0)
#else
    cg::grid_group grid = cg::this_grid();
    { volatile LAS unsigned* st0 = (volatile LAS unsigned*)(lds + 139264); if (tid < 2) st0[tid] = 0u; }
    __syncthreads();
    const XcdBarrier xbar = xcd_barrier_post((unsigned*)(ws + WS_BAR), (volatile LAS unsigned*)(lds + 139264));
#define SYNC(k) do { if (P.lo <= (k) && (k) + 1 < P.hi) { if ((k) == 0) grid.sync(); else xcd_barrier(xbar); } } while (0)
#endif
#ifndef WGM_DOWN
#define WGM_DOWN 4
#endif
#ifndef DUPMASK
#define DUPMASK 0u
#endif
#define IN(k) (P.lo <= (k) && (k) < P.hi)
#define REP(k) for (int rep_ = 0; rep_ < (((DUPMASK >> (k)) & 1u) ? 2 : 1); ++rep_)

    u64_t* SSQ = (u64_t*)(ws + WS_SSQ);
    bf16_t* YC = (bf16_t*)(ws + WS_YC);
    const float* rcos = (const float*)(ws + WS_RCOS); const float* rsin = (const float*)(ws + WS_RSIN);
    const float* acos_ = (const float*)(ws + WS_ACOS); const float* asin_ = (const float*)(ws + WS_ASIN);
    if (IN(0)) REP(0) {
        LAS float* scr = (LAS float*)(lds + wave * 16640);
        const size_t gsz = (size_t)DM * DFF;
#pragma unroll 1
        for (int i = 0; i < 4; ++i) {
            conv_matrix(P.in[2] + i * gsz, Wgu + (size_t)i * NGU * DM, DM, DFF, 1, ffn_norm + i * DM, scr, gw, NGW, lane);
            conv_matrix(P.in[3] + i * gsz, Wgu + (size_t)i * NGU * DM, DM, DFF, 2, ffn_norm + i * DM, scr, gw, NGW, lane);
            conv_matrix(P.in[4] + i * gsz, Wd + (size_t)i * DM * DFF, DFF, DM, 0, nullptr, scr, gw, NGW, lane);
        }
        conv_matrix(P.in[6], Win, DM, PW, 0, mix_norm, scr, gw, NGW, lane);
        conv_matrix(P.in[7], Wout, DM, DM, 0, nullptr, scr, gw, NGW, lane);
        conv_matrix(P.in[16], Wglu, 1024, 1024, 0, nullptr, scr, gw, NGW, lane);
        conv_matrix(P.in[18], Wqkv, DM, QW, 0, mix_norm + DM, scr, gw, NGW, lane);
        conv_matrix(P.in[19], Wco, DM, DM, 0, nullptr, scr, gw, NGW, lane);
        tables_phase(ws, nullptr, P.in[8], P.in[9], P.in[10], P.in[11], P.in[12], P.in[20], P.in[21], P.in[22], P.in[23], vcu * 512 + tid, G * 512);
        for (int i = vcu * 512 + tid; i < 6 * TT; i += G * 512) SSQ[TT + i] = 0u;
        cast_phase(x, XN, SSQ, gw, NGW, lane);
    }
    SYNC(0);
#if !MK_PER_PHASE
    if ((DUPMASK >> 20) & 1u) { for (int q_ = 0; q_ < 32; ++q_) grid.sync(); }
#endif
    if (IN(1)) { run_gemm(lds, XN, Wgu, TT, NGU, DM, EpiSwiglu{BIG, DFF, SSQ}); if ((DUPMASK >> 1) & 1u) { run_gemm(lds, XN, Wgu, TT, NGU, DM, EpiSwiglu{BIG, DFF, SSQ}); } }
    SYNC(1);
    if (IN(2)) run_gemm(lds, BIG, Wd, TT, DM, DFF, EpiResid<true, false, 1>{x, nullptr, XN, SSQ + 1 * TT}, WGM_DOWN, 1);
    if (IN(2) && ((DUPMASK >> 2) & 1u)) run_gemm(lds, BIG, Wd, TT, DM, DFF, EpiResid<false, false, 2>{nullptr, nullptr, XN, nullptr});
    SYNC(2);
    if (IN(3)) { run_gemm(lds, XN, Win, TT, PW, DM, EpiWin{BIG, rcos, rsin, SSQ + 1 * TT}); if ((DUPMASK >> 3) & 1u) { run_gemm(lds, XN, Win, TT, PW, DM, EpiWin{BIG, rcos, rsin, SSQ + 1 * TT}); } }
    SYNC(3);
    if (IN(4)) REP(4) {
        const bool do_ret = !(rep_ == 1 && ((DUPMASK >> 22) & 1u)), do_s5 = !(rep_ == 1 && ((DUPMASK >> 21) & 1u));
        unsigned mask = 0u; int bh = 0, lin = -1, s5i = vcu, s5g = G; bool s5 = true;
        if (G == 256) {
            if (vcu < 128) { bh = vcu >> 1; mask = (vcu & 1) ? 0x03FDu : 0xE402u; s5 = false; }
            else { const int j = vcu - 128; bh = j >> 1; mask = 1u << (11 + (j & 1)); s5i = j; s5g = 128; }
        } else lin = vcu;
        if (s5 && do_s5) s5_phase(lds, ws, BIG, P.in[13], P.in[14], P.in[15], ZB, s5i, s5g, wave, lane);
        __syncthreads();
        if (do_ret) for (;;) {
            int ub;
            if (lin < 0) { if (!mask) break; ub = 31 - __clz((int)mask); mask &= ~(1u << ub); }
            else { if (lin >= 1024) break; bh = lin >> 4; ub = 15 - (lin & 15); lin += G; }
            const int b = bh >> 2, h = bh & 3;
            attn_unit<0>(lds, BIG, PW, 1024 + h * 256, 2048 + h * 256, b, h, ub, YC, BIG, nullptr, 0.f);
        }
    }
    SYNC(4);
    if (IN(5)) run_gemm(lds, ZB, Wglu, TT, 1024, 1024, EpiGlu{ZB, P.in[17], YC});
    SYNC(5);
    if (IN(6)) run_gemm(lds, YC, Wout, TT, DM, DM, EpiResid<false, false, 0>{nullptr, nullptr, XN, SSQ + 2 * TT});
    if (IN(6) && ((DUPMASK >> 6) & 1u)) run_gemm(lds, YC, Wout, TT, DM, DM, EpiResid<false, false, 2>{nullptr, nullptr, XN, nullptr});
    SYNC(6);
    if (IN(7)) { run_gemm(lds, XN, Wgu + (size_t)1 * NGU * DM, TT, NGU, DM, EpiSwiglu{BIG, DFF, SSQ + 2 * TT}); if ((DUPMASK >> 7) & 1u) { run_gemm(lds, XN, Wgu + (size_t)1 * NGU * DM, TT, NGU, DM, EpiSwiglu{BIG, DFF, SSQ + 2 * TT}); } }
    SYNC(7);
    if (IN(8)) run_gemm(lds, BIG, Wd + (size_t)1 * DM * DFF, TT, DM, DFF, EpiResid<false, false, 1>{nullptr, nullptr, XN, SSQ + 3 * TT}, WGM_DOWN, 1);
    if (IN(8) && ((DUPMASK >> 8) & 1u)) run_gemm(lds, BIG, Wd + (size_t)1 * DM * DFF, TT, DM, DFF, EpiResid<false, false, 2>{nullptr, nullptr, XN, nullptr});
    SYNC(8);
    if (IN(9)) { run_gemm(lds, XN, Wgu + (size_t)2 * NGU * DM, TT, NGU, DM, EpiSwiglu{BIG, DFF, SSQ + 3 * TT}); if ((DUPMASK >> 9) & 1u) { run_gemm(lds, XN, Wgu + (size_t)2 * NGU * DM, TT, NGU, DM, EpiSwiglu{BIG, DFF, SSQ + 3 * TT}); } }
    SYNC(9);
    if (IN(10)) run_gemm(lds, BIG, Wd + (size_t)2 * DM * DFF, TT, DM, DFF, EpiResid<false, false, 1>{nullptr, nullptr, XN, SSQ + 4 * TT}, WGM_DOWN, 1);
    if (IN(10) && ((DUPMASK >> 10) & 1u)) run_gemm(lds, BIG, Wd + (size_t)2 * DM * DFF, TT, DM, DFF, EpiResid<false, false, 2>{nullptr, nullptr, XN, nullptr});
    SYNC(10);
    if (IN(11)) { run_gemm(lds, XN, Wqkv, TT, QW, DM, EpiQkv{BIG, acos_, asin_, SSQ + 4 * TT}); if ((DUPMASK >> 11) & 1u) { run_gemm(lds, XN, Wqkv, TT, QW, DM, EpiQkv{BIG, acos_, asin_, SSQ + 4 * TT}); } }
    SYNC(11);
#ifndef NO_A1
    if (IN(12)) REP(12) { const float lam = ((const float*)(ws + WS_CTL))[0]; attn_phase<1>(lds, BIG, QW, 2048, 4096, 8, YC, nullptr, P.in[24], lam, vcu, G); }
#endif
    SYNC(12);
    if (IN(13)) run_gemm(lds, YC, Wco, TT, DM, DM, EpiResid<false, false, 0>{nullptr, nullptr, XN, SSQ + 5 * TT});
    if (IN(13) && ((DUPMASK >> 13) & 1u)) run_gemm(lds, YC, Wco, TT, DM, DM, EpiResid<false, false, 2>{nullptr, nullptr, XN, nullptr});
    SYNC(13);
    if (IN(14)) { run_gemm(lds, XN, Wgu + (size_t)3 * NGU * DM, TT, NGU, DM, EpiSwiglu{BIG, DFF, SSQ + 5 * TT}); if ((DUPMASK >> 14) & 1u) { run_gemm(lds, XN, Wgu + (size_t)3 * NGU * DM, TT, NGU, DM, EpiSwiglu{BIG, DFF, SSQ + 5 * TT}); } }
    SYNC(14);
    if (IN(15)) run_gemm(lds, BIG, Wd + (size_t)3 * DM * DFF, TT, DM, DFF, EpiResid<false, false, 1>{nullptr, nullptr, XN, SSQ + 6 * TT}, WGM_DOWN, 1);
    if (IN(15) && ((DUPMASK >> 15) & 1u)) run_gemm(lds, BIG, Wd + (size_t)3 * DM * DFF, TT, DM, DFF, EpiResid<false, false, 2>{nullptr, nullptr, XN, nullptr});
    SYNC(15);
    if (IN(16)) final_phase(XN, SSQ + 6 * TT, P.in[25], out, gw, NGW, lane);
#undef IN
#undef SYNC
}

extern "C" void kernel_launch(void* const* d_in, const int* in_sizes, int n_in, void* d_out, int out_size, void* d_ws, size_t ws_size, hipStream_t stream) {
    static int grid = 0;
    if (grid == 0) {
        if (n_in != 26 || out_size != TT * DM || ws_size < WS_END) { fprintf(stderr, "kernel_launch: unexpected shapes (n_in %d, out %d, ws %zu < %zu)\n", n_in, out_size, ws_size, (size_t)WS_END); grid = -1; return; }
        int dev = 0, cus = 0, per_cu = 0;
        hipGetDevice(&dev); hipDeviceGetAttribute(&cus, hipDeviceAttributeMultiprocessorCount, dev);
        if (hipFuncSetAttribute((const void*)fwd_megakernel, hipFuncAttributeMaxDynamicSharedMemorySize, LDS_BYTES) != hipSuccess) { fprintf(stderr, "kernel_launch: hipFuncSetAttribute failed\n"); grid = -1; return; }
        if (hipOccupancyMaxActiveBlocksPerMultiprocessor(&per_cu, (const void*)fwd_megakernel, 512, LDS_BYTES) != hipSuccess || per_cu < 1) { fprintf(stderr, "kernel_launch: occupancy query says %d\n", per_cu); per_cu = 1; }
        (void)hipGetLastError();
        grid = cus * per_cu;
        fprintf(stderr, "kernel_launch: grid %d (cus %d x %d)\n", grid, cus, per_cu);
    }
    if (grid < 0) return;
    if (hipMemsetAsync((char*)d_ws + WS_BAR, 0, BAR_BYTES, stream) != hipSuccess) { fprintf(stderr, "kernel_launch: hipMemsetAsync failed\n"); return; }
    Params p{};
    for (int i = 0; i < 26; ++i) p.in[i] = (const float*)d_in[i];
    p.out = (float*)d_out; p.ws = (unsigned char*)d_ws;
#if MK_PER_PHASE
    for (int k = 0; k < NPHASE; ++k) { p.lo = k; p.hi = k + 1; hipLaunchKernelGGL(fwd_megakernel, dim3(grid), dim3(512), LDS_BYTES, stream, p); }
#else
    p.lo = 0; p.hi = NPHASE;
    void* args[] = {&p};
    hipError_t e = hipLaunchCooperativeKernel((const void*)fwd_megakernel, dim3(grid), dim3(512), args, LDS_BYTES, stream);
    if (e != hipSuccess) fprintf(stderr, "cooperative launch failed: %s (grid %d)\n", hipGetErrorString(e), grid);
#endif
}
```
